# Optimizing an MI355X kernel written in HIP

```python
import math
import jax, jax.numpy as jnp
from jax import lax
import numpy as np

D_MODEL = 2048
BATCH = 2
SEQ = 8192
DEPTH = 2

GRID_W = 64
CTX_LEN = 256
HEAD_DIM = 128
A_Q_HEADS = D_MODEL // HEAD_DIM
A_KV_HEADS = A_Q_HEADS // 4
A_GROUP = A_Q_HEADS // A_KV_HEADS
WINDOW = 128
BLOCK = 128
B_QK_DIM = HEAD_DIM
B_V_DIM = 2 * B_QK_DIM
B_HEADS = D_MODEL // B_V_DIM
A_WIDTH = A_Q_HEADS * HEAD_DIM
A_KV_WIDTH = A_KV_HEADS * HEAD_DIM
B_QK_WIDTH = B_HEADS * 2 * B_QK_DIM
B_WIDTH = B_HEADS * B_V_DIM
KV_SPLITS = (A_KV_WIDTH, A_KV_WIDTH, B_QK_WIDTH, B_WIDTH)
Q_SPLITS = (A_WIDTH, A_WIDTH, B_QK_WIDTH, B_WIDTH, D_MODEL, D_MODEL)
KV_COLS = sum(KV_SPLITS)
Q_COLS = sum(Q_SPLITS)
IN_COLS = KV_COLS + Q_COLS
ROPE_THETA = 10000.0
EPS = 1e-6
NEG = -1e30
ADA_STD = 0.5

kernel_name = "hybrid_gated_window_gqa_diff_attn_dit"


def rmsnorm(x, g):
    xf = x.astype(jnp.float32)
    y = xf * lax.rsqrt(jnp.mean(xf * xf, axis=-1, keepdims=True) + EPS)
    return (y * g.astype(jnp.float32)).astype(x.dtype)


def split_cols(p, sizes):
    idx = np.cumsum(sizes)[:-1].tolist()
    return jnp.split(p, idx, axis=-1)


def axial_rope_tables(n_lat):
    rows = n_lat // GRID_W
    r = jnp.repeat(jnp.arange(rows, dtype=jnp.float32), GRID_W)
    col = jnp.tile(jnp.arange(GRID_W, dtype=jnp.float32), rows)
    n_freq = HEAD_DIM // 4
    inv = ROPE_THETA ** (-jnp.arange(n_freq, dtype=jnp.float32) / n_freq)
    ang = jnp.concatenate([r[:, None] * inv, col[:, None] * inv], axis=-1)
    return jnp.cos(ang), jnp.sin(ang)


def apply_rope(x, cos, sin):
    half = x.shape[-1] // 2
    x1, x2 = x[..., :half], x[..., half:]
    c = cos[None, :, None, :].astype(x.dtype)
    s = sin[None, :, None, :].astype(x.dtype)
    return jnp.concatenate([x1 * c - x2 * s, x2 * c + x1 * s], axis=-1)


def adaln(cvec, w, b):
    m = jax.nn.silu(cvec) @ w + b
    return jnp.split(m, 3, axis=-1)


def window_gqa_latent(q, k, v, k_ctx, v_ctx, sink):
    B, S = q.shape[0], q.shape[1]
    C = k_ctx.shape[1]
    nb = S // BLOCK
    scale = HEAD_DIM ** -0.5
    qb = q.reshape(B, nb, BLOCK, A_KV_HEADS, A_GROUP, HEAD_DIM) * scale
    pad = ((0, 0), (BLOCK, BLOCK), (0, 0), (0, 0))
    kb = jnp.pad(k, pad).reshape(B, nb + 2, BLOCK, A_KV_HEADS, HEAD_DIM)
    vb = jnp.pad(v, pad).reshape(B, nb + 2, BLOCK, A_KV_HEADS, HEAD_DIM)
    kw = jnp.concatenate([kb[:, :-2], kb[:, 1:-1], kb[:, 2:]], axis=2)
    vw = jnp.concatenate([vb[:, :-2], vb[:, 1:-1], vb[:, 2:]], axis=2)
    s_loc = jnp.einsum('bnqhgd,bnkhd->bnhgqk', qb, kw).astype(jnp.float32)
    blk = jnp.arange(nb)[:, None, None]
    qpos = blk * BLOCK + jnp.arange(BLOCK)[None, :, None]
    kpos = (blk - 1) * BLOCK + jnp.arange(3 * BLOCK)[None, None, :]
    valid = (kpos >= 0) & (kpos < S) & (jnp.abs(qpos - kpos) <= WINDOW)
    s_loc = jnp.where(valid[None, :, None, None], s_loc, NEG)
    s_ctx = jnp.einsum('bnqhgd,bchd->bnhgqc', qb, k_ctx).astype(jnp.float32)
    s_sink = jnp.broadcast_to(sink.astype(jnp.float32).reshape(1, 1, A_KV_HEADS, A_GROUP, 1, 1),
                              s_ctx.shape[:-1] + (1,))
    p = jax.nn.softmax(jnp.concatenate([s_loc, s_ctx, s_sink], axis=-1), axis=-1)
    p_loc = p[..., :3 * BLOCK].astype(v.dtype)
    p_ctx = p[..., 3 * BLOCK:3 * BLOCK + C].astype(v.dtype)
    o = (jnp.einsum('bnhgqk,bnkhd->bnqhgd', p_loc, vw)
         + jnp.einsum('bnhgqc,bchd->bnqhgd', p_ctx, v_ctx))
    return o.reshape(B, S, A_WIDTH)


def window_gqa_context(q, k, v, sink):
    B, C = q.shape[0], q.shape[1]
    qg = q.reshape(B, C, A_KV_HEADS, A_GROUP, HEAD_DIM) * (HEAD_DIM ** -0.5)
    s = jnp.einsum('bqhgd,bkhd->bhgqk', qg, k).astype(jnp.float32)
    s_sink = jnp.broadcast_to(sink.astype(jnp.float32).reshape(1, A_KV_HEADS, A_GROUP, 1, 1),
                              s.shape[:-1] + (1,))
    p = jax.nn.softmax(jnp.concatenate([s, s_sink], axis=-1), axis=-1)[..., :C].astype(v.dtype)
    o = jnp.einsum('bhgqk,bkhd->bqhgd', p, v)
    return o.reshape(B, C, A_WIDTH)


def diff_attn_latent(q, k_all, v_all, lam):
    B, S = q.shape[0], q.shape[1]
    nb = S // BLOCK
    qb = jnp.moveaxis(q.reshape(B, nb, BLOCK, B_HEADS, 2, B_QK_DIM) * (B_QK_DIM ** -0.5), 1, 0)

    def one_block(qblk):
        s = jnp.einsum('bqhmd,bkhmd->bhmqk', qblk, k_all).astype(jnp.float32)
        p = jax.nn.softmax(s, axis=-1)
        pd = (p[:, :, 0] - lam * p[:, :, 1]).astype(v_all.dtype)
        return jnp.einsum('bhqk,bkhe->bqhe', pd, v_all)

    o = lax.map(one_block, qb)
    return jnp.moveaxis(o, 0, 1).reshape(B, S, B_HEADS, B_V_DIM)


def diff_attn_context(q, k, v, lam):
    s = jnp.einsum('bqhmd,bkhmd->bhmqk', q * (B_QK_DIM ** -0.5), k).astype(jnp.float32)
    p = jax.nn.softmax(s, axis=-1)
    pd = (p[:, :, 0] - lam * p[:, :, 1]).astype(v.dtype)
    return jnp.einsum('bhqk,bkhe->bqhe', pd, v)


def diff_output(o, g_sub, lam_init):
    B, L = o.shape[0], o.shape[1]
    return (rmsnorm(o, g_sub) * (1.0 - lam_init)).reshape(B, L, B_WIDTH)


def branch_merge(o_a, z_a, o_b, z_b, g_a, g_b, wpa, wpb, wo):
    y_a = (o_a * jax.nn.silu(z_a)) @ wpa
    y_b = (o_b * jax.nn.silu(z_b)) @ wpb
    return (jax.nn.sigmoid(g_a) * y_a + jax.nn.sigmoid(g_b) * y_b) @ wo


def setup_inputs(seed: int = 0) -> dict:
    key = jax.random.key(seed)
    ks = jax.random.split(key, 16)
    f32 = jnp.float32
    D = D_MODEL
    nrm = lambda k, shape, s: jax.random.normal(k, shape, f32) * s
    return {
        "x": nrm(ks[0], (BATCH, SEQ, D), 1.0),
        "c": nrm(ks[1], (BATCH, D), 1.0),
        "ctx": nrm(ks[2], (BATCH, CTX_LEN, D), 1.0),
        "c_ctx": nrm(ks[3], (D,), 1.0),
        "w_ada": nrm(ks[4], (DEPTH, D, 3 * D), ADA_STD * D ** -0.5),
        "b_ada": nrm(ks[5], (DEPTH, 3 * D), 0.01),
        "g_pre": 1.0 + nrm(ks[6], (DEPTH, D), 0.02),
        "g_post": 1.0 + nrm(ks[7], (DEPTH, D), 0.02),
        "w_in": nrm(ks[8], (DEPTH, D, IN_COLS), D ** -0.5),
        "sink": nrm(ks[9], (DEPTH, A_Q_HEADS), 1.0),
        "lam_qk": nrm(ks[10], (DEPTH, 4, B_QK_DIM), 0.1),
        "g_subln": 1.0 + nrm(ks[11], (DEPTH, B_V_DIM), 0.02),
        "w_proj_a": nrm(ks[12], (DEPTH, A_WIDTH, D), A_WIDTH ** -0.5),
        "w_proj_b": nrm(ks[13], (DEPTH, B_WIDTH, D), B_WIDTH ** -0.5),
        "w_out": nrm(ks[14], (DEPTH, D, D), D ** -0.5),
    }


def reference(x, c, ctx, c_ctx, w_ada, b_ada, g_pre, g_post, w_in, sink, lam_qk, g_subln,
              w_proj_a, w_proj_b, w_out):
    B, S = x.shape[0], x.shape[1]
    C = ctx.shape[1]
    cos, sin = axial_rope_tables(S)
    for l in range(DEPTH):
        last = l == DEPTH - 1
        lam_init = 0.8 - 0.6 * math.exp(-0.3 * l)
        lq1, lk1, lq2, lk2 = [t.astype(jnp.float32) for t in lam_qk[l]]
        lam = jnp.exp(jnp.sum(lq1 * lk1)) - jnp.exp(jnp.sum(lq2 * lk2)) + lam_init

        sh_x, sc_x, gt_x = adaln(c, w_ada[l], b_ada[l])
        sh_c, sc_c, gt_c = adaln(c_ctx, w_ada[l], b_ada[l])
        hx = rmsnorm(x, g_pre[l]) * (1.0 + sc_x[:, None]) + sh_x[:, None]
        hc = rmsnorm(ctx, g_pre[l]) * (1.0 + sc_c) + sh_c

        px = hx @ w_in[l]
        k_a, v_a, k_b, v_b = split_cols(px[..., :KV_COLS], KV_SPLITS)
        q_a, z_a, q_b, z_b, g_a, g_b = split_cols(px[..., KV_COLS:], Q_SPLITS)
        q_a = apply_rope(q_a.reshape(B, S, A_Q_HEADS, HEAD_DIM), cos, sin)
        k_a = apply_rope(k_a.reshape(B, S, A_KV_HEADS, HEAD_DIM), cos, sin)
        v_a = v_a.reshape(B, S, A_KV_HEADS, HEAD_DIM)
        q_b = apply_rope(q_b.reshape(B, S, 2 * B_HEADS, B_QK_DIM), cos, sin).reshape(B, S, B_HEADS, 2, B_QK_DIM)
        k_b = apply_rope(k_b.reshape(B, S, 2 * B_HEADS, B_QK_DIM), cos, sin).reshape(B, S, B_HEADS, 2, B_QK_DIM)
        v_b = v_b.reshape(B, S, B_HEADS, B_V_DIM)

        pc_kv = hc @ w_in[l][:, :KV_COLS]
        kc_a, vc_a, kc_b, vc_b = split_cols(pc_kv, KV_SPLITS)
        kc_a = kc_a.reshape(B, C, A_KV_HEADS, HEAD_DIM)
        vc_a = vc_a.reshape(B, C, A_KV_HEADS, HEAD_DIM)
        kc_b = kc_b.reshape(B, C, B_HEADS, 2, B_QK_DIM)
        vc_b = vc_b.reshape(B, C, B_HEADS, B_V_DIM)

        o_a = window_gqa_latent(q_a, k_a, v_a, kc_a, vc_a, sink[l])
        k_all = jnp.concatenate([kc_b, k_b], axis=1)
        v_all = jnp.concatenate([vc_b, v_b], axis=1)
        o_b = diff_output(diff_attn_latent(q_b, k_all, v_all, lam), g_subln[l], lam_init)
        out_x = branch_merge(o_a, z_a, o_b, z_b, g_a, g_b, w_proj_a[l], w_proj_b[l], w_out[l])

        if not last:
            pc_q = hc @ w_in[l][:, KV_COLS:]
            qc_a, zc_a, qc_b, zc_b, gc_a, gc_b = split_cols(pc_q, Q_SPLITS)
            oc_a = window_gqa_context(qc_a.reshape(B, C, A_Q_HEADS, HEAD_DIM), kc_a, vc_a, sink[l])
            oc_b = diff_output(diff_attn_context(qc_b.reshape(B, C, B_HEADS, 2, B_QK_DIM), kc_b, vc_b, lam),
                               g_subln[l], lam_init)
            out_c = branch_merge(oc_a, zc_a, oc_b, zc_b, gc_a, gc_b, w_proj_a[l], w_proj_b[l], w_out[l])
            ctx = ctx + gt_c * rmsnorm(out_c, g_post[l])

        x = x + gt_x[:, None] * rmsnorm(out_x, g_post[l])
    return x
```

```cpp
#include <hip/hip_runtime.h>
#include <hip/hip_bf16.h>
#include <hip/hip_cooperative_groups.h>
#include <cstdio>
#include <cstdint>
#include <cmath>
namespace cg = cooperative_groups;

constexpr int DM = 2048, NB = 2, SEQ = 8192, DEPTH = 2, CTX = 256;
constexpr int RPB = CTX + SEQ;
constexpr int MROWS = NB * RPB;
constexpr int INC = 17408;
constexpr int C_KA = 0, C_VA = 512, C_KB = 1024, C_VB = 3072, C_QA = 5120, C_ZA = 7168, C_QB = 9216, C_ZB = 11264, C_GA = 13312, C_GB = 15360;
constexpr float EPS = 1e-6f;

namespace pg8 {
#define PG8_LAS __attribute__((address_space(3)))
typedef unsigned short bf16_t;
typedef short bf16x8 __attribute__((ext_vector_type(8)));
typedef float f32x4 __attribute__((ext_vector_type(4)));
typedef unsigned u32x4 __attribute__((ext_vector_type(4)));
constexpr int BM = 256, BK = 64, HALF = 128, HTB = HALF * BK * 2  , STAGE_BYTES = 8 * HTB, NXCD = 8, WGM = 8;

__host__ __device__ __forceinline__ int lds_byte(int r, int c) { const int st = (r >> 4) * 2 + (c >> 5), rr = r & 15, cc = c & 31, ob = rr * 64 + cc * 2; return st * 1024 + (ob ^ (((ob >> 9) & 1) << 5)); }
__host__ __device__ __forceinline__ void stage_rc(int b, int& R, int& C) { const int st = b / 1024, sb = b % 1024, swz = sb ^ (((sb >> 9) & 1) << 5); R = (st >> 1) * 16 + swz / 64; C = (st & 1) * 32 + (swz % 64) / 2; }
__host__ __device__ __forceinline__ int perm32(int rho) { const int n = rho >> 4, i = rho & 15; return 8 * (i >> 2) + 4 * n + (i & 3); }

struct Unit { int pm, pn; };
struct Gemm { const bf16_t* A; const bf16_t* Bt; int M, N, K; };

struct StaticOrder {
    int nM, nN, nwg, G, c;
    __host__ __device__ void init(int M, int N, int G_, int c_) { nM = M / BM; nN = N / BM; nwg = nM * nN; G = G_; c = c_; }
    __host__ __device__ bool next(int i, Unit& u) const {
        const long L = (long)i * G + c; if (L >= nwg) return false;
        int wgid = (int)L; { const int q = nwg / NXCD, r = nwg % NXCD, xcd = wgid % NXCD, off = wgid / NXCD; wgid = (xcd < r ? xcd * (q + 1) : r * (q + 1) + (xcd - r) * q) + off; }
        const int nig = WGM * nN, gid = wgid / nig, fm = gid * WGM, gsz = (nM - fm) < WGM ? (nM - fm) : WGM;
        u.pm = fm + ((wgid % nig) % gsz); u.pn = (wgid % nig) / gsz; return true;
    }
    __device__ __forceinline__ void a_ready(const Unit&) const {}
    __device__ __forceinline__ void done(const Unit&) const {}
};

__device__ __forceinline__ unsigned cvt_pk_bf16(float lo, float hi) { unsigned r; asm volatile("v_cvt_pk_bf16_f32 %0, %1, %2" : "=v"(r) : "v"(lo), "v"(hi)); return r; }
typedef float f32x2 __attribute__((ext_vector_type(2)));

struct EpiBf16 {
    static constexpr bool PERM = true, AFTER_DRAIN = false;
    bf16_t* O; int ldc;
    __device__ __forceinline__ void operator()(const f32x4 (&acc)[2][2][4][2], const Unit& u, int wr, int wc, int fr, int fq) const {
        const int row0 = u.pm * BM + wr * 64 + fr; const int col0 = u.pn * BM + wc * 32 + 8 * fq;
#pragma unroll
        for (int ai = 0; ai < 2; ++ai)
#pragma unroll
            for (int m = 0; m < 4; ++m) { bf16_t* rowp = O + (size_t)(row0 + ai * HALF + m * 16) * ldc + col0;
#pragma unroll
                for (int bj = 0; bj < 2; ++bj) { const f32x4 v0 = acc[ai][bj][m][0], v1 = acc[ai][bj][m][1];
                    u32x4 w; w.x = cvt_pk_bf16(v0[0], v0[1]); w.y = cvt_pk_bf16(v0[2], v0[3]); w.z = cvt_pk_bf16(v1[0], v1[1]); w.w = cvt_pk_bf16(v1[2], v1[3]);
                    *(u32x4*)(rowp + bj * HALF) = w; } }
    }
};

template <class Epi, class Sched, bool ALIGN_EPI = false, bool SP2 = false>
__device__ __forceinline__ void gemm_phase(PG8_LAS unsigned char* lds, const Gemm g, const Sched& S, const Epi& E) {
    int tid_ = threadIdx.x; asm volatile("" : "+v"(tid_));
    const int tid = tid_, wid = __builtin_amdgcn_readfirstlane(tid >> 6), lane = tid & 63, wr = wid >> 2, wc = wid & 3, fr = lane & 15, fq = lane >> 4;
    const int K = g.K, nt = K / BK;
    unsigned voffA[2], voffB[2];
#pragma unroll
    for (int i = 0; i < 2; ++i) { int R, C; stage_rc(tid * 16 + i * 8192, R, C); const int Rb = Epi::PERM ? ((R & ~31) + perm32(R & 31)) : R;
        voffA[i] = (unsigned)(R * K + C) * 2u; voffB[i] = (unsigned)(Rb * K + C) * 2u; }
    const size_t kstep = (size_t)(BK * 2);
    const size_t hstep = (size_t)HALF * K * 2;
    const size_t tstep = 2 * hstep;
    const unsigned ldsw = (unsigned)wid * 1024u;
    const int aoff = lds_byte(wr * 64 + fr, fq * 8), boff = lds_byte(wc * 32 + fr, fq * 8);
#define PG8_SA(b, h) (((b) * 2 + (h)) * HTB)
#define PG8_SB(b, h) ((4 + (b) * 2 + (h)) * HTB)
#define PG8_STAGE(bufoff, gbase, voff) do { _Pragma("unroll") for (int _i = 0; _i < 2; ++_i) \
        __builtin_amdgcn_global_load_lds((const unsigned*)((const char*)(gbase) + (voff)[_i]), (PG8_LAS unsigned*)(lds + (bufoff) + ldsw + _i * 8192), 16, 0, 0); } while (0)
#define PG8_LDA(dst, b, h) do { _Pragma("unroll") for (int m = 0; m < 4; ++m) _Pragma("unroll") for (int k = 0; k < 2; ++k) dst[m][k] = *(const PG8_LAS bf16x8*)(lds + PG8_SA(b, h) + aoff + m * 2048 + k * 1024); } while (0)
#define PG8_LDB(dst, b, h) do { _Pragma("unroll") for (int n = 0; n < 2; ++n) _Pragma("unroll") for (int k = 0; k < 2; ++k) dst[n][k] = *(const PG8_LAS bf16x8*)(lds + PG8_SB(b, h) + boff + n * 2048 + k * 1024); } while (0)
#define PG8_MMA(ai, bj, At, Bt) do { __builtin_amdgcn_s_setprio(1); _Pragma("unroll") for (int m = 0; m < 4; ++m) _Pragma("unroll") for (int n = 0; n < 2; ++n) _Pragma("unroll") for (int k = 0; k < 2; ++k) \
        acc[ai][bj][m][n] = __builtin_amdgcn_mfma_f32_16x16x32_bf16(Bt[n][k], At[m][k], acc[ai][bj][m][n], 0, 0, 0); __builtin_amdgcn_s_setprio(0); } while (0)
#define PG8_WAIT_V(n) asm volatile("s_waitcnt vmcnt(" #n ")" ::: "memory")
#define PG8_WAIT_L(n) asm volatile("s_waitcnt lgkmcnt(" #n ")" ::: "memory")
#define PG8_BAR __builtin_amdgcn_s_barrier()
#define PG8_SCHED __builtin_amdgcn_sched_barrier(0)
    Unit cur, nxt; int ui = 0;
    if (!S.next(0, cur)) return;
    f32x4 acc[2][2][4][2];
#pragma unroll
    for (int a = 0; a < 2; ++a)
#pragma unroll
        for (int b = 0; b < 2; ++b)
#pragma unroll
            for (int m = 0; m < 4; ++m)
#pragma unroll
                for (int n = 0; n < 2; ++n) acc[a][b][m][n] = (f32x4){0.f, 0.f, 0.f, 0.f};
    bf16x8 At[4][2], B0[2][2], B1[2][2];
    const char* cA = (const char*)g.A + (size_t)cur.pm * tstep; const char* cB = (const char*)g.Bt + (size_t)cur.pn * tstep;
    S.a_ready(cur);
    if constexpr (SP2) {
        PG8_STAGE(PG8_SB(0, 0), cB, voffB); PG8_STAGE(PG8_SB(0, 1), cB + hstep, voffB); PG8_STAGE(PG8_SA(0, 0), cA, voffA); PG8_STAGE(PG8_SA(0, 1), cA + hstep, voffA);
        if (wr == 1) PG8_BAR;
        PG8_WAIT_V(2); PG8_BAR;
        PG8_STAGE(PG8_SB(1, 0), cB + kstep, voffB); PG8_STAGE(PG8_SA(1, 0), cA + kstep, voffA); PG8_STAGE(PG8_SB(1, 1), cB + hstep + kstep, voffB);
        PG8_WAIT_V(6); PG8_BAR;
    } else {
        PG8_STAGE(PG8_SB(0, 0), cB, voffB); PG8_STAGE(PG8_SA(0, 0), cA, voffA); PG8_STAGE(PG8_SB(0, 1), cB + hstep, voffB); PG8_STAGE(PG8_SA(0, 1), cA + hstep, voffA);
        if (wr == 1) PG8_BAR;
        PG8_WAIT_V(4); PG8_BAR;
        PG8_STAGE(PG8_SB(1, 0), cB + kstep, voffB); PG8_STAGE(PG8_SA(1, 0), cA + kstep, voffA); PG8_STAGE(PG8_SB(1, 1), cB + hstep + kstep, voffB);
        PG8_WAIT_V(6); PG8_BAR;
    }
    for (;;) {
        const bool has_next = S.next(ui + 1, nxt);
        const char* nA = has_next ? (const char*)g.A + (size_t)nxt.pm * tstep : cA; const char* nB = has_next ? (const char*)g.Bt + (size_t)nxt.pn * tstep : cB;
        for (int t = 0; t < nt; t += 2) {
            const bool last = (t == nt - 2);
            const char* a1 = cA + (size_t)(t + 1) * kstep;
            const char* a2 = last ? nA : cA + (size_t)(t + 2) * kstep; const char* b2 = last ? nB : cB + (size_t)(t + 2) * kstep;
            const char* a3 = a2 + kstep; const char* b3 = b2 + kstep;
            if (last && has_next) S.a_ready(nxt);
            if constexpr (SP2) {
            PG8_LDB(B0, 0, 0); PG8_LDB(B1, 0, 1); PG8_SCHED; PG8_LDA(At, 0, 0); PG8_STAGE(PG8_SA(1, 1), a1 + hstep, voffA);
            PG8_WAIT_V(8); PG8_WAIT_L(0); PG8_BAR; PG8_MMA(0, 0, At, B0); PG8_MMA(0, 1, At, B1); PG8_BAR; PG8_SCHED;
            PG8_LDA(At, 0, 1); PG8_STAGE(PG8_SB(0, 0), b2, voffB); PG8_STAGE(PG8_SB(0, 1), b2 + hstep, voffB); PG8_STAGE(PG8_SA(0, 0), a2, voffA);
            PG8_WAIT_V(8); PG8_WAIT_L(0); PG8_BAR; PG8_MMA(1, 0, At, B0); PG8_MMA(1, 1, At, B1); PG8_BAR; PG8_SCHED;
            PG8_LDB(B0, 1, 0); PG8_LDB(B1, 1, 1); PG8_SCHED; PG8_LDA(At, 1, 0); PG8_STAGE(PG8_SA(0, 1), a2 + hstep, voffA);
            PG8_WAIT_V(8); PG8_WAIT_L(0); PG8_BAR; PG8_MMA(0, 0, At, B0); PG8_MMA(0, 1, At, B1); PG8_BAR; PG8_SCHED;
            PG8_LDA(At, 1, 1); PG8_STAGE(PG8_SB(1, 0), b3, voffB); PG8_STAGE(PG8_SB(1, 1), b3 + hstep, voffB); PG8_STAGE(PG8_SA(1, 0), a3, voffA);
            PG8_WAIT_V(8); PG8_WAIT_L(0); PG8_BAR; PG8_MMA(1, 0, At, B0); PG8_MMA(1, 1, At, B1); PG8_BAR; PG8_SCHED;
            } else {
            PG8_LDB(B0, 0, 0); PG8_SCHED; PG8_LDA(At, 0, 0); PG8_STAGE(PG8_SA(1, 1), a1 + hstep, voffA);
            PG8_WAIT_L(8); PG8_BAR; PG8_WAIT_L(0); PG8_MMA(0, 0, At, B0); PG8_BAR; PG8_SCHED;
            PG8_LDB(B1, 0, 1); PG8_STAGE(PG8_SB(0, 0), b2, voffB);
            PG8_BAR; PG8_WAIT_L(0); PG8_MMA(0, 1, At, B1); PG8_BAR;
            PG8_LDA(At, 0, 1); PG8_STAGE(PG8_SA(0, 0), a2, voffA);
            PG8_BAR; PG8_WAIT_L(0); PG8_MMA(1, 0, At, B0); PG8_BAR; PG8_SCHED;
            PG8_STAGE(PG8_SB(0, 1), b2 + hstep, voffB);
            PG8_WAIT_V(6); PG8_BAR; PG8_MMA(1, 1, At, B1); PG8_BAR;
            PG8_LDB(B0, 1, 0); PG8_SCHED; PG8_LDA(At, 1, 0); PG8_STAGE(PG8_SA(0, 1), a2 + hstep, voffA);
            PG8_WAIT_L(8); PG8_BAR; PG8_WAIT_L(0); PG8_MMA(0, 0, At, B0); PG8_BAR; PG8_SCHED;
            PG8_LDB(B1, 1, 1); PG8_STAGE(PG8_SB(1, 0), b3, voffB);
            PG8_BAR; PG8_WAIT_L(0); PG8_MMA(0, 1, At, B1); PG8_BAR;
            PG8_LDA(At, 1, 1); PG8_STAGE(PG8_SA(1, 0), a3, voffA);
            PG8_BAR; PG8_WAIT_L(0); PG8_MMA(1, 0, At, B0); PG8_BAR; PG8_SCHED;
            PG8_STAGE(PG8_SB(1, 1), b3 + hstep, voffB);
            PG8_WAIT_V(6); PG8_BAR; PG8_MMA(1, 1, At, B1); PG8_BAR;
            }
        }
        if constexpr (ALIGN_EPI) { if (wr == 0) PG8_BAR; }
        if constexpr (!Epi::AFTER_DRAIN) { E(acc, cur, wr, wc, fr, fq); S.done(cur); }
        if (!has_next) break;
#pragma unroll
        for (int a = 0; a < 2; ++a)
#pragma unroll
            for (int b = 0; b < 2; ++b)
#pragma unroll
                for (int m = 0; m < 4; ++m)
#pragma unroll
                    for (int n = 0; n < 2; ++n) acc[a][b][m][n] = (f32x4){0.f, 0.f, 0.f, 0.f};
        cur = nxt; cA = nA; cB = nB; ++ui;
        if constexpr (ALIGN_EPI) { if (wr == 1) PG8_BAR; }
    }
    PG8_WAIT_V(0);
    if constexpr (!ALIGN_EPI) { if (wr == 0) PG8_BAR; }
    PG8_BAR;
    if constexpr (Epi::AFTER_DRAIN) { E.fused(acc, cur, wr, wc, fr, fq, lds, wid, lane); S.done(cur); }
#undef PG8_SA
#undef PG8_SB
#undef PG8_STAGE
#undef PG8_LDA
#undef PG8_LDB
#undef PG8_MMA
#undef PG8_WAIT_V
#undef PG8_WAIT_L
#undef PG8_BAR
#undef PG8_SCHED
}
}

namespace att {
using bf16 = unsigned short;
constexpr int D = 128, NW = 8, QBLK = 32, KVBLK = 64;
constexpr float SCALE = 0.088388347648318440f;
constexpr float THR = 8.f;
constexpr int SDEPTH = 2;
constexpr int LDQ = INC, LDK = INC, LDO = DM;
constexpr size_t SHM_V = KVBLK * D * 2, SHM_K = KVBLK * D * 2, SHM_ATTN = 2 * SHM_V + 2 * SHM_K + NW * 64 * 4;

using bf16x8 = __attribute__((ext_vector_type(8))) short;
using s16x4  = __attribute__((ext_vector_type(4))) short;
using f32x16 = __attribute__((ext_vector_type(16))) float;
using f32x8  = __attribute__((ext_vector_type(8))) float;
using u32x4  = __attribute__((ext_vector_type(4))) unsigned;
#define KSWZ(row, colB) ((row) * 256 + ((colB) ^ (((row) & 7) << 4)))
#define SBAR() __builtin_amdgcn_sched_barrier(0)
__device__ __forceinline__ int crow(int r, int hi) { return (r & 3) + 8 * (r >> 2) + 4 * hi; }
__device__ __forceinline__ unsigned cvtpk(float lo, float hi) {
  unsigned r; asm volatile("v_cvt_pk_bf16_f32 %0, %1, %2" : "=v"(r) : "v"(lo), "v"(hi)); return r;
}
template <typename TIn> struct Stage;
template <> struct Stage<bf16>  { using T = bf16x8;
  __device__ static __forceinline__ T ld8(const bf16* p) { return *reinterpret_cast<const bf16x8*>(p); }
  __device__ static __forceinline__ bf16x8 tobf(T x) { return x; } };
template <> struct Stage<float> { using T = f32x8;
  __device__ static __forceinline__ T ld8(const float* p) { return *reinterpret_cast<const f32x8*>(p); }
  __device__ static __forceinline__ bf16x8 tobf(T x) {
    u32x4 w = {cvtpk(x[0], x[1]), cvtpk(x[2], x[3]), cvtpk(x[4], x[5]), cvtpk(x[6], x[7])}; return *reinterpret_cast<bf16x8*>(&w); } };

__device__ __forceinline__ void partialSM(f32x16& p0, f32x16& p1, float& m_reg, float& mn, float& alpha) {
  constexpr float C = SCALE * 1.4426950408889634f;
  float pmax = p0[0]; for (int r = 1; r < 16; ++r) pmax = fmaxf(pmax, p0[r]); for (int r = 0; r < 16; ++r) pmax = fmaxf(pmax, p1[r]);
  { auto rr = __builtin_amdgcn_permlane32_swap(__float_as_uint(pmax), __float_as_uint(pmax), false, false);
    pmax = fmaxf(__uint_as_float(rr[0]), __uint_as_float(rr[1])); }
  if (__builtin_expect(__all(pmax - m_reg <= THR / SCALE), 1)) { mn = m_reg; alpha = 1.f; }
  else { mn = fmaxf(m_reg, pmax); alpha = __builtin_amdgcn_exp2f((m_reg - mn) * C); m_reg = mn; }
  float mnC = -mn * C;
  for (int r = 0; r < 16; ++r) p0[r] = fmaf(p0[r], C, mnC); for (int r = 0; r < 16; ++r) p1[r] = fmaf(p1[r], C, mnC);
  for (int r = 0; r < 16; ++r) p0[r] = __builtin_amdgcn_exp2f(p0[r]);
}
__device__ __forceinline__ void finishSM(f32x16& p0, f32x16& p1, float alpha, float& l_reg, bf16x8& pa0, bf16x8& pa1, bf16x8& pa2, bf16x8& pa3) {
  for (int r = 0; r < 16; ++r) p1[r] = __builtin_amdgcn_exp2f(p1[r]);
  float ps = 0; for (int r = 0; r < 16; ++r) ps += p0[r]; for (int r = 0; r < 16; ++r) ps += p1[r];
  { auto rr = __builtin_amdgcn_permlane32_swap(__float_as_uint(ps), __float_as_uint(ps), false, false);
    ps = __uint_as_float(rr[0]) + __uint_as_float(rr[1]); }
  l_reg = l_reg * alpha + ps;
#define PK4(P, BASE, OUT) do { unsigned a0 = cvtpk(P[BASE + 0], P[BASE + 1]), a1 = cvtpk(P[BASE + 2], P[BASE + 3]);   \
    unsigned b0 = cvtpk(P[BASE + 4], P[BASE + 5]), b1 = cvtpk(P[BASE + 6], P[BASE + 7]);                              \
    auto r0 = __builtin_amdgcn_permlane32_swap(a0, b0, false, false); auto r1 = __builtin_amdgcn_permlane32_swap(a1, b1, false, false); \
    u32x4 w = {r0[0], r1[0], r0[1], r1[1]}; OUT = *reinterpret_cast<bf16x8*>(&w); } while (0)
  PK4(p0, 0, pa0); PK4(p0, 8, pa1); PK4(p1, 0, pa2); PK4(p1, 8, pa3);
#undef PK4
}
__device__ __forceinline__ void qkt(f32x16& p0, f32x16& p1, const bf16* Ks, const bf16x8* qr, int r32, int hi) {
  p0 = f32x16{}; p1 = f32x16{};
  for (int d0 = 0; d0 < 8; ++d0) { int cb = (d0 * 16 + hi * 8) * 2;
    bf16x8 b0 = *reinterpret_cast<const bf16x8*>((const char*)Ks + KSWZ(r32, cb));
    bf16x8 b1 = *reinterpret_cast<const bf16x8*>((const char*)Ks + KSWZ(32 + r32, cb));
    p0 = __builtin_amdgcn_mfma_f32_32x32x16_bf16(b0, qr[d0], p0, 0, 0, 0);
    p1 = __builtin_amdgcn_mfma_f32_32x32x16_bf16(b1, qr[d0], p1, 0, 0, 0); }
}
__device__ __forceinline__ int v_st(int k, int c) { const int kk = (k & ~0xC) | ((k & 4) << 1) | ((k & 8) >> 1); return ((kk >> 3) * 4 + (c >> 5)) * 512 + ((kk & 7) * 32 + (c & 31)) * 2; }
__device__ __forceinline__ int v_rd_base(int lane) { return ((lane & 3) << 3) | (((lane >> 2) & 3) << 6) | (((lane >> 4) & 1) << 5) | (((lane >> 5) & 1) << 8); }
constexpr int v_rd_off(int d0, int ks, int half) { return d0 * 512 + ks * 4096 + half * 2048; }
template <int OFF> __device__ __forceinline__ s16x4 tr_read(int vb) {
  s16x4 r; asm volatile("ds_read_b64_tr_b16 %0, %1 offset:%2" : "=&v"(r) : "v"(vb), "i"(OFF) : "memory"); return r;
}
template <int D0> __device__ __forceinline__ void pv_one(f32x16& od, int vb, bf16x8 pa0, bf16x8 pa1, bf16x8 pa2, bf16x8 pa3) {
  const s16x4 l0 = tr_read<v_rd_off(D0, 0, 0)>(vb), h0 = tr_read<v_rd_off(D0, 0, 1)>(vb), l1 = tr_read<v_rd_off(D0, 1, 0)>(vb), h1 = tr_read<v_rd_off(D0, 1, 1)>(vb);
  const s16x4 l2 = tr_read<v_rd_off(D0, 2, 0)>(vb), h2 = tr_read<v_rd_off(D0, 2, 1)>(vb), l3 = tr_read<v_rd_off(D0, 3, 0)>(vb), h3 = tr_read<v_rd_off(D0, 3, 1)>(vb);
  asm volatile("s_waitcnt lgkmcnt(0)" ::: "memory"); SBAR();
#define PK(L, H) (bf16x8){L[0], L[1], L[2], L[3], H[0], H[1], H[2], H[3]}
  od = __builtin_amdgcn_mfma_f32_32x32x16_bf16(pa0, PK(l0, h0), od, 0, 0, 0);
  od = __builtin_amdgcn_mfma_f32_32x32x16_bf16(pa1, PK(l1, h1), od, 0, 0, 0);
  od = __builtin_amdgcn_mfma_f32_32x32x16_bf16(pa2, PK(l2, h2), od, 0, 0, 0);
  od = __builtin_amdgcn_mfma_f32_32x32x16_bf16(pa3, PK(l3, h3), od, 0, 0, 0);
#undef PK
}
__device__ __forceinline__ void pv_d0(f32x16* o, int vb, bf16x8 pa0, bf16x8 pa1, bf16x8 pa2, bf16x8 pa3) {
  pv_one<0>(o[0], vb, pa0, pa1, pa2, pa3); pv_one<1>(o[1], vb, pa0, pa1, pa2, pa3); pv_one<2>(o[2], vb, pa0, pa1, pa2, pa3); pv_one<3>(o[3], vb, pa0, pa1, pa2, pa3);
}

__device__ __forceinline__ void band_mask(f32x16& p0, f32x16& p1, int dq  , int hi) {
#pragma unroll
  for (int r = 0; r < 16; ++r) { const int d = dq - crow(r, hi);
    if ((unsigned)(d + 128) > 256u) p0[r] = -1e30f;
    if ((unsigned)(d + 96) > 256u) p1[r] = -1e30f; }
}
template <bool MASK>
__device__ __forceinline__ void attn_body(const bf16* __restrict__ Qb, const bf16* __restrict__ Kh, const bf16* __restrict__ Vh,
                                          bf16* __restrict__ Ob, int NT, int NCT, int lo, int qpos0, float sinkl2, char* lds) {
  using St = Stage<bf16>;
  int tid_ = threadIdx.x; asm volatile("" : "+v"(tid_));
  const int tid = tid_, wid = tid >> 6, lane = tid & 63, r32 = lane & 31, hi = lane >> 5;
  bf16* V_lds = (bf16*)lds; bf16* K_lds = (bf16*)(lds + 2 * SHM_V);
  float* ws = (float*)(lds + 2 * SHM_V + 2 * SHM_K) + wid * 64; float* li_l = ws; float* al_l = ws + 32;
  float m_reg = -1e30f, l_reg = 0; f32x16 o[4] = {}; bf16x8 qr[8];
  const bf16* Qw = Qb + (long)(wid * QBLK + r32) * LDQ + hi * 8;
#pragma unroll
  for (int d0 = 0; d0 < 8; ++d0) qr[d0] = St::ld8(Qw + d0 * 16);
  const int sr = tid >> 4, sc = (tid & 15) * 8, vst0 = v_st(sr, sc), vst1 = v_st(32 + sr, sc);
  const int vb0 = (int)(uintptr_t)V_lds + v_rd_base(lane);
  const int qi = qpos0 + wid * QBLK + r32;
  struct { typename St::T vs0, vs1, ks0, ks1; } sr_[SDEPTH];
#define TROW(j) (64 * (j) + ((j) >= NCT ? lo : 0))
#define SLOAD(i, k0) do { const long k0_ = (k0); sr_[i].vs0 = St::ld8(&Vh[(k0_ + sr) * LDK + sc]); sr_[i].vs1 = St::ld8(&Vh[(k0_ + 32 + sr) * LDK + sc]); \
    sr_[i].ks0 = St::ld8(&Kh[(k0_ + sr) * LDK + sc]); sr_[i].ks1 = St::ld8(&Kh[(k0_ + 32 + sr) * LDK + sc]); } while (0)
#define SWRITE(b, i) do { *(bf16x8*)((char*)V_lds + (b) * SHM_V + vst0) = St::tobf(sr_[i].vs0);          \
    *(bf16x8*)((char*)V_lds + (b) * SHM_V + vst1) = St::tobf(sr_[i].vs1); int kc = sc * 2;               \
    *(bf16x8*)((char*)K_lds + (b) * SHM_K + KSWZ(sr, kc)) = St::tobf(sr_[i].ks0);                       \
    *(bf16x8*)((char*)K_lds + (b) * SHM_K + KSWZ(32 + sr, kc)) = St::tobf(sr_[i].ks1); } while (0)
#define SWAIT() do { if constexpr (SDEPTH == 2) asm volatile("s_waitcnt vmcnt(4)" ::: "memory"); else asm volatile("s_waitcnt vmcnt(0)" ::: "memory"); } while (0)
#define RESC(a) do { if (__any((a) < 1.f)) { if (hi == 0) al_l[r32] = (a); asm volatile("s_waitcnt lgkmcnt(0)" ::: "memory"); \
    for (int d = 0; d < 4; ++d) for (int r = 0; r < 16; ++r) o[d][r] *= al_l[crow(r, hi)]; } } while (0)
#define AMASK(P0, P1, j) do { if constexpr (MASK) { if ((j) >= NCT) band_mask(P0, P1, qi - (lo + 64 * ((j) - NCT)), hi); } } while (0)
  f32x16 pA0, pA1, pB0, pB1; float mnA, mnB, alA, alB; bf16x8 pa0, pa1, pa2, pa3;
  constexpr int SE = 0, SO = SDEPTH - 1;
  SLOAD(SE, TROW(0)); asm volatile("s_waitcnt vmcnt(0)" ::: "memory"); SWRITE(0, SE); __syncthreads();
  qkt(pA0, pA1, K_lds, qr, r32, hi); AMASK(pA0, pA1, 0); partialSM(pA0, pA1, m_reg, mnA, alA);
  SLOAD(SO, TROW(1)); if constexpr (SDEPTH == 2) { if (2 < NT) SLOAD(SE, TROW(2)); }
  SWAIT(); SWRITE(1, SO); __syncthreads();
  for (int j = 1; j + 1 < NT; j += 2) {
    SBAR(); qkt(pB0, pB1, (bf16*)((char*)K_lds + SHM_K), qr, r32, hi); AMASK(pB0, pB1, j);
    finishSM(pA0, pA1, alA, l_reg, pa0, pa1, pa2, pa3); SBAR();
    SLOAD(SO, TROW(j + SDEPTH)); SBAR();
    pv_d0(o, vb0, pa0, pa1, pa2, pa3); partialSM(pB0, pB1, m_reg, mnB, alB);
    __syncthreads(); SWAIT(); SWRITE(0, SE);
    RESC(alB); __syncthreads();
    SBAR(); qkt(pA0, pA1, K_lds, qr, r32, hi); AMASK(pA0, pA1, j + 1);
    finishSM(pB0, pB1, alB, l_reg, pa0, pa1, pa2, pa3); SBAR();
    if (SDEPTH == 1 || j + 3 < NT) SLOAD(SE, TROW(j + 1 + SDEPTH)); SBAR();
    pv_d0(o, vb0 + (int)SHM_V, pa0, pa1, pa2, pa3); partialSM(pA0, pA1, m_reg, mnA, alA);
    __syncthreads(); SWAIT(); SWRITE(1, SO);
    RESC(alA); __syncthreads();
  }
  SBAR(); qkt(pB0, pB1, (bf16*)((char*)K_lds + SHM_K), qr, r32, hi); AMASK(pB0, pB1, NT - 1);
  finishSM(pA0, pA1, alA, l_reg, pa0, pa1, pa2, pa3); SBAR();
  pv_d0(o, vb0, pa0, pa1, pa2, pa3); partialSM(pB0, pB1, m_reg, mnB, alB);
  __syncthreads(); RESC(alB);
  finishSM(pB0, pB1, alB, l_reg, pa0, pa1, pa2, pa3); SBAR();
  pv_d0(o, vb0 + (int)SHM_V, pa0, pa1, pa2, pa3);
  l_reg += __builtin_amdgcn_exp2f(sinkl2 - m_reg * (SCALE * 1.4426950408889634f));
  if (hi == 0) li_l[r32] = l_reg; asm volatile("s_waitcnt lgkmcnt(0)" ::: "memory");
  float rli[16];
#pragma unroll
  for (int r = 0; r < 16; ++r) rli[r] = __builtin_amdgcn_rcpf(li_l[crow(r, hi)]);
  bf16* Ow = Ob + (long)(wid * QBLK) * LDO;
#pragma unroll
  for (int r = 0; r < 16; ++r) { int orow = crow(r, hi);
    for (int d0 = 0; d0 < 4; ++d0) { const float v = o[d0][r] * rli[r]; const unsigned u = __builtin_bit_cast(unsigned, v);
      Ow[(long)orow * LDO + d0 * 32 + r32] = (bf16)((u + 0x7fffu + ((u >> 16) & 1u)) >> 16); } }
  __syncthreads();
#undef TROW
#undef SLOAD
#undef SWRITE
#undef SWAIT
#undef RESC
#undef AMASK
}
}

constexpr size_t MiB = 1u << 20;
constexpr size_t SLOT = (size_t)MROWS * DM * 2;
constexpr size_t WS_MOD = 0;
constexpr size_t WS_COS = 2 * MiB, WS_SIN = 4 * MiB;
constexpr size_t WS_CTX1 = 6 * MiB;
constexpr size_t WS_WINT = 16 * MiB;
constexpr size_t WS_WPT = WS_WINT + 68 * MiB;
constexpr size_t WS_PX = WS_WPT + 48 * MiB;
constexpr size_t WS_S0 = WS_PX + (size_t)MROWS * INC * 2;
constexpr size_t WS_END = WS_S0 + 5 * SLOT;
static_assert(WS_END <= 4ull * DEPTH * DM * INC * 4, "workspace map exceeds the guaranteed 4x largest tensor");

constexpr int NWAVES = 8;
constexpr int LDS_BYTES = 147456;

#define GAS __attribute__((address_space(1)))
#define LAS __attribute__((address_space(3)))
typedef unsigned short bf16;
typedef unsigned v4u __attribute__((ext_vector_type(4)));
typedef unsigned v2u __attribute__((ext_vector_type(2)));
typedef float f32x4 __attribute__((ext_vector_type(4)));
#define LDS_WAIT() asm volatile("s_waitcnt lgkmcnt(0)" ::: "memory")
__device__ __forceinline__ unsigned f2bf(float f) { unsigned u = __builtin_bit_cast(unsigned, f); return (u + 0x7fffu + ((u >> 16) & 1u)) >> 16; }
__device__ __forceinline__ unsigned pk2(float lo, float hi) { return f2bf(lo) | (f2bf(hi) << 16); }
__device__ __forceinline__ float bflo(unsigned w) { return __builtin_bit_cast(float, w << 16); }
__device__ __forceinline__ float bfhi(unsigned w) { return __builtin_bit_cast(float, w & 0xffff0000u); }
__device__ __forceinline__ float siluf(float x) { return x / (1.f + __expf(-x)); }
__device__ __forceinline__ float sigmf(float x) { return 1.f / (1.f + __expf(-x)); }

struct Frame {
    LAS unsigned char* lds;
    int vcu, G;
    const float *x, *c, *ctx, *c_ctx, *w_ada, *b_ada, *g_pre, *g_post, *w_in, *sink, *lam_qk, *g_subln, *w_pa, *w_pb, *w_out;
    float* out; unsigned char* ws;
};

#define FRESH_IDS int tid_ = threadIdx.x; asm volatile("" : "+v"(tid_)); const int tid = tid_, lane = tid & 63, wave = __builtin_amdgcn_readfirstlane(tid >> 6); (void)lane; (void)wave;

__device__ __forceinline__ float wave_sum(float v) {
#pragma unroll
    for (int o = 1; o < 64; o <<= 1) v += __shfl_xor(v, o);
    return v;
}
__device__ __forceinline__ void p0_transpose_item(const float* W, int K, int N, bf16* WT, int row_off, LAS float* scr, int item, int lane) {
    const int nblk = N / 32, kb = item / nblk, nb = item % nblk, k0 = 64 * kb, n0 = 32 * nb;
#pragma unroll 8
    for (int i = 0; i < 32; ++i) { const int kk = 2 * i + (lane >> 5); scr[kk * 33 + (lane & 31)] = W[(size_t)(k0 + kk) * N + n0 + (lane & 31)]; }
    LDS_WAIT(); asm volatile("" ::: "memory");
    const int c = lane & 7;
#pragma unroll
    for (int j = 0; j < 4; ++j) { const int n = (lane >> 3) + 8 * j; const LAS float* s = scr + (8 * c) * 33 + n;
        v4u o; o.x = pk2(s[0 * 33], s[1 * 33]); o.y = pk2(s[2 * 33], s[3 * 33]); o.z = pk2(s[4 * 33], s[5 * 33]); o.w = pk2(s[6 * 33], s[7 * 33]);
        *(GAS v4u*)(WT + (size_t)(row_off + n0 + n) * K + k0 + 8 * c) = o; }
    LDS_WAIT(); asm volatile("" ::: "memory");
}

#define GW_LOOP(var, n) for (int var = F.vcu * NWAVES + wave; var < (n); var += F.G * NWAVES)

__device__ __forceinline__ void ph_prologue(Frame& F) {
    FRESH_IDS
    for (int ait = F.vcu; ait < 192; ait += F.G) {
        const int l = ait / 96, n0 = (ait % 96) * 64;
        LAS float* sv = (LAS float*)F.lds;
        LAS float* red = (LAS float*)(F.lds + 32768);
        for (int k = tid; k < DM; k += NWAVES * 64) { sv[k] = siluf(F.c[k]); sv[DM + k] = siluf(F.c[DM + k]); sv[2 * DM + k] = siluf(F.c_ctx[k]); }
        __syncthreads();
        const float* W = F.w_ada + (size_t)l * DM * 6144 + n0 + lane;
        float a0 = 0.f, a1 = 0.f, a2 = 0.f;
        const int kb = wave * 256;
#pragma unroll 8
        for (int k = 0; k < 256; ++k) { const float w = W[(size_t)(kb + k) * 6144]; a0 += sv[kb + k] * w; a1 += sv[DM + kb + k] * w; a2 += sv[2 * DM + kb + k] * w; }
        red[(wave * 3 + 0) * 64 + lane] = a0; red[(wave * 3 + 1) * 64 + lane] = a1; red[(wave * 3 + 2) * 64 + lane] = a2;
        __syncthreads();
        if (wave < 3) { float s = 0.f;
#pragma unroll
            for (int w = 0; w < 8; ++w) s += red[(w * 3 + wave) * 64 + lane];
            float* mod = (float*)(F.ws + WS_MOD);
            mod[(size_t)(l * 3 + wave) * 6144 + n0 + lane] = s + F.b_ada[(size_t)l * 6144 + n0 + lane]; }
        __syncthreads();
    }
    { float* ct = (float*)(F.ws + WS_COS); float* st = (float*)(F.ws + WS_SIN);
      for (int i = (F.vcu * NWAVES * 64) + tid; i < SEQ * 64; i += F.G * NWAVES * 64) {
          const int t = i >> 6, j = i & 63, f = j & 31; const float pos = (float)((j < 32) ? (t >> 6) : (t & 63));
          const float inv = expf(-(float)f * (9.210340371976184f / 32.f)); const float ang = pos * inv;
          ct[i] = cosf(ang); st[i] = sinf(ang); } }
    LAS float* scr = (LAS float*)(F.lds + wave * 16384);
    constexpr int I_IN = (DM / 64) * (INC / 32), I_P = (DM / 64) * (DM / 32);
    bf16* WinT = (bf16*)(F.ws + WS_WINT); bf16* WpT = (bf16*)(F.ws + WS_WPT);
    GW_LOOP(it, I_IN + 6 * I_P) {
        if (it < I_IN) { p0_transpose_item(F.w_in, DM, INC, WinT, 0, scr, it, lane); continue; }
        const int r = it - I_IN, mi = r / I_P, ii = r % I_P, l = mi / 3, w = mi % 3;
        const float* W = (w == 0 ? F.w_pa : (w == 1 ? F.w_pb : F.w_out)) + (size_t)l * DM * DM;
        p0_transpose_item(W, DM, DM, WpT + (size_t)mi * DM * DM, 0, scr, ii, lane);
    }
}

__device__ __forceinline__ void ph_hnorm(Frame& F, int l, const float* xcur, const float* ctxcur) {
    FRESH_IDS
    bf16* H = (bf16*)(F.ws + WS_S0);
    const float* gp = F.g_pre + (size_t)l * DM;
    GW_LOOP(row, MROWS) {
        const int b = row / RPB, rr = row % RPB; const float* src; int v;
        if (rr < CTX) { src = ctxcur + (size_t)(b * CTX + rr) * DM; v = 2; } else { src = xcur + (size_t)(b * SEQ + rr - CTX) * DM; v = b; }
        const float* md = (const float*)(F.ws + WS_MOD) + (size_t)(l * 3 + v) * 6144;
        f32x4 xv[8]; float s = 0.f;
#pragma unroll
        for (int j = 0; j < 8; ++j) { xv[j] = ((const f32x4*)src)[lane + 64 * j]; s += (xv[j].x * xv[j].x + xv[j].y * xv[j].y) + (xv[j].z * xv[j].z + xv[j].w * xv[j].w); }
        const float rs = rsqrtf(wave_sum(s) * (1.f / DM) + EPS);
#pragma unroll
        for (int j = 0; j < 8; ++j) { const int q = lane + 64 * j;
            const f32x4 g = ((const f32x4*)gp)[q], sh = ((const f32x4*)md)[q], sc = ((const f32x4*)(md + DM))[q];
            const f32x4 y = (xv[j] * rs) * g * (sc + 1.f) + sh;
            v2u o; o.x = pk2(y.x, y.y); o.y = pk2(y.z, y.w);
            *(v2u*)(H + (size_t)row * DM + 4 * q) = o; }
    }
}

__device__ __forceinline__ void ph_rope(Frame& F) {
    FRESH_IDS
    bf16* PX = (bf16*)(F.ws + WS_PX);
    const float* ct = (const float*)(F.ws + WS_COS); const float* st = (const float*)(F.ws + WS_SIN);
    const unsigned total = (unsigned)NB * SEQ * 52 * 8;
    for (unsigned idx = (unsigned)(F.vcu * NWAVES * 64 + tid); idx < total; idx += (unsigned)(F.G * NWAVES * 64)) {
        const unsigned ch = idx & 7, hr = idx >> 3, hh = hr % 52, rowL = hr / 52, b = rowL / SEQ, t = rowL % SEQ;
        const int col = (hh < 4) ? (C_KA + hh * 128) : (hh < 20) ? (C_KB + (hh - 4) * 128) : (hh < 36) ? (C_QA + (hh - 20) * 128) : (C_QB + (hh - 36) * 128);
        bf16* p = PX + (size_t)(b * RPB + CTX + t) * INC + col + ch * 8;
        const v4u x1 = *(const v4u*)p, x2 = *(const v4u*)(p + 64);
        const f32x4 c0 = *(const f32x4*)(ct + t * 64 + ch * 8), c1 = *(const f32x4*)(ct + t * 64 + ch * 8 + 4);
        const f32x4 s0 = *(const f32x4*)(st + t * 64 + ch * 8), s1 = *(const f32x4*)(st + t * 64 + ch * 8 + 4);
        v4u y1, y2;
#define ROPE2(W, CA, SA, CB, SB) { const float a0 = bflo(x1.W), a1 = bfhi(x1.W), b0 = bflo(x2.W), b1 = bfhi(x2.W); \
            y1.W = pk2(a0 * CA - b0 * SA, a1 * CB - b1 * SB); y2.W = pk2(b0 * CA + a0 * SA, b1 * CB + a1 * SB); }
        ROPE2(x, c0.x, s0.x, c0.y, s0.y) ROPE2(y, c0.z, s0.z, c0.w, s0.w) ROPE2(z, c1.x, s1.x, c1.y, s1.y) ROPE2(w, c1.z, s1.z, c1.w, s1.w)
#undef ROPE2
        *(v4u*)p = y1; *(v4u*)(p + 64) = y2;
    }
}

__device__ __forceinline__ void ph_convert_win(Frame& F, int l) {
    FRESH_IDS
    LAS float* scr = (LAS float*)(F.lds + wave * 16384);
    constexpr int I_IN = (DM / 64) * (INC / 32);
    bf16* WinT = (bf16*)(F.ws + WS_WINT);
    GW_LOOP(it, I_IN) p0_transpose_item(F.w_in + (size_t)l * DM * INC, DM, INC, WinT, 0, scr, it, lane);
}

__device__ __forceinline__ void ph_attn(Frame& F, int l, char* lds) {
    const att::bf16* PX = (const att::bf16*)(F.ws + WS_PX);
    att::bf16* OA = (att::bf16*)(F.ws + WS_S0);
    att::bf16* OB0 = (att::bf16*)(F.ws + WS_S0 + SLOT);
    const float NINF = -INFINITY;
    const int nB = 2048, nA = 1024, nC = (l == 0) ? 96 : 0;
    for (int u = F.vcu; u < nB + nA + nC; u += F.G) {
        if (u < nB) {
            const int hd = u >> 5, qb = u & 31, b = hd >> 5, h8 = (hd >> 2) & 7, m = (hd >> 1) & 1, vh = hd & 1;
            const size_t qrow = (size_t)b * RPB + CTX + qb * 256, krow = (size_t)b * RPB;
            att::attn_body<false>(PX + qrow * INC + C_QB + (h8 * 2 + m) * 128, PX + krow * INC + C_KB + (h8 * 2 + m) * 128, PX + krow * INC + C_VB + h8 * 256 + vh * 128,
                                  OB0 + (size_t)m * (SLOT / 2) + qrow * DM + h8 * 256 + vh * 128, RPB / 64, RPB / 64, 0, 0, NINF, lds);
        } else if (u < nB + nA) {
            const int v = u - nB, b = v >> 9, hq = (v >> 5) & 15, qb = v & 31, kvh = hq >> 2, q0 = qb * 256;
            const int lo = (q0 - 128 > 0) ? q0 - 128 : 0, he = (q0 + 384 < SEQ) ? q0 + 384 : SEQ, nloc = (he - lo) >> 6;
            const size_t qrow = (size_t)b * RPB + CTX + q0, krow = (size_t)b * RPB;
            const float sk = F.sink[l * 16 + hq] * 1.4426950408889634f;
            att::attn_body<true>(PX + qrow * INC + C_QA + hq * 128, PX + krow * INC + C_KA + kvh * 128, PX + krow * INC + C_VA + kvh * 128,
                                 OA + qrow * DM + hq * 128, 4 + nloc, 4, lo, q0, sk, lds);
        } else {
            const int v = u - nB - nA;
            if (v < 64) {
                const int hd = v, b = hd >> 5, h8 = (hd >> 2) & 7, m = (hd >> 1) & 1, vh = hd & 1; const size_t krow = (size_t)b * RPB;
                att::attn_body<false>(PX + krow * INC + C_QB + (h8 * 2 + m) * 128, PX + krow * INC + C_KB + (h8 * 2 + m) * 128, PX + krow * INC + C_VB + h8 * 256 + vh * 128,
                                      OB0 + (size_t)m * (SLOT / 2) + krow * DM + h8 * 256 + vh * 128, 4, 4, 0, 0, NINF, lds);
            } else {
                const int w = v - 64, b = w >> 4, hq = w & 15, kvh = hq >> 2; const size_t krow = (size_t)b * RPB;
                const float sk = F.sink[l * 16 + hq] * 1.4426950408889634f;
                att::attn_body<false>(PX + krow * INC + C_QA + hq * 128, PX + krow * INC + C_KA + kvh * 128, PX + krow * INC + C_VA + kvh * 128,
                                      OA + krow * DM + hq * 128, 4, 4, 0, 0, sk, lds);
            }
        }
    }
}

__device__ __forceinline__ void ph_post(Frame& F, int l) {
    FRESH_IDS
    const bf16* PX = (const bf16*)(F.ws + WS_PX);
    const bf16* OA = (const bf16*)(F.ws + WS_S0); const bf16* OB0 = (const bf16*)(F.ws + WS_S0 + SLOT); const bf16* OB1 = (const bf16*)(F.ws + WS_S0 + 2 * SLOT);
    bf16* GA = (bf16*)(F.ws + WS_S0 + 3 * SLOT); bf16* GB = (bf16*)(F.ws + WS_S0 + 4 * SLOT);
    const float lam_init = 0.8f - 0.6f * expf(-0.3f * (float)l);
    const float* lq = F.lam_qk + (size_t)l * 512;
    const float d1 = wave_sum(lq[lane] * lq[128 + lane] + lq[64 + lane] * lq[192 + lane]);
    const float d2 = wave_sum(lq[256 + lane] * lq[384 + lane] + lq[320 + lane] * lq[448 + lane]);
    const float lam = expf(d1) - expf(d2) + lam_init;
    const f32x4 gs = ((const f32x4*)(F.g_subln + (size_t)l * 256))[lane] * (1.f - lam_init);
    GW_LOOP(row, MROWS) {
        if (l != 0 && (row % RPB) < CTX) continue;
        const size_t ro = (size_t)row * DM, rp = (size_t)row * INC;
#pragma unroll
        for (int j = 0; j < 8; ++j) { const int c = 4 * (lane + 64 * j);
            const v2u oa = *(const v2u*)(OA + ro + c), za = *(const v2u*)(PX + rp + C_ZA + c);
            v2u o; o.x = pk2(bflo(oa.x) * siluf(bflo(za.x)), bfhi(oa.x) * siluf(bfhi(za.x))); o.y = pk2(bflo(oa.y) * siluf(bflo(za.y)), bfhi(oa.y) * siluf(bfhi(za.y)));
            *(v2u*)(GA + ro + c) = o; }
#pragma unroll
        for (int j = 0; j < 8; ++j) { const int c = 256 * j + 4 * lane;
            const v2u o0 = *(const v2u*)(OB0 + ro + c), o1 = *(const v2u*)(OB1 + ro + c), zb = *(const v2u*)(PX + rp + C_ZB + c);
            f32x4 d; d.x = bflo(o0.x) - lam * bflo(o1.x); d.y = bfhi(o0.x) - lam * bfhi(o1.x); d.z = bflo(o0.y) - lam * bflo(o1.y); d.w = bfhi(o0.y) - lam * bfhi(o1.y);
            const float ss = wave_sum((d.x * d.x + d.y * d.y) + (d.z * d.z + d.w * d.w));
            const float rs = rsqrtf(ss * (1.f / 256.f) + EPS);
            const f32x4 y = d * rs * gs;
            v2u o; o.x = pk2(y.x * siluf(bflo(zb.x)), y.y * siluf(bfhi(zb.x))); o.y = pk2(y.z * siluf(bflo(zb.y)), y.w * siluf(bfhi(zb.y)));
            *(v2u*)(GB + ro + c) = o; }
    }
}

__device__ __forceinline__ void ph_merge(Frame& F, int l) {
    FRESH_IDS
    const bf16* PX = (const bf16*)(F.ws + WS_PX);
    const bf16* YA = (const bf16*)(F.ws + WS_S0); const bf16* YB = (const bf16*)(F.ws + WS_S0 + SLOT); bf16* MG = (bf16*)(F.ws + WS_S0 + 2 * SLOT);
    const unsigned total = (unsigned)MROWS * (DM / 8);
    for (unsigned i = (unsigned)(F.vcu * NWAVES * 64 + tid); i < total; i += (unsigned)(F.G * NWAVES * 64)) {
        const unsigned row = i >> 8, c = (i & 255) * 8;
        if (l != 0 && (row % RPB) < CTX) continue;
        const v4u ya = *(const v4u*)(YA + (size_t)row * DM + c), yb = *(const v4u*)(YB + (size_t)row * DM + c);
        const v4u ga = *(const v4u*)(PX + (size_t)row * INC + C_GA + c), gb = *(const v4u*)(PX + (size_t)row * INC + C_GB + c);
        v4u o;
#define MRG(W) o.W = pk2(sigmf(bflo(ga.W)) * bflo(ya.W) + sigmf(bflo(gb.W)) * bflo(yb.W), sigmf(bfhi(ga.W)) * bfhi(ya.W) + sigmf(bfhi(gb.W)) * bfhi(yb.W));
        MRG(x) MRG(y) MRG(z) MRG(w)
#undef MRG
        *(v4u*)(MG + (size_t)row * DM + c) = o;
    }
}

__device__ __forceinline__ void ph_res(Frame& F, int l, const float* xcur, const float* ctxcur) {
    FRESH_IDS
    const bf16* OX = (const bf16*)(F.ws + WS_S0 + 3 * SLOT);
    const float* gp = F.g_post + (size_t)l * DM;
    GW_LOOP(row, MROWS) {
        const int b = row / RPB, rr = row % RPB; const float* src; float* dst; int v;
        if (rr < CTX) { if (l != 0) continue; src = ctxcur + (size_t)(b * CTX + rr) * DM; dst = (float*)(F.ws + WS_CTX1) + (size_t)(b * CTX + rr) * DM; v = 2; }
        else { src = xcur + (size_t)(b * SEQ + rr - CTX) * DM; dst = F.out + (size_t)(b * SEQ + rr - CTX) * DM; v = b; }
        const float* gt = (const float*)(F.ws + WS_MOD) + (size_t)(l * 3 + v) * 6144 + 2 * DM;
        f32x4 ov[8]; float s = 0.f;
#pragma unroll
        for (int j = 0; j < 8; ++j) { const v2u w = *(const v2u*)(OX + (size_t)row * DM + 4 * (lane + 64 * j));
            ov[j] = (f32x4){bflo(w.x), bfhi(w.x), bflo(w.y), bfhi(w.y)}; s += (ov[j].x * ov[j].x + ov[j].y * ov[j].y) + (ov[j].z * ov[j].z + ov[j].w * ov[j].w); }
        const float rs = rsqrtf(wave_sum(s) * (1.f / DM) + EPS);
#pragma unroll
        for (int j = 0; j < 8; ++j) { const int q = lane + 64 * j;
            const f32x4 g = ((const f32x4*)gp)[q], gate = ((const f32x4*)gt)[q], xr = ((const f32x4*)src)[q];
            ((f32x4*)dst)[q] = xr + gate * ((ov[j] * rs) * g); }
    }
}

__device__ __forceinline__ void run_gemm(Frame& F, const bf16* A, const bf16* Bt, int N, bf16* O) {
    pg8::Gemm g{A, Bt, MROWS, N, DM}; pg8::StaticOrder S; S.init(MROWS, N, F.G, (int)blockIdx.x);
    pg8::EpiBf16 E{O, N};
    pg8::gemm_phase<pg8::EpiBf16, pg8::StaticOrder, true, true>(F.lds, g, S, E);
}

struct Args { const float* in[15]; float* out; unsigned char* ws; };
__global__ void __launch_bounds__(NWAVES * 64, 2) fwd_mega(Args args) {
    extern __shared__ __attribute__((aligned(16))) unsigned char lds[];
    cg::grid_group grid = cg::this_grid();
    Frame F;
    F.lds = (LAS unsigned char*)lds;
    F.G = gridDim.x; { const int bx = blockIdx.x; F.vcu = (F.G % 8 == 0) ? (bx % 8) * (F.G / 8) + bx / 8 : bx; }
    F.x = args.in[0]; F.c = args.in[1]; F.ctx = args.in[2]; F.c_ctx = args.in[3]; F.w_ada = args.in[4]; F.b_ada = args.in[5]; F.g_pre = args.in[6]; F.g_post = args.in[7];
    F.w_in = args.in[8]; F.sink = args.in[9]; F.lam_qk = args.in[10]; F.g_subln = args.in[11]; F.w_pa = args.in[12]; F.w_pb = args.in[13]; F.w_out = args.in[14];
    F.out = args.out; F.ws = args.ws;
    bf16* WinT = (bf16*)(F.ws + WS_WINT); bf16* WpT = (bf16*)(F.ws + WS_WPT); bf16* PX = (bf16*)(F.ws + WS_PX);
    bf16* S0 = (bf16*)(F.ws + WS_S0); bf16* S1 = (bf16*)(F.ws + WS_S0 + SLOT); bf16* S2 = (bf16*)(F.ws + WS_S0 + 2 * SLOT); bf16* S3 = (bf16*)(F.ws + WS_S0 + 3 * SLOT); bf16* S4 = (bf16*)(F.ws + WS_S0 + 4 * SLOT);

    ph_prologue(F);
    grid.sync();
#pragma unroll 1
    for (int l = 0; l < DEPTH; ++l) {
        const float* xcur = (l == 0) ? F.x : F.out;
        const float* ctxcur = (l == 0) ? F.ctx : (const float*)(F.ws + WS_CTX1);
        ph_hnorm(F, l, xcur, ctxcur);
        grid.sync();
        run_gemm(F, S0, WinT, INC, PX);
        grid.sync();
        ph_rope(F);
        if (l + 1 < DEPTH) ph_convert_win(F, l + 1);
        grid.sync();
        ph_attn(F, l, (char*)lds);
        grid.sync();
        ph_post(F, l);
        grid.sync();
        run_gemm(F, S3, WpT + (size_t)(l * 3 + 0) * DM * DM, DM, S0);
        run_gemm(F, S4, WpT + (size_t)(l * 3 + 1) * DM * DM, DM, S1);
        grid.sync();
        ph_merge(F, l);
        grid.sync();
        run_gemm(F, S2, WpT + (size_t)(l * 3 + 2) * DM * DM, DM, S3);
        grid.sync();
        ph_res(F, l, xcur, ctxcur);
        grid.sync();
    }
}

extern "C" void kernel_launch(void* const* d_in, const int* in_sizes, int n_in, void* d_out, int out_size, void* d_ws, size_t ws_size, hipStream_t stream) {
    static int grid = 0;
    if (grid == 0) {
        if (n_in != 15 || out_size != NB * SEQ * DM || ws_size < WS_END) { fprintf(stderr, "kernel_launch: unexpected shapes: n_in %d out %d ws %zu (need %zu)\n", n_in, out_size, ws_size, (size_t)WS_END); grid = -1; return; }
        int dev = 0, cus = 0, per_cu = 0;
        if (hipGetDevice(&dev) != hipSuccess || hipDeviceGetAttribute(&cus, hipDeviceAttributeMultiprocessorCount, dev) != hipSuccess) { grid = -1; return; }
        if (hipFuncSetAttribute((const void*)fwd_mega, hipFuncAttributeMaxDynamicSharedMemorySize, LDS_BYTES) != hipSuccess) { fprintf(stderr, "kernel_launch: hipFuncSetAttribute failed\n"); grid = -1; return; }
        if (hipOccupancyMaxActiveBlocksPerMultiprocessor(&per_cu, (const void*)fwd_mega, NWAVES * 64, LDS_BYTES) != hipSuccess || per_cu < 1) { fprintf(stderr, "kernel_launch: occupancy query says %d\n", per_cu); per_cu = 1; }
        (void)hipGetLastError();
        grid = cus * per_cu;
    }
    if (grid < 0) return;
    Args a{};
    for (int i = 0; i < 15; ++i) a.in[i] = (const float*)d_in[i];
    a.out = (float*)d_out; a.ws = (unsigned char*)d_ws;
    void* kargs[] = {&a};
    hipError_t e = hipLaunchCooperativeKernel((const void*)fwd_mega, dim3(grid), dim3(NWAVES * 64), kargs, LDS_BYTES, stream);
    if (e != hipSuccess) fprintf(stderr, "kernel_launch: cooperative launch failed: %s (grid %d)\n", hipGetErrorString(e), grid);
}
```

```cpp
#include <hip/hip_runtime.h>
#include <hip/hip_bf16.h>
#include <hip/hip_cooperative_groups.h>
#include <cstdio>
#include <cstdint>
#include <cmath>
namespace cg = cooperative_groups;

constexpr int DM = 2048, NB = 2, SEQ = 8192, DEPTH = 2, CTX = 256;
constexpr int RPB = CTX + SEQ;
constexpr int MROWS = NB * RPB;
constexpr int INC = 17408;
constexpr int C_KA = 0, C_VA = 512, C_KB = 1024, C_VB = 3072, C_QA = 5120, C_ZA = 7168, C_QB = 9216, C_ZB = 11264, C_GA = 13312, C_GB = 15360;
constexpr float EPS = 1e-6f;

namespace pg8 {
#define PG8_LAS __attribute__((address_space(3)))
typedef unsigned short bf16_t;
typedef short bf16x8 __attribute__((ext_vector_type(8)));
typedef float f32x4 __attribute__((ext_vector_type(4)));
typedef unsigned u32x4 __attribute__((ext_vector_type(4)));
constexpr int BM = 256, BK = 64, HALF = 128, HTB = HALF * BK * 2  , STAGE_BYTES = 8 * HTB, NXCD = 8, WGM = 8;

__host__ __device__ __forceinline__ int lds_byte(int r, int c) { const int st = (r >> 4) * 2 + (c >> 5), rr = r & 15, cc = c & 31, ob = rr * 64 + cc * 2; return st * 1024 + (ob ^ (((ob >> 9) & 1) << 5)); }
__host__ __device__ __forceinline__ void stage_rc(int b, int& R, int& C) { const int st = b / 1024, sb = b % 1024, swz = sb ^ (((sb >> 9) & 1) << 5); R = (st >> 1) * 16 + swz / 64; C = (st & 1) * 32 + (swz % 64) / 2; }
__host__ __device__ __forceinline__ int perm32(int rho) { const int n = rho >> 4, i = rho & 15; return 8 * (i >> 2) + 4 * n + (i & 3); }

struct Unit { int pm, pn; };
struct Gemm { const bf16_t* A; const bf16_t* Bt; int M, N, K; };

struct StaticOrder {
    int nM, nN, nwg, G, c;
    __host__ __device__ void init(int M, int N, int G_, int c_) { nM = M / BM; nN = N / BM; nwg = nM * nN; G = G_; c = c_; }
    __host__ __device__ bool next(int i, Unit& u) const {
        const long L = (long)i * G + c; if (L >= nwg) return false;
        int wgid = (int)L; { const int q = nwg / NXCD, r = nwg % NXCD, xcd = wgid % NXCD, off = wgid / NXCD; wgid = (xcd < r ? xcd * (q + 1) : r * (q + 1) + (xcd - r) * q) + off; }
        const int nig = WGM * nN, gid = wgid / nig, fm = gid * WGM, gsz = (nM - fm) < WGM ? (nM - fm) : WGM;
        u.pm = fm + ((wgid % nig) % gsz); u.pn = (wgid % nig) / gsz; return true;
    }
    __device__ __forceinline__ void a_ready(const Unit&) const {}
    __device__ __forceinline__ void done(const Unit&) const {}
};

__device__ __forceinline__ unsigned cvt_pk_bf16(float lo, float hi) { unsigned r; asm volatile("v_cvt_pk_bf16_f32 %0, %1, %2" : "=v"(r) : "v"(lo), "v"(hi)); return r; }
typedef float f32x2 __attribute__((ext_vector_type(2)));

struct EpiBf16 {
    static constexpr bool PERM = true, AFTER_DRAIN = false;
    bf16_t* O; int ldc;
    __device__ __forceinline__ void operator()(const f32x4 (&acc)[2][2][4][2], const Unit& u, int wr, int wc, int fr, int fq) const {
        const int row0 = u.pm * BM + wr * 64 + fr; const int col0 = u.pn * BM + wc * 32 + 8 * fq;
#pragma unroll
        for (int ai = 0; ai < 2; ++ai)
#pragma unroll
            for (int m = 0; m < 4; ++m) { bf16_t* rowp = O + (size_t)(row0 + ai * HALF + m * 16) * ldc + col0;
#pragma unroll
                for (int bj = 0; bj < 2; ++bj) { const f32x4 v0 = acc[ai][bj][m][0], v1 = acc[ai][bj][m][1];
                    u32x4 w; w.x = cvt_pk_bf16(v0[0], v0[1]); w.y = cvt_pk_bf16(v0[2], v0[3]); w.z = cvt_pk_bf16(v1[0], v1[1]); w.w = cvt_pk_bf16(v1[2], v1[3]);
                    *(u32x4*)(rowp + bj * HALF) = w; } }
    }
};

__device__ __forceinline__ float sigm_(float x) { return 1.f / (1.f + __expf(-x)); }
__device__ __forceinline__ float blo_(unsigned w) { return __builtin_bit_cast(float, w << 16); }
__device__ __forceinline__ float bhi_(unsigned w) { return __builtin_bit_cast(float, w & 0xffff0000u); }
template <bool ADD> struct EpiGate {
    static constexpr bool PERM = true, AFTER_DRAIN = false;
    bf16_t* O; const bf16_t* T; const bf16_t* G; int ldc; int ldg;
    __device__ __forceinline__ void operator()(const f32x4 (&acc)[2][2][4][2], const Unit& u, int wr, int wc, int fr, int fq) const {
        const int row0 = u.pm * BM + wr * 64 + fr; const int col0 = u.pn * BM + wc * 32 + 8 * fq;
#pragma unroll
        for (int ai = 0; ai < 2; ++ai)
#pragma unroll
            for (int m = 0; m < 4; ++m) { const size_t row = (size_t)(row0 + ai * HALF + m * 16);
#pragma unroll
                for (int bj = 0; bj < 2; ++bj) { const f32x4 v0 = acc[ai][bj][m][0], v1 = acc[ai][bj][m][1];
                    const u32x4 g = *(const u32x4*)(G + row * ldg + col0 + bj * HALF);
                    float r0 = sigm_(blo_(g.x)) * v0[0], r1 = sigm_(bhi_(g.x)) * v0[1], r2 = sigm_(blo_(g.y)) * v0[2], r3 = sigm_(bhi_(g.y)) * v0[3];
                    float r4 = sigm_(blo_(g.z)) * v1[0], r5 = sigm_(bhi_(g.z)) * v1[1], r6 = sigm_(blo_(g.w)) * v1[2], r7 = sigm_(bhi_(g.w)) * v1[3];
                    if (ADD) { const u32x4 t = *(const u32x4*)(T + row * ldc + col0 + bj * HALF);
                        r0 += blo_(t.x); r1 += bhi_(t.x); r2 += blo_(t.y); r3 += bhi_(t.y); r4 += blo_(t.z); r5 += bhi_(t.z); r6 += blo_(t.w); r7 += bhi_(t.w); }
                    u32x4 w; w.x = cvt_pk_bf16(r0, r1); w.y = cvt_pk_bf16(r2, r3); w.z = cvt_pk_bf16(r4, r5); w.w = cvt_pk_bf16(r6, r7);
                    *(u32x4*)(O + row * ldc + col0 + bj * HALF) = w; } }
    }
};
struct RowSkipOrder {
    StaticOrder base; bool skip;
    __device__ void init(int N, int G_, int c_, bool skip_) { skip = skip_; base.init(skip_ ? 16384 : 16896, N, G_, c_); }
    __device__ bool next(int i, Unit& u) const { if (!base.next(i, u)) return false; if (skip) u.pm += 1 + (u.pm >= 32 ? 1 : 0); return true; }
    __device__ __forceinline__ void a_ready(const Unit&) const {}
    __device__ __forceinline__ void done(const Unit&) const {}
};

template <class Epi, class Sched, bool ALIGN_EPI = false, bool SP2 = false>
__device__ __forceinline__ void gemm_phase(PG8_LAS unsigned char* lds, const Gemm g, const Sched& S, const Epi& E) {
    int tid_ = threadIdx.x; asm volatile("" : "+v"(tid_));
    const int tid = tid_, wid = __builtin_amdgcn_readfirstlane(tid >> 6), lane = tid & 63, wr = wid >> 2, wc = wid & 3, fr = lane & 15, fq = lane >> 4;
    const int K = g.K, nt = K / BK;
    unsigned voffA[2], voffB[2];
#pragma unroll
    for (int i = 0; i < 2; ++i) { int R, C; stage_rc(tid * 16 + i * 8192, R, C); const int Rb = Epi::PERM ? ((R & ~31) + perm32(R & 31)) : R;
        voffA[i] = (unsigned)(R * K + C) * 2u; voffB[i] = (unsigned)(Rb * K + C) * 2u; }
    const size_t kstep = (size_t)(BK * 2);
    const size_t hstep = (size_t)HALF * K * 2;
    const size_t tstep = 2 * hstep;
    const unsigned ldsw = (unsigned)wid * 1024u;
    const int aoff = lds_byte(wr * 64 + fr, fq * 8), boff = lds_byte(wc * 32 + fr, fq * 8);
#define PG8_SA(b, h) (((b) * 2 + (h)) * HTB)
#define PG8_SB(b, h) ((4 + (b) * 2 + (h)) * HTB)
#define PG8_STAGE(bufoff, gbase, voff) do { _Pragma("unroll") for (int _i = 0; _i < 2; ++_i) \
        __builtin_amdgcn_global_load_lds((const unsigned*)((const char*)(gbase) + (voff)[_i]), (PG8_LAS unsigned*)(lds + (bufoff) + ldsw + _i * 8192), 16, 0, 0); } while (0)
#define PG8_LDA(dst, b, h) do { _Pragma("unroll") for (int m = 0; m < 4; ++m) _Pragma("unroll") for (int k = 0; k < 2; ++k) dst[m][k] = *(const PG8_LAS bf16x8*)(lds + PG8_SA(b, h) + aoff + m * 2048 + k * 1024); } while (0)
#define PG8_LDB(dst, b, h) do { _Pragma("unroll") for (int n = 0; n < 2; ++n) _Pragma("unroll") for (int k = 0; k < 2; ++k) dst[n][k] = *(const PG8_LAS bf16x8*)(lds + PG8_SB(b, h) + boff + n * 2048 + k * 1024); } while (0)
#define PG8_MMA(ai, bj, At, Bt) do { __builtin_amdgcn_s_setprio(1); _Pragma("unroll") for (int m = 0; m < 4; ++m) _Pragma("unroll") for (int n = 0; n < 2; ++n) _Pragma("unroll") for (int k = 0; k < 2; ++k) \
        acc[ai][bj][m][n] = __builtin_amdgcn_mfma_f32_16x16x32_bf16(Bt[n][k], At[m][k], acc[ai][bj][m][n], 0, 0, 0); __builtin_amdgcn_s_setprio(0); } while (0)
#define PG8_WAIT_V(n) asm volatile("s_waitcnt vmcnt(" #n ")" ::: "memory")
#define PG8_WAIT_L(n) asm volatile("s_waitcnt lgkmcnt(" #n ")" ::: "memory")
#define PG8_BAR __builtin_amdgcn_s_barrier()
#define PG8_SCHED __builtin_amdgcn_sched_barrier(0)
    Unit cur, nxt; int ui = 0;
    if (!S.next(0, cur)) return;
    f32x4 acc[2][2][4][2];
#pragma unroll
    for (int a = 0; a < 2; ++a)
#pragma unroll
        for (int b = 0; b < 2; ++b)
#pragma unroll
            for (int m = 0; m < 4; ++m)
#pragma unroll
                for (int n = 0; n < 2; ++n) acc[a][b][m][n] = (f32x4){0.f, 0.f, 0.f, 0.f};
    bf16x8 At[4][2], B0[2][2], B1[2][2];
    const char* cA = (const char*)g.A + (size_t)cur.pm * tstep; const char* cB = (const char*)g.Bt + (size_t)cur.pn * tstep;
    S.a_ready(cur);
    if constexpr (SP2) {
        PG8_STAGE(PG8_SB(0, 0), cB, voffB); PG8_STAGE(PG8_SB(0, 1), cB + hstep, voffB); PG8_STAGE(PG8_SA(0, 0), cA, voffA); PG8_STAGE(PG8_SA(0, 1), cA + hstep, voffA);
        if (wr == 1) PG8_BAR;
        PG8_WAIT_V(2); PG8_BAR;
        PG8_STAGE(PG8_SB(1, 0), cB + kstep, voffB); PG8_STAGE(PG8_SA(1, 0), cA + kstep, voffA); PG8_STAGE(PG8_SB(1, 1), cB + hstep + kstep, voffB);
        PG8_WAIT_V(6); PG8_BAR;
    } else {
        PG8_STAGE(PG8_SB(0, 0), cB, voffB); PG8_STAGE(PG8_SA(0, 0), cA, voffA); PG8_STAGE(PG8_SB(0, 1), cB + hstep, voffB); PG8_STAGE(PG8_SA(0, 1), cA + hstep, voffA);
        if (wr == 1) PG8_BAR;
        PG8_WAIT_V(4); PG8_BAR;
        PG8_STAGE(PG8_SB(1, 0), cB + kstep, voffB); PG8_STAGE(PG8_SA(1, 0), cA + kstep, voffA); PG8_STAGE(PG8_SB(1, 1), cB + hstep + kstep, voffB);
        PG8_WAIT_V(6); PG8_BAR;
    }
    for (;;) {
        const bool has_next = S.next(ui + 1, nxt);
        const char* nA = has_next ? (const char*)g.A + (size_t)nxt.pm * tstep : cA; const char* nB = has_next ? (const char*)g.Bt + (size_t)nxt.pn * tstep : cB;
        for (int t = 0; t < nt; t += 2) {
            const bool last = (t == nt - 2);
            const char* a1 = cA + (size_t)(t + 1) * kstep;
            const char* a2 = last ? nA : cA + (size_t)(t + 2) * kstep; const char* b2 = last ? nB : cB + (size_t)(t + 2) * kstep;
            const char* a3 = a2 + kstep; const char* b3 = b2 + kstep;
            if (last && has_next) S.a_ready(nxt);
            if constexpr (SP2) {
            PG8_LDB(B0, 0, 0); PG8_LDB(B1, 0, 1); PG8_SCHED; PG8_LDA(At, 0, 0); PG8_STAGE(PG8_SA(1, 1), a1 + hstep, voffA);
            PG8_WAIT_V(8); PG8_WAIT_L(0); PG8_BAR; PG8_MMA(0, 0, At, B0); PG8_MMA(0, 1, At, B1); PG8_BAR; PG8_SCHED;
            PG8_LDA(At, 0, 1); PG8_STAGE(PG8_SB(0, 0), b2, voffB); PG8_STAGE(PG8_SB(0, 1), b2 + hstep, voffB); PG8_STAGE(PG8_SA(0, 0), a2, voffA);
            PG8_WAIT_V(8); PG8_WAIT_L(0); PG8_BAR; PG8_MMA(1, 0, At, B0); PG8_MMA(1, 1, At, B1); PG8_BAR; PG8_SCHED;
            PG8_LDB(B0, 1, 0); PG8_LDB(B1, 1, 1); PG8_SCHED; PG8_LDA(At, 1, 0); PG8_STAGE(PG8_SA(0, 1), a2 + hstep, voffA);
            PG8_WAIT_V(8); PG8_WAIT_L(0); PG8_BAR; PG8_MMA(0, 0, At, B0); PG8_MMA(0, 1, At, B1); PG8_BAR; PG8_SCHED;
            PG8_LDA(At, 1, 1); PG8_STAGE(PG8_SB(1, 0), b3, voffB); PG8_STAGE(PG8_SB(1, 1), b3 + hstep, voffB); PG8_STAGE(PG8_SA(1, 0), a3, voffA);
            PG8_WAIT_V(8); PG8_WAIT_L(0); PG8_BAR; PG8_MMA(1, 0, At, B0); PG8_MMA(1, 1, At, B1); PG8_BAR; PG8_SCHED;
            } else {
            PG8_LDB(B0, 0, 0); PG8_SCHED; PG8_LDA(At, 0, 0); PG8_STAGE(PG8_SA(1, 1), a1 + hstep, voffA);
            PG8_WAIT_L(8); PG8_BAR; PG8_WAIT_L(0); PG8_MMA(0, 0, At, B0); PG8_BAR; PG8_SCHED;
            PG8_LDB(B1, 0, 1); PG8_STAGE(PG8_SB(0, 0), b2, voffB);
            PG8_BAR; PG8_WAIT_L(0); PG8_MMA(0, 1, At, B1); PG8_BAR;
            PG8_LDA(At, 0, 1); PG8_STAGE(PG8_SA(0, 0), a2, voffA);
            PG8_BAR; PG8_WAIT_L(0); PG8_MMA(1, 0, At, B0); PG8_BAR; PG8_SCHED;
            PG8_STAGE(PG8_SB(0, 1), b2 + hstep, voffB);
            PG8_WAIT_V(6); PG8_BAR; PG8_MMA(1, 1, At, B1); PG8_BAR;
            PG8_LDB(B0, 1, 0); PG8_SCHED; PG8_LDA(At, 1, 0); PG8_STAGE(PG8_SA(0, 1), a2 + hstep, voffA);
            PG8_WAIT_L(8); PG8_BAR; PG8_WAIT_L(0); PG8_MMA(0, 0, At, B0); PG8_BAR; PG8_SCHED;
            PG8_LDB(B1, 1, 1); PG8_STAGE(PG8_SB(1, 0), b3, voffB);
            PG8_BAR; PG8_WAIT_L(0); PG8_MMA(0, 1, At, B1); PG8_BAR;
            PG8_LDA(At, 1, 1); PG8_STAGE(PG8_SA(1, 0), a3, voffA);
            PG8_BAR; PG8_WAIT_L(0); PG8_MMA(1, 0, At, B0); PG8_BAR; PG8_SCHED;
            PG8_STAGE(PG8_SB(1, 1), b3 + hstep, voffB);
            PG8_WAIT_V(6); PG8_BAR; PG8_MMA(1, 1, At, B1); PG8_BAR;
            }
        }
        if constexpr (ALIGN_EPI) { if (wr == 0) PG8_BAR; }
        if constexpr (!Epi::AFTER_DRAIN) { E(acc, cur, wr, wc, fr, fq); S.done(cur); }
        if (!has_next) break;
#pragma unroll
        for (int a = 0; a < 2; ++a)
#pragma unroll
            for (int b = 0; b < 2; ++b)
#pragma unroll
                for (int m = 0; m < 4; ++m)
#pragma unroll
                    for (int n = 0; n < 2; ++n) acc[a][b][m][n] = (f32x4){0.f, 0.f, 0.f, 0.f};
        cur = nxt; cA = nA; cB = nB; ++ui;
        if constexpr (ALIGN_EPI) { if (wr == 1) PG8_BAR; }
    }
    PG8_WAIT_V(0);
    if constexpr (!ALIGN_EPI) { if (wr == 0) PG8_BAR; }
    PG8_BAR;
    if constexpr (Epi::AFTER_DRAIN) { E.fused(acc, cur, wr, wc, fr, fq, lds, wid, lane); S.done(cur); }
#undef PG8_SA
#undef PG8_SB
#undef PG8_STAGE
#undef PG8_LDA
#undef PG8_LDB
#undef PG8_MMA
#undef PG8_WAIT_V
#undef PG8_WAIT_L
#undef PG8_BAR
#undef PG8_SCHED
}
}

namespace att {
using bf16 = unsigned short;
constexpr int D = 128, NW = 8, QBLK = 32, KVBLK = 64;
constexpr float SCALE = 0.088388347648318440f;
constexpr float THR = 8.f;
constexpr int SDEPTH = 2;
constexpr int LDQ = INC, LDK = INC, LDO = DM;
constexpr size_t SHM_V = KVBLK * D * 2, SHM_K = KVBLK * D * 2, SHM_ATTN = 2 * SHM_V + 2 * SHM_K + NW * 64 * 4;

using bf16x8 = __attribute__((ext_vector_type(8))) short;
using s16x4  = __attribute__((ext_vector_type(4))) short;
using f32x16 = __attribute__((ext_vector_type(16))) float;
using f32x8  = __attribute__((ext_vector_type(8))) float;
using u32x4  = __attribute__((ext_vector_type(4))) unsigned;
#define KSWZ(row, colB) ((row) * 256 + ((colB) ^ (((row) & 7) << 4)))
#define SBAR() __builtin_amdgcn_sched_barrier(0)
__device__ __forceinline__ int crow(int r, int hi) { return (r & 3) + 8 * (r >> 2) + 4 * hi; }
__device__ __forceinline__ unsigned cvtpk(float lo, float hi) {
  unsigned r; asm volatile("v_cvt_pk_bf16_f32 %0, %1, %2" : "=v"(r) : "v"(lo), "v"(hi)); return r;
}
template <typename TIn> struct Stage;
template <> struct Stage<bf16>  { using T = bf16x8;
  __device__ static __forceinline__ T ld8(const bf16* p) { return *reinterpret_cast<const bf16x8*>(p); }
  __device__ static __forceinline__ bf16x8 tobf(T x) { return x; } };
template <> struct Stage<float> { using T = f32x8;
  __device__ static __forceinline__ T ld8(const float* p) { return *reinterpret_cast<const f32x8*>(p); }
  __device__ static __forceinline__ bf16x8 tobf(T x) {
    u32x4 w = {cvtpk(x[0], x[1]), cvtpk(x[2], x[3]), cvtpk(x[4], x[5]), cvtpk(x[6], x[7])}; return *reinterpret_cast<bf16x8*>(&w); } };

__device__ __forceinline__ void partialSM(f32x16& p0, f32x16& p1, float& m_reg, float& mn, float& alpha) {
  constexpr float C = SCALE * 1.4426950408889634f;
  float pmax = p0[0]; for (int r = 1; r < 16; ++r) pmax = fmaxf(pmax, p0[r]); for (int r = 0; r < 16; ++r) pmax = fmaxf(pmax, p1[r]);
  { auto rr = __builtin_amdgcn_permlane32_swap(__float_as_uint(pmax), __float_as_uint(pmax), false, false);
    pmax = fmaxf(__uint_as_float(rr[0]), __uint_as_float(rr[1])); }
  if (__builtin_expect(__all(pmax - m_reg <= THR / SCALE), 1)) { mn = m_reg; alpha = 1.f; }
  else { mn = fmaxf(m_reg, pmax); alpha = __builtin_amdgcn_exp2f((m_reg - mn) * C); m_reg = mn; }
  float mnC = -mn * C;
  for (int r = 0; r < 16; ++r) p0[r] = fmaf(p0[r], C, mnC); for (int r = 0; r < 16; ++r) p1[r] = fmaf(p1[r], C, mnC);
  for (int r = 0; r < 16; ++r) p0[r] = __builtin_amdgcn_exp2f(p0[r]);
}
__device__ __forceinline__ void finishSM(f32x16& p0, f32x16& p1, float alpha, float& l_reg, bf16x8& pa0, bf16x8& pa1, bf16x8& pa2, bf16x8& pa3) {
  for (int r = 0; r < 16; ++r) p1[r] = __builtin_amdgcn_exp2f(p1[r]);
  float ps = 0; for (int r = 0; r < 16; ++r) ps += p0[r]; for (int r = 0; r < 16; ++r) ps += p1[r];
  { auto rr = __builtin_amdgcn_permlane32_swap(__float_as_uint(ps), __float_as_uint(ps), false, false);
    ps = __uint_as_float(rr[0]) + __uint_as_float(rr[1]); }
  l_reg = l_reg * alpha + ps;
#define PK4(P, BASE, OUT) do { unsigned a0 = cvtpk(P[BASE + 0], P[BASE + 1]), a1 = cvtpk(P[BASE + 2], P[BASE + 3]);   \
    unsigned b0 = cvtpk(P[BASE + 4], P[BASE + 5]), b1 = cvtpk(P[BASE + 6], P[BASE + 7]);                              \
    auto r0 = __builtin_amdgcn_permlane32_swap(a0, b0, false, false); auto r1 = __builtin_amdgcn_permlane32_swap(a1, b1, false, false); \
    u32x4 w = {r0[0], r1[0], r0[1], r1[1]}; OUT = *reinterpret_cast<bf16x8*>(&w); } while (0)
  PK4(p0, 0, pa0); PK4(p0, 8, pa1); PK4(p1, 0, pa2); PK4(p1, 8, pa3);
#undef PK4
}
__device__ __forceinline__ void qkt(f32x16& p0, f32x16& p1, const bf16* Ks, const bf16x8* qr, int r32, int hi) {
  p0 = f32x16{}; p1 = f32x16{};
  for (int d0 = 0; d0 < 8; ++d0) { int cb = (d0 * 16 + hi * 8) * 2;
    bf16x8 b0 = *reinterpret_cast<const bf16x8*>((const char*)Ks + KSWZ(r32, cb));
    bf16x8 b1 = *reinterpret_cast<const bf16x8*>((const char*)Ks + KSWZ(32 + r32, cb));
    p0 = __builtin_amdgcn_mfma_f32_32x32x16_bf16(b0, qr[d0], p0, 0, 0, 0);
    p1 = __builtin_amdgcn_mfma_f32_32x32x16_bf16(b1, qr[d0], p1, 0, 0, 0); }
}
__device__ __forceinline__ int v_st(int k, int c) { const int kk = (k & ~0xC) | ((k & 4) << 1) | ((k & 8) >> 1); return ((kk >> 3) * 4 + (c >> 5)) * 512 + ((kk & 7) * 32 + (c & 31)) * 2; }
__device__ __forceinline__ int v_rd_base(int lane) { return ((lane & 3) << 3) | (((lane >> 2) & 3) << 6) | (((lane >> 4) & 1) << 5) | (((lane >> 5) & 1) << 8); }
constexpr int v_rd_off(int d0, int ks, int half) { return d0 * 512 + ks * 4096 + half * 2048; }
template <int OFF> __device__ __forceinline__ s16x4 tr_read(int vb) {
  s16x4 r; asm volatile("ds_read_b64_tr_b16 %0, %1 offset:%2" : "=&v"(r) : "v"(vb), "i"(OFF) : "memory"); return r;
}
template <int D0> __device__ __forceinline__ void pv_one(f32x16& od, int vb, bf16x8 pa0, bf16x8 pa1, bf16x8 pa2, bf16x8 pa3) {
  const s16x4 l0 = tr_read<v_rd_off(D0, 0, 0)>(vb), h0 = tr_read<v_rd_off(D0, 0, 1)>(vb), l1 = tr_read<v_rd_off(D0, 1, 0)>(vb), h1 = tr_read<v_rd_off(D0, 1, 1)>(vb);
  const s16x4 l2 = tr_read<v_rd_off(D0, 2, 0)>(vb), h2 = tr_read<v_rd_off(D0, 2, 1)>(vb), l3 = tr_read<v_rd_off(D0, 3, 0)>(vb), h3 = tr_read<v_rd_off(D0, 3, 1)>(vb);
  asm volatile("s_waitcnt lgkmcnt(0)" ::: "memory"); SBAR();
#define PK(L, H) (bf16x8){L[0], L[1], L[2], L[3], H[0], H[1], H[2], H[3]}
  od = __builtin_amdgcn_mfma_f32_32x32x16_bf16(pa0, PK(l0, h0), od, 0, 0, 0);
  od = __builtin_amdgcn_mfma_f32_32x32x16_bf16(pa1, PK(l1, h1), od, 0, 0, 0);
  od = __builtin_amdgcn_mfma_f32_32x32x16_bf16(pa2, PK(l2, h2), od, 0, 0, 0);
  od = __builtin_amdgcn_mfma_f32_32x32x16_bf16(pa3, PK(l3, h3), od, 0, 0, 0);
#undef PK
}
__device__ __forceinline__ void pv_d0(f32x16* o, int vb, bf16x8 pa0, bf16x8 pa1, bf16x8 pa2, bf16x8 pa3) {
  pv_one<0>(o[0], vb, pa0, pa1, pa2, pa3); pv_one<1>(o[1], vb, pa0, pa1, pa2, pa3); pv_one<2>(o[2], vb, pa0, pa1, pa2, pa3); pv_one<3>(o[3], vb, pa0, pa1, pa2, pa3);
}

__device__ __forceinline__ void band_mask(f32x16& p0, f32x16& p1, int dq  , int hi) {
#pragma unroll
  for (int r = 0; r < 16; ++r) { const int d = dq - crow(r, hi);
    if ((unsigned)(d + 128) > 256u) p0[r] = -1e30f;
    if ((unsigned)(d + 96) > 256u) p1[r] = -1e30f; }
}
template <bool MASK>
__device__ __forceinline__ void attn_body(const bf16* __restrict__ Qb, const bf16* __restrict__ Kh, const bf16* __restrict__ Vh,
                                          bf16* __restrict__ Ob, int NT, int NCT, int lo, int qpos0, float sinkl2, char* lds) {
  using St = Stage<bf16>;
  int tid_ = threadIdx.x; asm volatile("" : "+v"(tid_));
  const int tid = tid_, wid = tid >> 6, lane = tid & 63, r32 = lane & 31, hi = lane >> 5;
  bf16* V_lds = (bf16*)lds; bf16* K_lds = (bf16*)(lds + 2 * SHM_V);
  float* ws = (float*)(lds + 2 * SHM_V + 2 * SHM_K) + wid * 64; float* li_l = ws; float* al_l = ws + 32;
  float m_reg = -1e30f, l_reg = 0; f32x16 o[4] = {}; bf16x8 qr[8];
  const bf16* Qw = Qb + (long)(wid * QBLK + r32) * LDQ + hi * 8;
#pragma unroll
  for (int d0 = 0; d0 < 8; ++d0) qr[d0] = St::ld8(Qw + d0 * 16);
  const int sr = tid >> 4, sc = (tid & 15) * 8, vst0 = v_st(sr, sc), vst1 = v_st(32 + sr, sc);
  const int vb0 = (int)(uintptr_t)V_lds + v_rd_base(lane);
  const int qi = qpos0 + wid * QBLK + r32;
  struct { typename St::T vs0, vs1, ks0, ks1; } sr_[SDEPTH];
#define TROW(j) (64 * (j) + ((j) >= NCT ? lo : 0))
#define SLOAD(i, k0) do { const long k0_ = (k0); sr_[i].vs0 = St::ld8(&Vh[(k0_ + sr) * LDK + sc]); sr_[i].vs1 = St::ld8(&Vh[(k0_ + 32 + sr) * LDK + sc]); \
    sr_[i].ks0 = St::ld8(&Kh[(k0_ + sr) * LDK + sc]); sr_[i].ks1 = St::ld8(&Kh[(k0_ + 32 + sr) * LDK + sc]); } while (0)
#define SWRITE(b, i) do { *(bf16x8*)((char*)V_lds + (b) * SHM_V + vst0) = St::tobf(sr_[i].vs0);          \
    *(bf16x8*)((char*)V_lds + (b) * SHM_V + vst1) = St::tobf(sr_[i].vs1); int kc = sc * 2;               \
    *(bf16x8*)((char*)K_lds + (b) * SHM_K + KSWZ(sr, kc)) = St::tobf(sr_[i].ks0);                       \
    *(bf16x8*)((char*)K_lds + (b) * SHM_K + KSWZ(32 + sr, kc)) = St::tobf(sr_[i].ks1); } while (0)
#define SWAIT() do { if constexpr (SDEPTH == 2) asm volatile("s_waitcnt vmcnt(4)" ::: "memory"); else asm volatile("s_waitcnt vmcnt(0)" ::: "memory"); } while (0)
#define RESC(a) do { if (__any((a) < 1.f)) { if (hi == 0) al_l[r32] = (a); asm volatile("s_waitcnt lgkmcnt(0)" ::: "memory"); \
    for (int d = 0; d < 4; ++d) for (int r = 0; r < 16; ++r) o[d][r] *= al_l[crow(r, hi)]; } } while (0)
#define AMASK(P0, P1, j) do { if constexpr (MASK) { if ((j) >= NCT) band_mask(P0, P1, qi - (lo + 64 * ((j) - NCT)), hi); } } while (0)
  f32x16 pA0, pA1, pB0, pB1; float mnA, mnB, alA, alB; bf16x8 pa0, pa1, pa2, pa3;
  constexpr int SE = 0, SO = SDEPTH - 1;
  SLOAD(SE, TROW(0)); asm volatile("s_waitcnt vmcnt(0)" ::: "memory"); SWRITE(0, SE); __syncthreads();
  qkt(pA0, pA1, K_lds, qr, r32, hi); AMASK(pA0, pA1, 0); partialSM(pA0, pA1, m_reg, mnA, alA);
  SLOAD(SO, TROW(1)); if constexpr (SDEPTH == 2) { if (2 < NT) SLOAD(SE, TROW(2)); }
  SWAIT(); SWRITE(1, SO); __syncthreads();
  for (int j = 1; j + 1 < NT; j += 2) {
    SBAR(); qkt(pB0, pB1, (bf16*)((char*)K_lds + SHM_K), qr, r32, hi); AMASK(pB0, pB1, j);
    finishSM(pA0, pA1, alA, l_reg, pa0, pa1, pa2, pa3); SBAR();
    SLOAD(SO, TROW(j + SDEPTH)); SBAR();
    pv_d0(o, vb0, pa0, pa1, pa2, pa3); partialSM(pB0, pB1, m_reg, mnB, alB);
    __syncthreads(); SWAIT(); SWRITE(0, SE);
    RESC(alB); __syncthreads();
    SBAR(); qkt(pA0, pA1, K_lds, qr, r32, hi); AMASK(pA0, pA1, j + 1);
    finishSM(pB0, pB1, alB, l_reg, pa0, pa1, pa2, pa3); SBAR();
    if (SDEPTH == 1 || j + 3 < NT) SLOAD(SE, TROW(j + 1 + SDEPTH)); SBAR();
    pv_d0(o, vb0 + (int)SHM_V, pa0, pa1, pa2, pa3); partialSM(pA0, pA1, m_reg, mnA, alA);
    __syncthreads(); SWAIT(); SWRITE(1, SO);
    RESC(alA); __syncthreads();
  }
  SBAR(); qkt(pB0, pB1, (bf16*)((char*)K_lds + SHM_K), qr, r32, hi); AMASK(pB0, pB1, NT - 1);
  finishSM(pA0, pA1, alA, l_reg, pa0, pa1, pa2, pa3); SBAR();
  pv_d0(o, vb0, pa0, pa1, pa2, pa3); partialSM(pB0, pB1, m_reg, mnB, alB);
  __syncthreads(); RESC(alB);
  finishSM(pB0, pB1, alB, l_reg, pa0, pa1, pa2, pa3); SBAR();
  pv_d0(o, vb0 + (int)SHM_V, pa0, pa1, pa2, pa3);
  l_reg += __builtin_amdgcn_exp2f(sinkl2 - m_reg * (SCALE * 1.4426950408889634f));
  if (hi == 0) li_l[r32] = l_reg; asm volatile("s_waitcnt lgkmcnt(0)" ::: "memory");
  float rli[16];
#pragma unroll
  for (int r = 0; r < 16; ++r) rli[r] = __builtin_amdgcn_rcpf(li_l[crow(r, hi)]);
  bf16* Ow = Ob + (long)(wid * QBLK) * LDO;
#pragma unroll
  for (int r = 0; r < 16; ++r) { int orow = crow(r, hi);
    for (int d0 = 0; d0 < 4; ++d0) { const float v = o[d0][r] * rli[r]; const unsigned u = __builtin_bit_cast(unsigned, v);
      Ow[(long)orow * LDO + d0 * 32 + r32] = (bf16)((u + 0x7fffu + ((u >> 16) & 1u)) >> 16); } }
  __syncthreads();
#undef TROW
#undef SLOAD
#undef SWRITE
#undef SWAIT
#undef RESC
#undef AMASK
}
}

constexpr size_t MiB = 1u << 20;
constexpr size_t SLOT = (size_t)MROWS * DM * 2;
constexpr size_t WS_MOD = 0;
constexpr size_t WS_COS = 2 * MiB, WS_SIN = 4 * MiB;
constexpr size_t WS_CTX1 = 6 * MiB;
constexpr size_t WS_WINT = 16 * MiB;
constexpr size_t WS_WPT = WS_WINT + 68 * MiB;
constexpr size_t WS_PX = WS_WPT + 48 * MiB;
constexpr size_t WS_S0 = WS_PX + (size_t)MROWS * INC * 2;
constexpr size_t WS_END = WS_S0 + 5 * SLOT;
static_assert(WS_END <= 4ull * DEPTH * DM * INC * 4, "workspace map exceeds the guaranteed 4x largest tensor");

constexpr int NWAVES = 8;
constexpr int LDS_BYTES = 147456;

#define GAS __attribute__((address_space(1)))
#define LAS __attribute__((address_space(3)))
typedef unsigned short bf16;
typedef unsigned v4u __attribute__((ext_vector_type(4)));
typedef unsigned v2u __attribute__((ext_vector_type(2)));
typedef float f32x4 __attribute__((ext_vector_type(4)));
#define LDS_WAIT() asm volatile("s_waitcnt lgkmcnt(0)" ::: "memory")
__device__ __forceinline__ unsigned f2bf(float f) { unsigned u = __builtin_bit_cast(unsigned, f); return (u + 0x7fffu + ((u >> 16) & 1u)) >> 16; }
__device__ __forceinline__ unsigned pk2(float lo, float hi) { return f2bf(lo) | (f2bf(hi) << 16); }
__device__ __forceinline__ float bflo(unsigned w) { return __builtin_bit_cast(float, w << 16); }
__device__ __forceinline__ float bfhi(unsigned w) { return __builtin_bit_cast(float, w & 0xffff0000u); }
__device__ __forceinline__ float siluf(float x) { return x / (1.f + __expf(-x)); }
__device__ __forceinline__ float sigmf(float x) { return 1.f / (1.f + __expf(-x)); }

struct Frame {
    LAS unsigned char* lds;
    int vcu, G;
    const float *x, *c, *ctx, *c_ctx, *w_ada, *b_ada, *g_pre, *g_post, *w_in, *sink, *lam_qk, *g_subln, *w_pa, *w_pb, *w_out;
    float* out; unsigned char* ws;
};

#define FRESH_IDS int tid_ = threadIdx.x; asm volatile("" : "+v"(tid_)); const int tid = tid_, lane = tid & 63, wave = __builtin_amdgcn_readfirstlane(tid >> 6); (void)lane; (void)wave;

__device__ __forceinline__ float wave_sum(float v) {
#pragma unroll
    for (int o = 1; o < 64; o <<= 1) v += __shfl_xor(v, o);
    return v;
}
__device__ __forceinline__ void p0_transpose_item(const float* W, int K, int N, bf16* WT, int row_off, LAS float* scr, int item, int lane) {
    const int nblk = N / 32, kb = item / nblk, nb = item % nblk, k0 = 64 * kb, n0 = 32 * nb;
#pragma unroll 8
    for (int i = 0; i < 32; ++i) { const int kk = 2 * i + (lane >> 5); scr[kk * 33 + (lane & 31)] = W[(size_t)(k0 + kk) * N + n0 + (lane & 31)]; }
    LDS_WAIT(); asm volatile("" ::: "memory");
    const int c = lane & 7;
#pragma unroll
    for (int j = 0; j < 4; ++j) { const int n = (lane >> 3) + 8 * j; const LAS float* s = scr + (8 * c) * 33 + n;
        v4u o; o.x = pk2(s[0 * 33], s[1 * 33]); o.y = pk2(s[2 * 33], s[3 * 33]); o.z = pk2(s[4 * 33], s[5 * 33]); o.w = pk2(s[6 * 33], s[7 * 33]);
        *(GAS v4u*)(WT + (size_t)(row_off + n0 + n) * K + k0 + 8 * c) = o; }
    LDS_WAIT(); asm volatile("" ::: "memory");
}

#define GW_LOOP(var, n) for (int var = F.vcu * NWAVES + wave; var < (n); var += F.G * NWAVES)

__device__ __forceinline__ void ph_prologue(Frame& F) {
    FRESH_IDS
    for (int ait = F.vcu; ait < 192; ait += F.G) {
        const int l = ait / 96, n0 = (ait % 96) * 64;
        LAS float* sv = (LAS float*)F.lds;
        LAS float* red = (LAS float*)(F.lds + 32768);
        for (int k = tid; k < DM; k += NWAVES * 64) { sv[k] = siluf(F.c[k]); sv[DM + k] = siluf(F.c[DM + k]); sv[2 * DM + k] = siluf(F.c_ctx[k]); }
        __syncthreads();
        const float* W = F.w_ada + (size_t)l * DM * 6144 + n0 + lane;
        float a0 = 0.f, a1 = 0.f, a2 = 0.f;
        const int kb = wave * 256;
#pragma unroll 8
        for (int k = 0; k < 256; ++k) { const float w = W[(size_t)(kb + k) * 6144]; a0 += sv[kb + k] * w; a1 += sv[DM + kb + k] * w; a2 += sv[2 * DM + kb + k] * w; }
        red[(wave * 3 + 0) * 64 + lane] = a0; red[(wave * 3 + 1) * 64 + lane] = a1; red[(wave * 3 + 2) * 64 + lane] = a2;
        __syncthreads();
        if (wave < 3) { float s = 0.f;
#pragma unroll
            for (int w = 0; w < 8; ++w) s += red[(w * 3 + wave) * 64 + lane];
            float* mod = (float*)(F.ws + WS_MOD);
            mod[(size_t)(l * 3 + wave) * 6144 + n0 + lane] = s + F.b_ada[(size_t)l * 6144 + n0 + lane]; }
        __syncthreads();
    }
    { float* ct = (float*)(F.ws + WS_COS); float* st = (float*)(F.ws + WS_SIN);
      for (int i = (F.vcu * NWAVES * 64) + tid; i < SEQ * 64; i += F.G * NWAVES * 64) {
          const int t = i >> 6, j = i & 63, f = j & 31; const float pos = (float)((j < 32) ? (t >> 6) : (t & 63));
          const float inv = expf(-(float)f * (9.210340371976184f / 32.f)); const float ang = pos * inv;
          ct[i] = cosf(ang); st[i] = sinf(ang); } }
    LAS float* scr = (LAS float*)(F.lds + wave * 16384);
    constexpr int I_IN = (DM / 64) * (INC / 32), I_P = (DM / 64) * (DM / 32);
    bf16* WinT = (bf16*)(F.ws + WS_WINT); bf16* WpT = (bf16*)(F.ws + WS_WPT);
    GW_LOOP(it, I_IN + 6 * I_P) {
        if (it < I_IN) { p0_transpose_item(F.w_in, DM, INC, WinT, 0, scr, it, lane); continue; }
        const int r = it - I_IN, mi = r / I_P, ii = r % I_P, l = mi / 3, w = mi % 3;
        const float* W = (w == 0 ? F.w_pa : (w == 1 ? F.w_pb : F.w_out)) + (size_t)l * DM * DM;
        p0_transpose_item(W, DM, DM, WpT + (size_t)mi * DM * DM, 0, scr, ii, lane);
    }
}

__device__ __forceinline__ void ph_hnorm(Frame& F, int l, const float* xcur, const float* ctxcur) {
    FRESH_IDS
    bf16* H = (bf16*)(F.ws + WS_S0);
    const float* gp = F.g_pre + (size_t)l * DM;
    GW_LOOP(row, MROWS) {
        const int b = row / RPB, rr = row % RPB; const float* src; int v;
        if (rr < CTX) { src = ctxcur + (size_t)(b * CTX + rr) * DM; v = 2; } else { src = xcur + (size_t)(b * SEQ + rr - CTX) * DM; v = b; }
        const float* md = (const float*)(F.ws + WS_MOD) + (size_t)(l * 3 + v) * 6144;
        f32x4 xv[8]; float s = 0.f;
#pragma unroll
        for (int j = 0; j < 8; ++j) { xv[j] = ((const f32x4*)src)[lane + 64 * j]; s += (xv[j].x * xv[j].x + xv[j].y * xv[j].y) + (xv[j].z * xv[j].z + xv[j].w * xv[j].w); }
        const float rs = rsqrtf(wave_sum(s) * (1.f / DM) + EPS);
#pragma unroll
        for (int j = 0; j < 8; ++j) { const int q = lane + 64 * j;
            const f32x4 g = ((const f32x4*)gp)[q], sh = ((const f32x4*)md)[q], sc = ((const f32x4*)(md + DM))[q];
            const f32x4 y = (xv[j] * rs) * g * (sc + 1.f) + sh;
            v2u o; o.x = pk2(y.x, y.y); o.y = pk2(y.z, y.w);
            *(v2u*)(H + (size_t)row * DM + 4 * q) = o; }
    }
}

__device__ __forceinline__ void ph_rope(Frame& F) {
    FRESH_IDS
    bf16* PX = (bf16*)(F.ws + WS_PX);
    const float* ct = (const float*)(F.ws + WS_COS); const float* st = (const float*)(F.ws + WS_SIN);
    const unsigned total = (unsigned)NB * SEQ * 52 * 8;
    for (unsigned idx = (unsigned)(F.vcu * NWAVES * 64 + tid); idx < total; idx += (unsigned)(F.G * NWAVES * 64)) {
        const unsigned ch = idx & 7, hr = idx >> 3, hh = hr % 52, rowL = hr / 52, b = rowL / SEQ, t = rowL % SEQ;
        const int col = (hh < 4) ? (C_KA + hh * 128) : (hh < 20) ? (C_KB + (hh - 4) * 128) : (hh < 36) ? (C_QA + (hh - 20) * 128) : (C_QB + (hh - 36) * 128);
        bf16* p = PX + (size_t)(b * RPB + CTX + t) * INC + col + ch * 8;
        const v4u x1 = *(const v4u*)p, x2 = *(const v4u*)(p + 64);
        const f32x4 c0 = *(const f32x4*)(ct + t * 64 + ch * 8), c1 = *(const f32x4*)(ct + t * 64 + ch * 8 + 4);
        const f32x4 s0 = *(const f32x4*)(st + t * 64 + ch * 8), s1 = *(const f32x4*)(st + t * 64 + ch * 8 + 4);
        v4u y1, y2;
#define ROPE2(W, CA, SA, CB, SB) { const float a0 = bflo(x1.W), a1 = bfhi(x1.W), b0 = bflo(x2.W), b1 = bfhi(x2.W); \
            y1.W = pk2(a0 * CA - b0 * SA, a1 * CB - b1 * SB); y2.W = pk2(b0 * CA + a0 * SA, b1 * CB + a1 * SB); }
        ROPE2(x, c0.x, s0.x, c0.y, s0.y) ROPE2(y, c0.z, s0.z, c0.w, s0.w) ROPE2(z, c1.x, s1.x, c1.y, s1.y) ROPE2(w, c1.z, s1.z, c1.w, s1.w)
#undef ROPE2
        *(v4u*)p = y1; *(v4u*)(p + 64) = y2;
    }
}

__device__ __forceinline__ void ph_convert_win(Frame& F, int l) {
    FRESH_IDS
    LAS float* scr = (LAS float*)(F.lds + wave * 16384);
    constexpr int I_IN = (DM / 64) * (INC / 32);
    bf16* WinT = (bf16*)(F.ws + WS_WINT);
    GW_LOOP(it, I_IN) p0_transpose_item(F.w_in + (size_t)l * DM * INC, DM, INC, WinT, 0, scr, it, lane);
}

__device__ __forceinline__ void ph_attn(Frame& F, int l, char* lds) {
    const att::bf16* PX = (const att::bf16*)(F.ws + WS_PX);
    att::bf16* OA = (att::bf16*)(F.ws + WS_S0);
    att::bf16* OB0 = (att::bf16*)(F.ws + WS_S0 + SLOT);
    const float NINF = -INFINITY;
    const int nB = 2048, nA = 1024, nC = (l == 0) ? 96 : 0;
    for (int u = F.vcu; u < nB + nA + nC; u += F.G) {
        if (u < nB) {
            const int hd = u >> 5, qb = u & 31, b = hd >> 5, h8 = (hd >> 2) & 7, m = (hd >> 1) & 1, vh = hd & 1;
            const size_t qrow = (size_t)b * RPB + CTX + qb * 256, krow = (size_t)b * RPB;
            att::attn_body<false>(PX + qrow * INC + C_QB + (h8 * 2 + m) * 128, PX + krow * INC + C_KB + (h8 * 2 + m) * 128, PX + krow * INC + C_VB + h8 * 256 + vh * 128,
                                  OB0 + (size_t)m * (SLOT / 2) + qrow * DM + h8 * 256 + vh * 128, RPB / 64, RPB / 64, 0, 0, NINF, lds);
        } else if (u < nB + nA) {
            const int v = u - nB, b = v >> 9, hq = (v >> 5) & 15, qb = v & 31, kvh = hq >> 2, q0 = qb * 256;
            const int lo = (q0 - 128 > 0) ? q0 - 128 : 0, he = (q0 + 384 < SEQ) ? q0 + 384 : SEQ, nloc = (he - lo) >> 6;
            const size_t qrow = (size_t)b * RPB + CTX + q0, krow = (size_t)b * RPB;
            const float sk = F.sink[l * 16 + hq] * 1.4426950408889634f;
            att::attn_body<true>(PX + qrow * INC + C_QA + hq * 128, PX + krow * INC + C_KA + kvh * 128, PX + krow * INC + C_VA + kvh * 128,
                                 OA + qrow * DM + hq * 128, 4 + nloc, 4, lo, q0, sk, lds);
        } else {
            const int v = u - nB - nA;
            if (v < 64) {
                const int hd = v, b = hd >> 5, h8 = (hd >> 2) & 7, m = (hd >> 1) & 1, vh = hd & 1; const size_t krow = (size_t)b * RPB;
                att::attn_body<false>(PX + krow * INC + C_QB + (h8 * 2 + m) * 128, PX + krow * INC + C_KB + (h8 * 2 + m) * 128, PX + krow * INC + C_VB + h8 * 256 + vh * 128,
                                      OB0 + (size_t)m * (SLOT / 2) + krow * DM + h8 * 256 + vh * 128, 4, 4, 0, 0, NINF, lds);
            } else {
                const int w = v - 64, b = w >> 4, hq = w & 15, kvh = hq >> 2; const size_t krow = (size_t)b * RPB;
                const float sk = F.sink[l * 16 + hq] * 1.4426950408889634f;
                att::attn_body<false>(PX + krow * INC + C_QA + hq * 128, PX + krow * INC + C_KA + kvh * 128, PX + krow * INC + C_VA + kvh * 128,
                                      OA + krow * DM + hq * 128, 4, 4, 0, 0, sk, lds);
            }
        }
    }
}

__device__ __forceinline__ void ph_post(Frame& F, int l) {
    FRESH_IDS
    const bf16* PX = (const bf16*)(F.ws + WS_PX);
    const bf16* OA = (const bf16*)(F.ws + WS_S0); const bf16* OB0 = (const bf16*)(F.ws + WS_S0 + SLOT); const bf16* OB1 = (const bf16*)(F.ws + WS_S0 + 2 * SLOT);
    bf16* GA = (bf16*)(F.ws + WS_S0 + 3 * SLOT); bf16* GB = (bf16*)(F.ws + WS_S0 + 4 * SLOT);
    const float lam_init = 0.8f - 0.6f * expf(-0.3f * (float)l);
    const float* lq = F.lam_qk + (size_t)l * 512;
    const float d1 = wave_sum(lq[lane] * lq[128 + lane] + lq[64 + lane] * lq[192 + lane]);
    const float d2 = wave_sum(lq[256 + lane] * lq[384 + lane] + lq[320 + lane] * lq[448 + lane]);
    const float lam = expf(d1) - expf(d2) + lam_init;
    const f32x4 gs = ((const f32x4*)(F.g_subln + (size_t)l * 256))[lane] * (1.f - lam_init);
    GW_LOOP(row, MROWS) {
        if (l != 0 && (row % RPB) < CTX) continue;
        const size_t ro = (size_t)row * DM, rp = (size_t)row * INC;
#pragma unroll
        for (int j = 0; j < 8; ++j) { const int c = 4 * (lane + 64 * j);
            const v2u oa = *(const v2u*)(OA + ro + c), za = *(const v2u*)(PX + rp + C_ZA + c);
            v2u o; o.x = pk2(bflo(oa.x) * siluf(bflo(za.x)), bfhi(oa.x) * siluf(bfhi(za.x))); o.y = pk2(bflo(oa.y) * siluf(bflo(za.y)), bfhi(oa.y) * siluf(bfhi(za.y)));
            *(v2u*)(GA + ro + c) = o; }
#pragma unroll
        for (int j = 0; j < 8; ++j) { const int c = 256 * j + 4 * lane;
            const v2u o0 = *(const v2u*)(OB0 + ro + c), o1 = *(const v2u*)(OB1 + ro + c), zb = *(const v2u*)(PX + rp + C_ZB + c);
            f32x4 d; d.x = bflo(o0.x) - lam * bflo(o1.x); d.y = bfhi(o0.x) - lam * bfhi(o1.x); d.z = bflo(o0.y) - lam * bflo(o1.y); d.w = bfhi(o0.y) - lam * bfhi(o1.y);
            const float ss = wave_sum((d.x * d.x + d.y * d.y) + (d.z * d.z + d.w * d.w));
            const float rs = rsqrtf(ss * (1.f / 256.f) + EPS);
            const f32x4 y = d * rs * gs;
            v2u o; o.x = pk2(y.x * siluf(bflo(zb.x)), y.y * siluf(bfhi(zb.x))); o.y = pk2(y.z * siluf(bflo(zb.y)), y.w * siluf(bfhi(zb.y)));
            *(v2u*)(GB + ro + c) = o; }
    }
}

__device__ __forceinline__ void ph_merge(Frame& F, int l) {
    FRESH_IDS
    const bf16* PX = (const bf16*)(F.ws + WS_PX);
    const bf16* YA = (const bf16*)(F.ws + WS_S0); const bf16* YB = (const bf16*)(F.ws + WS_S0 + SLOT); bf16* MG = (bf16*)(F.ws + WS_S0 + 2 * SLOT);
    const unsigned total = (unsigned)MROWS * (DM / 8);
    for (unsigned i = (unsigned)(F.vcu * NWAVES * 64 + tid); i < total; i += (unsigned)(F.G * NWAVES * 64)) {
        const unsigned row = i >> 8, c = (i & 255) * 8;
        if (l != 0 && (row % RPB) < CTX) continue;
        const v4u ya = *(const v4u*)(YA + (size_t)row * DM + c), yb = *(const v4u*)(YB + (size_t)row * DM + c);
        const v4u ga = *(const v4u*)(PX + (size_t)row * INC + C_GA + c), gb = *(const v4u*)(PX + (size_t)row * INC + C_GB + c);
        v4u o;
#define MRG(W) o.W = pk2(sigmf(bflo(ga.W)) * bflo(ya.W) + sigmf(bflo(gb.W)) * bflo(yb.W), sigmf(bfhi(ga.W)) * bfhi(ya.W) + sigmf(bfhi(gb.W)) * bfhi(yb.W));
        MRG(x) MRG(y) MRG(z) MRG(w)
#undef MRG
        *(v4u*)(MG + (size_t)row * DM + c) = o;
    }
}

__device__ __forceinline__ void ph_res(Frame& F, int l, const float* xcur, const float* ctxcur) {
    FRESH_IDS
    const bf16* OX = (const bf16*)(F.ws + WS_S0 + 3 * SLOT);
    const float* gp = F.g_post + (size_t)l * DM;
    GW_LOOP(row, MROWS) {
        const int b = row / RPB, rr = row % RPB; const float* src; float* dst; int v;
        if (rr < CTX) { if (l != 0) continue; src = ctxcur + (size_t)(b * CTX + rr) * DM; dst = (float*)(F.ws + WS_CTX1) + (size_t)(b * CTX + rr) * DM; v = 2; }
        else { src = xcur + (size_t)(b * SEQ + rr - CTX) * DM; dst = F.out + (size_t)(b * SEQ + rr - CTX) * DM; v = b; }
        const float* gt = (const float*)(F.ws + WS_MOD) + (size_t)(l * 3 + v) * 6144 + 2 * DM;
        f32x4 ov[8]; float s = 0.f;
#pragma unroll
        for (int j = 0; j < 8; ++j) { const v2u w = *(const v2u*)(OX + (size_t)row * DM + 4 * (lane + 64 * j));
            ov[j] = (f32x4){bflo(w.x), bfhi(w.x), bflo(w.y), bfhi(w.y)}; s += (ov[j].x * ov[j].x + ov[j].y * ov[j].y) + (ov[j].z * ov[j].z + ov[j].w * ov[j].w); }
        const float rs = rsqrtf(wave_sum(s) * (1.f / DM) + EPS);
#pragma unroll
        for (int j = 0; j < 8; ++j) { const int q = lane + 64 * j;
            const f32x4 g = ((const f32x4*)gp)[q], gate = ((const f32x4*)gt)[q], xr = ((const f32x4*)src)[q];
            ((f32x4*)dst)[q] = xr + gate * ((ov[j] * rs) * g); }
    }
}

__device__ __forceinline__ void run_gemm(Frame& F, const bf16* A, const bf16* Bt, int N, bf16* O) {
    pg8::Gemm g{A, Bt, MROWS, N, DM}; pg8::RowSkipOrder S; S.init(N, F.G, (int)blockIdx.x, false);
    pg8::EpiBf16 E{O, N};
    pg8::gemm_phase<pg8::EpiBf16, pg8::RowSkipOrder, true, true>(F.lds, g, S, E);
}
__device__ __forceinline__ void run_gemm_skip(Frame& F, const bf16* A, const bf16* Bt, bf16* O, bool skip) {
    pg8::Gemm g{A, Bt, MROWS, DM, DM}; pg8::RowSkipOrder S; S.init(DM, F.G, (int)blockIdx.x, skip);
    pg8::EpiBf16 E{O, DM};
    pg8::gemm_phase<pg8::EpiBf16, pg8::RowSkipOrder, true, true>(F.lds, g, S, E);
}
template <bool ADD>
__device__ __forceinline__ void run_gemm_gate(Frame& F, const bf16* A, const bf16* Bt, bf16* O, const bf16* T, const bf16* G, bool skip) {
    pg8::Gemm g{A, Bt, MROWS, DM, DM}; pg8::RowSkipOrder S; S.init(DM, F.G, (int)blockIdx.x, skip);
    pg8::EpiGate<ADD> E{O, T, G, DM, INC};
    pg8::gemm_phase<pg8::EpiGate<ADD>, pg8::RowSkipOrder, true, true>(F.lds, g, S, E);
}

struct Args { const float* in[15]; float* out; unsigned char* ws; };
__global__ void __launch_bounds__(NWAVES * 64, 2) fwd_mega(Args args) {
    extern __shared__ __attribute__((aligned(16))) unsigned char lds[];
    cg::grid_group grid = cg::this_grid();
    Frame F;
    F.lds = (LAS unsigned char*)lds;
    F.G = gridDim.x; { const int bx = blockIdx.x; F.vcu = (F.G % 8 == 0) ? (bx % 8) * (F.G / 8) + bx / 8 : bx; }
    F.x = args.in[0]; F.c = args.in[1]; F.ctx = args.in[2]; F.c_ctx = args.in[3]; F.w_ada = args.in[4]; F.b_ada = args.in[5]; F.g_pre = args.in[6]; F.g_post = args.in[7];
    F.w_in = args.in[8]; F.sink = args.in[9]; F.lam_qk = args.in[10]; F.g_subln = args.in[11]; F.w_pa = args.in[12]; F.w_pb = args.in[13]; F.w_out = args.in[14];
    F.out = args.out; F.ws = args.ws;
    bf16* WinT = (bf16*)(F.ws + WS_WINT); bf16* WpT = (bf16*)(F.ws + WS_WPT); bf16* PX = (bf16*)(F.ws + WS_PX);
    bf16* S0 = (bf16*)(F.ws + WS_S0); bf16* S1 = (bf16*)(F.ws + WS_S0 + SLOT); bf16* S2 = (bf16*)(F.ws + WS_S0 + 2 * SLOT); bf16* S3 = (bf16*)(F.ws + WS_S0 + 3 * SLOT); bf16* S4 = (bf16*)(F.ws + WS_S0 + 4 * SLOT);

    ph_prologue(F);
    grid.sync();
#pragma unroll 1
    for (int l = 0; l < DEPTH; ++l) {
        const float* xcur = (l == 0) ? F.x : F.out;
        const float* ctxcur = (l == 0) ? F.ctx : (const float*)(F.ws + WS_CTX1);
        ph_hnorm(F, l, xcur, ctxcur);
        grid.sync();
        run_gemm(F, S0, WinT, INC, PX);
        grid.sync();
        ph_rope(F);
        if (l + 1 < DEPTH) ph_convert_win(F, l + 1);
        grid.sync();
        ph_attn(F, l, (char*)lds);
        grid.sync();
        ph_post(F, l);
        grid.sync();
        run_gemm_gate<false>(F, S3, WpT + (size_t)(l * 3 + 0) * DM * DM, S0, S0, PX + C_GA, l != 0);
        run_gemm_gate<true>(F, S4, WpT + (size_t)(l * 3 + 1) * DM * DM, S2, S0, PX + C_GB, l != 0);
        grid.sync();
        run_gemm_skip(F, S2, WpT + (size_t)(l * 3 + 2) * DM * DM, S3, l != 0);
        grid.sync();
        ph_res(F, l, xcur, ctxcur);
        grid.sync();
    }
}

extern "C" void kernel_launch(void* const* d_in, const int* in_sizes, int n_in, void* d_out, int out_size, void* d_ws, size_t ws_size, hipStream_t stream) {
    static int grid = 0;
    if (grid == 0) {
        if (n_in != 15 || out_size != NB * SEQ * DM || ws_size < WS_END) { fprintf(stderr, "kernel_launch: unexpected shapes: n_in %d out %d ws %zu (need %zu)\n", n_in, out_size, ws_size, (size_t)WS_END); grid = -1; return; }
        int dev = 0, cus = 0, per_cu = 0;
        if (hipGetDevice(&dev) != hipSuccess || hipDeviceGetAttribute(&cus, hipDeviceAttributeMultiprocessorCount, dev) != hipSuccess) { grid = -1; return; }
        if (hipFuncSetAttribute((const void*)fwd_mega, hipFuncAttributeMaxDynamicSharedMemorySize, LDS_BYTES) != hipSuccess) { fprintf(stderr, "kernel_launch: hipFuncSetAttribute failed\n"); grid = -1; return; }
        if (hipOccupancyMaxActiveBlocksPerMultiprocessor(&per_cu, (const void*)fwd_mega, NWAVES * 64, LDS_BYTES) != hipSuccess || per_cu < 1) { fprintf(stderr, "kernel_launch: occupancy query says %d\n", per_cu); per_cu = 1; }
        (void)hipGetLastError();
        grid = cus * per_cu;
    }
    if (grid < 0) return;
    Args a{};
    for (int i = 0; i < 15; ++i) a.in[i] = (const float*)d_in[i];
    a.out = (float*)d_out; a.ws = (unsigned char*)d_ws;
    void* kargs[] = {&a};
    hipError_t e = hipLaunchCooperativeKernel((const void*)fwd_mega, dim3(grid), dim3(NWAVES * 64), kargs, LDS_BYTES, stream);
    if (e != hipSuccess) fprintf(stderr, "kernel_launch: cooperative launch failed: %s (grid %d)\n", hipGetErrorString(e), grid);
}
```

```cpp
#include <hip/hip_runtime.h>
#include <hip/hip_bf16.h>
#include <hip/hip_cooperative_groups.h>
#include <cstdio>
#include <cstdint>
#include <cmath>
namespace cg = cooperative_groups;

constexpr int DM = 2048, NB = 2, SEQ = 8192, DEPTH = 2, CTX = 256;
constexpr int RPB = CTX + SEQ;
constexpr int MROWS = NB * RPB;
constexpr int INC = 17408;
constexpr int C_KA = 0, C_VA = 512, C_KB = 1024, C_VB = 3072, C_QA = 5120, C_ZA = 7168, C_QB = 9216, C_ZB = 11264, C_GA = 13312, C_GB = 15360;
constexpr float EPS = 1e-6f;

namespace pg8 {
#define PG8_LAS __attribute__((address_space(3)))
typedef unsigned short bf16_t;
typedef short bf16x8 __attribute__((ext_vector_type(8)));
typedef float f32x4 __attribute__((ext_vector_type(4)));
typedef unsigned u32x4 __attribute__((ext_vector_type(4)));
constexpr int BM = 256, BK = 64, HALF = 128, HTB = HALF * BK * 2  , STAGE_BYTES = 8 * HTB, NXCD = 8, WGM = 8;

__host__ __device__ __forceinline__ int lds_byte(int r, int c) { const int st = (r >> 4) * 2 + (c >> 5), rr = r & 15, cc = c & 31, ob = rr * 64 + cc * 2; return st * 1024 + (ob ^ (((ob >> 9) & 1) << 5)); }
__host__ __device__ __forceinline__ void stage_rc(int b, int& R, int& C) { const int st = b / 1024, sb = b % 1024, swz = sb ^ (((sb >> 9) & 1) << 5); R = (st >> 1) * 16 + swz / 64; C = (st & 1) * 32 + (swz % 64) / 2; }
__host__ __device__ __forceinline__ int perm32(int rho) { const int n = rho >> 4, i = rho & 15; return 8 * (i >> 2) + 4 * n + (i & 3); }

struct Unit { int pm, pn; };
struct Gemm { const bf16_t* A; const bf16_t* Bt; int M, N, K; };

struct StaticOrder {
    int nM, nN, nwg, G, c;
    __host__ __device__ void init(int M, int N, int G_, int c_) { nM = M / BM; nN = N / BM; nwg = nM * nN; G = G_; c = c_; }
    __host__ __device__ bool next(int i, Unit& u) const {
        const long L = (long)i * G + c; if (L >= nwg) return false;
        int wgid = (int)L; { const int q = nwg / NXCD, r = nwg % NXCD, xcd = wgid % NXCD, off = wgid / NXCD; wgid = (xcd < r ? xcd * (q + 1) : r * (q + 1) + (xcd - r) * q) + off; }
        const int nig = WGM * nN, gid = wgid / nig, fm = gid * WGM, gsz = (nM - fm) < WGM ? (nM - fm) : WGM;
        u.pm = fm + ((wgid % nig) % gsz); u.pn = (wgid % nig) / gsz; return true;
    }
    __device__ __forceinline__ void a_ready(const Unit&) const {}
    __device__ __forceinline__ void done(const Unit&) const {}
};

__device__ __forceinline__ unsigned cvt_pk_bf16(float lo, float hi) { unsigned r; asm volatile("v_cvt_pk_bf16_f32 %0, %1, %2" : "=v"(r) : "v"(lo), "v"(hi)); return r; }
typedef float f32x2 __attribute__((ext_vector_type(2)));

struct EpiBf16 {
    static constexpr bool PERM = true, AFTER_DRAIN = false;
    bf16_t* O; int ldc;
    __device__ __forceinline__ void operator()(const f32x4 (&acc)[2][2][4][2], const Unit& u, int wr, int wc, int fr, int fq) const {
        const int row0 = u.pm * BM + wr * 64 + fr; const int col0 = u.pn * BM + wc * 32 + 8 * fq;
#pragma unroll
        for (int ai = 0; ai < 2; ++ai)
#pragma unroll
            for (int m = 0; m < 4; ++m) { bf16_t* rowp = O + (size_t)(row0 + ai * HALF + m * 16) * ldc + col0;
#pragma unroll
                for (int bj = 0; bj < 2; ++bj) { const f32x4 v0 = acc[ai][bj][m][0], v1 = acc[ai][bj][m][1];
                    u32x4 w; w.x = cvt_pk_bf16(v0[0], v0[1]); w.y = cvt_pk_bf16(v0[2], v0[3]); w.z = cvt_pk_bf16(v1[0], v1[1]); w.w = cvt_pk_bf16(v1[2], v1[3]);
                    *(u32x4*)(rowp + bj * HALF) = w; } }
    }
};

__device__ __forceinline__ float sigm_(float x) { return 1.f / (1.f + __expf(-x)); }
__device__ __forceinline__ float blo_(unsigned w) { return __builtin_bit_cast(float, w << 16); }
__device__ __forceinline__ float bhi_(unsigned w) { return __builtin_bit_cast(float, w & 0xffff0000u); }
template <bool ADD> struct EpiGate {
    static constexpr bool PERM = true, AFTER_DRAIN = false;
    bf16_t* O; const bf16_t* T; const bf16_t* G; int ldc; int ldg;
    __device__ __forceinline__ void operator()(const f32x4 (&acc)[2][2][4][2], const Unit& u, int wr, int wc, int fr, int fq) const {
        const int row0 = u.pm * BM + wr * 64 + fr; const int col0 = u.pn * BM + wc * 32 + 8 * fq;
#pragma unroll
        for (int ai = 0; ai < 2; ++ai)
#pragma unroll
            for (int m = 0; m < 4; ++m) { const size_t row = (size_t)(row0 + ai * HALF + m * 16);
#pragma unroll
                for (int bj = 0; bj < 2; ++bj) { const f32x4 v0 = acc[ai][bj][m][0], v1 = acc[ai][bj][m][1];
                    const u32x4 g = *(const u32x4*)(G + row * ldg + col0 + bj * HALF);
                    float r0 = sigm_(blo_(g.x)) * v0[0], r1 = sigm_(bhi_(g.x)) * v0[1], r2 = sigm_(blo_(g.y)) * v0[2], r3 = sigm_(bhi_(g.y)) * v0[3];
                    float r4 = sigm_(blo_(g.z)) * v1[0], r5 = sigm_(bhi_(g.z)) * v1[1], r6 = sigm_(blo_(g.w)) * v1[2], r7 = sigm_(bhi_(g.w)) * v1[3];
                    if (ADD) { const u32x4 t = *(const u32x4*)(T + row * ldc + col0 + bj * HALF);
                        r0 += blo_(t.x); r1 += bhi_(t.x); r2 += blo_(t.y); r3 += bhi_(t.y); r4 += blo_(t.z); r5 += bhi_(t.z); r6 += blo_(t.w); r7 += bhi_(t.w); }
                    u32x4 w; w.x = cvt_pk_bf16(r0, r1); w.y = cvt_pk_bf16(r2, r3); w.z = cvt_pk_bf16(r4, r5); w.w = cvt_pk_bf16(r6, r7);
                    *(u32x4*)(O + row * ldc + col0 + bj * HALF) = w; } }
    }
};
struct RowSkipOrder {
    StaticOrder base; bool skip;
    __device__ void init(int N, int G_, int c_, bool skip_) { skip = skip_; base.init(skip_ ? 16384 : 16896, N, G_, c_); }
    __device__ bool next(int i, Unit& u) const { if (!base.next(i, u)) return false; if (skip) u.pm += 1 + (u.pm >= 32 ? 1 : 0); return true; }
    __device__ __forceinline__ void a_ready(const Unit&) const {}
    __device__ __forceinline__ void done(const Unit&) const {}
};

struct EpiRope {
    static constexpr bool PERM = true, AFTER_DRAIN = false;
    bf16_t* O; int ldc; const float* ct; const float* st;
    __device__ __forceinline__ void operator()(const f32x4 (&acc)[2][2][4][2], const Unit& u, int wr, int wc, int fr, int fq) const {
        const int pn = u.pn; const bool rope = pn < 2 || (pn >= 4 && pn < 12) || (pn >= 20 && pn < 28) || (pn >= 36 && pn < 44);
        const int row0 = u.pm * BM + wr * 64 + fr;
        if (!rope) {
            const int col0 = pn * BM + wc * 32 + 8 * fq;
#pragma unroll
            for (int ai = 0; ai < 2; ++ai)
#pragma unroll
                for (int m = 0; m < 4; ++m) { bf16_t* rowp = O + (size_t)(row0 + ai * HALF + m * 16) * ldc + col0;
#pragma unroll
                    for (int bj = 0; bj < 2; ++bj) { const f32x4 v0 = acc[ai][bj][m][0], v1 = acc[ai][bj][m][1];
                        u32x4 w; w.x = cvt_pk_bf16(v0[0], v0[1]); w.y = cvt_pk_bf16(v0[2], v0[3]); w.z = cvt_pk_bf16(v1[0], v1[1]); w.w = cvt_pk_bf16(v1[2], v1[3]);
                        *(u32x4*)(rowp + bj * HALF) = w; } }
            return;
        }
        const bool isctx = (u.pm == 0) || (u.pm == 33);
        const int i0 = 32 * (wc & 1) + 8 * fq, ocol = pn * BM + (wc >> 1) * 128 + i0;
        const int tbase = row0 - (u.pm >= 33 ? 8448 : 0) - 256;
#pragma unroll
        for (int ai = 0; ai < 2; ++ai)
#pragma unroll
            for (int m = 0; m < 4; ++m) { const int t = tbase + ai * HALF + m * 16;
                f32x4 c0 = {1.f, 1.f, 1.f, 1.f}, c1 = c0, s0 = {0.f, 0.f, 0.f, 0.f}, s1 = s0;
                if (!isctx) { const float* cp = ct + (size_t)t * 64 + i0; const float* sp = st + (size_t)t * 64 + i0;
                    c0 = *(const f32x4*)cp; c1 = *(const f32x4*)(cp + 4); s0 = *(const f32x4*)sp; s1 = *(const f32x4*)(sp + 4); }
                const f32x4 a0 = acc[ai][0][m][0], a1 = acc[ai][0][m][1], b0 = acc[ai][1][m][0], b1 = acc[ai][1][m][1];
                const f32x4 y0 = a0 * c0 - b0 * s0, y1 = a1 * c1 - b1 * s1, z0 = b0 * c0 + a0 * s0, z1 = b1 * c1 + a1 * s1;
                bf16_t* rowp = O + (size_t)(row0 + ai * HALF + m * 16) * ldc + ocol;
                u32x4 w; w.x = cvt_pk_bf16(y0[0], y0[1]); w.y = cvt_pk_bf16(y0[2], y0[3]); w.z = cvt_pk_bf16(y1[0], y1[1]); w.w = cvt_pk_bf16(y1[2], y1[3]);
                *(u32x4*)rowp = w;
                u32x4 x; x.x = cvt_pk_bf16(z0[0], z0[1]); x.y = cvt_pk_bf16(z0[2], z0[3]); x.z = cvt_pk_bf16(z1[0], z1[1]); x.w = cvt_pk_bf16(z1[2], z1[3]);
                *(u32x4*)(rowp + 64) = x; }
    }
};

template <class Epi, class Sched, bool ALIGN_EPI = false, bool SP2 = false>
__device__ __forceinline__ void gemm_phase(PG8_LAS unsigned char* lds, const Gemm g, const Sched& S, const Epi& E) {
    int tid_ = threadIdx.x; asm volatile("" : "+v"(tid_));
    const int tid = tid_, wid = __builtin_amdgcn_readfirstlane(tid >> 6), lane = tid & 63, wr = wid >> 2, wc = wid & 3, fr = lane & 15, fq = lane >> 4;
    const int K = g.K, nt = K / BK;
    unsigned voffA[2], voffB[2];
#pragma unroll
    for (int i = 0; i < 2; ++i) { int R, C; stage_rc(tid * 16 + i * 8192, R, C); const int Rb = Epi::PERM ? ((R & ~31) + perm32(R & 31)) : R;
        voffA[i] = (unsigned)(R * K + C) * 2u; voffB[i] = (unsigned)(Rb * K + C) * 2u; }
    const size_t kstep = (size_t)(BK * 2);
    const size_t hstep = (size_t)HALF * K * 2;
    const size_t tstep = 2 * hstep;
    const unsigned ldsw = (unsigned)wid * 1024u;
    const int aoff = lds_byte(wr * 64 + fr, fq * 8), boff = lds_byte(wc * 32 + fr, fq * 8);
#define PG8_SA(b, h) (((b) * 2 + (h)) * HTB)
#define PG8_SB(b, h) ((4 + (b) * 2 + (h)) * HTB)
#define PG8_STAGE(bufoff, gbase, voff) do { _Pragma("unroll") for (int _i = 0; _i < 2; ++_i) \
        __builtin_amdgcn_global_load_lds((const unsigned*)((const char*)(gbase) + (voff)[_i]), (PG8_LAS unsigned*)(lds + (bufoff) + ldsw + _i * 8192), 16, 0, 0); } while (0)
#define PG8_LDA(dst, b, h) do { _Pragma("unroll") for (int m = 0; m < 4; ++m) _Pragma("unroll") for (int k = 0; k < 2; ++k) dst[m][k] = *(const PG8_LAS bf16x8*)(lds + PG8_SA(b, h) + aoff + m * 2048 + k * 1024); } while (0)
#define PG8_LDB(dst, b, h) do { _Pragma("unroll") for (int n = 0; n < 2; ++n) _Pragma("unroll") for (int k = 0; k < 2; ++k) dst[n][k] = *(const PG8_LAS bf16x8*)(lds + PG8_SB(b, h) + boff + n * 2048 + k * 1024); } while (0)
#define PG8_MMA(ai, bj, At, Bt) do { __builtin_amdgcn_s_setprio(1); _Pragma("unroll") for (int m = 0; m < 4; ++m) _Pragma("unroll") for (int n = 0; n < 2; ++n) _Pragma("unroll") for (int k = 0; k < 2; ++k) \
        acc[ai][bj][m][n] = __builtin_amdgcn_mfma_f32_16x16x32_bf16(Bt[n][k], At[m][k], acc[ai][bj][m][n], 0, 0, 0); __builtin_amdgcn_s_setprio(0); } while (0)
#define PG8_WAIT_V(n) asm volatile("s_waitcnt vmcnt(" #n ")" ::: "memory")
#define PG8_WAIT_L(n) asm volatile("s_waitcnt lgkmcnt(" #n ")" ::: "memory")
#define PG8_BAR __builtin_amdgcn_s_barrier()
#define PG8_SCHED __builtin_amdgcn_sched_barrier(0)
    Unit cur, nxt; int ui = 0;
    if (!S.next(0, cur)) return;
    f32x4 acc[2][2][4][2];
#pragma unroll
    for (int a = 0; a < 2; ++a)
#pragma unroll
        for (int b = 0; b < 2; ++b)
#pragma unroll
            for (int m = 0; m < 4; ++m)
#pragma unroll
                for (int n = 0; n < 2; ++n) acc[a][b][m][n] = (f32x4){0.f, 0.f, 0.f, 0.f};
    bf16x8 At[4][2], B0[2][2], B1[2][2];
    const char* cA = (const char*)g.A + (size_t)cur.pm * tstep; const char* cB = (const char*)g.Bt + (size_t)cur.pn * tstep;
    S.a_ready(cur);
    if constexpr (SP2) {
        PG8_STAGE(PG8_SB(0, 0), cB, voffB); PG8_STAGE(PG8_SB(0, 1), cB + hstep, voffB); PG8_STAGE(PG8_SA(0, 0), cA, voffA); PG8_STAGE(PG8_SA(0, 1), cA + hstep, voffA);
        if (wr == 1) PG8_BAR;
        PG8_WAIT_V(2); PG8_BAR;
        PG8_STAGE(PG8_SB(1, 0), cB + kstep, voffB); PG8_STAGE(PG8_SA(1, 0), cA + kstep, voffA); PG8_STAGE(PG8_SB(1, 1), cB + hstep + kstep, voffB);
        PG8_WAIT_V(6); PG8_BAR;
    } else {
        PG8_STAGE(PG8_SB(0, 0), cB, voffB); PG8_STAGE(PG8_SA(0, 0), cA, voffA); PG8_STAGE(PG8_SB(0, 1), cB + hstep, voffB); PG8_STAGE(PG8_SA(0, 1), cA + hstep, voffA);
        if (wr == 1) PG8_BAR;
        PG8_WAIT_V(4); PG8_BAR;
        PG8_STAGE(PG8_SB(1, 0), cB + kstep, voffB); PG8_STAGE(PG8_SA(1, 0), cA + kstep, voffA); PG8_STAGE(PG8_SB(1, 1), cB + hstep + kstep, voffB);
        PG8_WAIT_V(6); PG8_BAR;
    }
    for (;;) {
        const bool has_next = S.next(ui + 1, nxt);
        const char* nA = has_next ? (const char*)g.A + (size_t)nxt.pm * tstep : cA; const char* nB = has_next ? (const char*)g.Bt + (size_t)nxt.pn * tstep : cB;
        for (int t = 0; t < nt; t += 2) {
            const bool last = (t == nt - 2);
            const char* a1 = cA + (size_t)(t + 1) * kstep;
            const char* a2 = last ? nA : cA + (size_t)(t + 2) * kstep; const char* b2 = last ? nB : cB + (size_t)(t + 2) * kstep;
            const char* a3 = a2 + kstep; const char* b3 = b2 + kstep;
            if (last && has_next) S.a_ready(nxt);
            if constexpr (SP2) {
            PG8_LDB(B0, 0, 0); PG8_LDB(B1, 0, 1); PG8_SCHED; PG8_LDA(At, 0, 0); PG8_STAGE(PG8_SA(1, 1), a1 + hstep, voffA);
            PG8_WAIT_V(8); PG8_WAIT_L(0); PG8_BAR; PG8_MMA(0, 0, At, B0); PG8_MMA(0, 1, At, B1); PG8_BAR; PG8_SCHED;
            PG8_LDA(At, 0, 1); PG8_STAGE(PG8_SB(0, 0), b2, voffB); PG8_STAGE(PG8_SB(0, 1), b2 + hstep, voffB); PG8_STAGE(PG8_SA(0, 0), a2, voffA);
            PG8_WAIT_V(8); PG8_WAIT_L(0); PG8_BAR; PG8_MMA(1, 0, At, B0); PG8_MMA(1, 1, At, B1); PG8_BAR; PG8_SCHED;
            PG8_LDB(B0, 1, 0); PG8_LDB(B1, 1, 1); PG8_SCHED; PG8_LDA(At, 1, 0); PG8_STAGE(PG8_SA(0, 1), a2 + hstep, voffA);
            PG8_WAIT_V(8); PG8_WAIT_L(0); PG8_BAR; PG8_MMA(0, 0, At, B0); PG8_MMA(0, 1, At, B1); PG8_BAR; PG8_SCHED;
            PG8_LDA(At, 1, 1); PG8_STAGE(PG8_SB(1, 0), b3, voffB); PG8_STAGE(PG8_SB(1, 1), b3 + hstep, voffB); PG8_STAGE(PG8_SA(1, 0), a3, voffA);
            PG8_WAIT_V(8); PG8_WAIT_L(0); PG8_BAR; PG8_MMA(1, 0, At, B0); PG8_MMA(1, 1, At, B1); PG8_BAR; PG8_SCHED;
            } else {
            PG8_LDB(B0, 0, 0); PG8_SCHED; PG8_LDA(At, 0, 0); PG8_STAGE(PG8_SA(1, 1), a1 + hstep, voffA);
            PG8_WAIT_L(8); PG8_BAR; PG8_WAIT_L(0); PG8_MMA(0, 0, At, B0); PG8_BAR; PG8_SCHED;
            PG8_LDB(B1, 0, 1); PG8_STAGE(PG8_SB(0, 0), b2, voffB);
            PG8_BAR; PG8_WAIT_L(0); PG8_MMA(0, 1, At, B1); PG8_BAR;
            PG8_LDA(At, 0, 1); PG8_STAGE(PG8_SA(0, 0), a2, voffA);
            PG8_BAR; PG8_WAIT_L(0); PG8_MMA(1, 0, At, B0); PG8_BAR; PG8_SCHED;
            PG8_STAGE(PG8_SB(0, 1), b2 + hstep, voffB);
            PG8_WAIT_V(6); PG8_BAR; PG8_MMA(1, 1, At, B1); PG8_BAR;
            PG8_LDB(B0, 1, 0); PG8_SCHED; PG8_LDA(At, 1, 0); PG8_STAGE(PG8_SA(0, 1), a2 + hstep, voffA);
            PG8_WAIT_L(8); PG8_BAR; PG8_WAIT_L(0); PG8_MMA(0, 0, At, B0); PG8_BAR; PG8_SCHED;
            PG8_LDB(B1, 1, 1); PG8_STAGE(PG8_SB(1, 0), b3, voffB);
            PG8_BAR; PG8_WAIT_L(0); PG8_MMA(0, 1, At, B1); PG8_BAR;
            PG8_LDA(At, 1, 1); PG8_STAGE(PG8_SA(1, 0), a3, voffA);
            PG8_BAR; PG8_WAIT_L(0); PG8_MMA(1, 0, At, B0); PG8_BAR; PG8_SCHED;
            PG8_STAGE(PG8_SB(1, 1), b3 + hstep, voffB);
            PG8_WAIT_V(6); PG8_BAR; PG8_MMA(1, 1, At, B1); PG8_BAR;
            }
        }
        if constexpr (ALIGN_EPI) { if (wr == 0) PG8_BAR; }
        if constexpr (!Epi::AFTER_DRAIN) { E(acc, cur, wr, wc, fr, fq); S.done(cur); }
        if (!has_next) break;
#pragma unroll
        for (int a = 0; a < 2; ++a)
#pragma unroll
            for (int b = 0; b < 2; ++b)
#pragma unroll
                for (int m = 0; m < 4; ++m)
#pragma unroll
                    for (int n = 0; n < 2; ++n) acc[a][b][m][n] = (f32x4){0.f, 0.f, 0.f, 0.f};
        cur = nxt; cA = nA; cB = nB; ++ui;
        if constexpr (ALIGN_EPI) { if (wr == 1) PG8_BAR; }
    }
    PG8_WAIT_V(0);
    if constexpr (!ALIGN_EPI) { if (wr == 0) PG8_BAR; }
    PG8_BAR;
    if constexpr (Epi::AFTER_DRAIN) { E.fused(acc, cur, wr, wc, fr, fq, lds, wid, lane); S.done(cur); }
#undef PG8_SA
#undef PG8_SB
#undef PG8_STAGE
#undef PG8_LDA
#undef PG8_LDB
#undef PG8_MMA
#undef PG8_WAIT_V
#undef PG8_WAIT_L
#undef PG8_BAR
#undef PG8_SCHED
}
}

namespace att {
using bf16 = unsigned short;
constexpr int D = 128, NW = 8, QBLK = 32, KVBLK = 64;
constexpr float SCALE = 0.088388347648318440f;
constexpr float THR = 8.f;
constexpr int SDEPTH = 2;
constexpr int LDQ = INC, LDK = INC, LDO = DM;
constexpr size_t SHM_V = KVBLK * D * 2, SHM_K = KVBLK * D * 2, SHM_ATTN = 2 * SHM_V + 2 * SHM_K + NW * 64 * 4;

using bf16x8 = __attribute__((ext_vector_type(8))) short;
using s16x4  = __attribute__((ext_vector_type(4))) short;
using f32x16 = __attribute__((ext_vector_type(16))) float;
using f32x8  = __attribute__((ext_vector_type(8))) float;
using u32x4  = __attribute__((ext_vector_type(4))) unsigned;
#define KSWZ(row, colB) ((row) * 256 + ((colB) ^ (((row) & 7) << 4)))
#define SBAR() __builtin_amdgcn_sched_barrier(0)
__device__ __forceinline__ int crow(int r, int hi) { return (r & 3) + 8 * (r >> 2) + 4 * hi; }
__device__ __forceinline__ unsigned cvtpk(float lo, float hi) {
  unsigned r; asm volatile("v_cvt_pk_bf16_f32 %0, %1, %2" : "=v"(r) : "v"(lo), "v"(hi)); return r;
}
template <typename TIn> struct Stage;
template <> struct Stage<bf16>  { using T = bf16x8;
  __device__ static __forceinline__ T ld8(const bf16* p) { return *reinterpret_cast<const bf16x8*>(p); }
  __device__ static __forceinline__ bf16x8 tobf(T x) { return x; } };
template <> struct Stage<float> { using T = f32x8;
  __device__ static __forceinline__ T ld8(const float* p) { return *reinterpret_cast<const f32x8*>(p); }
  __device__ static __forceinline__ bf16x8 tobf(T x) {
    u32x4 w = {cvtpk(x[0], x[1]), cvtpk(x[2], x[3]), cvtpk(x[4], x[5]), cvtpk(x[6], x[7])}; return *reinterpret_cast<bf16x8*>(&w); } };

__device__ __forceinline__ void partialSM(f32x16& p0, f32x16& p1, float& m_reg, float& mn, float& alpha) {
  constexpr float C = SCALE * 1.4426950408889634f;
  float pmax = p0[0]; for (int r = 1; r < 16; ++r) pmax = fmaxf(pmax, p0[r]); for (int r = 0; r < 16; ++r) pmax = fmaxf(pmax, p1[r]);
  { auto rr = __builtin_amdgcn_permlane32_swap(__float_as_uint(pmax), __float_as_uint(pmax), false, false);
    pmax = fmaxf(__uint_as_float(rr[0]), __uint_as_float(rr[1])); }
  if (__builtin_expect(__all(pmax - m_reg <= THR / SCALE), 1)) { mn = m_reg; alpha = 1.f; }
  else { mn = fmaxf(m_reg, pmax); alpha = __builtin_amdgcn_exp2f((m_reg - mn) * C); m_reg = mn; }
  float mnC = -mn * C;
  for (int r = 0; r < 16; ++r) p0[r] = fmaf(p0[r], C, mnC); for (int r = 0; r < 16; ++r) p1[r] = fmaf(p1[r], C, mnC);
  for (int r = 0; r < 16; ++r) p0[r] = __builtin_amdgcn_exp2f(p0[r]);
}
__device__ __forceinline__ void finishSM(f32x16& p0, f32x16& p1, float alpha, float& l_reg, bf16x8& pa0, bf16x8& pa1, bf16x8& pa2, bf16x8& pa3) {
  for (int r = 0; r < 16; ++r) p1[r] = __builtin_amdgcn_exp2f(p1[r]);
  float ps = 0; for (int r = 0; r < 16; ++r) ps += p0[r]; for (int r = 0; r < 16; ++r) ps += p1[r];
  { auto rr = __builtin_amdgcn_permlane32_swap(__float_as_uint(ps), __float_as_uint(ps), false, false);
    ps = __uint_as_float(rr[0]) + __uint_as_float(rr[1]); }
  l_reg = l_reg * alpha + ps;
#define PK4(P, BASE, OUT) do { unsigned a0 = cvtpk(P[BASE + 0], P[BASE + 1]), a1 = cvtpk(P[BASE + 2], P[BASE + 3]);   \
    unsigned b0 = cvtpk(P[BASE + 4], P[BASE + 5]), b1 = cvtpk(P[BASE + 6], P[BASE + 7]);                              \
    auto r0 = __builtin_amdgcn_permlane32_swap(a0, b0, false, false); auto r1 = __builtin_amdgcn_permlane32_swap(a1, b1, false, false); \
    u32x4 w = {r0[0], r1[0], r0[1], r1[1]}; OUT = *reinterpret_cast<bf16x8*>(&w); } while (0)
  PK4(p0, 0, pa0); PK4(p0, 8, pa1); PK4(p1, 0, pa2); PK4(p1, 8, pa3);
#undef PK4
}
__device__ __forceinline__ void qkt(f32x16& p0, f32x16& p1, const bf16* Ks, const bf16x8* qr, int r32, int hi) {
  p0 = f32x16{}; p1 = f32x16{};
  for (int d0 = 0; d0 < 8; ++d0) { int cb = (d0 * 16 + hi * 8) * 2;
    bf16x8 b0 = *reinterpret_cast<const bf16x8*>((const char*)Ks + KSWZ(r32, cb));
    bf16x8 b1 = *reinterpret_cast<const bf16x8*>((const char*)Ks + KSWZ(32 + r32, cb));
    p0 = __builtin_amdgcn_mfma_f32_32x32x16_bf16(b0, qr[d0], p0, 0, 0, 0);
    p1 = __builtin_amdgcn_mfma_f32_32x32x16_bf16(b1, qr[d0], p1, 0, 0, 0); }
}
__device__ __forceinline__ int v_st(int k, int c) { const int kk = (k & ~0xC) | ((k & 4) << 1) | ((k & 8) >> 1); return ((kk >> 3) * 4 + (c >> 5)) * 512 + ((kk & 7) * 32 + (c & 31)) * 2; }
__device__ __forceinline__ int v_rd_base(int lane) { return ((lane & 3) << 3) | (((lane >> 2) & 3) << 6) | (((lane >> 4) & 1) << 5) | (((lane >> 5) & 1) << 8); }
constexpr int v_rd_off(int d0, int ks, int half) { return d0 * 512 + ks * 4096 + half * 2048; }
template <int OFF> __device__ __forceinline__ s16x4 tr_read(int vb) {
  s16x4 r; asm volatile("ds_read_b64_tr_b16 %0, %1 offset:%2" : "=&v"(r) : "v"(vb), "i"(OFF) : "memory"); return r;
}
template <int D0> __device__ __forceinline__ void pv_one(f32x16& od, int vb, bf16x8 pa0, bf16x8 pa1, bf16x8 pa2, bf16x8 pa3) {
  const s16x4 l0 = tr_read<v_rd_off(D0, 0, 0)>(vb), h0 = tr_read<v_rd_off(D0, 0, 1)>(vb), l1 = tr_read<v_rd_off(D0, 1, 0)>(vb), h1 = tr_read<v_rd_off(D0, 1, 1)>(vb);
  const s16x4 l2 = tr_read<v_rd_off(D0, 2, 0)>(vb), h2 = tr_read<v_rd_off(D0, 2, 1)>(vb), l3 = tr_read<v_rd_off(D0, 3, 0)>(vb), h3 = tr_read<v_rd_off(D0, 3, 1)>(vb);
  asm volatile("s_waitcnt lgkmcnt(0)" ::: "memory"); SBAR();
#define PK(L, H) (bf16x8){L[0], L[1], L[2], L[3], H[0], H[1], H[2], H[3]}
  od = __builtin_amdgcn_mfma_f32_32x32x16_bf16(pa0, PK(l0, h0), od, 0, 0, 0);
  od = __builtin_amdgcn_mfma_f32_32x32x16_bf16(pa1, PK(l1, h1), od, 0, 0, 0);
  od = __builtin_amdgcn_mfma_f32_32x32x16_bf16(pa2, PK(l2, h2), od, 0, 0, 0);
  od = __builtin_amdgcn_mfma_f32_32x32x16_bf16(pa3, PK(l3, h3), od, 0, 0, 0);
#undef PK
}
__device__ __forceinline__ void pv_d0(f32x16* o, int vb, bf16x8 pa0, bf16x8 pa1, bf16x8 pa2, bf16x8 pa3) {
  pv_one<0>(o[0], vb, pa0, pa1, pa2, pa3); pv_one<1>(o[1], vb, pa0, pa1, pa2, pa3); pv_one<2>(o[2], vb, pa0, pa1, pa2, pa3); pv_one<3>(o[3], vb, pa0, pa1, pa2, pa3);
}

__device__ __forceinline__ void band_mask(f32x16& p0, f32x16& p1, int dq  , int hi) {
#pragma unroll
  for (int r = 0; r < 16; ++r) { const int d = dq - crow(r, hi);
    if ((unsigned)(d + 128) > 256u) p0[r] = -1e30f;
    if ((unsigned)(d + 96) > 256u) p1[r] = -1e30f; }
}
template <bool MASK>
__device__ __forceinline__ void attn_body(const bf16* __restrict__ Qb, const bf16* __restrict__ Kh, const bf16* __restrict__ Vh,
                                          bf16* __restrict__ Ob, int NT, int NCT, int lo, int qpos0, float sinkl2, char* lds) {
  using St = Stage<bf16>;
  int tid_ = threadIdx.x; asm volatile("" : "+v"(tid_));
  const int tid = tid_, wid = tid >> 6, lane = tid & 63, r32 = lane & 31, hi = lane >> 5;
  bf16* V_lds = (bf16*)lds; bf16* K_lds = (bf16*)(lds + 2 * SHM_V);
  float* ws = (float*)(lds + 2 * SHM_V + 2 * SHM_K) + wid * 64; float* li_l = ws; float* al_l = ws + 32;
  float m_reg = -1e30f, l_reg = 0; f32x16 o[4] = {}; bf16x8 qr[8];
  const bf16* Qw = Qb + (long)(wid * QBLK + r32) * LDQ + hi * 8;
#pragma unroll
  for (int d0 = 0; d0 < 8; ++d0) qr[d0] = St::ld8(Qw + d0 * 16);
  const int sr = tid >> 4, sc = (tid & 15) * 8, vst0 = v_st(sr, sc), vst1 = v_st(32 + sr, sc);
  const int vb0 = (int)(uintptr_t)V_lds + v_rd_base(lane);
  const int qi = qpos0 + wid * QBLK + r32;
  struct { typename St::T vs0, vs1, ks0, ks1; } sr_[SDEPTH];
#define TROW(j) (64 * (j) + ((j) >= NCT ? lo : 0))
#define SLOAD(i, k0) do { const long k0_ = (k0); sr_[i].vs0 = St::ld8(&Vh[(k0_ + sr) * LDK + sc]); sr_[i].vs1 = St::ld8(&Vh[(k0_ + 32 + sr) * LDK + sc]); \
    sr_[i].ks0 = St::ld8(&Kh[(k0_ + sr) * LDK + sc]); sr_[i].ks1 = St::ld8(&Kh[(k0_ + 32 + sr) * LDK + sc]); } while (0)
#define SWRITE(b, i) do { *(bf16x8*)((char*)V_lds + (b) * SHM_V + vst0) = St::tobf(sr_[i].vs0);          \
    *(bf16x8*)((char*)V_lds + (b) * SHM_V + vst1) = St::tobf(sr_[i].vs1); int kc = sc * 2;               \
    *(bf16x8*)((char*)K_lds + (b) * SHM_K + KSWZ(sr, kc)) = St::tobf(sr_[i].ks0);                       \
    *(bf16x8*)((char*)K_lds + (b) * SHM_K + KSWZ(32 + sr, kc)) = St::tobf(sr_[i].ks1); } while (0)
#define SWAIT() do { if constexpr (SDEPTH == 2) asm volatile("s_waitcnt vmcnt(4)" ::: "memory"); else asm volatile("s_waitcnt vmcnt(0)" ::: "memory"); } while (0)
#define RESC(a) do { if (__any((a) < 1.f)) { if (hi == 0) al_l[r32] = (a); asm volatile("s_waitcnt lgkmcnt(0)" ::: "memory"); \
    for (int d = 0; d < 4; ++d) for (int r = 0; r < 16; ++r) o[d][r] *= al_l[crow(r, hi)]; } } while (0)
#define AMASK(P0, P1, j) do { if constexpr (MASK) { if ((j) >= NCT) band_mask(P0, P1, qi - (lo + 64 * ((j) - NCT)), hi); } } while (0)
  f32x16 pA0, pA1, pB0, pB1; float mnA, mnB, alA, alB; bf16x8 pa0, pa1, pa2, pa3;
  constexpr int SE = 0, SO = SDEPTH - 1;
  SLOAD(SE, TROW(0)); asm volatile("s_waitcnt vmcnt(0)" ::: "memory"); SWRITE(0, SE); __syncthreads();
  qkt(pA0, pA1, K_lds, qr, r32, hi); AMASK(pA0, pA1, 0); partialSM(pA0, pA1, m_reg, mnA, alA);
  SLOAD(SO, TROW(1)); if constexpr (SDEPTH == 2) { if (2 < NT) SLOAD(SE, TROW(2)); }
  SWAIT(); SWRITE(1, SO); __syncthreads();
  for (int j = 1; j + 1 < NT; j += 2) {
    SBAR(); qkt(pB0, pB1, (bf16*)((char*)K_lds + SHM_K), qr, r32, hi); AMASK(pB0, pB1, j);
    finishSM(pA0, pA1, alA, l_reg, pa0, pa1, pa2, pa3); SBAR();
    SLOAD(SO, TROW(j + SDEPTH)); SBAR();
    pv_d0(o, vb0, pa0, pa1, pa2, pa3); partialSM(pB0, pB1, m_reg, mnB, alB);
    __syncthreads(); SWAIT(); SWRITE(0, SE);
    RESC(alB); __syncthreads();
    SBAR(); qkt(pA0, pA1, K_lds, qr, r32, hi); AMASK(pA0, pA1, j + 1);
    finishSM(pB0, pB1, alB, l_reg, pa0, pa1, pa2, pa3); SBAR();
    if (SDEPTH == 1 || j + 3 < NT) SLOAD(SE, TROW(j + 1 + SDEPTH)); SBAR();
    pv_d0(o, vb0 + (int)SHM_V, pa0, pa1, pa2, pa3); partialSM(pA0, pA1, m_reg, mnA, alA);
    __syncthreads(); SWAIT(); SWRITE(1, SO);
    RESC(alA); __syncthreads();
  }
  SBAR(); qkt(pB0, pB1, (bf16*)((char*)K_lds + SHM_K), qr, r32, hi); AMASK(pB0, pB1, NT - 1);
  finishSM(pA0, pA1, alA, l_reg, pa0, pa1, pa2, pa3); SBAR();
  pv_d0(o, vb0, pa0, pa1, pa2, pa3); partialSM(pB0, pB1, m_reg, mnB, alB);
  __syncthreads(); RESC(alB);
  finishSM(pB0, pB1, alB, l_reg, pa0, pa1, pa2, pa3); SBAR();
  pv_d0(o, vb0 + (int)SHM_V, pa0, pa1, pa2, pa3);
  l_reg += __builtin_amdgcn_exp2f(sinkl2 - m_reg * (SCALE * 1.4426950408889634f));
  if (hi == 0) li_l[r32] = l_reg; asm volatile("s_waitcnt lgkmcnt(0)" ::: "memory");
  float rli[16];
#pragma unroll
  for (int r = 0; r < 16; ++r) rli[r] = __builtin_amdgcn_rcpf(li_l[crow(r, hi)]);
  bf16* Ow = Ob + (long)(wid * QBLK) * LDO;
#pragma unroll
  for (int r = 0; r < 16; ++r) { int orow = crow(r, hi);
    for (int d0 = 0; d0 < 4; ++d0) { const float v = o[d0][r] * rli[r]; const unsigned u = __builtin_bit_cast(unsigned, v);
      Ow[(long)orow * LDO + d0 * 32 + r32] = (bf16)((u + 0x7fffu + ((u >> 16) & 1u)) >> 16); } }
  __syncthreads();
#undef TROW
#undef SLOAD
#undef SWRITE
#undef SWAIT
#undef RESC
#undef AMASK
}
}

constexpr size_t MiB = 1u << 20;
constexpr size_t SLOT = (size_t)MROWS * DM * 2;
constexpr size_t WS_MOD = 0;
constexpr size_t WS_COS = 2 * MiB, WS_SIN = 4 * MiB;
constexpr size_t WS_CTX1 = 6 * MiB;
constexpr size_t WS_WINT = 16 * MiB;
constexpr size_t WS_WPT = WS_WINT + 68 * MiB;
constexpr size_t WS_PX = WS_WPT + 48 * MiB;
constexpr size_t WS_S0 = WS_PX + (size_t)MROWS * INC * 2;
constexpr size_t WS_END = WS_S0 + 5 * SLOT;
static_assert(WS_END <= 4ull * DEPTH * DM * INC * 4, "workspace map exceeds the guaranteed 4x largest tensor");

constexpr int NWAVES = 8;
constexpr int LDS_BYTES = 147456;

#define GAS __attribute__((address_space(1)))
#define LAS __attribute__((address_space(3)))
typedef unsigned short bf16;
typedef unsigned v4u __attribute__((ext_vector_type(4)));
typedef unsigned v2u __attribute__((ext_vector_type(2)));
typedef float f32x4 __attribute__((ext_vector_type(4)));
#define LDS_WAIT() asm volatile("s_waitcnt lgkmcnt(0)" ::: "memory")
__device__ __forceinline__ unsigned f2bf(float f) { unsigned u = __builtin_bit_cast(unsigned, f); return (u + 0x7fffu + ((u >> 16) & 1u)) >> 16; }
__device__ __forceinline__ unsigned pk2(float lo, float hi) { return f2bf(lo) | (f2bf(hi) << 16); }
__device__ __forceinline__ float bflo(unsigned w) { return __builtin_bit_cast(float, w << 16); }
__device__ __forceinline__ float bfhi(unsigned w) { return __builtin_bit_cast(float, w & 0xffff0000u); }
__device__ __forceinline__ float siluf(float x) { return x / (1.f + __expf(-x)); }
__device__ __forceinline__ float sigmf(float x) { return 1.f / (1.f + __expf(-x)); }

struct Frame {
    LAS unsigned char* lds;
    int vcu, G;
    const float *x, *c, *ctx, *c_ctx, *w_ada, *b_ada, *g_pre, *g_post, *w_in, *sink, *lam_qk, *g_subln, *w_pa, *w_pb, *w_out;
    float* out; unsigned char* ws;
};

#define FRESH_IDS int tid_ = threadIdx.x; asm volatile("" : "+v"(tid_)); const int tid = tid_, lane = tid & 63, wave = __builtin_amdgcn_readfirstlane(tid >> 6); (void)lane; (void)wave;

__device__ __forceinline__ float wave_sum(float v) {
#pragma unroll
    for (int o = 1; o < 64; o <<= 1) v += __shfl_xor(v, o);
    return v;
}
__device__ __forceinline__ void p0_transpose_item(const float* W, int K, int N, bf16* WT, int row_off, LAS float* scr, int item, int lane) {
    const int nblk = N / 32, kb = item / nblk, nb = item % nblk, k0 = 64 * kb, n0 = 32 * nb;
#pragma unroll 8
    for (int i = 0; i < 32; ++i) { const int kk = 2 * i + (lane >> 5); scr[kk * 33 + (lane & 31)] = W[(size_t)(k0 + kk) * N + n0 + (lane & 31)]; }
    LDS_WAIT(); asm volatile("" ::: "memory");
    const int c = lane & 7;
#pragma unroll
    for (int j = 0; j < 4; ++j) { const int n = (lane >> 3) + 8 * j; const LAS float* s = scr + (8 * c) * 33 + n;
        v4u o; o.x = pk2(s[0 * 33], s[1 * 33]); o.y = pk2(s[2 * 33], s[3 * 33]); o.z = pk2(s[4 * 33], s[5 * 33]); o.w = pk2(s[6 * 33], s[7 * 33]);
        *(GAS v4u*)(WT + (size_t)(row_off + n0 + n) * K + k0 + 8 * c) = o; }
    LDS_WAIT(); asm volatile("" ::: "memory");
}

#define GW_LOOP(var, n) for (int var = F.vcu * NWAVES + wave; var < (n); var += F.G * NWAVES)

__device__ __forceinline__ int win_row_off(int n0) {
    const int tile = n0 >> 8; const bool rope = tile < 2 || (tile >= 4 && tile < 12) || (tile >= 20 && tile < 28) || (tile >= 36 && tile < 44);
    if (!rope) return 0;
    const int w = n0 & 255, hsel = w >> 7, half = (w >> 6) & 1, i = w & 63;
    return (half * 128 + hsel * 64 + i) - w;
}
__device__ __forceinline__ void ph_prologue(Frame& F) {
    FRESH_IDS
    for (int ait = F.vcu; ait < 192; ait += F.G) {
        const int l = ait / 96, n0 = (ait % 96) * 64;
        LAS float* sv = (LAS float*)F.lds;
        LAS float* red = (LAS float*)(F.lds + 32768);
        for (int k = tid; k < DM; k += NWAVES * 64) { sv[k] = siluf(F.c[k]); sv[DM + k] = siluf(F.c[DM + k]); sv[2 * DM + k] = siluf(F.c_ctx[k]); }
        __syncthreads();
        const float* W = F.w_ada + (size_t)l * DM * 6144 + n0 + lane;
        float a0 = 0.f, a1 = 0.f, a2 = 0.f;
        const int kb = wave * 256;
#pragma unroll 8
        for (int k = 0; k < 256; ++k) { const float w = W[(size_t)(kb + k) * 6144]; a0 += sv[kb + k] * w; a1 += sv[DM + kb + k] * w; a2 += sv[2 * DM + kb + k] * w; }
        red[(wave * 3 + 0) * 64 + lane] = a0; red[(wave * 3 + 1) * 64 + lane] = a1; red[(wave * 3 + 2) * 64 + lane] = a2;
        __syncthreads();
        if (wave < 3) { float s = 0.f;
#pragma unroll
            for (int w = 0; w < 8; ++w) s += red[(w * 3 + wave) * 64 + lane];
            float* mod = (float*)(F.ws + WS_MOD);
            mod[(size_t)(l * 3 + wave) * 6144 + n0 + lane] = s + F.b_ada[(size_t)l * 6144 + n0 + lane]; }
        __syncthreads();
    }
    { float* ct = (float*)(F.ws + WS_COS); float* st = (float*)(F.ws + WS_SIN);
      for (int i = (F.vcu * NWAVES * 64) + tid; i < SEQ * 64; i += F.G * NWAVES * 64) {
          const int t = i >> 6, j = i & 63, f = j & 31; const float pos = (float)((j < 32) ? (t >> 6) : (t & 63));
          const float inv = expf(-(float)f * (9.210340371976184f / 32.f)); const float ang = pos * inv;
          ct[i] = cosf(ang); st[i] = sinf(ang); } }
    LAS float* scr = (LAS float*)(F.lds + wave * 16384);
    constexpr int I_IN = (DM / 64) * (INC / 32), I_P = (DM / 64) * (DM / 32);
    bf16* WinT = (bf16*)(F.ws + WS_WINT); bf16* WpT = (bf16*)(F.ws + WS_WPT);
    GW_LOOP(it, I_IN + 6 * I_P) {
        if (it < I_IN) { p0_transpose_item(F.w_in, DM, INC, WinT, win_row_off(32 * (it % (INC / 32))), scr, it, lane); continue; }
        const int r = it - I_IN, mi = r / I_P, ii = r % I_P, l = mi / 3, w = mi % 3;
        const float* W = (w == 0 ? F.w_pa : (w == 1 ? F.w_pb : F.w_out)) + (size_t)l * DM * DM;
        p0_transpose_item(W, DM, DM, WpT + (size_t)mi * DM * DM, 0, scr, ii, lane);
    }
}

__device__ __forceinline__ void ph_hnorm(Frame& F, int l, const float* xcur, const float* ctxcur) {
    FRESH_IDS
    bf16* H = (bf16*)(F.ws + WS_S0);
    const float* gp = F.g_pre + (size_t)l * DM;
    GW_LOOP(row, MROWS) {
        const int b = row / RPB, rr = row % RPB; const float* src; int v;
        if (rr < CTX) { src = ctxcur + (size_t)(b * CTX + rr) * DM; v = 2; } else { src = xcur + (size_t)(b * SEQ + rr - CTX) * DM; v = b; }
        const float* md = (const float*)(F.ws + WS_MOD) + (size_t)(l * 3 + v) * 6144;
        f32x4 xv[8]; float s = 0.f;
#pragma unroll
        for (int j = 0; j < 8; ++j) { xv[j] = ((const f32x4*)src)[lane + 64 * j]; s += (xv[j].x * xv[j].x + xv[j].y * xv[j].y) + (xv[j].z * xv[j].z + xv[j].w * xv[j].w); }
        const float rs = rsqrtf(wave_sum(s) * (1.f / DM) + EPS);
#pragma unroll
        for (int j = 0; j < 8; ++j) { const int q = lane + 64 * j;
            const f32x4 g = ((const f32x4*)gp)[q], sh = ((const f32x4*)md)[q], sc = ((const f32x4*)(md + DM))[q];
            const f32x4 y = (xv[j] * rs) * g * (sc + 1.f) + sh;
            v2u o; o.x = pk2(y.x, y.y); o.y = pk2(y.z, y.w);
            *(v2u*)(H + (size_t)row * DM + 4 * q) = o; }
    }
}

__device__ __forceinline__ void ph_rope(Frame& F) {
    FRESH_IDS
    bf16* PX = (bf16*)(F.ws + WS_PX);
    const float* ct = (const float*)(F.ws + WS_COS); const float* st = (const float*)(F.ws + WS_SIN);
    const unsigned total = (unsigned)NB * SEQ * 52 * 8;
    for (unsigned idx = (unsigned)(F.vcu * NWAVES * 64 + tid); idx < total; idx += (unsigned)(F.G * NWAVES * 64)) {
        const unsigned ch = idx & 7, hr = idx >> 3, hh = hr % 52, rowL = hr / 52, b = rowL / SEQ, t = rowL % SEQ;
        const int col = (hh < 4) ? (C_KA + hh * 128) : (hh < 20) ? (C_KB + (hh - 4) * 128) : (hh < 36) ? (C_QA + (hh - 20) * 128) : (C_QB + (hh - 36) * 128);
        bf16* p = PX + (size_t)(b * RPB + CTX + t) * INC + col + ch * 8;
        const v4u x1 = *(const v4u*)p, x2 = *(const v4u*)(p + 64);
        const f32x4 c0 = *(const f32x4*)(ct + t * 64 + ch * 8), c1 = *(const f32x4*)(ct + t * 64 + ch * 8 + 4);
        const f32x4 s0 = *(const f32x4*)(st + t * 64 + ch * 8), s1 = *(const f32x4*)(st + t * 64 + ch * 8 + 4);
        v4u y1, y2;
#define ROPE2(W, CA, SA, CB, SB) { const float a0 = bflo(x1.W), a1 = bfhi(x1.W), b0 = bflo(x2.W), b1 = bfhi(x2.W); \
            y1.W = pk2(a0 * CA - b0 * SA, a1 * CB - b1 * SB); y2.W = pk2(b0 * CA + a0 * SA, b1 * CB + a1 * SB); }
        ROPE2(x, c0.x, s0.x, c0.y, s0.y) ROPE2(y, c0.z, s0.z, c0.w, s0.w) ROPE2(z, c1.x, s1.x, c1.y, s1.y) ROPE2(w, c1.z, s1.z, c1.w, s1.w)
#undef ROPE2
        *(v4u*)p = y1; *(v4u*)(p + 64) = y2;
    }
}

__device__ __forceinline__ void ph_convert_win(Frame& F, int l) {
    FRESH_IDS
    LAS float* scr = (LAS float*)(F.lds + wave * 16384);
    constexpr int I_IN = (DM / 64) * (INC / 32);
    bf16* WinT = (bf16*)(F.ws + WS_WINT);
    GW_LOOP(it, I_IN) p0_transpose_item(F.w_in + (size_t)l * DM * INC, DM, INC, WinT, win_row_off(32 * (it % (INC / 32))), scr, it, lane);
}

__device__ __forceinline__ void ph_attn(Frame& F, int l, char* lds) {
    const att::bf16* PX = (const att::bf16*)(F.ws + WS_PX);
    att::bf16* OA = (att::bf16*)(F.ws + WS_S0);
    att::bf16* OB0 = (att::bf16*)(F.ws + WS_S0 + SLOT);
    const float NINF = -INFINITY;
    const int nB = 2048, nA = 1024, nC = (l == 0) ? 96 : 0;
    for (int u = F.vcu; u < nB + nA + nC; u += F.G) {
        if (u < nB) {
            const int hd = u >> 5, qb = u & 31, b = hd >> 5, h8 = (hd >> 2) & 7, m = (hd >> 1) & 1, vh = hd & 1;
            const size_t qrow = (size_t)b * RPB + CTX + qb * 256, krow = (size_t)b * RPB;
            att::attn_body<false>(PX + qrow * INC + C_QB + (h8 * 2 + m) * 128, PX + krow * INC + C_KB + (h8 * 2 + m) * 128, PX + krow * INC + C_VB + h8 * 256 + vh * 128,
                                  OB0 + (size_t)m * (SLOT / 2) + qrow * DM + h8 * 256 + vh * 128, RPB / 64, RPB / 64, 0, 0, NINF, lds);
        } else if (u < nB + nA) {
            const int v = u - nB, b = v >> 9, hq = (v >> 5) & 15, qb = v & 31, kvh = hq >> 2, q0 = qb * 256;
            const int lo = (q0 - 128 > 0) ? q0 - 128 : 0, he = (q0 + 384 < SEQ) ? q0 + 384 : SEQ, nloc = (he - lo) >> 6;
            const size_t qrow = (size_t)b * RPB + CTX + q0, krow = (size_t)b * RPB;
            const float sk = F.sink[l * 16 + hq] * 1.4426950408889634f;
            att::attn_body<true>(PX + qrow * INC + C_QA + hq * 128, PX + krow * INC + C_KA + kvh * 128, PX + krow * INC + C_VA + kvh * 128,
                                 OA + qrow * DM + hq * 128, 4 + nloc, 4, lo, q0, sk, lds);
        } else {
            const int v = u - nB - nA;
            if (v < 64) {
                const int hd = v, b = hd >> 5, h8 = (hd >> 2) & 7, m = (hd >> 1) & 1, vh = hd & 1; const size_t krow = (size_t)b * RPB;
                att::attn_body<false>(PX + krow * INC + C_QB + (h8 * 2 + m) * 128, PX + krow * INC + C_KB + (h8 * 2 + m) * 128, PX + krow * INC + C_VB + h8 * 256 + vh * 128,
                                      OB0 + (size_t)m * (SLOT / 2) + krow * DM + h8 * 256 + vh * 128, 4, 4, 0, 0, NINF, lds);
            } else {
                const int w = v - 64, b = w >> 4, hq = w & 15, kvh = hq >> 2; const size_t krow = (size_t)b * RPB;
                const float sk = F.sink[l * 16 + hq] * 1.4426950408889634f;
                att::attn_body<false>(PX + krow * INC + C_QA + hq * 128, PX + krow * INC + C_KA + kvh * 128, PX + krow * INC + C_VA + kvh * 128,
                                      OA + krow * DM + hq * 128, 4, 4, 0, 0, sk, lds);
            }
        }
    }
}

__device__ __forceinline__ void ph_post(Frame& F, int l) {
    FRESH_IDS
    const bf16* PX = (const bf16*)(F.ws + WS_PX);
    const bf16* OA = (const bf16*)(F.ws + WS_S0); const bf16* OB0 = (const bf16*)(F.ws + WS_S0 + SLOT); const bf16* OB1 = (const bf16*)(F.ws + WS_S0 + 2 * SLOT);
    bf16* GA = (bf16*)(F.ws + WS_S0 + 3 * SLOT); bf16* GB = (bf16*)(F.ws + WS_S0 + 4 * SLOT);
    const float lam_init = 0.8f - 0.6f * expf(-0.3f * (float)l);
    const float* lq = F.lam_qk + (size_t)l * 512;
    const float d1 = wave_sum(lq[lane] * lq[128 + lane] + lq[64 + lane] * lq[192 + lane]);
    const float d2 = wave_sum(lq[256 + lane] * lq[384 + lane] + lq[320 + lane] * lq[448 + lane]);
    const float lam = expf(d1) - expf(d2) + lam_init;
    const f32x4 gs = ((const f32x4*)(F.g_subln + (size_t)l * 256))[lane] * (1.f - lam_init);
    GW_LOOP(row, MROWS) {
        if (l != 0 && (row % RPB) < CTX) continue;
        const size_t ro = (size_t)row * DM, rp = (size_t)row * INC;
#pragma unroll
        for (int j = 0; j < 8; ++j) { const int c = 4 * (lane + 64 * j);
            const v2u oa = *(const v2u*)(OA + ro + c), za = *(const v2u*)(PX + rp + C_ZA + c);
            v2u o; o.x = pk2(bflo(oa.x) * siluf(bflo(za.x)), bfhi(oa.x) * siluf(bfhi(za.x))); o.y = pk2(bflo(oa.y) * siluf(bflo(za.y)), bfhi(oa.y) * siluf(bfhi(za.y)));
            *(v2u*)(GA + ro + c) = o; }
#pragma unroll
        for (int j = 0; j < 8; ++j) { const int c = 256 * j + 4 * lane;
            const v2u o0 = *(const v2u*)(OB0 + ro + c), o1 = *(const v2u*)(OB1 + ro + c), zb = *(const v2u*)(PX + rp + C_ZB + c);
            f32x4 d; d.x = bflo(o0.x) - lam * bflo(o1.x); d.y = bfhi(o0.x) - lam * bfhi(o1.x); d.z = bflo(o0.y) - lam * bflo(o1.y); d.w = bfhi(o0.y) - lam * bfhi(o1.y);
            const float ss = wave_sum((d.x * d.x + d.y * d.y) + (d.z * d.z + d.w * d.w));
            const float rs = rsqrtf(ss * (1.f / 256.f) + EPS);
            const f32x4 y = d * rs * gs;
            v2u o; o.x = pk2(y.x * siluf(bflo(zb.x)), y.y * siluf(bfhi(zb.x))); o.y = pk2(y.z * siluf(bflo(zb.y)), y.w * siluf(bfhi(zb.y)));
            *(v2u*)(GB + ro + c) = o; }
    }
}

__device__ __forceinline__ void ph_merge(Frame& F, int l) {
    FRESH_IDS
    const bf16* PX = (const bf16*)(F.ws + WS_PX);
    const bf16* YA = (const bf16*)(F.ws + WS_S0); const bf16* YB = (const bf16*)(F.ws + WS_S0 + SLOT); bf16* MG = (bf16*)(F.ws + WS_S0 + 2 * SLOT);
    const unsigned total = (unsigned)MROWS * (DM / 8);
    for (unsigned i = (unsigned)(F.vcu * NWAVES * 64 + tid); i < total; i += (unsigned)(F.G * NWAVES * 64)) {
        const unsigned row = i >> 8, c = (i & 255) * 8;
        if (l != 0 && (row % RPB) < CTX) continue;
        const v4u ya = *(const v4u*)(YA + (size_t)row * DM + c), yb = *(const v4u*)(YB + (size_t)row * DM + c);
        const v4u ga = *(const v4u*)(PX + (size_t)row * INC + C_GA + c), gb = *(const v4u*)(PX + (size_t)row * INC + C_GB + c);
        v4u o;
#define MRG(W) o.W = pk2(sigmf(bflo(ga.W)) * bflo(ya.W) + sigmf(bflo(gb.W)) * bflo(yb.W), sigmf(bfhi(ga.W)) * bfhi(ya.W) + sigmf(bfhi(gb.W)) * bfhi(yb.W));
        MRG(x) MRG(y) MRG(z) MRG(w)
#undef MRG
        *(v4u*)(MG + (size_t)row * DM + c) = o;
    }
}

__device__ __forceinline__ void ph_res(Frame& F, int l, const float* xcur, const float* ctxcur) {
    FRESH_IDS
    const bf16* OX = (const bf16*)(F.ws + WS_S0 + 3 * SLOT);
    bf16* H = (bf16*)(F.ws + WS_S0);
    const float* gp = F.g_post + (size_t)l * DM;
    const bool nxt = (l + 1 < DEPTH);
    const float* gpn = F.g_pre + (size_t)(l + 1) * DM;
    GW_LOOP(row, MROWS) {
        const int b = row / RPB, rr = row % RPB; const float* src; float* dst; int v;
        if (rr < CTX) { if (!nxt) continue; src = ctxcur + (size_t)(b * CTX + rr) * DM; dst = nullptr; v = 2; }
        else { src = xcur + (size_t)(b * SEQ + rr - CTX) * DM; dst = F.out + (size_t)(b * SEQ + rr - CTX) * DM; v = b; }
        const float* gt = (const float*)(F.ws + WS_MOD) + (size_t)(l * 3 + v) * 6144 + 2 * DM;
        f32x4 ov[8]; float s = 0.f;
#pragma unroll
        for (int j = 0; j < 8; ++j) { const v2u w = *(const v2u*)(OX + (size_t)row * DM + 4 * (lane + 64 * j));
            ov[j] = (f32x4){bflo(w.x), bfhi(w.x), bflo(w.y), bfhi(w.y)}; s += (ov[j].x * ov[j].x + ov[j].y * ov[j].y) + (ov[j].z * ov[j].z + ov[j].w * ov[j].w); }
        const float rs = rsqrtf(wave_sum(s) * (1.f / DM) + EPS);
        float s2 = 0.f;
#pragma unroll
        for (int j = 0; j < 8; ++j) { const int q = lane + 64 * j;
            const f32x4 g = ((const f32x4*)gp)[q], gate = ((const f32x4*)gt)[q], xr = ((const f32x4*)src)[q];
            ov[j] = xr + gate * ((ov[j] * rs) * g);
            if (dst) ((f32x4*)dst)[q] = ov[j];
            s2 += (ov[j].x * ov[j].x + ov[j].y * ov[j].y) + (ov[j].z * ov[j].z + ov[j].w * ov[j].w); }
        if (nxt) {
            const float* md = (const float*)(F.ws + WS_MOD) + (size_t)((l + 1) * 3 + v) * 6144;
            const float rs2 = rsqrtf(wave_sum(s2) * (1.f / DM) + EPS);
#pragma unroll
            for (int j = 0; j < 8; ++j) { const int q = lane + 64 * j;
                const f32x4 g = ((const f32x4*)gpn)[q], sh = ((const f32x4*)md)[q], sc = ((const f32x4*)(md + DM))[q];
                const f32x4 y = (ov[j] * rs2) * g * (sc + 1.f) + sh;
                v2u o; o.x = pk2(y.x, y.y); o.y = pk2(y.z, y.w);
                *(v2u*)(H + (size_t)row * DM + 4 * q) = o; }
        }
    }
}

__device__ __forceinline__ void run_gemm_in(Frame& F, const bf16* A, const bf16* Bt, bf16* O) {
    pg8::Gemm g{A, Bt, MROWS, INC, DM}; pg8::RowSkipOrder S; S.init(INC, F.G, (int)blockIdx.x, false);
    pg8::EpiRope E{O, INC, (const float*)(F.ws + WS_COS), (const float*)(F.ws + WS_SIN)};
    pg8::gemm_phase<pg8::EpiRope, pg8::RowSkipOrder, true, true>(F.lds, g, S, E);
}
__device__ __forceinline__ void run_gemm_skip(Frame& F, const bf16* A, const bf16* Bt, bf16* O, bool skip) {
    pg8::Gemm g{A, Bt, MROWS, DM, DM}; pg8::RowSkipOrder S; S.init(DM, F.G, (int)blockIdx.x, skip);
    pg8::EpiBf16 E{O, DM};
    pg8::gemm_phase<pg8::EpiBf16, pg8::RowSkipOrder, true, true>(F.lds, g, S, E);
}
template <bool ADD>
__device__ __forceinline__ void run_gemm_gate(Frame& F, const bf16* A, const bf16* Bt, bf16* O, const bf16* T, const bf16* G, bool skip) {
    pg8::Gemm g{A, Bt, MROWS, DM, DM}; pg8::RowSkipOrder S; S.init(DM, F.G, (int)blockIdx.x, skip);
    pg8::EpiGate<ADD> E{O, T, G, DM, INC};
    pg8::gemm_phase<pg8::EpiGate<ADD>, pg8::RowSkipOrder, true, true>(F.lds, g, S, E);
}

struct Args { const float* in[15]; float* out; unsigned char* ws; };
__global__ void __launch_bounds__(NWAVES * 64, 2) fwd_mega(Args args) {
    extern __shared__ __attribute__((aligned(16))) unsigned char lds[];
    cg::grid_group grid = cg::this_grid();
    Frame F;
    F.lds = (LAS unsigned char*)lds;
    F.G = gridDim.x; { const int bx = blockIdx.x; F.vcu = (F.G % 8 == 0) ? (bx % 8) * (F.G / 8) + bx / 8 : bx; }
    F.x = args.in[0]; F.c = args.in[1]; F.ctx = args.in[2]; F.c_ctx = args.in[3]; F.w_ada = args.in[4]; F.b_ada = args.in[5]; F.g_pre = args.in[6]; F.g_post = args.in[7];
    F.w_in = args.in[8]; F.sink = args.in[9]; F.lam_qk = args.in[10]; F.g_subln = args.in[11]; F.w_pa = args.in[12]; F.w_pb = args.in[13]; F.w_out = args.in[14];
    F.out = args.out; F.ws = args.ws;
    bf16* WinT = (bf16*)(F.ws + WS_WINT); bf16* WpT = (bf16*)(F.ws + WS_WPT); bf16* PX = (bf16*)(F.ws + WS_PX);
    bf16* S0 = (bf16*)(F.ws + WS_S0); bf16* S1 = (bf16*)(F.ws + WS_S0 + SLOT); bf16* S2 = (bf16*)(F.ws + WS_S0 + 2 * SLOT); bf16* S3 = (bf16*)(F.ws + WS_S0 + 3 * SLOT); bf16* S4 = (bf16*)(F.ws + WS_S0 + 4 * SLOT);

    ph_prologue(F);
    grid.sync();
#pragma unroll 1
    for (int l = 0; l < DEPTH; ++l) {
        const float* xcur = (l == 0) ? F.x : F.out;
        const float* ctxcur = (l == 0) ? F.ctx : (const float*)(F.ws + WS_CTX1);
        if (l == 0) { ph_hnorm(F, l, xcur, ctxcur); grid.sync(); }
        run_gemm_in(F, S0, WinT, PX);
        grid.sync();
        ph_attn(F, l, (char*)lds);
        grid.sync();
        ph_post(F, l);
        if (l + 1 < DEPTH) ph_convert_win(F, l + 1);
        grid.sync();
        run_gemm_gate<false>(F, S3, WpT + (size_t)(l * 3 + 0) * DM * DM, S0, S0, PX + C_GA, l != 0);
        run_gemm_gate<true>(F, S4, WpT + (size_t)(l * 3 + 1) * DM * DM, S2, S0, PX + C_GB, l != 0);
        grid.sync();
        run_gemm_skip(F, S2, WpT + (size_t)(l * 3 + 2) * DM * DM, S3, l != 0);
        grid.sync();
        ph_res(F, l, xcur, ctxcur);
        grid.sync();
    }
}

extern "C" void kernel_launch(void* const* d_in, const int* in_sizes, int n_in, void* d_out, int out_size, void* d_ws, size_t ws_size, hipStream_t stream) {
    static int grid = 0;
    if (grid == 0) {
        if (n_in != 15 || out_size != NB * SEQ * DM || ws_size < WS_END) { fprintf(stderr, "kernel_launch: unexpected shapes: n_in %d out %d ws %zu (need %zu)\n", n_in, out_size, ws_size, (size_t)WS_END); grid = -1; return; }
        int dev = 0, cus = 0, per_cu = 0;
        if (hipGetDevice(&dev) != hipSuccess || hipDeviceGetAttribute(&cus, hipDeviceAttributeMultiprocessorCount, dev) != hipSuccess) { grid = -1; return; }
        if (hipFuncSetAttribute((const void*)fwd_mega, hipFuncAttributeMaxDynamicSharedMemorySize, LDS_BYTES) != hipSuccess) { fprintf(stderr, "kernel_launch: hipFuncSetAttribute failed\n"); grid = -1; return; }
        if (hipOccupancyMaxActiveBlocksPerMultiprocessor(&per_cu, (const void*)fwd_mega, NWAVES * 64, LDS_BYTES) != hipSuccess || per_cu < 1) { fprintf(stderr, "kernel_launch: occupancy query says %d\n", per_cu); per_cu = 1; }
        (void)hipGetLastError();
        grid = cus * per_cu;
    }
    if (grid < 0) return;
    Args a{};
    for (int i = 0; i < 15; ++i) a.in[i] = (const float*)d_in[i];
    a.out = (float*)d_out; a.ws = (unsigned char*)d_ws;
    void* kargs[] = {&a};
    hipError_t e = hipLaunchCooperativeKernel((const void*)fwd_mega, dim3(grid), dim3(NWAVES * 64), kargs, LDS_BYTES, stream);
    if (e != hipSuccess) fprintf(stderr, "kernel_launch: cooperative launch failed: %s (grid %d)\n", hipGetErrorString(e), grid);
}
```

```cpp
#include <hip/hip_runtime.h>
#include <hip/hip_bf16.h>
#include <hip/hip_cooperative_groups.h>
#include <cstdio>
#include <cstdint>
#include <cmath>
namespace cg = cooperative_groups;

constexpr int DM = 2048, NB = 2, SEQ = 8192, DEPTH = 2, CTX = 256;
constexpr int RPB = CTX + SEQ;
constexpr int MROWS = NB * RPB;
constexpr int INC = 17408;
constexpr int C_KA = 0, C_VA = 512, C_KB = 1024, C_VB = 3072, C_QA = 5120, C_ZA = 7168, C_QB = 9216, C_ZB = 11264, C_GA = 13312, C_GB = 15360;
constexpr float EPS = 1e-6f;

namespace pg8 {
#define PG8_LAS __attribute__((address_space(3)))
typedef unsigned short bf16_t;
typedef short bf16x8 __attribute__((ext_vector_type(8)));
typedef float f32x4 __attribute__((ext_vector_type(4)));
typedef unsigned u32x4 __attribute__((ext_vector_type(4)));
constexpr int BM = 256, BK = 64, HALF = 128, HTB = HALF * BK * 2  , STAGE_BYTES = 8 * HTB, NXCD = 8, WGM = 8;

__host__ __device__ __forceinline__ int lds_byte(int r, int c) { const int st = (r >> 4) * 2 + (c >> 5), rr = r & 15, cc = c & 31, ob = rr * 64 + cc * 2; return st * 1024 + (ob ^ (((ob >> 9) & 1) << 5)); }
__host__ __device__ __forceinline__ void stage_rc(int b, int& R, int& C) { const int st = b / 1024, sb = b % 1024, swz = sb ^ (((sb >> 9) & 1) << 5); R = (st >> 1) * 16 + swz / 64; C = (st & 1) * 32 + (swz % 64) / 2; }
__host__ __device__ __forceinline__ int perm32(int rho) { const int n = rho >> 4, i = rho & 15; return 8 * (i >> 2) + 4 * n + (i & 3); }

struct Unit { int pm, pn; };
struct Gemm { const bf16_t* A; const bf16_t* Bt; int M, N, K; };

struct StaticOrder {
    int nM, nN, nwg, G, c;
    __host__ __device__ void init(int M, int N, int G_, int c_) { nM = M / BM; nN = N / BM; nwg = nM * nN; G = G_; c = c_; }
    __host__ __device__ bool next(int i, Unit& u) const {
        const long L = (long)i * G + c; if (L >= nwg) return false;
        int wgid = (int)L; { const int q = nwg / NXCD, r = nwg % NXCD, xcd = wgid % NXCD, off = wgid / NXCD; wgid = (xcd < r ? xcd * (q + 1) : r * (q + 1) + (xcd - r) * q) + off; }
        const int nig = WGM * nN, gid = wgid / nig, fm = gid * WGM, gsz = (nM - fm) < WGM ? (nM - fm) : WGM;
        u.pm = fm + ((wgid % nig) % gsz); u.pn = (wgid % nig) / gsz; return true;
    }
    __device__ __forceinline__ void a_ready(const Unit&) const {}
    __device__ __forceinline__ void done(const Unit&) const {}
};

__device__ __forceinline__ unsigned cvt_pk_bf16(float lo, float hi) { unsigned r; asm volatile("v_cvt_pk_bf16_f32 %0, %1, %2" : "=v"(r) : "v"(lo), "v"(hi)); return r; }
typedef float f32x2 __attribute__((ext_vector_type(2)));

struct EpiBf16 {
    static constexpr bool PERM = true, AFTER_DRAIN = false;
    bf16_t* O; int ldc;
    __device__ __forceinline__ void operator()(const f32x4 (&acc)[2][2][4][2], const Unit& u, int wr, int wc, int fr, int fq) const {
        const int row0 = u.pm * BM + wr * 64 + fr; const int col0 = u.pn * BM + wc * 32 + 8 * fq;
#pragma unroll
        for (int ai = 0; ai < 2; ++ai)
#pragma unroll
            for (int m = 0; m < 4; ++m) { bf16_t* rowp = O + (size_t)(row0 + ai * HALF + m * 16) * ldc + col0;
#pragma unroll
                for (int bj = 0; bj < 2; ++bj) { const f32x4 v0 = acc[ai][bj][m][0], v1 = acc[ai][bj][m][1];
                    u32x4 w; w.x = cvt_pk_bf16(v0[0], v0[1]); w.y = cvt_pk_bf16(v0[2], v0[3]); w.z = cvt_pk_bf16(v1[0], v1[1]); w.w = cvt_pk_bf16(v1[2], v1[3]);
                    *(u32x4*)(rowp + bj * HALF) = w; } }
    }
};

__device__ __forceinline__ float sigm_(float x) { return 1.f / (1.f + __expf(-x)); }
__device__ __forceinline__ float blo_(unsigned w) { return __builtin_bit_cast(float, w << 16); }
__device__ __forceinline__ float bhi_(unsigned w) { return __builtin_bit_cast(float, w & 0xffff0000u); }
template <bool ADD> struct EpiGate {
    static constexpr bool PERM = true, AFTER_DRAIN = false;
    bf16_t* O; const bf16_t* T; const bf16_t* G; int ldc; int ldg;
    __device__ __forceinline__ void operator()(const f32x4 (&acc)[2][2][4][2], const Unit& u, int wr, int wc, int fr, int fq) const {
        const int row0 = u.pm * BM + wr * 64 + fr; const int col0 = u.pn * BM + wc * 32 + 8 * fq;
#pragma unroll
        for (int ai = 0; ai < 2; ++ai)
#pragma unroll
            for (int m = 0; m < 4; ++m) { const size_t row = (size_t)(row0 + ai * HALF + m * 16);
#pragma unroll
                for (int bj = 0; bj < 2; ++bj) { const f32x4 v0 = acc[ai][bj][m][0], v1 = acc[ai][bj][m][1];
                    const u32x4 g = *(const u32x4*)(G + row * ldg + col0 + bj * HALF);
                    float r0 = sigm_(blo_(g.x)) * v0[0], r1 = sigm_(bhi_(g.x)) * v0[1], r2 = sigm_(blo_(g.y)) * v0[2], r3 = sigm_(bhi_(g.y)) * v0[3];
                    float r4 = sigm_(blo_(g.z)) * v1[0], r5 = sigm_(bhi_(g.z)) * v1[1], r6 = sigm_(blo_(g.w)) * v1[2], r7 = sigm_(bhi_(g.w)) * v1[3];
                    if (ADD) { const u32x4 t = *(const u32x4*)(T + row * ldc + col0 + bj * HALF);
                        r0 += blo_(t.x); r1 += bhi_(t.x); r2 += blo_(t.y); r3 += bhi_(t.y); r4 += blo_(t.z); r5 += bhi_(t.z); r6 += blo_(t.w); r7 += bhi_(t.w); }
                    u32x4 w; w.x = cvt_pk_bf16(r0, r1); w.y = cvt_pk_bf16(r2, r3); w.z = cvt_pk_bf16(r4, r5); w.w = cvt_pk_bf16(r6, r7);
                    *(u32x4*)(O + row * ldc + col0 + bj * HALF) = w; } }
    }
};
struct RowSkipOrder {
    StaticOrder base; bool skip;
    __device__ void init(int N, int G_, int c_, bool skip_) { skip = skip_; base.init(skip_ ? 16384 : 16896, N, G_, c_); }
    __device__ bool next(int i, Unit& u) const { if (!base.next(i, u)) return false; if (skip) u.pm += 1 + (u.pm >= 32 ? 1 : 0); return true; }
    __device__ __forceinline__ void a_ready(const Unit&) const {}
    __device__ __forceinline__ void done(const Unit&) const {}
};

struct EpiRope {
    static constexpr bool PERM = true, AFTER_DRAIN = false;
    bf16_t* O; int ldc; const float* ct; const float* st;
    __device__ __forceinline__ void operator()(const f32x4 (&acc)[2][2][4][2], const Unit& u, int wr, int wc, int fr, int fq) const {
        const int pn = u.pn; const bool rope = pn < 2 || (pn >= 4 && pn < 12) || (pn >= 20 && pn < 28) || (pn >= 36 && pn < 44);
        const int row0 = u.pm * BM + wr * 64 + fr;
        if (!rope) {
            const int col0 = pn * BM + wc * 32 + 8 * fq;
#pragma unroll
            for (int ai = 0; ai < 2; ++ai)
#pragma unroll
                for (int m = 0; m < 4; ++m) { bf16_t* rowp = O + (size_t)(row0 + ai * HALF + m * 16) * ldc + col0;
#pragma unroll
                    for (int bj = 0; bj < 2; ++bj) { const f32x4 v0 = acc[ai][bj][m][0], v1 = acc[ai][bj][m][1];
                        u32x4 w; w.x = cvt_pk_bf16(v0[0], v0[1]); w.y = cvt_pk_bf16(v0[2], v0[3]); w.z = cvt_pk_bf16(v1[0], v1[1]); w.w = cvt_pk_bf16(v1[2], v1[3]);
                        *(u32x4*)(rowp + bj * HALF) = w; } }
            return;
        }
        const bool isctx = (u.pm == 0) || (u.pm == 33);
        const int i0 = 32 * (wc & 1) + 8 * fq, ocol = pn * BM + (wc >> 1) * 128 + i0;
        const int tbase = row0 - (u.pm >= 33 ? 8448 : 0) - 256;
#pragma unroll
        for (int ai = 0; ai < 2; ++ai)
#pragma unroll
            for (int m = 0; m < 4; ++m) { const int t = tbase + ai * HALF + m * 16;
                f32x4 c0 = {1.f, 1.f, 1.f, 1.f}, c1 = c0, s0 = {0.f, 0.f, 0.f, 0.f}, s1 = s0;
                if (!isctx) { const float* cp = ct + (size_t)t * 64 + i0; const float* sp = st + (size_t)t * 64 + i0;
                    c0 = *(const f32x4*)cp; c1 = *(const f32x4*)(cp + 4); s0 = *(const f32x4*)sp; s1 = *(const f32x4*)(sp + 4); }
                const f32x4 a0 = acc[ai][0][m][0], a1 = acc[ai][0][m][1], b0 = acc[ai][1][m][0], b1 = acc[ai][1][m][1];
                const f32x4 y0 = a0 * c0 - b0 * s0, y1 = a1 * c1 - b1 * s1, z0 = b0 * c0 + a0 * s0, z1 = b1 * c1 + a1 * s1;
                bf16_t* rowp = O + (size_t)(row0 + ai * HALF + m * 16) * ldc + ocol;
                u32x4 w; w.x = cvt_pk_bf16(y0[0], y0[1]); w.y = cvt_pk_bf16(y0[2], y0[3]); w.z = cvt_pk_bf16(y1[0], y1[1]); w.w = cvt_pk_bf16(y1[2], y1[3]);
                *(u32x4*)rowp = w;
                u32x4 x; x.x = cvt_pk_bf16(z0[0], z0[1]); x.y = cvt_pk_bf16(z0[2], z0[3]); x.z = cvt_pk_bf16(z1[0], z1[1]); x.w = cvt_pk_bf16(z1[2], z1[3]);
                *(u32x4*)(rowp + 64) = x; }
    }
};

template <class Epi, class Sched, bool ALIGN_EPI = false, bool SP2 = false>
__device__ __forceinline__ void gemm_phase(PG8_LAS unsigned char* lds, const Gemm g, const Sched& S, const Epi& E) {
    int tid_ = threadIdx.x; asm volatile("" : "+v"(tid_));
    const int tid = tid_, wid = __builtin_amdgcn_readfirstlane(tid >> 6), lane = tid & 63, wr = wid >> 2, wc = wid & 3, fr = lane & 15, fq = lane >> 4;
    const int K = g.K, nt = K / BK;
    unsigned voffA[2], voffB[2];
#pragma unroll
    for (int i = 0; i < 2; ++i) { int R, C; stage_rc(tid * 16 + i * 8192, R, C); const int Rb = Epi::PERM ? ((R & ~31) + perm32(R & 31)) : R;
        voffA[i] = (unsigned)(R * K + C) * 2u; voffB[i] = (unsigned)(Rb * K + C) * 2u; }
    const size_t kstep = (size_t)(BK * 2);
    const size_t hstep = (size_t)HALF * K * 2;
    const size_t tstep = 2 * hstep;
    const unsigned ldsw = (unsigned)wid * 1024u;
    const int aoff = lds_byte(wr * 64 + fr, fq * 8), boff = lds_byte(wc * 32 + fr, fq * 8);
#define PG8_SA(b, h) (((b) * 2 + (h)) * HTB)
#define PG8_SB(b, h) ((4 + (b) * 2 + (h)) * HTB)
#define PG8_STAGE(bufoff, gbase, voff) do { _Pragma("unroll") for (int _i = 0; _i < 2; ++_i) \
        __builtin_amdgcn_global_load_lds((const unsigned*)((const char*)(gbase) + (voff)[_i]), (PG8_LAS unsigned*)(lds + (bufoff) + ldsw + _i * 8192), 16, 0, 0); } while (0)
#define PG8_LDA(dst, b, h) do { _Pragma("unroll") for (int m = 0; m < 4; ++m) _Pragma("unroll") for (int k = 0; k < 2; ++k) dst[m][k] = *(const PG8_LAS bf16x8*)(lds + PG8_SA(b, h) + aoff + m * 2048 + k * 1024); } while (0)
#define PG8_LDB(dst, b, h) do { _Pragma("unroll") for (int n = 0; n < 2; ++n) _Pragma("unroll") for (int k = 0; k < 2; ++k) dst[n][k] = *(const PG8_LAS bf16x8*)(lds + PG8_SB(b, h) + boff + n * 2048 + k * 1024); } while (0)
#define PG8_MMA(ai, bj, At, Bt) do { __builtin_amdgcn_s_setprio(1); _Pragma("unroll") for (int m = 0; m < 4; ++m) _Pragma("unroll") for (int n = 0; n < 2; ++n) _Pragma("unroll") for (int k = 0; k < 2; ++k) \
        acc[ai][bj][m][n] = __builtin_amdgcn_mfma_f32_16x16x32_bf16(Bt[n][k], At[m][k], acc[ai][bj][m][n], 0, 0, 0); __builtin_amdgcn_s_setprio(0); } while (0)
#define PG8_WAIT_V(n) asm volatile("s_waitcnt vmcnt(" #n ")" ::: "memory")
#define PG8_WAIT_L(n) asm volatile("s_waitcnt lgkmcnt(" #n ")" ::: "memory")
#define PG8_BAR __builtin_amdgcn_s_barrier()
#define PG8_SCHED __builtin_amdgcn_sched_barrier(0)
    Unit cur, nxt; int ui = 0;
    if (!S.next(0, cur)) return;
    f32x4 acc[2][2][4][2];
#pragma unroll
    for (int a = 0; a < 2; ++a)
#pragma unroll
        for (int b = 0; b < 2; ++b)
#pragma unroll
            for (int m = 0; m < 4; ++m)
#pragma unroll
                for (int n = 0; n < 2; ++n) acc[a][b][m][n] = (f32x4){0.f, 0.f, 0.f, 0.f};
    bf16x8 At[4][2], B0[2][2], B1[2][2];
    const char* cA = (const char*)g.A + (size_t)cur.pm * tstep; const char* cB = (const char*)g.Bt + (size_t)cur.pn * tstep;
    S.a_ready(cur);
    if constexpr (SP2) {
        PG8_STAGE(PG8_SB(0, 0), cB, voffB); PG8_STAGE(PG8_SB(0, 1), cB + hstep, voffB); PG8_STAGE(PG8_SA(0, 0), cA, voffA); PG8_STAGE(PG8_SA(0, 1), cA + hstep, voffA);
        if (wr == 1) PG8_BAR;
        PG8_WAIT_V(2); PG8_BAR;
        PG8_STAGE(PG8_SB(1, 0), cB + kstep, voffB); PG8_STAGE(PG8_SA(1, 0), cA + kstep, voffA); PG8_STAGE(PG8_SB(1, 1), cB + hstep + kstep, voffB);
        PG8_WAIT_V(6); PG8_BAR;
    } else {
        PG8_STAGE(PG8_SB(0, 0), cB, voffB); PG8_STAGE(PG8_SA(0, 0), cA, voffA); PG8_STAGE(PG8_SB(0, 1), cB + hstep, voffB); PG8_STAGE(PG8_SA(0, 1), cA + hstep, voffA);
        if (wr == 1) PG8_BAR;
        PG8_WAIT_V(4); PG8_BAR;
        PG8_STAGE(PG8_SB(1, 0), cB + kstep, voffB); PG8_STAGE(PG8_SA(1, 0), cA + kstep, voffA); PG8_STAGE(PG8_SB(1, 1), cB + hstep + kstep, voffB);
        PG8_WAIT_V(6); PG8_BAR;
    }
    for (;;) {
        const bool has_next = S.next(ui + 1, nxt);
        const char* nA = has_next ? (const char*)g.A + (size_t)nxt.pm * tstep : cA; const char* nB = has_next ? (const char*)g.Bt + (size_t)nxt.pn * tstep : cB;
        for (int t = 0; t < nt; t += 2) {
            const bool last = (t == nt - 2);
            const char* a1 = cA + (size_t)(t + 1) * kstep;
            const char* a2 = last ? nA : cA + (size_t)(t + 2) * kstep; const char* b2 = last ? nB : cB + (size_t)(t + 2) * kstep;
            const char* a3 = a2 + kstep; const char* b3 = b2 + kstep;
            if (last && has_next) S.a_ready(nxt);
            if constexpr (SP2) {
            PG8_LDB(B0, 0, 0); PG8_LDB(B1, 0, 1); PG8_SCHED; PG8_LDA(At, 0, 0); PG8_STAGE(PG8_SA(1, 1), a1 + hstep, voffA);
            PG8_WAIT_V(8); PG8_WAIT_L(0); PG8_BAR; PG8_MMA(0, 0, At, B0); PG8_MMA(0, 1, At, B1); PG8_BAR; PG8_SCHED;
            PG8_LDA(At, 0, 1); PG8_STAGE(PG8_SB(0, 0), b2, voffB); PG8_STAGE(PG8_SB(0, 1), b2 + hstep, voffB); PG8_STAGE(PG8_SA(0, 0), a2, voffA);
            PG8_WAIT_V(8); PG8_WAIT_L(0); PG8_BAR; PG8_MMA(1, 0, At, B0); PG8_MMA(1, 1, At, B1); PG8_BAR; PG8_SCHED;
            PG8_LDB(B0, 1, 0); PG8_LDB(B1, 1, 1); PG8_SCHED; PG8_LDA(At, 1, 0); PG8_STAGE(PG8_SA(0, 1), a2 + hstep, voffA);
            PG8_WAIT_V(8); PG8_WAIT_L(0); PG8_BAR; PG8_MMA(0, 0, At, B0); PG8_MMA(0, 1, At, B1); PG8_BAR; PG8_SCHED;
            PG8_LDA(At, 1, 1); PG8_STAGE(PG8_SB(1, 0), b3, voffB); PG8_STAGE(PG8_SB(1, 1), b3 + hstep, voffB); PG8_STAGE(PG8_SA(1, 0), a3, voffA);
            PG8_WAIT_V(8); PG8_WAIT_L(0); PG8_BAR; PG8_MMA(1, 0, At, B0); PG8_MMA(1, 1, At, B1); PG8_BAR; PG8_SCHED;
            } else {
            PG8_LDB(B0, 0, 0); PG8_SCHED; PG8_LDA(At, 0, 0); PG8_STAGE(PG8_SA(1, 1), a1 + hstep, voffA);
            PG8_WAIT_L(8); PG8_BAR; PG8_WAIT_L(0); PG8_MMA(0, 0, At, B0); PG8_BAR; PG8_SCHED;
            PG8_LDB(B1, 0, 1); PG8_STAGE(PG8_SB(0, 0), b2, voffB);
            PG8_BAR; PG8_WAIT_L(0); PG8_MMA(0, 1, At, B1); PG8_BAR;
            PG8_LDA(At, 0, 1); PG8_STAGE(PG8_SA(0, 0), a2, voffA);
            PG8_BAR; PG8_WAIT_L(0); PG8_MMA(1, 0, At, B0); PG8_BAR; PG8_SCHED;
            PG8_STAGE(PG8_SB(0, 1), b2 + hstep, voffB);
            PG8_WAIT_V(6); PG8_BAR; PG8_MMA(1, 1, At, B1); PG8_BAR;
            PG8_LDB(B0, 1, 0); PG8_SCHED; PG8_LDA(At, 1, 0); PG8_STAGE(PG8_SA(0, 1), a2 + hstep, voffA);
            PG8_WAIT_L(8); PG8_BAR; PG8_WAIT_L(0); PG8_MMA(0, 0, At, B0); PG8_BAR; PG8_SCHED;
            PG8_LDB(B1, 1, 1); PG8_STAGE(PG8_SB(1, 0), b3, voffB);
            PG8_BAR; PG8_WAIT_L(0); PG8_MMA(0, 1, At, B1); PG8_BAR;
            PG8_LDA(At, 1, 1); PG8_STAGE(PG8_SA(1, 0), a3, voffA);
            PG8_BAR; PG8_WAIT_L(0); PG8_MMA(1, 0, At, B0); PG8_BAR; PG8_SCHED;
            PG8_STAGE(PG8_SB(1, 1), b3 + hstep, voffB);
            PG8_WAIT_V(6); PG8_BAR; PG8_MMA(1, 1, At, B1); PG8_BAR;
            }
        }
        if constexpr (ALIGN_EPI) { if (wr == 0) PG8_BAR; }
        if constexpr (!Epi::AFTER_DRAIN) { E(acc, cur, wr, wc, fr, fq); S.done(cur); }
        if (!has_next) break;
#pragma unroll
        for (int a = 0; a < 2; ++a)
#pragma unroll
            for (int b = 0; b < 2; ++b)
#pragma unroll
                for (int m = 0; m < 4; ++m)
#pragma unroll
                    for (int n = 0; n < 2; ++n) acc[a][b][m][n] = (f32x4){0.f, 0.f, 0.f, 0.f};
        cur = nxt; cA = nA; cB = nB; ++ui;
        if constexpr (ALIGN_EPI) { if (wr == 1) PG8_BAR; }
    }
    PG8_WAIT_V(0);
    if constexpr (!ALIGN_EPI) { if (wr == 0) PG8_BAR; }
    PG8_BAR;
    if constexpr (Epi::AFTER_DRAIN) { E.fused(acc, cur, wr, wc, fr, fq, lds, wid, lane); S.done(cur); }
#undef PG8_SA
#undef PG8_SB
#undef PG8_STAGE
#undef PG8_LDA
#undef PG8_LDB
#undef PG8_MMA
#undef PG8_WAIT_V
#undef PG8_WAIT_L
#undef PG8_BAR
#undef PG8_SCHED
}
}

namespace att {
using bf16 = unsigned short;
constexpr int D = 128, NW = 8, QBLK = 32, KVBLK = 64;
constexpr float SCALE = 0.088388347648318440f;
constexpr float THR = 8.f;
constexpr int SDEPTH = 2;
constexpr int LDQ = INC, LDK = INC, LDO = DM;
constexpr size_t SHM_V = KVBLK * D * 2, SHM_K = KVBLK * D * 2, SHM_ATTN = 2 * SHM_V + 2 * SHM_K + NW * 64 * 4;

using bf16x8 = __attribute__((ext_vector_type(8))) short;
using s16x4  = __attribute__((ext_vector_type(4))) short;
using f32x16 = __attribute__((ext_vector_type(16))) float;
using f32x8  = __attribute__((ext_vector_type(8))) float;
using u32x4  = __attribute__((ext_vector_type(4))) unsigned;
#define KSWZ(row, colB) ((row) * 256 + ((colB) ^ (((row) & 7) << 4)))
#define SBAR() __builtin_amdgcn_sched_barrier(0)
__device__ __forceinline__ int crow(int r, int hi) { return (r & 3) + 8 * (r >> 2) + 4 * hi; }
__device__ __forceinline__ unsigned cvtpk(float lo, float hi) {
  unsigned r; asm volatile("v_cvt_pk_bf16_f32 %0, %1, %2" : "=v"(r) : "v"(lo), "v"(hi)); return r;
}
template <typename TIn> struct Stage;
template <> struct Stage<bf16>  { using T = bf16x8;
  __device__ static __forceinline__ T ld8(const bf16* p) { return *reinterpret_cast<const bf16x8*>(p); }
  __device__ static __forceinline__ bf16x8 tobf(T x) { return x; } };
template <> struct Stage<float> { using T = f32x8;
  __device__ static __forceinline__ T ld8(const float* p) { return *reinterpret_cast<const f32x8*>(p); }
  __device__ static __forceinline__ bf16x8 tobf(T x) {
    u32x4 w = {cvtpk(x[0], x[1]), cvtpk(x[2], x[3]), cvtpk(x[4], x[5]), cvtpk(x[6], x[7])}; return *reinterpret_cast<bf16x8*>(&w); } };

__device__ __forceinline__ void partialSM(f32x16& p0, f32x16& p1, float& m_reg, float& mn, float& alpha) {
  constexpr float C = SCALE * 1.4426950408889634f;
  float pmax = p0[0]; for (int r = 1; r < 16; ++r) pmax = fmaxf(pmax, p0[r]); for (int r = 0; r < 16; ++r) pmax = fmaxf(pmax, p1[r]);
  { auto rr = __builtin_amdgcn_permlane32_swap(__float_as_uint(pmax), __float_as_uint(pmax), false, false);
    pmax = fmaxf(__uint_as_float(rr[0]), __uint_as_float(rr[1])); }
  if (__builtin_expect(__all(pmax - m_reg <= THR / SCALE), 1)) { mn = m_reg; alpha = 1.f; }
  else { mn = fmaxf(m_reg, pmax); alpha = __builtin_amdgcn_exp2f((m_reg - mn) * C); m_reg = mn; }
  float mnC = -mn * C;
  for (int r = 0; r < 16; ++r) p0[r] = fmaf(p0[r], C, mnC); for (int r = 0; r < 16; ++r) p1[r] = fmaf(p1[r], C, mnC);
  for (int r = 0; r < 16; ++r) p0[r] = __builtin_amdgcn_exp2f(p0[r]);
}
__device__ __forceinline__ void finishSM(f32x16& p0, f32x16& p1, float alpha, float& l_reg, bf16x8& pa0, bf16x8& pa1, bf16x8& pa2, bf16x8& pa3) {
  for (int r = 0; r < 16; ++r) p1[r] = __builtin_amdgcn_exp2f(p1[r]);
  float ps = 0; for (int r = 0; r < 16; ++r) ps += p0[r]; for (int r = 0; r < 16; ++r) ps += p1[r];
  { auto rr = __builtin_amdgcn_permlane32_swap(__float_as_uint(ps), __float_as_uint(ps), false, false);
    ps = __uint_as_float(rr[0]) + __uint_as_float(rr[1]); }
  l_reg = l_reg * alpha + ps;
#define PK4(P, BASE, OUT) do { unsigned a0 = cvtpk(P[BASE + 0], P[BASE + 1]), a1 = cvtpk(P[BASE + 2], P[BASE + 3]);   \
    unsigned b0 = cvtpk(P[BASE + 4], P[BASE + 5]), b1 = cvtpk(P[BASE + 6], P[BASE + 7]);                              \
    auto r0 = __builtin_amdgcn_permlane32_swap(a0, b0, false, false); auto r1 = __builtin_amdgcn_permlane32_swap(a1, b1, false, false); \
    u32x4 w = {r0[0], r1[0], r0[1], r1[1]}; OUT = *reinterpret_cast<bf16x8*>(&w); } while (0)
  PK4(p0, 0, pa0); PK4(p0, 8, pa1); PK4(p1, 0, pa2); PK4(p1, 8, pa3);
#undef PK4
}
__device__ __forceinline__ void qkt(f32x16& p0, f32x16& p1, const bf16* Ks, const bf16x8* qr, int r32, int hi) {
  p0 = f32x16{}; p1 = f32x16{};
  for (int d0 = 0; d0 < 8; ++d0) { int cb = (d0 * 16 + hi * 8) * 2;
    bf16x8 b0 = *reinterpret_cast<const bf16x8*>((const char*)Ks + KSWZ(r32, cb));
    bf16x8 b1 = *reinterpret_cast<const bf16x8*>((const char*)Ks + KSWZ(32 + r32, cb));
    p0 = __builtin_amdgcn_mfma_f32_32x32x16_bf16(b0, qr[d0], p0, 0, 0, 0);
    p1 = __builtin_amdgcn_mfma_f32_32x32x16_bf16(b1, qr[d0], p1, 0, 0, 0); }
}
__device__ __forceinline__ int v_st(int k, int c) { const int kk = (k & ~0xC) | ((k & 4) << 1) | ((k & 8) >> 1); return ((kk >> 3) * 4 + (c >> 5)) * 512 + ((kk & 7) * 32 + (c & 31)) * 2; }
__device__ __forceinline__ int v_rd_base(int lane) { return ((lane & 3) << 3) | (((lane >> 2) & 3) << 6) | (((lane >> 4) & 1) << 5) | (((lane >> 5) & 1) << 8); }
constexpr int v_rd_off(int d0, int ks, int half) { return d0 * 512 + ks * 4096 + half * 2048; }
template <int OFF> __device__ __forceinline__ s16x4 tr_read(int vb) {
  s16x4 r; asm volatile("ds_read_b64_tr_b16 %0, %1 offset:%2" : "=&v"(r) : "v"(vb), "i"(OFF) : "memory"); return r;
}
template <int D0> __device__ __forceinline__ void pv_one(f32x16& od, int vb, bf16x8 pa0, bf16x8 pa1, bf16x8 pa2, bf16x8 pa3) {
  const s16x4 l0 = tr_read<v_rd_off(D0, 0, 0)>(vb), h0 = tr_read<v_rd_off(D0, 0, 1)>(vb), l1 = tr_read<v_rd_off(D0, 1, 0)>(vb), h1 = tr_read<v_rd_off(D0, 1, 1)>(vb);
  const s16x4 l2 = tr_read<v_rd_off(D0, 2, 0)>(vb), h2 = tr_read<v_rd_off(D0, 2, 1)>(vb), l3 = tr_read<v_rd_off(D0, 3, 0)>(vb), h3 = tr_read<v_rd_off(D0, 3, 1)>(vb);
  asm volatile("s_waitcnt lgkmcnt(0)" ::: "memory"); SBAR();
#define PK(L, H) (bf16x8){L[0], L[1], L[2], L[3], H[0], H[1], H[2], H[3]}
  od = __builtin_amdgcn_mfma_f32_32x32x16_bf16(pa0, PK(l0, h0), od, 0, 0, 0);
  od = __builtin_amdgcn_mfma_f32_32x32x16_bf16(pa1, PK(l1, h1), od, 0, 0, 0);
  od = __builtin_amdgcn_mfma_f32_32x32x16_bf16(pa2, PK(l2, h2), od, 0, 0, 0);
  od = __builtin_amdgcn_mfma_f32_32x32x16_bf16(pa3, PK(l3, h3), od, 0, 0, 0);
#undef PK
}
__device__ __forceinline__ void pv_d0(f32x16* o, int vb, bf16x8 pa0, bf16x8 pa1, bf16x8 pa2, bf16x8 pa3) {
  pv_one<0>(o[0], vb, pa0, pa1, pa2, pa3); pv_one<1>(o[1], vb, pa0, pa1, pa2, pa3); pv_one<2>(o[2], vb, pa0, pa1, pa2, pa3); pv_one<3>(o[3], vb, pa0, pa1, pa2, pa3);
}

__device__ __forceinline__ void band_mask(f32x16& p0, f32x16& p1, int dq  , int hi) {
#pragma unroll
  for (int r = 0; r < 16; ++r) { const int d = dq - crow(r, hi);
    if ((unsigned)(d + 128) > 256u) p0[r] = -1e30f;
    if ((unsigned)(d + 96) > 256u) p1[r] = -1e30f; }
}
template <bool MASK>
__device__ __forceinline__ void attn_body(const bf16* __restrict__ Qb, const bf16* __restrict__ Kh, const bf16* __restrict__ Vh,
                                          bf16* __restrict__ Ob, int NT, int NCT, int lo, int qpos0, float sinkl2, char* lds) {
  using St = Stage<bf16>;
  int tid_ = threadIdx.x; asm volatile("" : "+v"(tid_));
  const int tid = tid_, wid = tid >> 6, lane = tid & 63, r32 = lane & 31, hi = lane >> 5;
  bf16* V_lds = (bf16*)lds; bf16* K_lds = (bf16*)(lds + 2 * SHM_V);
  float* ws = (float*)(lds + 2 * SHM_V + 2 * SHM_K) + wid * 64; float* li_l = ws; float* al_l = ws + 32;
  float m_reg = -1e30f, l_reg = 0; f32x16 o[4] = {}; bf16x8 qr[8];
  const bf16* Qw = Qb + (long)(wid * QBLK + r32) * LDQ + hi * 8;
#pragma unroll
  for (int d0 = 0; d0 < 8; ++d0) qr[d0] = St::ld8(Qw + d0 * 16);
  const int sr = tid >> 4, sc = (tid & 15) * 8, vst0 = v_st(sr, sc), vst1 = v_st(32 + sr, sc);
  const int vb0 = (int)(uintptr_t)V_lds + v_rd_base(lane);
  const int qi = qpos0 + wid * QBLK + r32;
  struct { typename St::T vs0, vs1, ks0, ks1; } sr_[SDEPTH];
#define TROW(j) (64 * (j) + ((j) >= NCT ? lo : 0))
#define SLOAD(i, k0) do { const long k0_ = (k0); sr_[i].vs0 = St::ld8(&Vh[(k0_ + sr) * LDK + sc]); sr_[i].vs1 = St::ld8(&Vh[(k0_ + 32 + sr) * LDK + sc]); \
    sr_[i].ks0 = St::ld8(&Kh[(k0_ + sr) * LDK + sc]); sr_[i].ks1 = St::ld8(&Kh[(k0_ + 32 + sr) * LDK + sc]); } while (0)
#define SWRITE(b, i) do { *(bf16x8*)((char*)V_lds + (b) * SHM_V + vst0) = St::tobf(sr_[i].vs0);          \
    *(bf16x8*)((char*)V_lds + (b) * SHM_V + vst1) = St::tobf(sr_[i].vs1); int kc = sc * 2;               \
    *(bf16x8*)((char*)K_lds + (b) * SHM_K + KSWZ(sr, kc)) = St::tobf(sr_[i].ks0);                       \
    *(bf16x8*)((char*)K_lds + (b) * SHM_K + KSWZ(32 + sr, kc)) = St::tobf(sr_[i].ks1); } while (0)
#define SWAIT() do { if constexpr (SDEPTH == 2) asm volatile("s_waitcnt vmcnt(4)" ::: "memory"); else asm volatile("s_waitcnt vmcnt(0)" ::: "memory"); } while (0)
#define RESC(a) do { if (__any((a) < 1.f)) { if (hi == 0) al_l[r32] = (a); asm volatile("s_waitcnt lgkmcnt(0)" ::: "memory"); \
    for (int d = 0; d < 4; ++d) for (int r = 0; r < 16; ++r) o[d][r] *= al_l[crow(r, hi)]; } } while (0)
#define AMASK(P0, P1, j) do { if constexpr (MASK) { if ((j) >= NCT) band_mask(P0, P1, qi - (lo + 64 * ((j) - NCT)), hi); } } while (0)
  f32x16 pA0, pA1, pB0, pB1; float mnA, mnB, alA, alB; bf16x8 pa0, pa1, pa2, pa3;
  constexpr int SE = 0, SO = SDEPTH - 1;
  SLOAD(SE, TROW(0)); asm volatile("s_waitcnt vmcnt(0)" ::: "memory"); SWRITE(0, SE); __syncthreads();
  qkt(pA0, pA1, K_lds, qr, r32, hi); AMASK(pA0, pA1, 0); partialSM(pA0, pA1, m_reg, mnA, alA);
  SLOAD(SO, TROW(1)); if constexpr (SDEPTH == 2) { if (2 < NT) SLOAD(SE, TROW(2)); }
  SWAIT(); SWRITE(1, SO); __syncthreads();
  for (int j = 1; j + 1 < NT; j += 2) {
    SBAR(); qkt(pB0, pB1, (bf16*)((char*)K_lds + SHM_K), qr, r32, hi); AMASK(pB0, pB1, j);
    finishSM(pA0, pA1, alA, l_reg, pa0, pa1, pa2, pa3); SBAR();
    SLOAD(SO, TROW(j + SDEPTH)); SBAR();
    pv_d0(o, vb0, pa0, pa1, pa2, pa3); partialSM(pB0, pB1, m_reg, mnB, alB);
    __syncthreads(); SWAIT(); SWRITE(0, SE);
    RESC(alB); __syncthreads();
    SBAR(); qkt(pA0, pA1, K_lds, qr, r32, hi); AMASK(pA0, pA1, j + 1);
    finishSM(pB0, pB1, alB, l_reg, pa0, pa1, pa2, pa3); SBAR();
    if (SDEPTH == 1 || j + 3 < NT) SLOAD(SE, TROW(j + 1 + SDEPTH)); SBAR();
    pv_d0(o, vb0 + (int)SHM_V, pa0, pa1, pa2, pa3); partialSM(pA0, pA1, m_reg, mnA, alA);
    __syncthreads(); SWAIT(); SWRITE(1, SO);
    RESC(alA); __syncthreads();
  }
  SBAR(); qkt(pB0, pB1, (bf16*)((char*)K_lds + SHM_K), qr, r32, hi); AMASK(pB0, pB1, NT - 1);
  finishSM(pA0, pA1, alA, l_reg, pa0, pa1, pa2, pa3); SBAR();
  pv_d0(o, vb0, pa0, pa1, pa2, pa3); partialSM(pB0, pB1, m_reg, mnB, alB);
  __syncthreads(); RESC(alB);
  finishSM(pB0, pB1, alB, l_reg, pa0, pa1, pa2, pa3); SBAR();
  pv_d0(o, vb0 + (int)SHM_V, pa0, pa1, pa2, pa3);
  l_reg += __builtin_amdgcn_exp2f(sinkl2 - m_reg * (SCALE * 1.4426950408889634f));
  if (hi == 0) li_l[r32] = l_reg; asm volatile("s_waitcnt lgkmcnt(0)" ::: "memory");
  float rli[16];
#pragma unroll
  for (int r = 0; r < 16; ++r) rli[r] = __builtin_amdgcn_rcpf(li_l[crow(r, hi)]);
  bf16* Ow = Ob + (long)(wid * QBLK) * LDO;
#pragma unroll
  for (int r = 0; r < 16; ++r) { int orow = crow(r, hi);
    for (int d0 = 0; d0 < 4; ++d0) { const float v = o[d0][r] * rli[r]; const unsigned u = __builtin_bit_cast(unsigned, v);
      Ow[(long)orow * LDO + d0 * 32 + r32] = (bf16)((u + 0x7fffu + ((u >> 16) & 1u)) >> 16); } }
  __syncthreads();
#undef TROW
#undef SLOAD
#undef SWRITE
#undef SWAIT
#undef RESC
#undef AMASK
}

#define ATT_LAS __attribute__((address_space(3)))
__device__ __forceinline__ void attn_body_v256(const bf16* __restrict__ Qb, const bf16* __restrict__ Kh, const bf16* __restrict__ Vh,
                                               bf16* __restrict__ Ob, int NT, ATT_LAS unsigned char* ldsl) {
  using St = Stage<bf16>;
  int tid_ = threadIdx.x; asm volatile("" : "+v"(tid_));
  const int tid = tid_, wid = __builtin_amdgcn_readfirstlane(tid >> 6), lane = tid & 63, r32 = lane & 31, hi = lane >> 5;
  char* lds = (char*)ldsl;
  char* V_lds = lds; char* K_lds = lds + 65536;
  float* ws = (float*)(lds + 98304) + wid * 64; float* li_l = ws; float* al_l = ws + 32;
  float m_reg = -1e30f, l_reg = 0; f32x16 o[8] = {}; bf16x8 qr[8];
  const bf16* Qw = Qb + (long)(wid * QBLK + r32) * LDQ + hi * 8;
#pragma unroll
  for (int d0 = 0; d0 < 8; ++d0) qr[d0] = St::ld8(Qw + d0 * 16);
  unsigned offK0, offV0;
  { const int row = wid * 4 + (lane >> 4), colB = ((lane & 15) * 16) ^ ((row & 7) << 4); offK0 = (unsigned)row * (LDK * 2) + (unsigned)colB;
    const int sub = wid * 2 + (lane >> 5), kkhi = sub >> 2, cblk = sub & 3, within = (lane & 31) * 16, kk = kkhi * 8 + (within >> 6);
    const int k = (kk & ~0xC) | ((kk & 4) << 1) | ((kk & 8) >> 1), c = cblk * 32 + ((within & 63) >> 1);
    offV0 = (unsigned)k * (LDK * 2) + (unsigned)c * 2; }
  const int vb0 = (int)(uintptr_t)V_lds + v_rd_base(lane);
#define DMA_TILE(j, buf) do { const char* kb_ = (const char*)Kh + (size_t)(j) * (64 * LDK * 2) + offK0; const char* vb_ = (const char*)Vh + (size_t)(j) * (64 * LDK * 2) + offV0; \
    _Pragma("unroll") for (int i_ = 0; i_ < 2; ++i_) __builtin_amdgcn_global_load_lds((const unsigned*)(kb_ + i_ * (32 * LDK * 2)), (ATT_LAS unsigned*)(ldsl + 65536 + (buf) * 16384 + (i_ * 8 + wid) * 1024), 16, 0, 0); \
    _Pragma("unroll") for (int i_ = 0; i_ < 4; ++i_) __builtin_amdgcn_global_load_lds((const unsigned*)(vb_ + (i_ & 1) * (32 * LDK * 2) + (i_ >> 1) * 256), (ATT_LAS unsigned*)(ldsl + (buf) * 32768 + (i_ * 8 + wid) * 1024), 16, 0, 0); } while (0)
#define RESC8(a) do { if (__any((a) < 1.f)) { if (hi == 0) al_l[r32] = (a); asm volatile("s_waitcnt lgkmcnt(0)" ::: "memory"); \
    for (int d = 0; d < 8; ++d) for (int r = 0; r < 16; ++r) o[d][r] *= al_l[crow(r, hi)]; } } while (0)
#define TILE_SYNC() do { asm volatile("s_waitcnt vmcnt(0)" ::: "memory"); __builtin_amdgcn_s_barrier(); asm volatile("" ::: "memory"); } while (0)
  f32x16 p0, p1; float mn, al; bf16x8 pa0, pa1, pa2, pa3;
  DMA_TILE(0, 0);
  for (int j = 0; j < NT; j += 2) {
    TILE_SYNC(); DMA_TILE(j + 1, 1);
    qkt(p0, p1, (const bf16*)K_lds, qr, r32, hi); partialSM(p0, p1, m_reg, mn, al); RESC8(al); finishSM(p0, p1, al, l_reg, pa0, pa1, pa2, pa3); SBAR();
    pv_d0(o, vb0, pa0, pa1, pa2, pa3); pv_d0(o + 4, vb0 + 16384, pa0, pa1, pa2, pa3);
    TILE_SYNC(); if (j + 2 < NT) DMA_TILE(j + 2, 0);
    qkt(p0, p1, (const bf16*)(K_lds + 16384), qr, r32, hi); partialSM(p0, p1, m_reg, mn, al); RESC8(al); finishSM(p0, p1, al, l_reg, pa0, pa1, pa2, pa3); SBAR();
    pv_d0(o, vb0 + 32768, pa0, pa1, pa2, pa3); pv_d0(o + 4, vb0 + 32768 + 16384, pa0, pa1, pa2, pa3);
  }
  if (hi == 0) li_l[r32] = l_reg; asm volatile("s_waitcnt lgkmcnt(0)" ::: "memory");
  float rli[16];
#pragma unroll
  for (int r = 0; r < 16; ++r) rli[r] = __builtin_amdgcn_rcpf(li_l[crow(r, hi)]);
  bf16* Ow = Ob + (long)(wid * QBLK) * LDO;
#pragma unroll
  for (int r = 0; r < 16; ++r) { int orow = crow(r, hi);
#pragma unroll
    for (int d0 = 0; d0 < 8; ++d0) { const float v = o[d0][r] * rli[r]; const unsigned u = __builtin_bit_cast(unsigned, v);
      Ow[(long)orow * LDO + d0 * 32 + r32] = (bf16)((u + 0x7fffu + ((u >> 16) & 1u)) >> 16); } }
#undef DMA_TILE
#undef RESC8
#undef TILE_SYNC
}
}

constexpr size_t MiB = 1u << 20;
constexpr size_t SLOT = (size_t)MROWS * DM * 2;
constexpr size_t WS_MOD = 0;
constexpr size_t WS_COS = 2 * MiB, WS_SIN = 4 * MiB;
constexpr size_t WS_CTX1 = 6 * MiB;
constexpr size_t WS_WINT = 16 * MiB;
constexpr size_t WS_WPT = WS_WINT + 68 * MiB;
constexpr size_t WS_PX = WS_WPT + 48 * MiB;
constexpr size_t WS_S0 = WS_PX + (size_t)MROWS * INC * 2;
constexpr size_t WS_END = WS_S0 + 5 * SLOT;
static_assert(WS_END <= 4ull * DEPTH * DM * INC * 4, "workspace map exceeds the guaranteed 4x largest tensor");

constexpr int NWAVES = 8;
constexpr int LDS_BYTES = 147456;

#define GAS __attribute__((address_space(1)))
#define LAS __attribute__((address_space(3)))
typedef unsigned short bf16;
typedef unsigned v4u __attribute__((ext_vector_type(4)));
typedef unsigned v2u __attribute__((ext_vector_type(2)));
typedef float f32x4 __attribute__((ext_vector_type(4)));
#define LDS_WAIT() asm volatile("s_waitcnt lgkmcnt(0)" ::: "memory")
__device__ __forceinline__ unsigned f2bf(float f) { unsigned u = __builtin_bit_cast(unsigned, f); return (u + 0x7fffu + ((u >> 16) & 1u)) >> 16; }
__device__ __forceinline__ unsigned pk2(float lo, float hi) { return f2bf(lo) | (f2bf(hi) << 16); }
__device__ __forceinline__ float bflo(unsigned w) { return __builtin_bit_cast(float, w << 16); }
__device__ __forceinline__ float bfhi(unsigned w) { return __builtin_bit_cast(float, w & 0xffff0000u); }
__device__ __forceinline__ float siluf(float x) { return x / (1.f + __expf(-x)); }
__device__ __forceinline__ float sigmf(float x) { return 1.f / (1.f + __expf(-x)); }

struct Frame {
    LAS unsigned char* lds;
    int vcu, G;
    const float *x, *c, *ctx, *c_ctx, *w_ada, *b_ada, *g_pre, *g_post, *w_in, *sink, *lam_qk, *g_subln, *w_pa, *w_pb, *w_out;
    float* out; unsigned char* ws;
};

#define FRESH_IDS int tid_ = threadIdx.x; asm volatile("" : "+v"(tid_)); const int tid = tid_, lane = tid & 63, wave = __builtin_amdgcn_readfirstlane(tid >> 6); (void)lane; (void)wave;

__device__ __forceinline__ float wave_sum(float v) {
#pragma unroll
    for (int o = 1; o < 64; o <<= 1) v += __shfl_xor(v, o);
    return v;
}
__device__ __forceinline__ void p0_transpose_item(const float* W, int K, int N, bf16* WT, int row_off, LAS float* scr, int item, int lane) {
    const int nblk = N / 32, kb = item / nblk, nb = item % nblk, k0 = 64 * kb, n0 = 32 * nb;
#pragma unroll 8
    for (int i = 0; i < 32; ++i) { const int kk = 2 * i + (lane >> 5); scr[kk * 33 + (lane & 31)] = W[(size_t)(k0 + kk) * N + n0 + (lane & 31)]; }
    LDS_WAIT(); asm volatile("" ::: "memory");
    const int c = lane & 7;
#pragma unroll
    for (int j = 0; j < 4; ++j) { const int n = (lane >> 3) + 8 * j; const LAS float* s = scr + (8 * c) * 33 + n;
        v4u o; o.x = pk2(s[0 * 33], s[1 * 33]); o.y = pk2(s[2 * 33], s[3 * 33]); o.z = pk2(s[4 * 33], s[5 * 33]); o.w = pk2(s[6 * 33], s[7 * 33]);
        *(GAS v4u*)(WT + (size_t)(row_off + n0 + n) * K + k0 + 8 * c) = o; }
    LDS_WAIT(); asm volatile("" ::: "memory");
}

#define GW_LOOP(var, n) for (int var = F.vcu * NWAVES + wave; var < (n); var += F.G * NWAVES)

__device__ __forceinline__ int win_row_off(int n0) {
    const int tile = n0 >> 8; const bool rope = tile < 2 || (tile >= 4 && tile < 12) || (tile >= 20 && tile < 28) || (tile >= 36 && tile < 44);
    if (!rope) return 0;
    const int w = n0 & 255, hsel = w >> 7, half = (w >> 6) & 1, i = w & 63;
    return (half * 128 + hsel * 64 + i) - w;
}
__device__ __forceinline__ void ph_prologue(Frame& F) {
    FRESH_IDS
    for (int ait = F.vcu; ait < 192; ait += F.G) {
        const int l = ait / 96, n0 = (ait % 96) * 64;
        LAS float* sv = (LAS float*)F.lds;
        LAS float* red = (LAS float*)(F.lds + 32768);
        for (int k = tid; k < DM; k += NWAVES * 64) { sv[k] = siluf(F.c[k]); sv[DM + k] = siluf(F.c[DM + k]); sv[2 * DM + k] = siluf(F.c_ctx[k]); }
        __syncthreads();
        const float* W = F.w_ada + (size_t)l * DM * 6144 + n0 + lane;
        float a0 = 0.f, a1 = 0.f, a2 = 0.f;
        const int kb = wave * 256;
#pragma unroll 8
        for (int k = 0; k < 256; ++k) { const float w = W[(size_t)(kb + k) * 6144]; a0 += sv[kb + k] * w; a1 += sv[DM + kb + k] * w; a2 += sv[2 * DM + kb + k] * w; }
        red[(wave * 3 + 0) * 64 + lane] = a0; red[(wave * 3 + 1) * 64 + lane] = a1; red[(wave * 3 + 2) * 64 + lane] = a2;
        __syncthreads();
        if (wave < 3) { float s = 0.f;
#pragma unroll
            for (int w = 0; w < 8; ++w) s += red[(w * 3 + wave) * 64 + lane];
            float* mod = (float*)(F.ws + WS_MOD);
            mod[(size_t)(l * 3 + wave) * 6144 + n0 + lane] = s + F.b_ada[(size_t)l * 6144 + n0 + lane]; }
        __syncthreads();
    }
    { float* ct = (float*)(F.ws + WS_COS); float* st = (float*)(F.ws + WS_SIN);
      for (int i = (F.vcu * NWAVES * 64) + tid; i < SEQ * 64; i += F.G * NWAVES * 64) {
          const int t = i >> 6, j = i & 63, f = j & 31; const float pos = (float)((j < 32) ? (t >> 6) : (t & 63));
          const float inv = expf(-(float)f * (9.210340371976184f / 32.f)); const float ang = pos * inv;
          ct[i] = cosf(ang); st[i] = sinf(ang); } }
    LAS float* scr = (LAS float*)(F.lds + wave * 16384);
    constexpr int I_IN = (DM / 64) * (INC / 32), I_P = (DM / 64) * (DM / 32);
    bf16* WinT = (bf16*)(F.ws + WS_WINT); bf16* WpT = (bf16*)(F.ws + WS_WPT);
    GW_LOOP(it, I_IN + 6 * I_P) {
        if (it < I_IN) { p0_transpose_item(F.w_in, DM, INC, WinT, win_row_off(32 * (it % (INC / 32))), scr, it, lane); continue; }
        const int r = it - I_IN, mi = r / I_P, ii = r % I_P, l = mi / 3, w = mi % 3;
        const float* W = (w == 0 ? F.w_pa : (w == 1 ? F.w_pb : F.w_out)) + (size_t)l * DM * DM;
        p0_transpose_item(W, DM, DM, WpT + (size_t)mi * DM * DM, 0, scr, ii, lane);
    }
}

__device__ __forceinline__ void ph_hnorm(Frame& F, int l, const float* xcur, const float* ctxcur) {
    FRESH_IDS
    bf16* H = (bf16*)(F.ws + WS_S0);
    const float* gp = F.g_pre + (size_t)l * DM;
    GW_LOOP(row, MROWS) {
        const int b = row / RPB, rr = row % RPB; const float* src; int v;
        if (rr < CTX) { src = ctxcur + (size_t)(b * CTX + rr) * DM; v = 2; } else { src = xcur + (size_t)(b * SEQ + rr - CTX) * DM; v = b; }
        const float* md = (const float*)(F.ws + WS_MOD) + (size_t)(l * 3 + v) * 6144;
        f32x4 xv[8]; float s = 0.f;
#pragma unroll
        for (int j = 0; j < 8; ++j) { xv[j] = ((const f32x4*)src)[lane + 64 * j]; s += (xv[j].x * xv[j].x + xv[j].y * xv[j].y) + (xv[j].z * xv[j].z + xv[j].w * xv[j].w); }
        const float rs = rsqrtf(wave_sum(s) * (1.f / DM) + EPS);
#pragma unroll
        for (int j = 0; j < 8; ++j) { const int q = lane + 64 * j;
            const f32x4 g = ((const f32x4*)gp)[q], sh = ((const f32x4*)md)[q], sc = ((const f32x4*)(md + DM))[q];
            const f32x4 y = (xv[j] * rs) * g * (sc + 1.f) + sh;
            v2u o; o.x = pk2(y.x, y.y); o.y = pk2(y.z, y.w);
            *(v2u*)(H + (size_t)row * DM + 4 * q) = o; }
    }
}

__device__ __forceinline__ void ph_rope(Frame& F) {
    FRESH_IDS
    bf16* PX = (bf16*)(F.ws + WS_PX);
    const float* ct = (const float*)(F.ws + WS_COS); const float* st = (const float*)(F.ws + WS_SIN);
    const unsigned total = (unsigned)NB * SEQ * 52 * 8;
    for (unsigned idx = (unsigned)(F.vcu * NWAVES * 64 + tid); idx < total; idx += (unsigned)(F.G * NWAVES * 64)) {
        const unsigned ch = idx & 7, hr = idx >> 3, hh = hr % 52, rowL = hr / 52, b = rowL / SEQ, t = rowL % SEQ;
        const int col = (hh < 4) ? (C_KA + hh * 128) : (hh < 20) ? (C_KB + (hh - 4) * 128) : (hh < 36) ? (C_QA + (hh - 20) * 128) : (C_QB + (hh - 36) * 128);
        bf16* p = PX + (size_t)(b * RPB + CTX + t) * INC + col + ch * 8;
        const v4u x1 = *(const v4u*)p, x2 = *(const v4u*)(p + 64);
        const f32x4 c0 = *(const f32x4*)(ct + t * 64 + ch * 8), c1 = *(const f32x4*)(ct + t * 64 + ch * 8 + 4);
        const f32x4 s0 = *(const f32x4*)(st + t * 64 + ch * 8), s1 = *(const f32x4*)(st + t * 64 + ch * 8 + 4);
        v4u y1, y2;
#define ROPE2(W, CA, SA, CB, SB) { const float a0 = bflo(x1.W), a1 = bfhi(x1.W), b0 = bflo(x2.W), b1 = bfhi(x2.W); \
            y1.W = pk2(a0 * CA - b0 * SA, a1 * CB - b1 * SB); y2.W = pk2(b0 * CA + a0 * SA, b1 * CB + a1 * SB); }
        ROPE2(x, c0.x, s0.x, c0.y, s0.y) ROPE2(y, c0.z, s0.z, c0.w, s0.w) ROPE2(z, c1.x, s1.x, c1.y, s1.y) ROPE2(w, c1.z, s1.z, c1.w, s1.w)
#undef ROPE2
        *(v4u*)p = y1; *(v4u*)(p + 64) = y2;
    }
}

__device__ __forceinline__ void ph_convert_win(Frame& F, int l) {
    FRESH_IDS
    LAS float* scr = (LAS float*)(F.lds + wave * 16384);
    constexpr int I_IN = (DM / 64) * (INC / 32);
    bf16* WinT = (bf16*)(F.ws + WS_WINT);
    GW_LOOP(it, I_IN) p0_transpose_item(F.w_in + (size_t)l * DM * INC, DM, INC, WinT, win_row_off(32 * (it % (INC / 32))), scr, it, lane);
}

__device__ __forceinline__ void ph_attn(Frame& F, int l, char* lds) {
    const att::bf16* PX = (const att::bf16*)(F.ws + WS_PX);
    att::bf16* OA = (att::bf16*)(F.ws + WS_S0);
    att::bf16* OB0 = (att::bf16*)(F.ws + WS_S0 + SLOT);
    const float NINF = -INFINITY;
    const int nB = 1024, nA = 1024, nC = (l == 0) ? 64 : 0;
    for (int u = F.vcu; u < nB + nA + nC; u += F.G) {
        if (u < nB) {
            const int hd = u >> 5, qb = u & 31, b = hd >> 4, h8 = (hd >> 1) & 7, m = hd & 1;
            const size_t qrow = (size_t)b * RPB + CTX + qb * 256, krow = (size_t)b * RPB;
            att::attn_body_v256(PX + qrow * INC + C_QB + (h8 * 2 + m) * 128, PX + krow * INC + C_KB + (h8 * 2 + m) * 128, PX + krow * INC + C_VB + h8 * 256,
                                OB0 + (size_t)m * (SLOT / 2) + qrow * DM + h8 * 256, RPB / 64, F.lds);
            __syncthreads();
        } else if (u < nB + nA) {
            const int v = u - nB, b = v >> 9, hq = (v >> 5) & 15, qb = v & 31, kvh = hq >> 2, q0 = qb * 256;
            const int lo = (q0 - 128 > 0) ? q0 - 128 : 0, he = (q0 + 384 < SEQ) ? q0 + 384 : SEQ, nloc = (he - lo) >> 6;
            const size_t qrow = (size_t)b * RPB + CTX + q0, krow = (size_t)b * RPB;
            const float sk = F.sink[l * 16 + hq] * 1.4426950408889634f;
            att::attn_body<true>(PX + qrow * INC + C_QA + hq * 128, PX + krow * INC + C_KA + kvh * 128, PX + krow * INC + C_VA + kvh * 128,
                                 OA + qrow * DM + hq * 128, 4 + nloc, 4, lo, q0, sk, lds);
        } else {
            const int v = u - nB - nA;
            if (v < 32) {
                const int hd = v, b = hd >> 4, h8 = (hd >> 1) & 7, m = hd & 1; const size_t krow = (size_t)b * RPB;
                att::attn_body_v256(PX + krow * INC + C_QB + (h8 * 2 + m) * 128, PX + krow * INC + C_KB + (h8 * 2 + m) * 128, PX + krow * INC + C_VB + h8 * 256,
                                    OB0 + (size_t)m * (SLOT / 2) + krow * DM + h8 * 256, 4, F.lds);
                __syncthreads();
            } else {
                const int w = v - 32, b = w >> 4, hq = w & 15, kvh = hq >> 2; const size_t krow = (size_t)b * RPB;
                const float sk = F.sink[l * 16 + hq] * 1.4426950408889634f;
                att::attn_body<false>(PX + krow * INC + C_QA + hq * 128, PX + krow * INC + C_KA + kvh * 128, PX + krow * INC + C_VA + kvh * 128,
                                      OA + krow * DM + hq * 128, 4, 4, 0, 0, sk, lds);
            }
        }
    }
}

__device__ __forceinline__ void ph_post(Frame& F, int l) {
    FRESH_IDS
    const bf16* PX = (const bf16*)(F.ws + WS_PX);
    const bf16* OA = (const bf16*)(F.ws + WS_S0); const bf16* OB0 = (const bf16*)(F.ws + WS_S0 + SLOT); const bf16* OB1 = (const bf16*)(F.ws + WS_S0 + 2 * SLOT);
    bf16* GA = (bf16*)(F.ws + WS_S0 + 3 * SLOT); bf16* GB = (bf16*)(F.ws + WS_S0 + 4 * SLOT);
    const float lam_init = 0.8f - 0.6f * expf(-0.3f * (float)l);
    const float* lq = F.lam_qk + (size_t)l * 512;
    const float d1 = wave_sum(lq[lane] * lq[128 + lane] + lq[64 + lane] * lq[192 + lane]);
    const float d2 = wave_sum(lq[256 + lane] * lq[384 + lane] + lq[320 + lane] * lq[448 + lane]);
    const float lam = expf(d1) - expf(d2) + lam_init;
    const f32x4 gs = ((const f32x4*)(F.g_subln + (size_t)l * 256))[lane] * (1.f - lam_init);
    GW_LOOP(row, MROWS) {
        if (l != 0 && (row % RPB) < CTX) continue;
        const size_t ro = (size_t)row * DM, rp = (size_t)row * INC;
#pragma unroll
        for (int j = 0; j < 8; ++j) { const int c = 4 * (lane + 64 * j);
            const v2u oa = *(const v2u*)(OA + ro + c), za = *(const v2u*)(PX + rp + C_ZA + c);
            v2u o; o.x = pk2(bflo(oa.x) * siluf(bflo(za.x)), bfhi(oa.x) * siluf(bfhi(za.x))); o.y = pk2(bflo(oa.y) * siluf(bflo(za.y)), bfhi(oa.y) * siluf(bfhi(za.y)));
            *(v2u*)(GA + ro + c) = o; }
#pragma unroll
        for (int j = 0; j < 8; ++j) { const int c = 256 * j + 4 * lane;
            const v2u o0 = *(const v2u*)(OB0 + ro + c), o1 = *(const v2u*)(OB1 + ro + c), zb = *(const v2u*)(PX + rp + C_ZB + c);
            f32x4 d; d.x = bflo(o0.x) - lam * bflo(o1.x); d.y = bfhi(o0.x) - lam * bfhi(o1.x); d.z = bflo(o0.y) - lam * bflo(o1.y); d.w = bfhi(o0.y) - lam * bfhi(o1.y);
            const float ss = wave_sum((d.x * d.x + d.y * d.y) + (d.z * d.z + d.w * d.w));
            const float rs = rsqrtf(ss * (1.f / 256.f) + EPS);
            const f32x4 y = d * rs * gs;
            v2u o; o.x = pk2(y.x * siluf(bflo(zb.x)), y.y * siluf(bfhi(zb.x))); o.y = pk2(y.z * siluf(bflo(zb.y)), y.w * siluf(bfhi(zb.y)));
            *(v2u*)(GB + ro + c) = o; }
    }
}

__device__ __forceinline__ void ph_merge(Frame& F, int l) {
    FRESH_IDS
    const bf16* PX = (const bf16*)(F.ws + WS_PX);
    const bf16* YA = (const bf16*)(F.ws + WS_S0); const bf16* YB = (const bf16*)(F.ws + WS_S0 + SLOT); bf16* MG = (bf16*)(F.ws + WS_S0 + 2 * SLOT);
    const unsigned total = (unsigned)MROWS * (DM / 8);
    for (unsigned i = (unsigned)(F.vcu * NWAVES * 64 + tid); i < total; i += (unsigned)(F.G * NWAVES * 64)) {
        const unsigned row = i >> 8, c = (i & 255) * 8;
        if (l != 0 && (row % RPB) < CTX) continue;
        const v4u ya = *(const v4u*)(YA + (size_t)row * DM + c), yb = *(const v4u*)(YB + (size_t)row * DM + c);
        const v4u ga = *(const v4u*)(PX + (size_t)row * INC + C_GA + c), gb = *(const v4u*)(PX + (size_t)row * INC + C_GB + c);
        v4u o;
#define MRG(W) o.W = pk2(sigmf(bflo(ga.W)) * bflo(ya.W) + sigmf(bflo(gb.W)) * bflo(yb.W), sigmf(bfhi(ga.W)) * bfhi(ya.W) + sigmf(bfhi(gb.W)) * bfhi(yb.W));
        MRG(x) MRG(y) MRG(z) MRG(w)
#undef MRG
        *(v4u*)(MG + (size_t)row * DM + c) = o;
    }
}

__device__ __forceinline__ void ph_res(Frame& F, int l, const float* xcur, const float* ctxcur) {
    FRESH_IDS
    const bf16* OX = (const bf16*)(F.ws + WS_S0 + 3 * SLOT);
    bf16* H = (bf16*)(F.ws + WS_S0);
    const float* gp = F.g_post + (size_t)l * DM;
    const bool nxt = (l + 1 < DEPTH);
    const float* gpn = F.g_pre + (size_t)(l + 1) * DM;
    GW_LOOP(row, MROWS) {
        const int b = row / RPB, rr = row % RPB; const float* src; float* dst; int v;
        if (rr < CTX) { if (!nxt) continue; src = ctxcur + (size_t)(b * CTX + rr) * DM; dst = nullptr; v = 2; }
        else { src = xcur + (size_t)(b * SEQ + rr - CTX) * DM; dst = F.out + (size_t)(b * SEQ + rr - CTX) * DM; v = b; }
        const float* gt = (const float*)(F.ws + WS_MOD) + (size_t)(l * 3 + v) * 6144 + 2 * DM;
        f32x4 ov[8]; float s = 0.f;
#pragma unroll
        for (int j = 0; j < 8; ++j) { const v2u w = *(const v2u*)(OX + (size_t)row * DM + 4 * (lane + 64 * j));
            ov[j] = (f32x4){bflo(w.x), bfhi(w.x), bflo(w.y), bfhi(w.y)}; s += (ov[j].x * ov[j].x + ov[j].y * ov[j].y) + (ov[j].z * ov[j].z + ov[j].w * ov[j].w); }
        const float rs = rsqrtf(wave_sum(s) * (1.f / DM) + EPS);
        float s2 = 0.f;
#pragma unroll
        for (int j = 0; j < 8; ++j) { const int q = lane + 64 * j;
            const f32x4 g = ((const f32x4*)gp)[q], gate = ((const f32x4*)gt)[q], xr = ((const f32x4*)src)[q];
            ov[j] = xr + gate * ((ov[j] * rs) * g);
            if (dst) ((f32x4*)dst)[q] = ov[j];
            s2 += (ov[j].x * ov[j].x + ov[j].y * ov[j].y) + (ov[j].z * ov[j].z + ov[j].w * ov[j].w); }
        if (nxt) {
            const float* md = (const float*)(F.ws + WS_MOD) + (size_t)((l + 1) * 3 + v) * 6144;
            const float rs2 = rsqrtf(wave_sum(s2) * (1.f / DM) + EPS);
#pragma unroll
            for (int j = 0; j < 8; ++j) { const int q = lane + 64 * j;
                const f32x4 g = ((const f32x4*)gpn)[q], sh = ((const f32x4*)md)[q], sc = ((const f32x4*)(md + DM))[q];
                const f32x4 y = (ov[j] * rs2) * g * (sc + 1.f) + sh;
                v2u o; o.x = pk2(y.x, y.y); o.y = pk2(y.z, y.w);
                *(v2u*)(H + (size_t)row * DM + 4 * q) = o; }
        }
    }
}

__device__ __forceinline__ void run_gemm_in(Frame& F, const bf16* A, const bf16* Bt, bf16* O) {
    pg8::Gemm g{A, Bt, MROWS, INC, DM}; pg8::RowSkipOrder S; S.init(INC, F.G, (int)blockIdx.x, false);
    pg8::EpiRope E{O, INC, (const float*)(F.ws + WS_COS), (const float*)(F.ws + WS_SIN)};
    pg8::gemm_phase<pg8::EpiRope, pg8::RowSkipOrder, true, true>(F.lds, g, S, E);
}
__device__ __forceinline__ void run_gemm_skip(Frame& F, const bf16* A, const bf16* Bt, bf16* O, bool skip) {
    pg8::Gemm g{A, Bt, MROWS, DM, DM}; pg8::RowSkipOrder S; S.init(DM, F.G, (int)blockIdx.x, skip);
    pg8::EpiBf16 E{O, DM};
    pg8::gemm_phase<pg8::EpiBf16, pg8::RowSkipOrder, true, true>(F.lds, g, S, E);
}
template <bool ADD>
__device__ __forceinline__ void run_gemm_gate(Frame& F, const bf16* A, const bf16* Bt, bf16* O, const bf16* T, const bf16* G, bool skip) {
    pg8::Gemm g{A, Bt, MROWS, DM, DM}; pg8::RowSkipOrder S; S.init(DM, F.G, (int)blockIdx.x, skip);
    pg8::EpiGate<ADD> E{O, T, G, DM, INC};
    pg8::gemm_phase<pg8::EpiGate<ADD>, pg8::RowSkipOrder, true, true>(F.lds, g, S, E);
}

struct Args { const float* in[15]; float* out; unsigned char* ws; };
__global__ void __launch_bounds__(NWAVES * 64, 2) fwd_mega(Args args) {
    extern __shared__ __attribute__((aligned(16))) unsigned char lds[];
    cg::grid_group grid = cg::this_grid();
    Frame F;
    F.lds = (LAS unsigned char*)lds;
    F.G = gridDim.x; { const int bx = blockIdx.x; F.vcu = (F.G % 8 == 0) ? (bx % 8) * (F.G / 8) + bx / 8 : bx; }
    F.x = args.in[0]; F.c = args.in[1]; F.ctx = args.in[2]; F.c_ctx = args.in[3]; F.w_ada = args.in[4]; F.b_ada = args.in[5]; F.g_pre = args.in[6]; F.g_post = args.in[7];
    F.w_in = args.in[8]; F.sink = args.in[9]; F.lam_qk = args.in[10]; F.g_subln = args.in[11]; F.w_pa = args.in[12]; F.w_pb = args.in[13]; F.w_out = args.in[14];
    F.out = args.out; F.ws = args.ws;
    bf16* WinT = (bf16*)(F.ws + WS_WINT); bf16* WpT = (bf16*)(F.ws + WS_WPT); bf16* PX = (bf16*)(F.ws + WS_PX);
    bf16* S0 = (bf16*)(F.ws + WS_S0); bf16* S1 = (bf16*)(F.ws + WS_S0 + SLOT); bf16* S2 = (bf16*)(F.ws + WS_S0 + 2 * SLOT); bf16* S3 = (bf16*)(F.ws + WS_S0 + 3 * SLOT); bf16* S4 = (bf16*)(F.ws + WS_S0 + 4 * SLOT);

    ph_prologue(F);
    grid.sync();
#pragma unroll 1
    for (int l = 0; l < DEPTH; ++l) {
        const float* xcur = (l == 0) ? F.x : F.out;
        const float* ctxcur = (l == 0) ? F.ctx : (const float*)(F.ws + WS_CTX1);
        if (l == 0) { ph_hnorm(F, l, xcur, ctxcur); grid.sync(); }
        run_gemm_in(F, S0, WinT, PX);
        grid.sync();
        ph_attn(F, l, (char*)lds);
        grid.sync();
        ph_post(F, l);
        if (l + 1 < DEPTH) ph_convert_win(F, l + 1);
        grid.sync();
        run_gemm_gate<false>(F, S3, WpT + (size_t)(l * 3 + 0) * DM * DM, S0, S0, PX + C_GA, l != 0);
        run_gemm_gate<true>(F, S4, WpT + (size_t)(l * 3 + 1) * DM * DM, S2, S0, PX + C_GB, l != 0);
        grid.sync();
        run_gemm_skip(F, S2, WpT + (size_t)(l * 3 + 2) * DM * DM, S3, l != 0);
        grid.sync();
        ph_res(F, l, xcur, ctxcur);
        grid.sync();
    }
}

extern "C" void kernel_launch(void* const* d_in, const int* in_sizes, int n_in, void* d_out, int out_size, void* d_ws, size_t ws_size, hipStream_t stream) {
    static int grid = 0;
    if (grid == 0) {
        if (n_in != 15 || out_size != NB * SEQ * DM || ws_size < WS_END) { fprintf(stderr, "kernel_launch: unexpected shapes: n_in %d out %d ws %zu (need %zu)\n", n_in, out_size, ws_size, (size_t)WS_END); grid = -1; return; }
        int dev = 0, cus = 0, per_cu = 0;
        if (hipGetDevice(&dev) != hipSuccess || hipDeviceGetAttribute(&cus, hipDeviceAttributeMultiprocessorCount, dev) != hipSuccess) { grid = -1; return; }
        if (hipFuncSetAttribute((const void*)fwd_mega, hipFuncAttributeMaxDynamicSharedMemorySize, LDS_BYTES) != hipSuccess) { fprintf(stderr, "kernel_launch: hipFuncSetAttribute failed\n"); grid = -1; return; }
        if (hipOccupancyMaxActiveBlocksPerMultiprocessor(&per_cu, (const void*)fwd_mega, NWAVES * 64, LDS_BYTES) != hipSuccess || per_cu < 1) { fprintf(stderr, "kernel_launch: occupancy query says %d\n", per_cu); per_cu = 1; }
        (void)hipGetLastError();
        grid = cus * per_cu;
    }
    if (grid < 0) return;
    Args a{};
    for (int i = 0; i < 15; ++i) a.in[i] = (const float*)d_in[i];
    a.out = (float*)d_out; a.ws = (unsigned char*)d_ws;
    void* kargs[] = {&a};
    hipError_t e = hipLaunchCooperativeKernel((const void*)fwd_mega, dim3(grid), dim3(NWAVES * 64), kargs, LDS_BYTES, stream);
    if (e != hipSuccess) fprintf(stderr, "kernel_launch: cooperative launch failed: %s (grid %d)\n", hipGetErrorString(e), grid);
}
```

```cpp
#include <hip/hip_runtime.h>
#include <hip/hip_bf16.h>
#include <hip/hip_cooperative_groups.h>
#include <cstdio>
#include <cstdint>
#include <cmath>
namespace cg = cooperative_groups;

constexpr int DM = 2048, NB = 2, SEQ = 8192, DEPTH = 2, CTX = 256;
constexpr int RPB = CTX + SEQ;
constexpr int MROWS = NB * RPB;
constexpr int INC = 17408;
constexpr int C_KA = 0, C_VA = 512, C_KB = 1024, C_VB = 3072, C_QA = 5120, C_ZA = 7168, C_QB = 9216, C_ZB = 11264, C_GA = 13312, C_GB = 15360;
constexpr float EPS = 1e-6f;

namespace pg8 {
#define PG8_LAS __attribute__((address_space(3)))
typedef unsigned short bf16_t;
typedef short bf16x8 __attribute__((ext_vector_type(8)));
typedef float f32x4 __attribute__((ext_vector_type(4)));
typedef unsigned u32x4 __attribute__((ext_vector_type(4)));
constexpr int BM = 256, BK = 64, HALF = 128, HTB = HALF * BK * 2  , STAGE_BYTES = 8 * HTB, NXCD = 8, WGM = 8;

__host__ __device__ __forceinline__ int lds_byte(int r, int c) { const int st = (r >> 4) * 2 + (c >> 5), rr = r & 15, cc = c & 31, ob = rr * 64 + cc * 2; return st * 1024 + (ob ^ (((ob >> 9) & 1) << 5)); }
__host__ __device__ __forceinline__ void stage_rc(int b, int& R, int& C) { const int st = b / 1024, sb = b % 1024, swz = sb ^ (((sb >> 9) & 1) << 5); R = (st >> 1) * 16 + swz / 64; C = (st & 1) * 32 + (swz % 64) / 2; }
__host__ __device__ __forceinline__ int perm32(int rho) { const int n = rho >> 4, i = rho & 15; return 8 * (i >> 2) + 4 * n + (i & 3); }

struct Unit { int pm, pn; };
struct Gemm { const bf16_t* A; const bf16_t* Bt; int M, N, K; };

struct StaticOrder {
    int nM, nN, nwg, G, c;
    __host__ __device__ void init(int M, int N, int G_, int c_) { nM = M / BM; nN = N / BM; nwg = nM * nN; G = G_; c = c_; }
    __host__ __device__ bool next(int i, Unit& u) const {
        const long L = (long)i * G + c; if (L >= nwg) return false;
        int wgid = (int)L; { const int q = nwg / NXCD, r = nwg % NXCD, xcd = wgid % NXCD, off = wgid / NXCD; wgid = (xcd < r ? xcd * (q + 1) : r * (q + 1) + (xcd - r) * q) + off; }
        const int nig = WGM * nN, gid = wgid / nig, fm = gid * WGM, gsz = (nM - fm) < WGM ? (nM - fm) : WGM;
        u.pm = fm + ((wgid % nig) % gsz); u.pn = (wgid % nig) / gsz; return true;
    }
    __device__ __forceinline__ void a_ready(const Unit&) const {}
    __device__ __forceinline__ void done(const Unit&) const {}
};

__device__ __forceinline__ unsigned cvt_pk_bf16(float lo, float hi) { unsigned r; asm volatile("v_cvt_pk_bf16_f32 %0, %1, %2" : "=v"(r) : "v"(lo), "v"(hi)); return r; }
typedef float f32x2 __attribute__((ext_vector_type(2)));

struct EpiBf16 {
    static constexpr bool PERM = true, AFTER_DRAIN = false;
    bf16_t* O; int ldc;
    __device__ __forceinline__ void operator()(const f32x4 (&acc)[2][2][4][2], const Unit& u, int wr, int wc, int fr, int fq) const {
        const int row0 = u.pm * BM + wr * 64 + fr; const int col0 = u.pn * BM + wc * 32 + 8 * fq;
#pragma unroll
        for (int ai = 0; ai < 2; ++ai)
#pragma unroll
            for (int m = 0; m < 4; ++m) { bf16_t* rowp = O + (size_t)(row0 + ai * HALF + m * 16) * ldc + col0;
#pragma unroll
                for (int bj = 0; bj < 2; ++bj) { const f32x4 v0 = acc[ai][bj][m][0], v1 = acc[ai][bj][m][1];
                    u32x4 w; w.x = cvt_pk_bf16(v0[0], v0[1]); w.y = cvt_pk_bf16(v0[2], v0[3]); w.z = cvt_pk_bf16(v1[0], v1[1]); w.w = cvt_pk_bf16(v1[2], v1[3]);
                    *(u32x4*)(rowp + bj * HALF) = w; } }
    }
};

__device__ __forceinline__ float sigm_(float x) { return 1.f / (1.f + __expf(-x)); }
__device__ __forceinline__ float blo_(unsigned w) { return __builtin_bit_cast(float, w << 16); }
__device__ __forceinline__ float bhi_(unsigned w) { return __builtin_bit_cast(float, w & 0xffff0000u); }
template <bool ADD> struct EpiGate {
    static constexpr bool PERM = true, AFTER_DRAIN = false;
    bf16_t* O; const bf16_t* T; const bf16_t* G; int ldc; int ldg;
    __device__ __forceinline__ void operator()(const f32x4 (&acc)[2][2][4][2], const Unit& u, int wr, int wc, int fr, int fq) const {
        const int row0 = u.pm * BM + wr * 64 + fr; const int col0 = u.pn * BM + wc * 32 + 8 * fq;
#pragma unroll
        for (int ai = 0; ai < 2; ++ai)
#pragma unroll
            for (int m = 0; m < 4; ++m) { const size_t row = (size_t)(row0 + ai * HALF + m * 16);
#pragma unroll
                for (int bj = 0; bj < 2; ++bj) { const f32x4 v0 = acc[ai][bj][m][0], v1 = acc[ai][bj][m][1];
                    const u32x4 g = *(const u32x4*)(G + row * ldg + col0 + bj * HALF);
                    float r0 = sigm_(blo_(g.x)) * v0[0], r1 = sigm_(bhi_(g.x)) * v0[1], r2 = sigm_(blo_(g.y)) * v0[2], r3 = sigm_(bhi_(g.y)) * v0[3];
                    float r4 = sigm_(blo_(g.z)) * v1[0], r5 = sigm_(bhi_(g.z)) * v1[1], r6 = sigm_(blo_(g.w)) * v1[2], r7 = sigm_(bhi_(g.w)) * v1[3];
                    if (ADD) { const u32x4 t = *(const u32x4*)(T + row * ldc + col0 + bj * HALF);
                        r0 += blo_(t.x); r1 += bhi_(t.x); r2 += blo_(t.y); r3 += bhi_(t.y); r4 += blo_(t.z); r5 += bhi_(t.z); r6 += blo_(t.w); r7 += bhi_(t.w); }
                    u32x4 w; w.x = cvt_pk_bf16(r0, r1); w.y = cvt_pk_bf16(r2, r3); w.z = cvt_pk_bf16(r4, r5); w.w = cvt_pk_bf16(r6, r7);
                    *(u32x4*)(O + row * ldc + col0 + bj * HALF) = w; } }
    }
};
struct RowSkipOrder {
    StaticOrder base; bool skip;
    __device__ void init(int N, int G_, int c_, bool skip_) { skip = skip_; base.init(skip_ ? 16384 : 16896, N, G_, c_); }
    __device__ bool next(int i, Unit& u) const { if (!base.next(i, u)) return false; if (skip) u.pm += 1 + (u.pm >= 32 ? 1 : 0); return true; }
    __device__ __forceinline__ void a_ready(const Unit&) const {}
    __device__ __forceinline__ void done(const Unit&) const {}
};

struct EpiRope {
    static constexpr bool PERM = true, AFTER_DRAIN = false;
    bf16_t* O; int ldc; const float* ct; const float* st;
    __device__ __forceinline__ void operator()(const f32x4 (&acc)[2][2][4][2], const Unit& u, int wr, int wc, int fr, int fq) const {
        const int pn = u.pn; const bool rope = pn < 2 || (pn >= 4 && pn < 12) || (pn >= 20 && pn < 28) || (pn >= 36 && pn < 44);
        const int row0 = u.pm * BM + wr * 64 + fr;
        if (!rope) {
            const int col0 = pn * BM + wc * 32 + 8 * fq;
#pragma unroll
            for (int ai = 0; ai < 2; ++ai)
#pragma unroll
                for (int m = 0; m < 4; ++m) { bf16_t* rowp = O + (size_t)(row0 + ai * HALF + m * 16) * ldc + col0;
#pragma unroll
                    for (int bj = 0; bj < 2; ++bj) { const f32x4 v0 = acc[ai][bj][m][0], v1 = acc[ai][bj][m][1];
                        u32x4 w; w.x = cvt_pk_bf16(v0[0], v0[1]); w.y = cvt_pk_bf16(v0[2], v0[3]); w.z = cvt_pk_bf16(v1[0], v1[1]); w.w = cvt_pk_bf16(v1[2], v1[3]);
                        *(u32x4*)(rowp + bj * HALF) = w; } }
            return;
        }
        const bool isctx = (u.pm == 0) || (u.pm == 33);
        const int i0 = 32 * (wc & 1) + 8 * fq, ocol = pn * BM + (wc >> 1) * 128 + i0;
        const int tbase = row0 - (u.pm >= 33 ? 8448 : 0) - 256;
#pragma unroll
        for (int ai = 0; ai < 2; ++ai)
#pragma unroll
            for (int m = 0; m < 4; ++m) { const int t = tbase + ai * HALF + m * 16;
                f32x4 c0 = {1.f, 1.f, 1.f, 1.f}, c1 = c0, s0 = {0.f, 0.f, 0.f, 0.f}, s1 = s0;
                if (!isctx) { const float* cp = ct + (size_t)t * 64 + i0; const float* sp = st + (size_t)t * 64 + i0;
                    c0 = *(const f32x4*)cp; c1 = *(const f32x4*)(cp + 4); s0 = *(const f32x4*)sp; s1 = *(const f32x4*)(sp + 4); }
                const f32x4 a0 = acc[ai][0][m][0], a1 = acc[ai][0][m][1], b0 = acc[ai][1][m][0], b1 = acc[ai][1][m][1];
                const f32x4 y0 = a0 * c0 - b0 * s0, y1 = a1 * c1 - b1 * s1, z0 = b0 * c0 + a0 * s0, z1 = b1 * c1 + a1 * s1;
                bf16_t* rowp = O + (size_t)(row0 + ai * HALF + m * 16) * ldc + ocol;
                u32x4 w; w.x = cvt_pk_bf16(y0[0], y0[1]); w.y = cvt_pk_bf16(y0[2], y0[3]); w.z = cvt_pk_bf16(y1[0], y1[1]); w.w = cvt_pk_bf16(y1[2], y1[3]);
                *(u32x4*)rowp = w;
                u32x4 x; x.x = cvt_pk_bf16(z0[0], z0[1]); x.y = cvt_pk_bf16(z0[2], z0[3]); x.z = cvt_pk_bf16(z1[0], z1[1]); x.w = cvt_pk_bf16(z1[2], z1[3]);
                *(u32x4*)(rowp + 64) = x; }
    }
};

template <class Epi, class Sched, bool ALIGN_EPI = false, bool SP2 = false>
__device__ __forceinline__ void gemm_phase(PG8_LAS unsigned char* lds, const Gemm g, const Sched& S, const Epi& E) {
    int tid_ = threadIdx.x; asm volatile("" : "+v"(tid_));
    const int tid = tid_, wid = __builtin_amdgcn_readfirstlane(tid >> 6), lane = tid & 63, wr = wid >> 2, wc = wid & 3, fr = lane & 15, fq = lane >> 4;
    const int K = g.K, nt = K / BK;
    unsigned voffA[2], voffB[2];
#pragma unroll
    for (int i = 0; i < 2; ++i) { int R, C; stage_rc(tid * 16 + i * 8192, R, C); const int Rb = Epi::PERM ? ((R & ~31) + perm32(R & 31)) : R;
        voffA[i] = (unsigned)(R * K + C) * 2u; voffB[i] = (unsigned)(Rb * K + C) * 2u; }
    const size_t kstep = (size_t)(BK * 2);
    const size_t hstep = (size_t)HALF * K * 2;
    const size_t tstep = 2 * hstep;
    const unsigned ldsw = (unsigned)wid * 1024u;
    const int aoff = lds_byte(wr * 64 + fr, fq * 8), boff = lds_byte(wc * 32 + fr, fq * 8);
#define PG8_SA(b, h) (((b) * 2 + (h)) * HTB)
#define PG8_SB(b, h) ((4 + (b) * 2 + (h)) * HTB)
#define PG8_STAGE(bufoff, gbase, voff) do { _Pragma("unroll") for (int _i = 0; _i < 2; ++_i) \
        __builtin_amdgcn_global_load_lds((const unsigned*)((const char*)(gbase) + (voff)[_i]), (PG8_LAS unsigned*)(lds + (bufoff) + ldsw + _i * 8192), 16, 0, 0); } while (0)
#define PG8_LDA(dst, b, h) do { _Pragma("unroll") for (int m = 0; m < 4; ++m) _Pragma("unroll") for (int k = 0; k < 2; ++k) dst[m][k] = *(const PG8_LAS bf16x8*)(lds + PG8_SA(b, h) + aoff + m * 2048 + k * 1024); } while (0)
#define PG8_LDB(dst, b, h) do { _Pragma("unroll") for (int n = 0; n < 2; ++n) _Pragma("unroll") for (int k = 0; k < 2; ++k) dst[n][k] = *(const PG8_LAS bf16x8*)(lds + PG8_SB(b, h) + boff + n * 2048 + k * 1024); } while (0)
#define PG8_MMA(ai, bj, At, Bt) do { __builtin_amdgcn_s_setprio(1); _Pragma("unroll") for (int m = 0; m < 4; ++m) _Pragma("unroll") for (int n = 0; n < 2; ++n) _Pragma("unroll") for (int k = 0; k < 2; ++k) \
        acc[ai][bj][m][n] = __builtin_amdgcn_mfma_f32_16x16x32_bf16(Bt[n][k], At[m][k], acc[ai][bj][m][n], 0, 0, 0); __builtin_amdgcn_s_setprio(0); } while (0)
#define PG8_WAIT_V(n) asm volatile("s_waitcnt vmcnt(" #n ")" ::: "memory")
#define PG8_WAIT_L(n) asm volatile("s_waitcnt lgkmcnt(" #n ")" ::: "memory")
#define PG8_BAR __builtin_amdgcn_s_barrier()
#define PG8_SCHED __builtin_amdgcn_sched_barrier(0)
    Unit cur, nxt; int ui = 0;
    if (!S.next(0, cur)) return;
    f32x4 acc[2][2][4][2];
#pragma unroll
    for (int a = 0; a < 2; ++a)
#pragma unroll
        for (int b = 0; b < 2; ++b)
#pragma unroll
            for (int m = 0; m < 4; ++m)
#pragma unroll
                for (int n = 0; n < 2; ++n) acc[a][b][m][n] = (f32x4){0.f, 0.f, 0.f, 0.f};
    bf16x8 At[4][2], B0[2][2], B1[2][2];
    const char* cA = (const char*)g.A + (size_t)cur.pm * tstep; const char* cB = (const char*)g.Bt + (size_t)cur.pn * tstep;
    S.a_ready(cur);
    if constexpr (SP2) {
        PG8_STAGE(PG8_SB(0, 0), cB, voffB); PG8_STAGE(PG8_SB(0, 1), cB + hstep, voffB); PG8_STAGE(PG8_SA(0, 0), cA, voffA); PG8_STAGE(PG8_SA(0, 1), cA + hstep, voffA);
        if (wr == 1) PG8_BAR;
        PG8_WAIT_V(2); PG8_BAR;
        PG8_STAGE(PG8_SB(1, 0), cB + kstep, voffB); PG8_STAGE(PG8_SA(1, 0), cA + kstep, voffA); PG8_STAGE(PG8_SB(1, 1), cB + hstep + kstep, voffB);
        PG8_WAIT_V(6); PG8_BAR;
    } else {
        PG8_STAGE(PG8_SB(0, 0), cB, voffB); PG8_STAGE(PG8_SA(0, 0), cA, voffA); PG8_STAGE(PG8_SB(0, 1), cB + hstep, voffB); PG8_STAGE(PG8_SA(0, 1), cA + hstep, voffA);
        if (wr == 1) PG8_BAR;
        PG8_WAIT_V(4); PG8_BAR;
        PG8_STAGE(PG8_SB(1, 0), cB + kstep, voffB); PG8_STAGE(PG8_SA(1, 0), cA + kstep, voffA); PG8_STAGE(PG8_SB(1, 1), cB + hstep + kstep, voffB);
        PG8_WAIT_V(6); PG8_BAR;
    }
    for (;;) {
        const bool has_next = S.next(ui + 1, nxt);
        const char* nA = has_next ? (const char*)g.A + (size_t)nxt.pm * tstep : cA; const char* nB = has_next ? (const char*)g.Bt + (size_t)nxt.pn * tstep : cB;
        for (int t = 0; t < nt; t += 2) {
            const bool last = (t == nt - 2);
            const char* a1 = cA + (size_t)(t + 1) * kstep;
            const char* a2 = last ? nA : cA + (size_t)(t + 2) * kstep; const char* b2 = last ? nB : cB + (size_t)(t + 2) * kstep;
            const char* a3 = a2 + kstep; const char* b3 = b2 + kstep;
            if (last && has_next) S.a_ready(nxt);
            if constexpr (SP2) {
            PG8_LDB(B0, 0, 0); PG8_LDB(B1, 0, 1); PG8_SCHED; PG8_LDA(At, 0, 0); PG8_STAGE(PG8_SA(1, 1), a1 + hstep, voffA);
            PG8_WAIT_V(8); PG8_WAIT_L(0); PG8_BAR; PG8_MMA(0, 0, At, B0); PG8_MMA(0, 1, At, B1); PG8_BAR; PG8_SCHED;
            PG8_LDA(At, 0, 1); PG8_STAGE(PG8_SB(0, 0), b2, voffB); PG8_STAGE(PG8_SB(0, 1), b2 + hstep, voffB); PG8_STAGE(PG8_SA(0, 0), a2, voffA);
            PG8_WAIT_V(8); PG8_WAIT_L(0); PG8_BAR; PG8_MMA(1, 0, At, B0); PG8_MMA(1, 1, At, B1); PG8_BAR; PG8_SCHED;
            PG8_LDB(B0, 1, 0); PG8_LDB(B1, 1, 1); PG8_SCHED; PG8_LDA(At, 1, 0); PG8_STAGE(PG8_SA(0, 1), a2 + hstep, voffA);
            PG8_WAIT_V(8); PG8_WAIT_L(0); PG8_BAR; PG8_MMA(0, 0, At, B0); PG8_MMA(0, 1, At, B1); PG8_BAR; PG8_SCHED;
            PG8_LDA(At, 1, 1); PG8_STAGE(PG8_SB(1, 0), b3, voffB); PG8_STAGE(PG8_SB(1, 1), b3 + hstep, voffB); PG8_STAGE(PG8_SA(1, 0), a3, voffA);
            PG8_WAIT_V(8); PG8_WAIT_L(0); PG8_BAR; PG8_MMA(1, 0, At, B0); PG8_MMA(1, 1, At, B1); PG8_BAR; PG8_SCHED;
            } else {
            PG8_LDB(B0, 0, 0); PG8_SCHED; PG8_LDA(At, 0, 0); PG8_STAGE(PG8_SA(1, 1), a1 + hstep, voffA);
            PG8_WAIT_L(8); PG8_BAR; PG8_WAIT_L(0); PG8_MMA(0, 0, At, B0); PG8_BAR; PG8_SCHED;
            PG8_LDB(B1, 0, 1); PG8_STAGE(PG8_SB(0, 0), b2, voffB);
            PG8_BAR; PG8_WAIT_L(0); PG8_MMA(0, 1, At, B1); PG8_BAR;
            PG8_LDA(At, 0, 1); PG8_STAGE(PG8_SA(0, 0), a2, voffA);
            PG8_BAR; PG8_WAIT_L(0); PG8_MMA(1, 0, At, B0); PG8_BAR; PG8_SCHED;
            PG8_STAGE(PG8_SB(0, 1), b2 + hstep, voffB);
            PG8_WAIT_V(6); PG8_BAR; PG8_MMA(1, 1, At, B1); PG8_BAR;
            PG8_LDB(B0, 1, 0); PG8_SCHED; PG8_LDA(At, 1, 0); PG8_STAGE(PG8_SA(0, 1), a2 + hstep, voffA);
            PG8_WAIT_L(8); PG8_BAR; PG8_WAIT_L(0); PG8_MMA(0, 0, At, B0); PG8_BAR; PG8_SCHED;
            PG8_LDB(B1, 1, 1); PG8_STAGE(PG8_SB(1, 0), b3, voffB);
            PG8_BAR; PG8_WAIT_L(0); PG8_MMA(0, 1, At, B1); PG8_BAR;
            PG8_LDA(At, 1, 1); PG8_STAGE(PG8_SA(1, 0), a3, voffA);
            PG8_BAR; PG8_WAIT_L(0); PG8_MMA(1, 0, At, B0); PG8_BAR; PG8_SCHED;
            PG8_STAGE(PG8_SB(1, 1), b3 + hstep, voffB);
            PG8_WAIT_V(6); PG8_BAR; PG8_MMA(1, 1, At, B1); PG8_BAR;
            }
        }
        if constexpr (ALIGN_EPI) { if (wr == 0) PG8_BAR; }
        if constexpr (!Epi::AFTER_DRAIN) { E(acc, cur, wr, wc, fr, fq); S.done(cur); }
        if (!has_next) break;
#pragma unroll
        for (int a = 0; a < 2; ++a)
#pragma unroll
            for (int b = 0; b < 2; ++b)
#pragma unroll
                for (int m = 0; m < 4; ++m)
#pragma unroll
                    for (int n = 0; n < 2; ++n) acc[a][b][m][n] = (f32x4){0.f, 0.f, 0.f, 0.f};
        cur = nxt; cA = nA; cB = nB; ++ui;
        if constexpr (ALIGN_EPI) { if (wr == 1) PG8_BAR; }
    }
    PG8_WAIT_V(0);
    if constexpr (!ALIGN_EPI) { if (wr == 0) PG8_BAR; }
    PG8_BAR;
    if constexpr (Epi::AFTER_DRAIN) { E.fused(acc, cur, wr, wc, fr, fq, lds, wid, lane); S.done(cur); }
#undef PG8_SA
#undef PG8_SB
#undef PG8_STAGE
#undef PG8_LDA
#undef PG8_LDB
#undef PG8_MMA
#undef PG8_WAIT_V
#undef PG8_WAIT_L
#undef PG8_BAR
#undef PG8_SCHED
}
}

namespace att {
using bf16 = unsigned short;
constexpr int D = 128, NW = 8, QBLK = 32, KVBLK = 64;
constexpr float SCALE = 0.088388347648318440f;
constexpr float THR = 8.f;
constexpr int SDEPTH = 2;
constexpr int LDQ = INC, LDK = INC, LDO = DM;
constexpr size_t SHM_V = KVBLK * D * 2, SHM_K = KVBLK * D * 2, SHM_ATTN = 2 * SHM_V + 2 * SHM_K + NW * 64 * 4;

using bf16x8 = __attribute__((ext_vector_type(8))) short;
using s16x4  = __attribute__((ext_vector_type(4))) short;
using f32x16 = __attribute__((ext_vector_type(16))) float;
using f32x8  = __attribute__((ext_vector_type(8))) float;
using u32x4  = __attribute__((ext_vector_type(4))) unsigned;
#define KSWZ(row, colB) ((row) * 256 + ((colB) ^ (((row) & 7) << 4)))
#define SBAR() __builtin_amdgcn_sched_barrier(0)
__device__ __forceinline__ int crow(int r, int hi) { return (r & 3) + 8 * (r >> 2) + 4 * hi; }
__device__ __forceinline__ unsigned cvtpk(float lo, float hi) {
  unsigned r; asm volatile("v_cvt_pk_bf16_f32 %0, %1, %2" : "=v"(r) : "v"(lo), "v"(hi)); return r;
}
template <typename TIn> struct Stage;
template <> struct Stage<bf16>  { using T = bf16x8;
  __device__ static __forceinline__ T ld8(const bf16* p) { return *reinterpret_cast<const bf16x8*>(p); }
  __device__ static __forceinline__ bf16x8 tobf(T x) { return x; } };
template <> struct Stage<float> { using T = f32x8;
  __device__ static __forceinline__ T ld8(const float* p) { return *reinterpret_cast<const f32x8*>(p); }
  __device__ static __forceinline__ bf16x8 tobf(T x) {
    u32x4 w = {cvtpk(x[0], x[1]), cvtpk(x[2], x[3]), cvtpk(x[4], x[5]), cvtpk(x[6], x[7])}; return *reinterpret_cast<bf16x8*>(&w); } };

__device__ __forceinline__ void partialSM(f32x16& p0, f32x16& p1, float& m_reg, float& mn, float& alpha) {
  constexpr float C = SCALE * 1.4426950408889634f;
  float pmax = p0[0]; for (int r = 1; r < 16; ++r) pmax = fmaxf(pmax, p0[r]); for (int r = 0; r < 16; ++r) pmax = fmaxf(pmax, p1[r]);
  { auto rr = __builtin_amdgcn_permlane32_swap(__float_as_uint(pmax), __float_as_uint(pmax), false, false);
    pmax = fmaxf(__uint_as_float(rr[0]), __uint_as_float(rr[1])); }
  if (__builtin_expect(__all(pmax - m_reg <= THR / SCALE), 1)) { mn = m_reg; alpha = 1.f; }
  else { mn = fmaxf(m_reg, pmax); alpha = __builtin_amdgcn_exp2f((m_reg - mn) * C); m_reg = mn; }
  float mnC = -mn * C;
  for (int r = 0; r < 16; ++r) p0[r] = fmaf(p0[r], C, mnC); for (int r = 0; r < 16; ++r) p1[r] = fmaf(p1[r], C, mnC);
  for (int r = 0; r < 16; ++r) p0[r] = __builtin_amdgcn_exp2f(p0[r]);
}
__device__ __forceinline__ void finishSM(f32x16& p0, f32x16& p1, float alpha, float& l_reg, bf16x8& pa0, bf16x8& pa1, bf16x8& pa2, bf16x8& pa3) {
  for (int r = 0; r < 16; ++r) p1[r] = __builtin_amdgcn_exp2f(p1[r]);
  float ps = 0; for (int r = 0; r < 16; ++r) ps += p0[r]; for (int r = 0; r < 16; ++r) ps += p1[r];
  { auto rr = __builtin_amdgcn_permlane32_swap(__float_as_uint(ps), __float_as_uint(ps), false, false);
    ps = __uint_as_float(rr[0]) + __uint_as_float(rr[1]); }
  l_reg = l_reg * alpha + ps;
#define PK4(P, BASE, OUT) do { unsigned a0 = cvtpk(P[BASE + 0], P[BASE + 1]), a1 = cvtpk(P[BASE + 2], P[BASE + 3]);   \
    unsigned b0 = cvtpk(P[BASE + 4], P[BASE + 5]), b1 = cvtpk(P[BASE + 6], P[BASE + 7]);                              \
    auto r0 = __builtin_amdgcn_permlane32_swap(a0, b0, false, false); auto r1 = __builtin_amdgcn_permlane32_swap(a1, b1, false, false); \
    u32x4 w = {r0[0], r1[0], r0[1], r1[1]}; OUT = *reinterpret_cast<bf16x8*>(&w); } while (0)
  PK4(p0, 0, pa0); PK4(p0, 8, pa1); PK4(p1, 0, pa2); PK4(p1, 8, pa3);
#undef PK4
}
__device__ __forceinline__ void qkt(f32x16& p0, f32x16& p1, const bf16* Ks, const bf16x8* qr, int r32, int hi) {
  p0 = f32x16{}; p1 = f32x16{};
  for (int d0 = 0; d0 < 8; ++d0) { int cb = (d0 * 16 + hi * 8) * 2;
    bf16x8 b0 = *reinterpret_cast<const bf16x8*>((const char*)Ks + KSWZ(r32, cb));
    bf16x8 b1 = *reinterpret_cast<const bf16x8*>((const char*)Ks + KSWZ(32 + r32, cb));
    p0 = __builtin_amdgcn_mfma_f32_32x32x16_bf16(b0, qr[d0], p0, 0, 0, 0);
    p1 = __builtin_amdgcn_mfma_f32_32x32x16_bf16(b1, qr[d0], p1, 0, 0, 0); }
}
__device__ __forceinline__ int v_st(int k, int c) { const int kk = (k & ~0xC) | ((k & 4) << 1) | ((k & 8) >> 1); return ((kk >> 3) * 4 + (c >> 5)) * 512 + ((kk & 7) * 32 + (c & 31)) * 2; }
__device__ __forceinline__ int v_rd_base(int lane) { return ((lane & 3) << 3) | (((lane >> 2) & 3) << 6) | (((lane >> 4) & 1) << 5) | (((lane >> 5) & 1) << 8); }
constexpr int v_rd_off(int d0, int ks, int half) { return d0 * 512 + ks * 4096 + half * 2048; }
template <int OFF> __device__ __forceinline__ s16x4 tr_read(int vb) {
  s16x4 r; asm volatile("ds_read_b64_tr_b16 %0, %1 offset:%2" : "=&v"(r) : "v"(vb), "i"(OFF) : "memory"); return r;
}
template <int D0> __device__ __forceinline__ void pv_one(f32x16& od, int vb, bf16x8 pa0, bf16x8 pa1, bf16x8 pa2, bf16x8 pa3) {
  const s16x4 l0 = tr_read<v_rd_off(D0, 0, 0)>(vb), h0 = tr_read<v_rd_off(D0, 0, 1)>(vb), l1 = tr_read<v_rd_off(D0, 1, 0)>(vb), h1 = tr_read<v_rd_off(D0, 1, 1)>(vb);
  const s16x4 l2 = tr_read<v_rd_off(D0, 2, 0)>(vb), h2 = tr_read<v_rd_off(D0, 2, 1)>(vb), l3 = tr_read<v_rd_off(D0, 3, 0)>(vb), h3 = tr_read<v_rd_off(D0, 3, 1)>(vb);
  asm volatile("s_waitcnt lgkmcnt(0)" ::: "memory"); SBAR();
#define PK(L, H) (bf16x8){L[0], L[1], L[2], L[3], H[0], H[1], H[2], H[3]}
  od = __builtin_amdgcn_mfma_f32_32x32x16_bf16(pa0, PK(l0, h0), od, 0, 0, 0);
  od = __builtin_amdgcn_mfma_f32_32x32x16_bf16(pa1, PK(l1, h1), od, 0, 0, 0);
  od = __builtin_amdgcn_mfma_f32_32x32x16_bf16(pa2, PK(l2, h2), od, 0, 0, 0);
  od = __builtin_amdgcn_mfma_f32_32x32x16_bf16(pa3, PK(l3, h3), od, 0, 0, 0);
#undef PK
}
__device__ __forceinline__ void pv_d0(f32x16* o, int vb, bf16x8 pa0, bf16x8 pa1, bf16x8 pa2, bf16x8 pa3) {
  pv_one<0>(o[0], vb, pa0, pa1, pa2, pa3); pv_one<1>(o[1], vb, pa0, pa1, pa2, pa3); pv_one<2>(o[2], vb, pa0, pa1, pa2, pa3); pv_one<3>(o[3], vb, pa0, pa1, pa2, pa3);
}

__device__ __forceinline__ void band_mask(f32x16& p0, f32x16& p1, int dq  , int hi) {
#pragma unroll
  for (int r = 0; r < 16; ++r) { const int d = dq - crow(r, hi);
    if ((unsigned)(d + 128) > 256u) p0[r] = -1e30f;
    if ((unsigned)(d + 96) > 256u) p1[r] = -1e30f; }
}
template <bool MASK>
__device__ __forceinline__ void attn_body(const bf16* __restrict__ Qb, const bf16* __restrict__ Kh, const bf16* __restrict__ Vh,
                                          bf16* __restrict__ Ob, int NT, int NCT, int lo, int qpos0, float sinkl2, char* lds) {
  using St = Stage<bf16>;
  int tid_ = threadIdx.x; asm volatile("" : "+v"(tid_));
  const int tid = tid_, wid = tid >> 6, lane = tid & 63, r32 = lane & 31, hi = lane >> 5;
  bf16* V_lds = (bf16*)lds; bf16* K_lds = (bf16*)(lds + 2 * SHM_V);
  float* ws = (float*)(lds + 2 * SHM_V + 2 * SHM_K) + wid * 64; float* li_l = ws; float* al_l = ws + 32;
  float m_reg = -1e30f, l_reg = 0; f32x16 o[4] = {}; bf16x8 qr[8];
  const bf16* Qw = Qb + (long)(wid * QBLK + r32) * LDQ + hi * 8;
#pragma unroll
  for (int d0 = 0; d0 < 8; ++d0) qr[d0] = St::ld8(Qw + d0 * 16);
  const int sr = tid >> 4, sc = (tid & 15) * 8, vst0 = v_st(sr, sc), vst1 = v_st(32 + sr, sc);
  const int vb0 = (int)(uintptr_t)V_lds + v_rd_base(lane);
  const int qi = qpos0 + wid * QBLK + r32;
  struct { typename St::T vs0, vs1, ks0, ks1; } sr_[SDEPTH];
#define TROW(j) (64 * (j) + ((j) >= NCT ? lo : 0))
#define SLOAD(i, k0) do { const long k0_ = (k0); sr_[i].vs0 = St::ld8(&Vh[(k0_ + sr) * LDK + sc]); sr_[i].vs1 = St::ld8(&Vh[(k0_ + 32 + sr) * LDK + sc]); \
    sr_[i].ks0 = St::ld8(&Kh[(k0_ + sr) * LDK + sc]); sr_[i].ks1 = St::ld8(&Kh[(k0_ + 32 + sr) * LDK + sc]); } while (0)
#define SWRITE(b, i) do { *(bf16x8*)((char*)V_lds + (b) * SHM_V + vst0) = St::tobf(sr_[i].vs0);          \
    *(bf16x8*)((char*)V_lds + (b) * SHM_V + vst1) = St::tobf(sr_[i].vs1); int kc = sc * 2;               \
    *(bf16x8*)((char*)K_lds + (b) * SHM_K + KSWZ(sr, kc)) = St::tobf(sr_[i].ks0);                       \
    *(bf16x8*)((char*)K_lds + (b) * SHM_K + KSWZ(32 + sr, kc)) = St::tobf(sr_[i].ks1); } while (0)
#define SWAIT() do { if constexpr (SDEPTH == 2) asm volatile("s_waitcnt vmcnt(4)" ::: "memory"); else asm volatile("s_waitcnt vmcnt(0)" ::: "memory"); } while (0)
#define RESC(a) do { if (__any((a) < 1.f)) { if (hi == 0) al_l[r32] = (a); asm volatile("s_waitcnt lgkmcnt(0)" ::: "memory"); \
    for (int d = 0; d < 4; ++d) for (int r = 0; r < 16; ++r) o[d][r] *= al_l[crow(r, hi)]; } } while (0)
#define AMASK(P0, P1, j) do { if constexpr (MASK) { if ((j) >= NCT) band_mask(P0, P1, qi - (lo + 64 * ((j) - NCT)), hi); } } while (0)
  f32x16 pA0, pA1, pB0, pB1; float mnA, mnB, alA, alB; bf16x8 pa0, pa1, pa2, pa3;
  constexpr int SE = 0, SO = SDEPTH - 1;
  SLOAD(SE, TROW(0)); asm volatile("s_waitcnt vmcnt(0)" ::: "memory"); SWRITE(0, SE); __syncthreads();
  qkt(pA0, pA1, K_lds, qr, r32, hi); AMASK(pA0, pA1, 0); partialSM(pA0, pA1, m_reg, mnA, alA);
  SLOAD(SO, TROW(1)); if constexpr (SDEPTH == 2) { if (2 < NT) SLOAD(SE, TROW(2)); }
  SWAIT(); SWRITE(1, SO); __syncthreads();
  for (int j = 1; j + 1 < NT; j += 2) {
    SBAR(); qkt(pB0, pB1, (bf16*)((char*)K_lds + SHM_K), qr, r32, hi); AMASK(pB0, pB1, j);
    finishSM(pA0, pA1, alA, l_reg, pa0, pa1, pa2, pa3); SBAR();
    SLOAD(SO, TROW(j + SDEPTH)); SBAR();
    pv_d0(o, vb0, pa0, pa1, pa2, pa3); partialSM(pB0, pB1, m_reg, mnB, alB);
    __syncthreads(); SWAIT(); SWRITE(0, SE);
    RESC(alB); __syncthreads();
    SBAR(); qkt(pA0, pA1, K_lds, qr, r32, hi); AMASK(pA0, pA1, j + 1);
    finishSM(pB0, pB1, alB, l_reg, pa0, pa1, pa2, pa3); SBAR();
    if (SDEPTH == 1 || j + 3 < NT) SLOAD(SE, TROW(j + 1 + SDEPTH)); SBAR();
    pv_d0(o, vb0 + (int)SHM_V, pa0, pa1, pa2, pa3); partialSM(pA0, pA1, m_reg, mnA, alA);
    __syncthreads(); SWAIT(); SWRITE(1, SO);
    RESC(alA); __syncthreads();
  }
  SBAR(); qkt(pB0, pB1, (bf16*)((char*)K_lds + SHM_K), qr, r32, hi); AMASK(pB0, pB1, NT - 1);
  finishSM(pA0, pA1, alA, l_reg, pa0, pa1, pa2, pa3); SBAR();
  pv_d0(o, vb0, pa0, pa1, pa2, pa3); partialSM(pB0, pB1, m_reg, mnB, alB);
  __syncthreads(); RESC(alB);
  finishSM(pB0, pB1, alB, l_reg, pa0, pa1, pa2, pa3); SBAR();
  pv_d0(o, vb0 + (int)SHM_V, pa0, pa1, pa2, pa3);
  l_reg += __builtin_amdgcn_exp2f(sinkl2 - m_reg * (SCALE * 1.4426950408889634f));
  if (hi == 0) li_l[r32] = l_reg; asm volatile("s_waitcnt lgkmcnt(0)" ::: "memory");
  float rli[16];
#pragma unroll
  for (int r = 0; r < 16; ++r) rli[r] = __builtin_amdgcn_rcpf(li_l[crow(r, hi)]);
  bf16* Ow = Ob + (long)(wid * QBLK) * LDO;
#pragma unroll
  for (int r = 0; r < 16; ++r) { int orow = crow(r, hi);
    for (int d0 = 0; d0 < 4; ++d0) { const float v = o[d0][r] * rli[r]; const unsigned u = __builtin_bit_cast(unsigned, v);
      Ow[(long)orow * LDO + d0 * 32 + r32] = (bf16)((u + 0x7fffu + ((u >> 16) & 1u)) >> 16); } }
  __syncthreads();
#undef TROW
#undef SLOAD
#undef SWRITE
#undef SWAIT
#undef RESC
#undef AMASK
}

#define ATT_LAS __attribute__((address_space(3)))
__device__ __forceinline__ void attn_body_v256(const bf16* __restrict__ Qb, const bf16* __restrict__ Kh, const bf16* __restrict__ Vh,
                                               bf16* __restrict__ Ob, int NT, ATT_LAS unsigned char* ldsl) {
  using St = Stage<bf16>;
  int tid_ = threadIdx.x; asm volatile("" : "+v"(tid_));
  const int tid = tid_, wid = __builtin_amdgcn_readfirstlane(tid >> 6), lane = tid & 63, r32 = lane & 31, hi = lane >> 5;
  char* lds = (char*)ldsl;
  char* V_lds = lds; char* K_lds = lds + 65536;
  float* ws = (float*)(lds + 98304) + wid * 64; float* li_l = ws; float* al_l = ws + 32;
  float m_reg = -1e30f, l_reg = 0; f32x16 o[8] = {}; bf16x8 qr[8];
  const bf16* Qw = Qb + (long)(wid * QBLK + r32) * LDQ + hi * 8;
#pragma unroll
  for (int d0 = 0; d0 < 8; ++d0) qr[d0] = St::ld8(Qw + d0 * 16);
  unsigned offK0, offV0;
  { const int row = wid * 4 + (lane >> 4), colB = ((lane & 15) * 16) ^ ((row & 7) << 4); offK0 = (unsigned)row * (LDK * 2) + (unsigned)colB;
    const int sub = wid * 2 + (lane >> 5), kkhi = sub >> 2, cblk = sub & 3, within = (lane & 31) * 16, kk = kkhi * 8 + (within >> 6);
    const int k = (kk & ~0xC) | ((kk & 4) << 1) | ((kk & 8) >> 1), c = cblk * 32 + ((within & 63) >> 1);
    offV0 = (unsigned)k * (LDK * 2) + (unsigned)c * 2; }
  const int vb0 = (int)(uintptr_t)V_lds + v_rd_base(lane);
#define DMA_TILE(j, buf) do { const char* kb_ = (const char*)Kh + (size_t)(j) * (64 * LDK * 2) + offK0; const char* vb_ = (const char*)Vh + (size_t)(j) * (64 * LDK * 2) + offV0; \
    _Pragma("unroll") for (int i_ = 0; i_ < 2; ++i_) __builtin_amdgcn_global_load_lds((const unsigned*)(kb_ + i_ * (32 * LDK * 2)), (ATT_LAS unsigned*)(ldsl + 65536 + (buf) * 16384 + (i_ * 8 + wid) * 1024), 16, 0, 0); \
    _Pragma("unroll") for (int i_ = 0; i_ < 4; ++i_) __builtin_amdgcn_global_load_lds((const unsigned*)(vb_ + (i_ & 1) * (32 * LDK * 2) + (i_ >> 1) * 256), (ATT_LAS unsigned*)(ldsl + (buf) * 32768 + (i_ * 8 + wid) * 1024), 16, 0, 0); } while (0)
#define RESC8(a) do { if (__any((a) < 1.f)) { if (hi == 0) al_l[r32] = (a); asm volatile("s_waitcnt lgkmcnt(0)" ::: "memory"); \
    for (int d = 0; d < 8; ++d) for (int r = 0; r < 16; ++r) o[d][r] *= al_l[crow(r, hi)]; } } while (0)
#define TILE_SYNC() do { asm volatile("s_waitcnt vmcnt(0)" ::: "memory"); __builtin_amdgcn_s_barrier(); asm volatile("" ::: "memory"); } while (0)
  f32x16 p0, p1; float mn, al; bf16x8 pa0, pa1, pa2, pa3;
#pragma unroll
  for (int d0 = 0; d0 < 8; ++d0) asm volatile("" : "+v"(qr[d0]));
  DMA_TILE(0, 0);
  for (int j = 0; j < NT; j += 2) {
    TILE_SYNC(); DMA_TILE(j + 1, 1);
    qkt(p0, p1, (const bf16*)K_lds, qr, r32, hi); partialSM(p0, p1, m_reg, mn, al); RESC8(al); finishSM(p0, p1, al, l_reg, pa0, pa1, pa2, pa3); SBAR();
    pv_d0(o, vb0, pa0, pa1, pa2, pa3); pv_d0(o + 4, vb0 + 16384, pa0, pa1, pa2, pa3);
    TILE_SYNC(); if (j + 2 < NT) DMA_TILE(j + 2, 0);
    qkt(p0, p1, (const bf16*)(K_lds + 16384), qr, r32, hi); partialSM(p0, p1, m_reg, mn, al); RESC8(al); finishSM(p0, p1, al, l_reg, pa0, pa1, pa2, pa3); SBAR();
    pv_d0(o, vb0 + 32768, pa0, pa1, pa2, pa3); pv_d0(o + 4, vb0 + 32768 + 16384, pa0, pa1, pa2, pa3);
  }
  if (hi == 0) li_l[r32] = l_reg; asm volatile("s_waitcnt lgkmcnt(0)" ::: "memory");
  float rli[16];
#pragma unroll
  for (int r = 0; r < 16; ++r) rli[r] = __builtin_amdgcn_rcpf(li_l[crow(r, hi)]);
  bf16* Ow = Ob + (long)(wid * QBLK) * LDO;
#pragma unroll
  for (int r = 0; r < 16; ++r) { int orow = crow(r, hi);
#pragma unroll
    for (int d0 = 0; d0 < 8; ++d0) { const float v = o[d0][r] * rli[r]; const unsigned u = __builtin_bit_cast(unsigned, v);
      Ow[(long)orow * LDO + d0 * 32 + r32] = (bf16)((u + 0x7fffu + ((u >> 16) & 1u)) >> 16); } }
#undef DMA_TILE
#undef RESC8
#undef TILE_SYNC
}
}

constexpr size_t MiB = 1u << 20;
constexpr size_t SLOT = (size_t)MROWS * DM * 2;
constexpr size_t WS_MOD = 0;
constexpr size_t WS_BAR = 1 * MiB, WS_BAR_BYTES = 16384;
constexpr size_t WS_COS = 2 * MiB, WS_SIN = 4 * MiB;
constexpr size_t WS_CTX1 = 6 * MiB;
constexpr size_t WS_WINT = 16 * MiB;
constexpr size_t WS_WPT = WS_WINT + 68 * MiB;
constexpr size_t WS_PX = WS_WPT + 48 * MiB;
constexpr size_t WS_S0 = WS_PX + (size_t)MROWS * INC * 2;
constexpr size_t WS_END = WS_S0 + 5 * SLOT;
static_assert(WS_END <= 4ull * DEPTH * DM * INC * 4, "workspace map exceeds the guaranteed 4x largest tensor");

constexpr int NWAVES = 8;
constexpr int LDS_BYTES = 147456;

#define GAS __attribute__((address_space(1)))
#define LAS __attribute__((address_space(3)))
typedef unsigned short bf16;
typedef unsigned v4u __attribute__((ext_vector_type(4)));
typedef unsigned v2u __attribute__((ext_vector_type(2)));
typedef float f32x4 __attribute__((ext_vector_type(4)));
#define LDS_WAIT() asm volatile("s_waitcnt lgkmcnt(0)" ::: "memory")
__device__ __forceinline__ unsigned f2bf(float f) { unsigned u = __builtin_bit_cast(unsigned, f); return (u + 0x7fffu + ((u >> 16) & 1u)) >> 16; }
__device__ __forceinline__ unsigned pk2(float lo, float hi) { return f2bf(lo) | (f2bf(hi) << 16); }
__device__ __forceinline__ float bflo(unsigned w) { return __builtin_bit_cast(float, w << 16); }
__device__ __forceinline__ float bfhi(unsigned w) { return __builtin_bit_cast(float, w & 0xffff0000u); }
__device__ __forceinline__ float siluf(float x) { return x / (1.f + __expf(-x)); }
__device__ __forceinline__ float sigmf(float x) { return 1.f / (1.f + __expf(-x)); }

struct Frame {
    LAS unsigned char* lds;
    int vcu, G;
    const float *x, *c, *ctx, *c_ctx, *w_ada, *b_ada, *g_pre, *g_post, *w_in, *sink, *lam_qk, *g_subln, *w_pa, *w_pb, *w_out;
    float* out; unsigned char* ws;
};

#define XB_TMO      128
#define XB_XCNT(j)  (256  + 64 * (j))
#define XB_XSUB(j)  (1280 + 64 * (j))
#define XB_XGEN(j)  (2304 + 64 * (j))
#define XB_TOP      3328
#define XB_TOPGEN   3392
#define XCD_BAR_WORDS 3456
#define XB_SPIN_CAP (1u << 18)

__device__ __forceinline__ unsigned xb_ld(unsigned* p)              { return __hip_atomic_load(p, __ATOMIC_RELAXED, __HIP_MEMORY_SCOPE_AGENT); }
__device__ __forceinline__ unsigned xb_add(unsigned* p, unsigned v) { return __hip_atomic_fetch_add(p, v, __ATOMIC_RELAXED, __HIP_MEMORY_SCOPE_AGENT); }
__device__ __forceinline__ unsigned xb_xcc_id() { return (unsigned)__builtin_amdgcn_s_getreg((3 << 11) | 20) & 0xFu; }
#define XB_SPIN(cond, bar) do { unsigned _sp = 0; while (cond) { __builtin_amdgcn_s_sleep(1); \
    if ((++_sp & 255u) == 0u) { if (xb_ld(&(bar)[XB_TMO])) break; if (_sp > XB_SPIN_CAP) { atomicAdd(&(bar)[XB_TMO], 1u); break; } } } } while (0)

struct XcdBarrier {
    unsigned* bar; unsigned x;
    volatile LAS unsigned* st;
};

__device__ __forceinline__ XcdBarrier xcd_barrier_post(unsigned* bar, volatile LAS unsigned* st) {
    XcdBarrier b; b.bar = bar; b.x = xb_xcc_id(); b.st = st;
    if (threadIdx.x == 0) (void)xb_add(&bar[XB_XCNT(b.x)], 1u);
    return b;
}
__device__ __forceinline__ void xcd_barrier_complete(unsigned* bar, unsigned x, unsigned& nloc, unsigned& nx) {
    const unsigned G = gridDim.x * gridDim.y * gridDim.z;
    unsigned sum, cnt, mine, sp = 0u;
    for (;;) {
        sum = 0u; cnt = 0u; mine = 0u;
#pragma unroll
        for (unsigned j = 0; j < 16; ++j) { const unsigned c = xb_ld(&bar[XB_XCNT(j)]); sum += c; cnt += (c > 0u) ? 1u : 0u; mine = (j == x) ? c : mine; }
        if (sum == G) break;
        __builtin_amdgcn_s_sleep(1);
        if ((++sp & 255u) == 0u) { if (xb_ld(&bar[XB_TMO])) break; if (sp > XB_SPIN_CAP) { atomicAdd(&bar[XB_TMO], 1u); break; } }
    }
    nloc = mine > 0u ? mine : 1u; nx = cnt > 0u ? cnt : 1u;
}

__device__ __forceinline__ void xcd_barrier(const XcdBarrier& b) {
    asm volatile("s_waitcnt vmcnt(0)" ::: "memory");
    __syncthreads();
    if (threadIdx.x == 0) {
        unsigned* bar = b.bar;
        __builtin_amdgcn_s_waitcnt(0);
        unsigned nloc = b.st[0], nx = b.st[1];
        if (nloc == 0u) { xcd_barrier_complete(bar, b.x, nloc, nx); b.st[0] = nloc; b.st[1] = nx; }
        const unsigned old = xb_add(&bar[XB_XSUB(b.x)], 1u);
        const unsigned gen = old / nloc;
        if (old + 1u == (gen + 1u) * nloc) {
            __builtin_amdgcn_fence(__ATOMIC_RELEASE, "agent");
            asm volatile("s_waitcnt vmcnt(0)" ::: "memory");
            const unsigned og = xb_add(&bar[XB_TOP], 1u);
            const unsigned tg = og / nx;
            if (og + 1u == (tg + 1u) * nx) xb_add(&bar[XB_TOPGEN], 1u);
            else XB_SPIN(xb_ld(&bar[XB_TOPGEN]) == tg, bar);
            __builtin_amdgcn_fence(__ATOMIC_ACQUIRE, "agent");
            xb_add(&bar[XB_XGEN(b.x)], 1u);
            asm volatile("s_waitcnt vmcnt(0)" ::: "memory");
        } else {
            XB_SPIN(xb_ld(&bar[XB_XGEN(b.x)]) == gen, bar);
            __builtin_amdgcn_fence(__ATOMIC_ACQUIRE, "agent");
            asm volatile("s_waitcnt vmcnt(0)" ::: "memory");
        }
    }
    __syncthreads();
}

#define FRESH_IDS int tid_ = threadIdx.x; asm volatile("" : "+v"(tid_)); const int tid = tid_, lane = tid & 63, wave = __builtin_amdgcn_readfirstlane(tid >> 6); (void)lane; (void)wave;

__device__ __forceinline__ float wave_sum(float v) {
#pragma unroll
    for (int o = 1; o < 64; o <<= 1) v += __shfl_xor(v, o);
    return v;
}
__device__ __forceinline__ void p0_transpose_item(const float* W, int K, int N, bf16* WT, int row_off, LAS float* scr, int item, int lane) {
    const int nblk = N / 32, kb = item / nblk, nb = item % nblk, k0 = 64 * kb, n0 = 32 * nb;
#pragma unroll 8
    for (int i = 0; i < 32; ++i) { const int kk = 2 * i + (lane >> 5); scr[kk * 33 + (lane & 31)] = W[(size_t)(k0 + kk) * N + n0 + (lane & 31)]; }
    LDS_WAIT(); asm volatile("" ::: "memory");
    const int c = lane & 7;
#pragma unroll
    for (int j = 0; j < 4; ++j) { const int n = (lane >> 3) + 8 * j; const LAS float* s = scr + (8 * c) * 33 + n;
        v4u o; o.x = pk2(s[0 * 33], s[1 * 33]); o.y = pk2(s[2 * 33], s[3 * 33]); o.z = pk2(s[4 * 33], s[5 * 33]); o.w = pk2(s[6 * 33], s[7 * 33]);
        *(GAS v4u*)(WT + (size_t)(row_off + n0 + n) * K + k0 + 8 * c) = o; }
    LDS_WAIT(); asm volatile("" ::: "memory");
}

#define GW_LOOP(var, n) for (int var = F.vcu * NWAVES + wave; var < (n); var += F.G * NWAVES)

__device__ __forceinline__ int win_row_off(int n0) {
    const int tile = n0 >> 8; const bool rope = tile < 2 || (tile >= 4 && tile < 12) || (tile >= 20 && tile < 28) || (tile >= 36 && tile < 44);
    if (!rope) return 0;
    const int w = n0 & 255, hsel = w >> 7, half = (w >> 6) & 1, i = w & 63;
    return (half * 128 + hsel * 64 + i) - w;
}
__device__ __forceinline__ void ph_prologue(Frame& F) {
    FRESH_IDS
    for (int ait = F.vcu; ait < 192; ait += F.G) {
        const int l = ait / 96, n0 = (ait % 96) * 64;
        LAS float* sv = (LAS float*)F.lds;
        LAS float* red = (LAS float*)(F.lds + 32768);
        for (int k = tid; k < DM; k += NWAVES * 64) { sv[k] = siluf(F.c[k]); sv[DM + k] = siluf(F.c[DM + k]); sv[2 * DM + k] = siluf(F.c_ctx[k]); }
        __syncthreads();
        const float* W = F.w_ada + (size_t)l * DM * 6144 + n0 + lane;
        float a0 = 0.f, a1 = 0.f, a2 = 0.f;
        const int kb = wave * 256;
#pragma unroll 8
        for (int k = 0; k < 256; ++k) { const float w = W[(size_t)(kb + k) * 6144]; a0 += sv[kb + k] * w; a1 += sv[DM + kb + k] * w; a2 += sv[2 * DM + kb + k] * w; }
        red[(wave * 3 + 0) * 64 + lane] = a0; red[(wave * 3 + 1) * 64 + lane] = a1; red[(wave * 3 + 2) * 64 + lane] = a2;
        __syncthreads();
        if (wave < 3) { float s = 0.f;
#pragma unroll
            for (int w = 0; w < 8; ++w) s += red[(w * 3 + wave) * 64 + lane];
            float* mod = (float*)(F.ws + WS_MOD);
            mod[(size_t)(l * 3 + wave) * 6144 + n0 + lane] = s + F.b_ada[(size_t)l * 6144 + n0 + lane]; }
        __syncthreads();
    }
    { float* ct = (float*)(F.ws + WS_COS); float* st = (float*)(F.ws + WS_SIN);
      for (int i = (F.vcu * NWAVES * 64) + tid; i < SEQ * 64; i += F.G * NWAVES * 64) {
          const int t = i >> 6, j = i & 63, f = j & 31; const float pos = (float)((j < 32) ? (t >> 6) : (t & 63));
          const float inv = expf(-(float)f * (9.210340371976184f / 32.f)); const float ang = pos * inv;
          ct[i] = cosf(ang); st[i] = sinf(ang); } }
    LAS float* scr = (LAS float*)(F.lds + wave * 16384);
    constexpr int I_IN = (DM / 64) * (INC / 32), I_P = (DM / 64) * (DM / 32);
    bf16* WinT = (bf16*)(F.ws + WS_WINT); bf16* WpT = (bf16*)(F.ws + WS_WPT);
    GW_LOOP(it, I_IN + 6 * I_P) {
        if (it < I_IN) { p0_transpose_item(F.w_in, DM, INC, WinT, win_row_off(32 * (it % (INC / 32))), scr, it, lane); continue; }
        const int r = it - I_IN, mi = r / I_P, ii = r % I_P, l = mi / 3, w = mi % 3;
        const float* W = (w == 0 ? F.w_pa : (w == 1 ? F.w_pb : F.w_out)) + (size_t)l * DM * DM;
        p0_transpose_item(W, DM, DM, WpT + (size_t)mi * DM * DM, 0, scr, ii, lane);
    }
}

__device__ __forceinline__ void ph_hnorm(Frame& F, int l, const float* xcur, const float* ctxcur) {
    FRESH_IDS
    bf16* H = (bf16*)(F.ws + WS_S0);
    const float* gp = F.g_pre + (size_t)l * DM;
    GW_LOOP(row, MROWS) {
        const int b = row / RPB, rr = row % RPB; const float* src; int v;
        if (rr < CTX) { src = ctxcur + (size_t)(b * CTX + rr) * DM; v = 2; } else { src = xcur + (size_t)(b * SEQ + rr - CTX) * DM; v = b; }
        const float* md = (const float*)(F.ws + WS_MOD) + (size_t)(l * 3 + v) * 6144;
        f32x4 xv[8]; float s = 0.f;
#pragma unroll
        for (int j = 0; j < 8; ++j) { xv[j] = ((const f32x4*)src)[lane + 64 * j]; s += (xv[j].x * xv[j].x + xv[j].y * xv[j].y) + (xv[j].z * xv[j].z + xv[j].w * xv[j].w); }
        const float rs = rsqrtf(wave_sum(s) * (1.f / DM) + EPS);
#pragma unroll
        for (int j = 0; j < 8; ++j) { const int q = lane + 64 * j;
            const f32x4 g = ((const f32x4*)gp)[q], sh = ((const f32x4*)md)[q], sc = ((const f32x4*)(md + DM))[q];
            const f32x4 y = (xv[j] * rs) * g * (sc + 1.f) + sh;
            v2u o; o.x = pk2(y.x, y.y); o.y = pk2(y.z, y.w);
            *(v2u*)(H + (size_t)row * DM + 4 * q) = o; }
    }
}

__device__ __forceinline__ void ph_rope(Frame& F) {
    FRESH_IDS
    bf16* PX = (bf16*)(F.ws + WS_PX);
    const float* ct = (const float*)(F.ws + WS_COS); const float* st = (const float*)(F.ws + WS_SIN);
    const unsigned total = (unsigned)NB * SEQ * 52 * 8;
    for (unsigned idx = (unsigned)(F.vcu * NWAVES * 64 + tid); idx < total; idx += (unsigned)(F.G * NWAVES * 64)) {
        const unsigned ch = idx & 7, hr = idx >> 3, hh = hr % 52, rowL = hr / 52, b = rowL / SEQ, t = rowL % SEQ;
        const int col = (hh < 4) ? (C_KA + hh * 128) : (hh < 20) ? (C_KB + (hh - 4) * 128) : (hh < 36) ? (C_QA + (hh - 20) * 128) : (C_QB + (hh - 36) * 128);
        bf16* p = PX + (size_t)(b * RPB + CTX + t) * INC + col + ch * 8;
        const v4u x1 = *(const v4u*)p, x2 = *(const v4u*)(p + 64);
        const f32x4 c0 = *(const f32x4*)(ct + t * 64 + ch * 8), c1 = *(const f32x4*)(ct + t * 64 + ch * 8 + 4);
        const f32x4 s0 = *(const f32x4*)(st + t * 64 + ch * 8), s1 = *(const f32x4*)(st + t * 64 + ch * 8 + 4);
        v4u y1, y2;
#define ROPE2(W, CA, SA, CB, SB) { const float a0 = bflo(x1.W), a1 = bfhi(x1.W), b0 = bflo(x2.W), b1 = bfhi(x2.W); \
            y1.W = pk2(a0 * CA - b0 * SA, a1 * CB - b1 * SB); y2.W = pk2(b0 * CA + a0 * SA, b1 * CB + a1 * SB); }
        ROPE2(x, c0.x, s0.x, c0.y, s0.y) ROPE2(y, c0.z, s0.z, c0.w, s0.w) ROPE2(z, c1.x, s1.x, c1.y, s1.y) ROPE2(w, c1.z, s1.z, c1.w, s1.w)
#undef ROPE2
        *(v4u*)p = y1; *(v4u*)(p + 64) = y2;
    }
}

__device__ __forceinline__ void ph_convert_win(Frame& F, int l) {
    FRESH_IDS
    LAS float* scr = (LAS float*)(F.lds + wave * 16384);
    constexpr int I_IN = (DM / 64) * (INC / 32);
    bf16* WinT = (bf16*)(F.ws + WS_WINT);
    GW_LOOP(it, I_IN) p0_transpose_item(F.w_in + (size_t)l * DM * INC, DM, INC, WinT, win_row_off(32 * (it % (INC / 32))), scr, it, lane);
}

__device__ __forceinline__ void ph_attn(Frame& F, int l, char* lds) {
    const att::bf16* PX = (const att::bf16*)(F.ws + WS_PX);
    att::bf16* OA = (att::bf16*)(F.ws + WS_S0);
    att::bf16* OB0 = (att::bf16*)(F.ws + WS_S0 + SLOT);
    const float NINF = -INFINITY;
    const int nB = 1024, nA = 1024, nC = (l == 0) ? 64 : 0;
    for (int u = F.vcu; u < nB + nA + nC; u += F.G) {
        if (u < nB) {
            const int hd = u >> 5, qb = u & 31, b = hd >> 4, h8 = (hd >> 1) & 7, m = hd & 1;
            const size_t qrow = (size_t)b * RPB + CTX + qb * 256, krow = (size_t)b * RPB;
            att::attn_body_v256(PX + qrow * INC + C_QB + (h8 * 2 + m) * 128, PX + krow * INC + C_KB + (h8 * 2 + m) * 128, PX + krow * INC + C_VB + h8 * 256,
                                OB0 + (size_t)m * (SLOT / 2) + qrow * DM + h8 * 256, RPB / 64, F.lds);
            __syncthreads();
        } else if (u < nB + nA) {
            const int v = u - nB, b = v >> 9, hq = (v >> 5) & 15, qb = v & 31, kvh = hq >> 2, q0 = qb * 256;
            const int lo = (q0 - 128 > 0) ? q0 - 128 : 0, he = (q0 + 384 < SEQ) ? q0 + 384 : SEQ, nloc = (he - lo) >> 6;
            const size_t qrow = (size_t)b * RPB + CTX + q0, krow = (size_t)b * RPB;
            const float sk = F.sink[l * 16 + hq] * 1.4426950408889634f;
            att::attn_body<true>(PX + qrow * INC + C_QA + hq * 128, PX + krow * INC + C_KA + kvh * 128, PX + krow * INC + C_VA + kvh * 128,
                                 OA + qrow * DM + hq * 128, 4 + nloc, 4, lo, q0, sk, lds);
        } else {
            const int v = u - nB - nA;
            if (v < 32) {
                const int hd = v, b = hd >> 4, h8 = (hd >> 1) & 7, m = hd & 1; const size_t krow = (size_t)b * RPB;
                att::attn_body_v256(PX + krow * INC + C_QB + (h8 * 2 + m) * 128, PX + krow * INC + C_KB + (h8 * 2 + m) * 128, PX + krow * INC + C_VB + h8 * 256,
                                    OB0 + (size_t)m * (SLOT / 2) + krow * DM + h8 * 256, 4, F.lds);
                __syncthreads();
            } else {
                const int w = v - 32, b = w >> 4, hq = w & 15, kvh = hq >> 2; const size_t krow = (size_t)b * RPB;
                const float sk = F.sink[l * 16 + hq] * 1.4426950408889634f;
                att::attn_body<false>(PX + krow * INC + C_QA + hq * 128, PX + krow * INC + C_KA + kvh * 128, PX + krow * INC + C_VA + kvh * 128,
                                      OA + krow * DM + hq * 128, 4, 4, 0, 0, sk, lds);
            }
        }
    }
}

__device__ __forceinline__ void ph_post(Frame& F, int l) {
    FRESH_IDS
    const bf16* PX = (const bf16*)(F.ws + WS_PX);
    const bf16* OA = (const bf16*)(F.ws + WS_S0); const bf16* OB0 = (const bf16*)(F.ws + WS_S0 + SLOT); const bf16* OB1 = (const bf16*)(F.ws + WS_S0 + 2 * SLOT);
    bf16* GA = (bf16*)(F.ws + WS_S0 + 3 * SLOT); bf16* GB = (bf16*)(F.ws + WS_S0 + 4 * SLOT);
    const float lam_init = 0.8f - 0.6f * expf(-0.3f * (float)l);
    const float* lq = F.lam_qk + (size_t)l * 512;
    const float d1 = wave_sum(lq[lane] * lq[128 + lane] + lq[64 + lane] * lq[192 + lane]);
    const float d2 = wave_sum(lq[256 + lane] * lq[384 + lane] + lq[320 + lane] * lq[448 + lane]);
    const float lam = expf(d1) - expf(d2) + lam_init;
    const f32x4 gs = ((const f32x4*)(F.g_subln + (size_t)l * 256))[lane] * (1.f - lam_init);
    GW_LOOP(row, MROWS) {
        if (l != 0 && (row % RPB) < CTX) continue;
        const size_t ro = (size_t)row * DM, rp = (size_t)row * INC;
#pragma unroll
        for (int j = 0; j < 8; ++j) { const int c = 4 * (lane + 64 * j);
            const v2u oa = *(const v2u*)(OA + ro + c), za = *(const v2u*)(PX + rp + C_ZA + c);
            v2u o; o.x = pk2(bflo(oa.x) * siluf(bflo(za.x)), bfhi(oa.x) * siluf(bfhi(za.x))); o.y = pk2(bflo(oa.y) * siluf(bflo(za.y)), bfhi(oa.y) * siluf(bfhi(za.y)));
            *(v2u*)(GA + ro + c) = o; }
#pragma unroll
        for (int j = 0; j < 8; ++j) { const int c = 256 * j + 4 * lane;
            const v2u o0 = *(const v2u*)(OB0 + ro + c), o1 = *(const v2u*)(OB1 + ro + c), zb = *(const v2u*)(PX + rp + C_ZB + c);
            f32x4 d; d.x = bflo(o0.x) - lam * bflo(o1.x); d.y = bfhi(o0.x) - lam * bfhi(o1.x); d.z = bflo(o0.y) - lam * bflo(o1.y); d.w = bfhi(o0.y) - lam * bfhi(o1.y);
            const float ss = wave_sum((d.x * d.x + d.y * d.y) + (d.z * d.z + d.w * d.w));
            const float rs = rsqrtf(ss * (1.f / 256.f) + EPS);
            const f32x4 y = d * rs * gs;
            v2u o; o.x = pk2(y.x * siluf(bflo(zb.x)), y.y * siluf(bfhi(zb.x))); o.y = pk2(y.z * siluf(bflo(zb.y)), y.w * siluf(bfhi(zb.y)));
            *(v2u*)(GB + ro + c) = o; }
    }
}

__device__ __forceinline__ void ph_merge(Frame& F, int l) {
    FRESH_IDS
    const bf16* PX = (const bf16*)(F.ws + WS_PX);
    const bf16* YA = (const bf16*)(F.ws + WS_S0); const bf16* YB = (const bf16*)(F.ws + WS_S0 + SLOT); bf16* MG = (bf16*)(F.ws + WS_S0 + 2 * SLOT);
    const unsigned total = (unsigned)MROWS * (DM / 8);
    for (unsigned i = (unsigned)(F.vcu * NWAVES * 64 + tid); i < total; i += (unsigned)(F.G * NWAVES * 64)) {
        const unsigned row = i >> 8, c = (i & 255) * 8;
        if (l != 0 && (row % RPB) < CTX) continue;
        const v4u ya = *(const v4u*)(YA + (size_t)row * DM + c), yb = *(const v4u*)(YB + (size_t)row * DM + c);
        const v4u ga = *(const v4u*)(PX + (size_t)row * INC + C_GA + c), gb = *(const v4u*)(PX + (size_t)row * INC + C_GB + c);
        v4u o;
#define MRG(W) o.W = pk2(sigmf(bflo(ga.W)) * bflo(ya.W) + sigmf(bflo(gb.W)) * bflo(yb.W), sigmf(bfhi(ga.W)) * bfhi(ya.W) + sigmf(bfhi(gb.W)) * bfhi(yb.W));
        MRG(x) MRG(y) MRG(z) MRG(w)
#undef MRG
        *(v4u*)(MG + (size_t)row * DM + c) = o;
    }
}

__device__ __forceinline__ void ph_res(Frame& F, int l, const float* xcur, const float* ctxcur) {
    FRESH_IDS
    const bf16* OX = (const bf16*)(F.ws + WS_S0 + 3 * SLOT);
    bf16* H = (bf16*)(F.ws + WS_S0);
    const float* gp = F.g_post + (size_t)l * DM;
    const bool nxt = (l + 1 < DEPTH);
    const float* gpn = F.g_pre + (size_t)(l + 1) * DM;
    GW_LOOP(row, MROWS) {
        const int b = row / RPB, rr = row % RPB; const float* src; float* dst; int v;
        if (rr < CTX) { if (!nxt) continue; src = ctxcur + (size_t)(b * CTX + rr) * DM; dst = nullptr; v = 2; }
        else { src = xcur + (size_t)(b * SEQ + rr - CTX) * DM; dst = F.out + (size_t)(b * SEQ + rr - CTX) * DM; v = b; }
        const float* gt = (const float*)(F.ws + WS_MOD) + (size_t)(l * 3 + v) * 6144 + 2 * DM;
        f32x4 ov[8]; float s = 0.f;
#pragma unroll
        for (int j = 0; j < 8; ++j) { const v2u w = *(const v2u*)(OX + (size_t)row * DM + 4 * (lane + 64 * j));
            ov[j] = (f32x4){bflo(w.x), bfhi(w.x), bflo(w.y), bfhi(w.y)}; s += (ov[j].x * ov[j].x + ov[j].y * ov[j].y) + (ov[j].z * ov[j].z + ov[j].w * ov[j].w); }
        const float rs = rsqrtf(wave_sum(s) * (1.f / DM) + EPS);
        float s2 = 0.f;
#pragma unroll
        for (int j = 0; j < 8; ++j) { const int q = lane + 64 * j;
            const f32x4 g = ((const f32x4*)gp)[q], gate = ((const f32x4*)gt)[q], xr = ((const f32x4*)src)[q];
            ov[j] = xr + gate * ((ov[j] * rs) * g);
            if (dst) ((f32x4*)dst)[q] = ov[j];
            s2 += (ov[j].x * ov[j].x + ov[j].y * ov[j].y) + (ov[j].z * ov[j].z + ov[j].w * ov[j].w); }
        if (nxt) {
            const float* md = (const float*)(F.ws + WS_MOD) + (size_t)((l + 1) * 3 + v) * 6144;
            const float rs2 = rsqrtf(wave_sum(s2) * (1.f / DM) + EPS);
#pragma unroll
            for (int j = 0; j < 8; ++j) { const int q = lane + 64 * j;
                const f32x4 g = ((const f32x4*)gpn)[q], sh = ((const f32x4*)md)[q], sc = ((const f32x4*)(md + DM))[q];
                const f32x4 y = (ov[j] * rs2) * g * (sc + 1.f) + sh;
                v2u o; o.x = pk2(y.x, y.y); o.y = pk2(y.z, y.w);
                *(v2u*)(H + (size_t)row * DM + 4 * q) = o; }
        }
    }
}

__device__ __forceinline__ void run_gemm_in(Frame& F, const bf16* A, const bf16* Bt, bf16* O) {
    pg8::Gemm g{A, Bt, MROWS, INC, DM}; pg8::RowSkipOrder S; S.init(INC, F.G, (int)blockIdx.x, false);
    pg8::EpiRope E{O, INC, (const float*)(F.ws + WS_COS), (const float*)(F.ws + WS_SIN)};
    pg8::gemm_phase<pg8::EpiRope, pg8::RowSkipOrder, true, true>(F.lds, g, S, E);
}
__device__ __forceinline__ void run_gemm_skip(Frame& F, const bf16* A, const bf16* Bt, bf16* O, bool skip) {
    pg8::Gemm g{A, Bt, MROWS, DM, DM}; pg8::RowSkipOrder S; S.init(DM, F.G, (int)blockIdx.x, skip);
    pg8::EpiBf16 E{O, DM};
    pg8::gemm_phase<pg8::EpiBf16, pg8::RowSkipOrder, true, true>(F.lds, g, S, E);
}
template <bool ADD>
__device__ __forceinline__ void run_gemm_gate(Frame& F, const bf16* A, const bf16* Bt, bf16* O, const bf16* T, const bf16* G, bool skip) {
    pg8::Gemm g{A, Bt, MROWS, DM, DM}; pg8::RowSkipOrder S; S.init(DM, F.G, (int)blockIdx.x, skip);
    pg8::EpiGate<ADD> E{O, T, G, DM, INC};
    pg8::gemm_phase<pg8::EpiGate<ADD>, pg8::RowSkipOrder, true, true>(F.lds, g, S, E);
}

struct Args { const float* in[15]; float* out; unsigned char* ws; };
__global__ void __launch_bounds__(NWAVES * 64, 2) fwd_mega(Args args) {
    extern __shared__ __attribute__((aligned(16))) unsigned char lds[];
    cg::grid_group grid = cg::this_grid();
    Frame F;
    F.lds = (LAS unsigned char*)lds;
    F.G = gridDim.x; { const int bx = blockIdx.x; F.vcu = (F.G % 8 == 0) ? (bx % 8) * (F.G / 8) + bx / 8 : bx; }
    F.x = args.in[0]; F.c = args.in[1]; F.ctx = args.in[2]; F.c_ctx = args.in[3]; F.w_ada = args.in[4]; F.b_ada = args.in[5]; F.g_pre = args.in[6]; F.g_post = args.in[7];
    F.w_in = args.in[8]; F.sink = args.in[9]; F.lam_qk = args.in[10]; F.g_subln = args.in[11]; F.w_pa = args.in[12]; F.w_pb = args.in[13]; F.w_out = args.in[14];
    F.out = args.out; F.ws = args.ws;
    volatile LAS unsigned* MISC = (volatile LAS unsigned*)(F.lds + 131072 + 320);
    if (threadIdx.x < 32) MISC[threadIdx.x] = 0u;
    __syncthreads();
    const XcdBarrier bar = xcd_barrier_post((unsigned*)(F.ws + WS_BAR), MISC + 8);
    bf16* WinT = (bf16*)(F.ws + WS_WINT); bf16* WpT = (bf16*)(F.ws + WS_WPT); bf16* PX = (bf16*)(F.ws + WS_PX);
    bf16* S0 = (bf16*)(F.ws + WS_S0); bf16* S1 = (bf16*)(F.ws + WS_S0 + SLOT); bf16* S2 = (bf16*)(F.ws + WS_S0 + 2 * SLOT); bf16* S3 = (bf16*)(F.ws + WS_S0 + 3 * SLOT); bf16* S4 = (bf16*)(F.ws + WS_S0 + 4 * SLOT);

    ph_prologue(F);
    grid.sync();
#pragma unroll 1
    for (int l = 0; l < DEPTH; ++l) {
        const float* xcur = (l == 0) ? F.x : F.out;
        const float* ctxcur = (l == 0) ? F.ctx : (const float*)(F.ws + WS_CTX1);
        if (l == 0) { ph_hnorm(F, l, xcur, ctxcur); xcd_barrier(bar); }
        run_gemm_in(F, S0, WinT, PX);
        xcd_barrier(bar);
        ph_attn(F, l, (char*)lds);
        xcd_barrier(bar);
        ph_post(F, l);
        if (l + 1 < DEPTH) ph_convert_win(F, l + 1);
        xcd_barrier(bar);
        run_gemm_gate<false>(F, S3, WpT + (size_t)(l * 3 + 0) * DM * DM, S0, S0, PX + C_GA, l != 0);
        run_gemm_gate<true>(F, S4, WpT + (size_t)(l * 3 + 1) * DM * DM, S2, S0, PX + C_GB, l != 0);
        xcd_barrier(bar);
        run_gemm_skip(F, S2, WpT + (size_t)(l * 3 + 2) * DM * DM, S3, l != 0);
        xcd_barrier(bar);
        ph_res(F, l, xcur, ctxcur);
        if (l + 1 < DEPTH) xcd_barrier(bar);
    }
}

extern "C" void kernel_launch(void* const* d_in, const int* in_sizes, int n_in, void* d_out, int out_size, void* d_ws, size_t ws_size, hipStream_t stream) {
    static int grid = 0;
    if (grid == 0) {
        if (n_in != 15 || out_size != NB * SEQ * DM || ws_size < WS_END) { fprintf(stderr, "kernel_launch: unexpected shapes: n_in %d out %d ws %zu (need %zu)\n", n_in, out_size, ws_size, (size_t)WS_END); grid = -1; return; }
        int dev = 0, cus = 0, per_cu = 0;
        if (hipGetDevice(&dev) != hipSuccess || hipDeviceGetAttribute(&cus, hipDeviceAttributeMultiprocessorCount, dev) != hipSuccess) { grid = -1; return; }
        if (hipFuncSetAttribute((const void*)fwd_mega, hipFuncAttributeMaxDynamicSharedMemorySize, LDS_BYTES) != hipSuccess) { fprintf(stderr, "kernel_launch: hipFuncSetAttribute failed\n"); grid = -1; return; }
        if (hipOccupancyMaxActiveBlocksPerMultiprocessor(&per_cu, (const void*)fwd_mega, NWAVES * 64, LDS_BYTES) != hipSuccess || per_cu < 1) { fprintf(stderr, "kernel_launch: occupancy query says %d\n", per_cu); per_cu = 1; }
        (void)hipGetLastError();
        grid = cus * per_cu;
    }
    if (grid < 0) return;
    if (hipMemsetAsync((char*)d_ws + WS_BAR, 0, WS_BAR_BYTES, stream) != hipSuccess) { fprintf(stderr, "kernel_launch: memset of the barrier words failed\n"); return; }
    Args a{};
    for (int i = 0; i < 15; ++i) a.in[i] = (const float*)d_in[i];
    a.out = (float*)d_out; a.ws = (unsigned char*)d_ws;
    void* kargs[] = {&a};
    hipError_t e = hipLaunchCooperativeKernel((const void*)fwd_mega, dim3(grid), dim3(NWAVES * 64), kargs, LDS_BYTES, stream);
    if (e != hipSuccess) fprintf(stderr, "kernel_launch: cooperative launch failed: %s (grid %d)\n", hipGetErrorString(e), grid);
}
```

```cpp
#include <hip/hip_runtime.h>
#include <hip/hip_bf16.h>
#include <hip/hip_cooperative_groups.h>
#include <cstdio>
#include <cstdint>
#include <cmath>
namespace cg = cooperative_groups;

constexpr int DM = 2048, NB = 2, SEQ = 8192, DEPTH = 2, CTX = 256;
constexpr int RPB = CTX + SEQ;
constexpr int MROWS = NB * RPB;
constexpr int INC = 17408;
constexpr int C_KA = 0, C_VA = 512, C_KB = 1024, C_VB = 3072, C_QA = 5120, C_ZA = 7168, C_QB = 9216, C_ZB = 11264, C_GA = 13312, C_GB = 15360;
constexpr float EPS = 1e-6f;

namespace pg8 {
#define PG8_LAS __attribute__((address_space(3)))
typedef unsigned short bf16_t;
typedef short bf16x8 __attribute__((ext_vector_type(8)));
typedef float f32x4 __attribute__((ext_vector_type(4)));
typedef unsigned u32x4 __attribute__((ext_vector_type(4)));
constexpr int BM = 256, BK = 64, HALF = 128, HTB = HALF * BK * 2  , STAGE_BYTES = 8 * HTB, NXCD = 8, WGM = 8;

__host__ __device__ __forceinline__ int lds_byte(int r, int c) { const int st = (r >> 4) * 2 + (c >> 5), rr = r & 15, cc = c & 31, ob = rr * 64 + cc * 2; return st * 1024 + (ob ^ (((ob >> 9) & 1) << 5)); }
__host__ __device__ __forceinline__ void stage_rc(int b, int& R, int& C) { const int st = b / 1024, sb = b % 1024, swz = sb ^ (((sb >> 9) & 1) << 5); R = (st >> 1) * 16 + swz / 64; C = (st & 1) * 32 + (swz % 64) / 2; }
__host__ __device__ __forceinline__ int perm32(int rho) { const int n = rho >> 4, i = rho & 15; return 8 * (i >> 2) + 4 * n + (i & 3); }

struct Unit { int pm, pn; };
struct Gemm { const bf16_t* A; const bf16_t* Bt; int M, N, K; };

struct StaticOrder {
    int nM, nN, nwg, G, c;
    __host__ __device__ void init(int M, int N, int G_, int c_) { nM = M / BM; nN = N / BM; nwg = nM * nN; G = G_; c = c_; }
    __host__ __device__ bool next(int i, Unit& u) const {
        const long L = (long)i * G + c; if (L >= nwg) return false;
        int wgid = (int)L; { const int q = nwg / NXCD, r = nwg % NXCD, xcd = wgid % NXCD, off = wgid / NXCD; wgid = (xcd < r ? xcd * (q + 1) : r * (q + 1) + (xcd - r) * q) + off; }
        const int nig = WGM * nN, gid = wgid / nig, fm = gid * WGM, gsz = (nM - fm) < WGM ? (nM - fm) : WGM;
        u.pm = fm + ((wgid % nig) % gsz); u.pn = (wgid % nig) / gsz; return true;
    }
    __device__ __forceinline__ void a_ready(const Unit&) const {}
    __device__ __forceinline__ void done(const Unit&) const {}
};

__device__ __forceinline__ unsigned cvt_pk_bf16(float lo, float hi) { unsigned r; asm volatile("v_cvt_pk_bf16_f32 %0, %1, %2" : "=v"(r) : "v"(lo), "v"(hi)); return r; }
typedef float f32x2 __attribute__((ext_vector_type(2)));

struct EpiBf16 {
    static constexpr bool PERM = true, AFTER_DRAIN = false;
    bf16_t* O; int ldc;
    __device__ __forceinline__ void operator()(const f32x4 (&acc)[2][2][4][2], const Unit& u, int wr, int wc, int fr, int fq) const {
        const int row0 = u.pm * BM + wr * 64 + fr; const int col0 = u.pn * BM + wc * 32 + 8 * fq;
#pragma unroll
        for (int ai = 0; ai < 2; ++ai)
#pragma unroll
            for (int m = 0; m < 4; ++m) { bf16_t* rowp = O + (size_t)(row0 + ai * HALF + m * 16) * ldc + col0;
#pragma unroll
                for (int bj = 0; bj < 2; ++bj) { const f32x4 v0 = acc[ai][bj][m][0], v1 = acc[ai][bj][m][1];
                    u32x4 w; w.x = cvt_pk_bf16(v0[0], v0[1]); w.y = cvt_pk_bf16(v0[2], v0[3]); w.z = cvt_pk_bf16(v1[0], v1[1]); w.w = cvt_pk_bf16(v1[2], v1[3]);
                    *(u32x4*)(rowp + bj * HALF) = w; } }
    }
};

__device__ __forceinline__ float sigm_(float x) { return 1.f / (1.f + __expf(-x)); }
__device__ __forceinline__ float blo_(unsigned w) { return __builtin_bit_cast(float, w << 16); }
__device__ __forceinline__ float bhi_(unsigned w) { return __builtin_bit_cast(float, w & 0xffff0000u); }
template <bool ADD> struct EpiGate {
    static constexpr bool PERM = true, AFTER_DRAIN = false;
    bf16_t* O; const bf16_t* T; const bf16_t* G; int ldc; int ldg;
    __device__ __forceinline__ void operator()(const f32x4 (&acc)[2][2][4][2], const Unit& u, int wr, int wc, int fr, int fq) const {
        const int row0 = u.pm * BM + wr * 64 + fr; const int col0 = u.pn * BM + wc * 32 + 8 * fq;
#pragma unroll
        for (int ai = 0; ai < 2; ++ai)
#pragma unroll
            for (int m = 0; m < 4; ++m) { const size_t row = (size_t)(row0 + ai * HALF + m * 16);
#pragma unroll
                for (int bj = 0; bj < 2; ++bj) { const f32x4 v0 = acc[ai][bj][m][0], v1 = acc[ai][bj][m][1];
                    const u32x4 g = *(const u32x4*)(G + row * ldg + col0 + bj * HALF);
                    float r0 = sigm_(blo_(g.x)) * v0[0], r1 = sigm_(bhi_(g.x)) * v0[1], r2 = sigm_(blo_(g.y)) * v0[2], r3 = sigm_(bhi_(g.y)) * v0[3];
                    float r4 = sigm_(blo_(g.z)) * v1[0], r5 = sigm_(bhi_(g.z)) * v1[1], r6 = sigm_(blo_(g.w)) * v1[2], r7 = sigm_(bhi_(g.w)) * v1[3];
                    if (ADD) { const u32x4 t = *(const u32x4*)(T + row * ldc + col0 + bj * HALF);
                        r0 += blo_(t.x); r1 += bhi_(t.x); r2 += blo_(t.y); r3 += bhi_(t.y); r4 += blo_(t.z); r5 += bhi_(t.z); r6 += blo_(t.w); r7 += bhi_(t.w); }
                    u32x4 w; w.x = cvt_pk_bf16(r0, r1); w.y = cvt_pk_bf16(r2, r3); w.z = cvt_pk_bf16(r4, r5); w.w = cvt_pk_bf16(r6, r7);
                    *(u32x4*)(O + row * ldc + col0 + bj * HALF) = w; } }
    }
};
struct RowSkipOrder {
    StaticOrder base; bool skip;
    __device__ void init(int N, int G_, int c_, bool skip_) { skip = skip_; base.init(skip_ ? 16384 : 16896, N, G_, c_); }
    __device__ bool next(int i, Unit& u) const { if (!base.next(i, u)) return false; if (skip) u.pm += 1 + (u.pm >= 32 ? 1 : 0); return true; }
    __device__ __forceinline__ void a_ready(const Unit&) const {}
    __device__ __forceinline__ void done(const Unit&) const {}
};

struct EpiRope {
    static constexpr bool PERM = true, AFTER_DRAIN = false;
    bf16_t* O; int ldc; const float* ct; const float* st;
    __device__ __forceinline__ void operator()(const f32x4 (&acc)[2][2][4][2], const Unit& u, int wr, int wc, int fr, int fq) const {
        const int pn = u.pn; const bool rope = pn < 2 || (pn >= 4 && pn < 12) || (pn >= 20 && pn < 28) || (pn >= 36 && pn < 44);
        const int row0 = u.pm * BM + wr * 64 + fr;
        if (!rope) {
            const int col0 = pn * BM + wc * 32 + 8 * fq;
#pragma unroll
            for (int ai = 0; ai < 2; ++ai)
#pragma unroll
                for (int m = 0; m < 4; ++m) { bf16_t* rowp = O + (size_t)(row0 + ai * HALF + m * 16) * ldc + col0;
#pragma unroll
                    for (int bj = 0; bj < 2; ++bj) { const f32x4 v0 = acc[ai][bj][m][0], v1 = acc[ai][bj][m][1];
                        u32x4 w; w.x = cvt_pk_bf16(v0[0], v0[1]); w.y = cvt_pk_bf16(v0[2], v0[3]); w.z = cvt_pk_bf16(v1[0], v1[1]); w.w = cvt_pk_bf16(v1[2], v1[3]);
                        *(u32x4*)(rowp + bj * HALF) = w; } }
            return;
        }
        const bool isctx = (u.pm == 0) || (u.pm == 33);
        const int i0 = 32 * (wc & 1) + 8 * fq, ocol = pn * BM + (wc >> 1) * 128 + i0;
        const int tbase = row0 - (u.pm >= 33 ? 8448 : 0) - 256;
#pragma unroll
        for (int ai = 0; ai < 2; ++ai)
#pragma unroll
            for (int m = 0; m < 4; ++m) { const int t = tbase + ai * HALF + m * 16;
                f32x4 c0 = {1.f, 1.f, 1.f, 1.f}, c1 = c0, s0 = {0.f, 0.f, 0.f, 0.f}, s1 = s0;
                if (!isctx) { const float* cp = ct + (size_t)t * 64 + i0; const float* sp = st + (size_t)t * 64 + i0;
                    c0 = *(const f32x4*)cp; c1 = *(const f32x4*)(cp + 4); s0 = *(const f32x4*)sp; s1 = *(const f32x4*)(sp + 4); }
                const f32x4 a0 = acc[ai][0][m][0], a1 = acc[ai][0][m][1], b0 = acc[ai][1][m][0], b1 = acc[ai][1][m][1];
                const f32x4 y0 = a0 * c0 - b0 * s0, y1 = a1 * c1 - b1 * s1, z0 = b0 * c0 + a0 * s0, z1 = b1 * c1 + a1 * s1;
                bf16_t* rowp = O + (size_t)(row0 + ai * HALF + m * 16) * ldc + ocol;
                u32x4 w; w.x = cvt_pk_bf16(y0[0], y0[1]); w.y = cvt_pk_bf16(y0[2], y0[3]); w.z = cvt_pk_bf16(y1[0], y1[1]); w.w = cvt_pk_bf16(y1[2], y1[3]);
                *(u32x4*)rowp = w;
                u32x4 x; x.x = cvt_pk_bf16(z0[0], z0[1]); x.y = cvt_pk_bf16(z0[2], z0[3]); x.z = cvt_pk_bf16(z1[0], z1[1]); x.w = cvt_pk_bf16(z1[2], z1[3]);
                *(u32x4*)(rowp + 64) = x; }
    }
};

template <class Epi, class Sched, bool ALIGN_EPI = false, bool SP2 = false>
__device__ __forceinline__ void gemm_phase(PG8_LAS unsigned char* lds, const Gemm g, const Sched& S, const Epi& E) {
    int tid_ = threadIdx.x; asm volatile("" : "+v"(tid_));
    const int tid = tid_, wid = __builtin_amdgcn_readfirstlane(tid >> 6), lane = tid & 63, wr = wid >> 2, wc = wid & 3, fr = lane & 15, fq = lane >> 4;
    const int K = g.K, nt = K / BK;
    unsigned voffA[2], voffB[2];
#pragma unroll
    for (int i = 0; i < 2; ++i) { int R, C; stage_rc(tid * 16 + i * 8192, R, C); const int Rb = Epi::PERM ? ((R & ~31) + perm32(R & 31)) : R;
        voffA[i] = (unsigned)(R * K + C) * 2u; voffB[i] = (unsigned)(Rb * K + C) * 2u; }
    const size_t kstep = (size_t)(BK * 2);
    const size_t hstep = (size_t)HALF * K * 2;
    const size_t tstep = 2 * hstep;
    const unsigned ldsw = (unsigned)wid * 1024u;
    const int aoff = lds_byte(wr * 64 + fr, fq * 8), boff = lds_byte(wc * 32 + fr, fq * 8);
#define PG8_SA(b, h) (((b) * 2 + (h)) * HTB)
#define PG8_SB(b, h) ((4 + (b) * 2 + (h)) * HTB)
#define PG8_STAGE(bufoff, gbase, voff) do { _Pragma("unroll") for (int _i = 0; _i < 2; ++_i) \
        __builtin_amdgcn_global_load_lds((const unsigned*)((const char*)(gbase) + (voff)[_i]), (PG8_LAS unsigned*)(lds + (bufoff) + ldsw + _i * 8192), 16, 0, 0); } while (0)
#define PG8_LDA(dst, b, h) do { _Pragma("unroll") for (int m = 0; m < 4; ++m) _Pragma("unroll") for (int k = 0; k < 2; ++k) dst[m][k] = *(const PG8_LAS bf16x8*)(lds + PG8_SA(b, h) + aoff + m * 2048 + k * 1024); } while (0)
#define PG8_LDB(dst, b, h) do { _Pragma("unroll") for (int n = 0; n < 2; ++n) _Pragma("unroll") for (int k = 0; k < 2; ++k) dst[n][k] = *(const PG8_LAS bf16x8*)(lds + PG8_SB(b, h) + boff + n * 2048 + k * 1024); } while (0)
#define PG8_MMA(ai, bj, At, Bt) do { __builtin_amdgcn_s_setprio(1); _Pragma("unroll") for (int m = 0; m < 4; ++m) _Pragma("unroll") for (int n = 0; n < 2; ++n) _Pragma("unroll") for (int k = 0; k < 2; ++k) \
        acc[ai][bj][m][n] = __builtin_amdgcn_mfma_f32_16x16x32_bf16(Bt[n][k], At[m][k], acc[ai][bj][m][n], 0, 0, 0); __builtin_amdgcn_s_setprio(0); } while (0)
#define PG8_WAIT_V(n) asm volatile("s_waitcnt vmcnt(" #n ")" ::: "memory")
#define PG8_WAIT_L(n) asm volatile("s_waitcnt lgkmcnt(" #n ")" ::: "memory")
#define PG8_BAR __builtin_amdgcn_s_barrier()
#define PG8_SCHED __builtin_amdgcn_sched_barrier(0)
    Unit cur, nxt; int ui = 0;
    if (!S.next(0, cur)) return;
    f32x4 acc[2][2][4][2];
#pragma unroll
    for (int a = 0; a < 2; ++a)
#pragma unroll
        for (int b = 0; b < 2; ++b)
#pragma unroll
            for (int m = 0; m < 4; ++m)
#pragma unroll
                for (int n = 0; n < 2; ++n) acc[a][b][m][n] = (f32x4){0.f, 0.f, 0.f, 0.f};
    bf16x8 At[4][2], B0[2][2], B1[2][2];
    const char* cA = (const char*)g.A + (size_t)cur.pm * tstep; const char* cB = (const char*)g.Bt + (size_t)cur.pn * tstep;
    S.a_ready(cur);
    if constexpr (SP2) {
        PG8_STAGE(PG8_SB(0, 0), cB, voffB); PG8_STAGE(PG8_SB(0, 1), cB + hstep, voffB); PG8_STAGE(PG8_SA(0, 0), cA, voffA); PG8_STAGE(PG8_SA(0, 1), cA + hstep, voffA);
        if (wr == 1) PG8_BAR;
        PG8_WAIT_V(2); PG8_BAR;
        PG8_STAGE(PG8_SB(1, 0), cB + kstep, voffB); PG8_STAGE(PG8_SA(1, 0), cA + kstep, voffA); PG8_STAGE(PG8_SB(1, 1), cB + hstep + kstep, voffB);
        PG8_WAIT_V(6); PG8_BAR;
    } else {
        PG8_STAGE(PG8_SB(0, 0), cB, voffB); PG8_STAGE(PG8_SA(0, 0), cA, voffA); PG8_STAGE(PG8_SB(0, 1), cB + hstep, voffB); PG8_STAGE(PG8_SA(0, 1), cA + hstep, voffA);
        if (wr == 1) PG8_BAR;
        PG8_WAIT_V(4); PG8_BAR;
        PG8_STAGE(PG8_SB(1, 0), cB + kstep, voffB); PG8_STAGE(PG8_SA(1, 0), cA + kstep, voffA); PG8_STAGE(PG8_SB(1, 1), cB + hstep + kstep, voffB);
        PG8_WAIT_V(6); PG8_BAR;
    }
    for (;;) {
        const bool has_next = S.next(ui + 1, nxt);
        const char* nA = has_next ? (const char*)g.A + (size_t)nxt.pm * tstep : cA; const char* nB = has_next ? (const char*)g.Bt + (size_t)nxt.pn * tstep : cB;
        for (int t = 0; t < nt; t += 2) {
            const bool last = (t == nt - 2);
            const char* a1 = cA + (size_t)(t + 1) * kstep;
            const char* a2 = last ? nA : cA + (size_t)(t + 2) * kstep; const char* b2 = last ? nB : cB + (size_t)(t + 2) * kstep;
            const char* a3 = a2 + kstep; const char* b3 = b2 + kstep;
            if (last && has_next) S.a_ready(nxt);
            if constexpr (SP2) {
            PG8_LDB(B0, 0, 0); PG8_LDB(B1, 0, 1); PG8_SCHED; PG8_LDA(At, 0, 0); PG8_STAGE(PG8_SA(1, 1), a1 + hstep, voffA);
            PG8_WAIT_V(8); PG8_WAIT_L(0); PG8_BAR; PG8_MMA(0, 0, At, B0); PG8_MMA(0, 1, At, B1); PG8_BAR; PG8_SCHED;
            PG8_LDA(At, 0, 1); PG8_STAGE(PG8_SB(0, 0), b2, voffB); PG8_STAGE(PG8_SB(0, 1), b2 + hstep, voffB); PG8_STAGE(PG8_SA(0, 0), a2, voffA);
            PG8_WAIT_V(8); PG8_WAIT_L(0); PG8_BAR; PG8_MMA(1, 0, At, B0); PG8_MMA(1, 1, At, B1); PG8_BAR; PG8_SCHED;
            PG8_LDB(B0, 1, 0); PG8_LDB(B1, 1, 1); PG8_SCHED; PG8_LDA(At, 1, 0); PG8_STAGE(PG8_SA(0, 1), a2 + hstep, voffA);
            PG8_WAIT_V(8); PG8_WAIT_L(0); PG8_BAR; PG8_MMA(0, 0, At, B0); PG8_MMA(0, 1, At, B1); PG8_BAR; PG8_SCHED;
            PG8_LDA(At, 1, 1); PG8_STAGE(PG8_SB(1, 0), b3, voffB); PG8_STAGE(PG8_SB(1, 1), b3 + hstep, voffB); PG8_STAGE(PG8_SA(1, 0), a3, voffA);
            PG8_WAIT_V(8); PG8_WAIT_L(0); PG8_BAR; PG8_MMA(1, 0, At, B0); PG8_MMA(1, 1, At, B1); PG8_BAR; PG8_SCHED;
            } else {
            PG8_LDB(B0, 0, 0); PG8_SCHED; PG8_LDA(At, 0, 0); PG8_STAGE(PG8_SA(1, 1), a1 + hstep, voffA);
            PG8_WAIT_L(8); PG8_BAR; PG8_WAIT_L(0); PG8_MMA(0, 0, At, B0); PG8_BAR; PG8_SCHED;
            PG8_LDB(B1, 0, 1); PG8_STAGE(PG8_SB(0, 0), b2, voffB);
            PG8_BAR; PG8_WAIT_L(0); PG8_MMA(0, 1, At, B1); PG8_BAR;
            PG8_LDA(At, 0, 1); PG8_STAGE(PG8_SA(0, 0), a2, voffA);
            PG8_BAR; PG8_WAIT_L(0); PG8_MMA(1, 0, At, B0); PG8_BAR; PG8_SCHED;
            PG8_STAGE(PG8_SB(0, 1), b2 + hstep, voffB);
            PG8_WAIT_V(6); PG8_BAR; PG8_MMA(1, 1, At, B1); PG8_BAR;
            PG8_LDB(B0, 1, 0); PG8_SCHED; PG8_LDA(At, 1, 0); PG8_STAGE(PG8_SA(0, 1), a2 + hstep, voffA);
            PG8_WAIT_L(8); PG8_BAR; PG8_WAIT_L(0); PG8_MMA(0, 0, At, B0); PG8_BAR; PG8_SCHED;
            PG8_LDB(B1, 1, 1); PG8_STAGE(PG8_SB(1, 0), b3, voffB);
            PG8_BAR; PG8_WAIT_L(0); PG8_MMA(0, 1, At, B1); PG8_BAR;
            PG8_LDA(At, 1, 1); PG8_STAGE(PG8_SA(1, 0), a3, voffA);
            PG8_BAR; PG8_WAIT_L(0); PG8_MMA(1, 0, At, B0); PG8_BAR; PG8_SCHED;
            PG8_STAGE(PG8_SB(1, 1), b3 + hstep, voffB);
            PG8_WAIT_V(6); PG8_BAR; PG8_MMA(1, 1, At, B1); PG8_BAR;
            }
        }
        if constexpr (ALIGN_EPI) { if (wr == 0) PG8_BAR; }
        if constexpr (!Epi::AFTER_DRAIN) { E(acc, cur, wr, wc, fr, fq); S.done(cur); }
        if (!has_next) break;
#pragma unroll
        for (int a = 0; a < 2; ++a)
#pragma unroll
            for (int b = 0; b < 2; ++b)
#pragma unroll
                for (int m = 0; m < 4; ++m)
#pragma unroll
                    for (int n = 0; n < 2; ++n) acc[a][b][m][n] = (f32x4){0.f, 0.f, 0.f, 0.f};
        cur = nxt; cA = nA; cB = nB; ++ui;
        if constexpr (ALIGN_EPI) { if (wr == 1) PG8_BAR; }
    }
    PG8_WAIT_V(0);
    if constexpr (!ALIGN_EPI) { if (wr == 0) PG8_BAR; }
    PG8_BAR;
    if constexpr (Epi::AFTER_DRAIN) { E.fused(acc, cur, wr, wc, fr, fq, lds, wid, lane); S.done(cur); }
#undef PG8_SA
#undef PG8_SB
#undef PG8_STAGE
#undef PG8_LDA
#undef PG8_LDB
#undef PG8_MMA
#undef PG8_WAIT_V
#undef PG8_WAIT_L
#undef PG8_BAR
#undef PG8_SCHED
}
}

namespace att {
using bf16 = unsigned short;
constexpr int D = 128, NW = 8, QBLK = 32, KVBLK = 64;
constexpr float SCALE = 0.088388347648318440f;
constexpr float THR = 8.f;
constexpr int SDEPTH = 2;
constexpr int LDQ = INC, LDK = INC, LDO = DM;
constexpr size_t SHM_V = KVBLK * D * 2, SHM_K = KVBLK * D * 2, SHM_ATTN = 2 * SHM_V + 2 * SHM_K + NW * 64 * 4;

using bf16x8 = __attribute__((ext_vector_type(8))) short;
using s16x4  = __attribute__((ext_vector_type(4))) short;
using f32x16 = __attribute__((ext_vector_type(16))) float;
using f32x8  = __attribute__((ext_vector_type(8))) float;
using u32x4  = __attribute__((ext_vector_type(4))) unsigned;
#define KSWZ(row, colB) ((row) * 256 + ((colB) ^ (((row) & 7) << 4)))
#define SBAR() __builtin_amdgcn_sched_barrier(0)
__device__ __forceinline__ int crow(int r, int hi) { return (r & 3) + 8 * (r >> 2) + 4 * hi; }
__device__ __forceinline__ unsigned cvtpk(float lo, float hi) {
  unsigned r; asm volatile("v_cvt_pk_bf16_f32 %0, %1, %2" : "=v"(r) : "v"(lo), "v"(hi)); return r;
}
template <typename TIn> struct Stage;
template <> struct Stage<bf16>  { using T = bf16x8;
  __device__ static __forceinline__ T ld8(const bf16* p) { return *reinterpret_cast<const bf16x8*>(p); }
  __device__ static __forceinline__ bf16x8 tobf(T x) { return x; } };
template <> struct Stage<float> { using T = f32x8;
  __device__ static __forceinline__ T ld8(const float* p) { return *reinterpret_cast<const f32x8*>(p); }
  __device__ static __forceinline__ bf16x8 tobf(T x) {
    u32x4 w = {cvtpk(x[0], x[1]), cvtpk(x[2], x[3]), cvtpk(x[4], x[5]), cvtpk(x[6], x[7])}; return *reinterpret_cast<bf16x8*>(&w); } };

__device__ __forceinline__ void partialSM(f32x16& p0, f32x16& p1, float& m_reg, float& mn, float& alpha) {
  constexpr float C = SCALE * 1.4426950408889634f;
  float pmax = p0[0]; for (int r = 1; r < 16; ++r) pmax = fmaxf(pmax, p0[r]); for (int r = 0; r < 16; ++r) pmax = fmaxf(pmax, p1[r]);
  { auto rr = __builtin_amdgcn_permlane32_swap(__float_as_uint(pmax), __float_as_uint(pmax), false, false);
    pmax = fmaxf(__uint_as_float(rr[0]), __uint_as_float(rr[1])); }
  if (__builtin_expect(__all(pmax - m_reg <= THR / SCALE), 1)) { mn = m_reg; alpha = 1.f; }
  else { mn = fmaxf(m_reg, pmax); alpha = __builtin_amdgcn_exp2f((m_reg - mn) * C); m_reg = mn; }
  float mnC = -mn * C;
  for (int r = 0; r < 16; ++r) p0[r] = fmaf(p0[r], C, mnC); for (int r = 0; r < 16; ++r) p1[r] = fmaf(p1[r], C, mnC);
  for (int r = 0; r < 16; ++r) p0[r] = __builtin_amdgcn_exp2f(p0[r]);
}
__device__ __forceinline__ void finishSM(f32x16& p0, f32x16& p1, float alpha, float& l_reg, bf16x8& pa0, bf16x8& pa1, bf16x8& pa2, bf16x8& pa3) {
  for (int r = 0; r < 16; ++r) p1[r] = __builtin_amdgcn_exp2f(p1[r]);
  float ps = 0; for (int r = 0; r < 16; ++r) ps += p0[r]; for (int r = 0; r < 16; ++r) ps += p1[r];
  { auto rr = __builtin_amdgcn_permlane32_swap(__float_as_uint(ps), __float_as_uint(ps), false, false);
    ps = __uint_as_float(rr[0]) + __uint_as_float(rr[1]); }
  l_reg = l_reg * alpha + ps;
#define PK4(P, BASE, OUT) do { unsigned a0 = cvtpk(P[BASE + 0], P[BASE + 1]), a1 = cvtpk(P[BASE + 2], P[BASE + 3]);   \
    unsigned b0 = cvtpk(P[BASE + 4], P[BASE + 5]), b1 = cvtpk(P[BASE + 6], P[BASE + 7]);                              \
    auto r0 = __builtin_amdgcn_permlane32_swap(a0, b0, false, false); auto r1 = __builtin_amdgcn_permlane32_swap(a1, b1, false, false); \
    u32x4 w = {r0[0], r1[0], r0[1], r1[1]}; OUT = *reinterpret_cast<bf16x8*>(&w); } while (0)
  PK4(p0, 0, pa0); PK4(p0, 8, pa1); PK4(p1, 0, pa2); PK4(p1, 8, pa3);
#undef PK4
}
__device__ __forceinline__ void qkt(f32x16& p0, f32x16& p1, const bf16* Ks, const bf16x8* qr, int r32, int hi) {
  p0 = f32x16{}; p1 = f32x16{};
  for (int d0 = 0; d0 < 8; ++d0) { int cb = (d0 * 16 + hi * 8) * 2;
    bf16x8 b0 = *reinterpret_cast<const bf16x8*>((const char*)Ks + KSWZ(r32, cb));
    bf16x8 b1 = *reinterpret_cast<const bf16x8*>((const char*)Ks + KSWZ(32 + r32, cb));
    p0 = __builtin_amdgcn_mfma_f32_32x32x16_bf16(b0, qr[d0], p0, 0, 0, 0);
    p1 = __builtin_amdgcn_mfma_f32_32x32x16_bf16(b1, qr[d0], p1, 0, 0, 0); }
}
__device__ __forceinline__ int v_st(int k, int c) { const int kk = (k & ~0xC) | ((k & 4) << 1) | ((k & 8) >> 1); return ((kk >> 3) * 4 + (c >> 5)) * 512 + ((kk & 7) * 32 + (c & 31)) * 2; }
__device__ __forceinline__ int v_rd_base(int lane) { return ((lane & 3) << 3) | (((lane >> 2) & 3) << 6) | (((lane >> 4) & 1) << 5) | (((lane >> 5) & 1) << 8); }
constexpr int v_rd_off(int d0, int ks, int half) { return d0 * 512 + ks * 4096 + half * 2048; }
template <int OFF> __device__ __forceinline__ s16x4 tr_read(int vb) {
  s16x4 r; asm volatile("ds_read_b64_tr_b16 %0, %1 offset:%2" : "=&v"(r) : "v"(vb), "i"(OFF) : "memory"); return r;
}
template <int D0> __device__ __forceinline__ void pv_one(f32x16& od, int vb, bf16x8 pa0, bf16x8 pa1, bf16x8 pa2, bf16x8 pa3) {
  const s16x4 l0 = tr_read<v_rd_off(D0, 0, 0)>(vb), h0 = tr_read<v_rd_off(D0, 0, 1)>(vb), l1 = tr_read<v_rd_off(D0, 1, 0)>(vb), h1 = tr_read<v_rd_off(D0, 1, 1)>(vb);
  const s16x4 l2 = tr_read<v_rd_off(D0, 2, 0)>(vb), h2 = tr_read<v_rd_off(D0, 2, 1)>(vb), l3 = tr_read<v_rd_off(D0, 3, 0)>(vb), h3 = tr_read<v_rd_off(D0, 3, 1)>(vb);
  asm volatile("s_waitcnt lgkmcnt(0)" ::: "memory"); SBAR();
#define PK(L, H) (bf16x8){L[0], L[1], L[2], L[3], H[0], H[1], H[2], H[3]}
  od = __builtin_amdgcn_mfma_f32_32x32x16_bf16(pa0, PK(l0, h0), od, 0, 0, 0);
  od = __builtin_amdgcn_mfma_f32_32x32x16_bf16(pa1, PK(l1, h1), od, 0, 0, 0);
  od = __builtin_amdgcn_mfma_f32_32x32x16_bf16(pa2, PK(l2, h2), od, 0, 0, 0);
  od = __builtin_amdgcn_mfma_f32_32x32x16_bf16(pa3, PK(l3, h3), od, 0, 0, 0);
#undef PK
}
__device__ __forceinline__ void pv_d0(f32x16* o, int vb, bf16x8 pa0, bf16x8 pa1, bf16x8 pa2, bf16x8 pa3) {
  pv_one<0>(o[0], vb, pa0, pa1, pa2, pa3); pv_one<1>(o[1], vb, pa0, pa1, pa2, pa3); pv_one<2>(o[2], vb, pa0, pa1, pa2, pa3); pv_one<3>(o[3], vb, pa0, pa1, pa2, pa3);
}

__device__ __forceinline__ void band_mask(f32x16& p0, f32x16& p1, int dq  , int hi) {
#pragma unroll
  for (int r = 0; r < 16; ++r) { const int d = dq - crow(r, hi);
    if ((unsigned)(d + 128) > 256u) p0[r] = -1e30f;
    if ((unsigned)(d + 96) > 256u) p1[r] = -1e30f; }
}
template <bool MASK>
__device__ __forceinline__ void attn_body(const bf16* __restrict__ Qb, const bf16* __restrict__ Kh, const bf16* __restrict__ Vh,
                                          bf16* __restrict__ Ob, int NT, int NCT, int lo, int qpos0, float sinkl2, char* lds) {
  using St = Stage<bf16>;
  int tid_ = threadIdx.x; asm volatile("" : "+v"(tid_));
  const int tid = tid_, wid = tid >> 6, lane = tid & 63, r32 = lane & 31, hi = lane >> 5;
  bf16* V_lds = (bf16*)lds; bf16* K_lds = (bf16*)(lds + 2 * SHM_V);
  float* ws = (float*)(lds + 2 * SHM_V + 2 * SHM_K) + wid * 64; float* li_l = ws; float* al_l = ws + 32;
  float m_reg = -1e30f, l_reg = 0; f32x16 o[4] = {}; bf16x8 qr[8];
  const bf16* Qw = Qb + (long)(wid * QBLK + r32) * LDQ + hi * 8;
#pragma unroll
  for (int d0 = 0; d0 < 8; ++d0) qr[d0] = St::ld8(Qw + d0 * 16);
  const int sr = tid >> 4, sc = (tid & 15) * 8, vst0 = v_st(sr, sc), vst1 = v_st(32 + sr, sc);
  const int vb0 = (int)(uintptr_t)V_lds + v_rd_base(lane);
  const int qi = qpos0 + wid * QBLK + r32;
  struct { typename St::T vs0, vs1, ks0, ks1; } sr_[SDEPTH];
#define TROW(j) (64 * (j) + ((j) >= NCT ? lo : 0))
#define SLOAD(i, k0) do { const long k0_ = (k0); sr_[i].vs0 = St::ld8(&Vh[(k0_ + sr) * LDK + sc]); sr_[i].vs1 = St::ld8(&Vh[(k0_ + 32 + sr) * LDK + sc]); \
    sr_[i].ks0 = St::ld8(&Kh[(k0_ + sr) * LDK + sc]); sr_[i].ks1 = St::ld8(&Kh[(k0_ + 32 + sr) * LDK + sc]); } while (0)
#define SWRITE(b, i) do { *(bf16x8*)((char*)V_lds + (b) * SHM_V + vst0) = St::tobf(sr_[i].vs0);          \
    *(bf16x8*)((char*)V_lds + (b) * SHM_V + vst1) = St::tobf(sr_[i].vs1); int kc = sc * 2;               \
    *(bf16x8*)((char*)K_lds + (b) * SHM_K + KSWZ(sr, kc)) = St::tobf(sr_[i].ks0);                       \
    *(bf16x8*)((char*)K_lds + (b) * SHM_K + KSWZ(32 + sr, kc)) = St::tobf(sr_[i].ks1); } while (0)
#define SWAIT() do { if constexpr (SDEPTH == 2) asm volatile("s_waitcnt vmcnt(4)" ::: "memory"); else asm volatile("s_waitcnt vmcnt(0)" ::: "memory"); } while (0)
#define RESC(a) do { if (__any((a) < 1.f)) { if (hi == 0) al_l[r32] = (a); asm volatile("s_waitcnt lgkmcnt(0)" ::: "memory"); \
    for (int d = 0; d < 4; ++d) for (int r = 0; r < 16; ++r) o[d][r] *= al_l[crow(r, hi)]; } } while (0)
#define AMASK(P0, P1, j) do { if constexpr (MASK) { if ((j) >= NCT) band_mask(P0, P1, qi - (lo + 64 * ((j) - NCT)), hi); } } while (0)
  f32x16 pA0, pA1, pB0, pB1; float mnA, mnB, alA, alB; bf16x8 pa0, pa1, pa2, pa3;
  constexpr int SE = 0, SO = SDEPTH - 1;
  SLOAD(SE, TROW(0)); asm volatile("s_waitcnt vmcnt(0)" ::: "memory"); SWRITE(0, SE); __syncthreads();
  qkt(pA0, pA1, K_lds, qr, r32, hi); AMASK(pA0, pA1, 0); partialSM(pA0, pA1, m_reg, mnA, alA);
  SLOAD(SO, TROW(1)); if constexpr (SDEPTH == 2) { if (2 < NT) SLOAD(SE, TROW(2)); }
  SWAIT(); SWRITE(1, SO); __syncthreads();
  for (int j = 1; j + 1 < NT; j += 2) {
    SBAR(); qkt(pB0, pB1, (bf16*)((char*)K_lds + SHM_K), qr, r32, hi); AMASK(pB0, pB1, j);
    finishSM(pA0, pA1, alA, l_reg, pa0, pa1, pa2, pa3); SBAR();
    SLOAD(SO, TROW(j + SDEPTH)); SBAR();
    pv_d0(o, vb0, pa0, pa1, pa2, pa3); partialSM(pB0, pB1, m_reg, mnB, alB);
    __syncthreads(); SWAIT(); SWRITE(0, SE);
    RESC(alB); __syncthreads();
    SBAR(); qkt(pA0, pA1, K_lds, qr, r32, hi); AMASK(pA0, pA1, j + 1);
    finishSM(pB0, pB1, alB, l_reg, pa0, pa1, pa2, pa3); SBAR();
    if (SDEPTH == 1 || j + 3 < NT) SLOAD(SE, TROW(j + 1 + SDEPTH)); SBAR();
    pv_d0(o, vb0 + (int)SHM_V, pa0, pa1, pa2, pa3); partialSM(pA0, pA1, m_reg, mnA, alA);
    __syncthreads(); SWAIT(); SWRITE(1, SO);
    RESC(alA); __syncthreads();
  }
  SBAR(); qkt(pB0, pB1, (bf16*)((char*)K_lds + SHM_K), qr, r32, hi); AMASK(pB0, pB1, NT - 1);
  finishSM(pA0, pA1, alA, l_reg, pa0, pa1, pa2, pa3); SBAR();
  pv_d0(o, vb0, pa0, pa1, pa2, pa3); partialSM(pB0, pB1, m_reg, mnB, alB);
  __syncthreads(); RESC(alB);
  finishSM(pB0, pB1, alB, l_reg, pa0, pa1, pa2, pa3); SBAR();
  pv_d0(o, vb0 + (int)SHM_V, pa0, pa1, pa2, pa3);
  l_reg += __builtin_amdgcn_exp2f(sinkl2 - m_reg * (SCALE * 1.4426950408889634f));
  if (hi == 0) li_l[r32] = l_reg; asm volatile("s_waitcnt lgkmcnt(0)" ::: "memory");
  float rli[16];
#pragma unroll
  for (int r = 0; r < 16; ++r) rli[r] = __builtin_amdgcn_rcpf(li_l[crow(r, hi)]);
  bf16* Ow = Ob + (long)(wid * QBLK) * LDO;
#pragma unroll
  for (int r = 0; r < 16; ++r) { int orow = crow(r, hi);
    for (int d0 = 0; d0 < 4; ++d0) { const float v = o[d0][r] * rli[r]; const unsigned u = __builtin_bit_cast(unsigned, v);
      Ow[(long)orow * LDO + d0 * 32 + r32] = (bf16)((u + 0x7fffu + ((u >> 16) & 1u)) >> 16); } }
  __syncthreads();
#undef TROW
#undef SLOAD
#undef SWRITE
#undef SWAIT
#undef RESC
#undef AMASK
}

template <int OFF> __device__ __forceinline__ bf16x8 k_read(int addr) { bf16x8 r; asm volatile("ds_read_b128 %0, %1 offset:%2" : "=&v"(r) : "v"(addr), "i"(OFF) : "memory"); return r; }
__device__ __forceinline__ void qkt_pipe(f32x16& p0, f32x16& p1, const bf16* Ks, const bf16x8* qr, int r32, int hi) {
  p0 = f32x16{}; p1 = f32x16{};
  const int kb = (int)(uintptr_t)Ks + r32 * 256, sw = (r32 & 7) << 4;
  const int e0 = kb + ((0 * 32 + hi * 16) ^ sw), e1 = kb + ((1 * 32 + hi * 16) ^ sw), e2 = kb + ((2 * 32 + hi * 16) ^ sw), e3 = kb + ((3 * 32 + hi * 16) ^ sw);
  bf16x8 a0, a1, b0, b1;
#define LGK(n) do { asm volatile("s_waitcnt lgkmcnt(" #n ")" ::: "memory"); SBAR(); } while (0)
#define MM(A0, A1, d) do { p0 = __builtin_amdgcn_mfma_f32_32x32x16_bf16(A0, qr[d], p0, 0, 0, 0); p1 = __builtin_amdgcn_mfma_f32_32x32x16_bf16(A1, qr[d], p1, 0, 0, 0); SBAR(); } while (0)
  a0 = k_read<0>(e0); a1 = k_read<8192>(e0); b0 = k_read<0>(e1); b1 = k_read<8192>(e1);
  LGK(2); MM(a0, a1, 0); a0 = k_read<0>(e2); a1 = k_read<8192>(e2);
  LGK(2); MM(b0, b1, 1); b0 = k_read<0>(e3); b1 = k_read<8192>(e3);
  LGK(2); MM(a0, a1, 2); a0 = k_read<128>(e0); a1 = k_read<8320>(e0);
  LGK(2); MM(b0, b1, 3); b0 = k_read<128>(e1); b1 = k_read<8320>(e1);
  LGK(2); MM(a0, a1, 4); a0 = k_read<128>(e2); a1 = k_read<8320>(e2);
  LGK(2); MM(b0, b1, 5); b0 = k_read<128>(e3); b1 = k_read<8320>(e3);
  LGK(2); MM(a0, a1, 6);
  LGK(0); MM(b0, b1, 7);
#undef LGK
#undef MM
}
struct VFr { s16x4 l0, h0, l1, h1, l2, h2, l3, h3; };
template <int DB> __device__ __forceinline__ void pv_ld(VFr& f, int vb) {
  constexpr int I = (DB >> 2) * 16384, D0 = DB & 3;
  f.l0 = tr_read<I + v_rd_off(D0, 0, 0)>(vb); f.h0 = tr_read<I + v_rd_off(D0, 0, 1)>(vb); f.l1 = tr_read<I + v_rd_off(D0, 1, 0)>(vb); f.h1 = tr_read<I + v_rd_off(D0, 1, 1)>(vb);
  f.l2 = tr_read<I + v_rd_off(D0, 2, 0)>(vb); f.h2 = tr_read<I + v_rd_off(D0, 2, 1)>(vb); f.l3 = tr_read<I + v_rd_off(D0, 3, 0)>(vb); f.h3 = tr_read<I + v_rd_off(D0, 3, 1)>(vb);
}
__device__ __forceinline__ void pv_mm(f32x16& od, const VFr& f, bf16x8 pa0, bf16x8 pa1, bf16x8 pa2, bf16x8 pa3) {
#define PK(L, H) (bf16x8){L[0], L[1], L[2], L[3], H[0], H[1], H[2], H[3]}
  od = __builtin_amdgcn_mfma_f32_32x32x16_bf16(pa0, PK(f.l0, f.h0), od, 0, 0, 0);
  od = __builtin_amdgcn_mfma_f32_32x32x16_bf16(pa1, PK(f.l1, f.h1), od, 0, 0, 0);
  od = __builtin_amdgcn_mfma_f32_32x32x16_bf16(pa2, PK(f.l2, f.h2), od, 0, 0, 0);
  od = __builtin_amdgcn_mfma_f32_32x32x16_bf16(pa3, PK(f.l3, f.h3), od, 0, 0, 0);
#undef PK
}
__device__ __forceinline__ void pv_all(f32x16* o, int vb, bf16x8 pa0, bf16x8 pa1, bf16x8 pa2, bf16x8 pa3) {
  VFr fa, fb;
#define W8() do { asm volatile("s_waitcnt lgkmcnt(8)" ::: "memory"); SBAR(); } while (0)
#define W0() do { asm volatile("s_waitcnt lgkmcnt(0)" ::: "memory"); SBAR(); } while (0)
  pv_ld<0>(fa, vb);
  pv_ld<1>(fb, vb); W8(); pv_mm(o[0], fa, pa0, pa1, pa2, pa3); SBAR();
  pv_ld<2>(fa, vb); W8(); pv_mm(o[1], fb, pa0, pa1, pa2, pa3); SBAR();
  pv_ld<3>(fb, vb); W8(); pv_mm(o[2], fa, pa0, pa1, pa2, pa3); SBAR();
  pv_ld<4>(fa, vb); W8(); pv_mm(o[3], fb, pa0, pa1, pa2, pa3); SBAR();
  pv_ld<5>(fb, vb); W8(); pv_mm(o[4], fa, pa0, pa1, pa2, pa3); SBAR();
  pv_ld<6>(fa, vb); W8(); pv_mm(o[5], fb, pa0, pa1, pa2, pa3); SBAR();
  pv_ld<7>(fb, vb); W8(); pv_mm(o[6], fa, pa0, pa1, pa2, pa3); SBAR();
  W0(); pv_mm(o[7], fb, pa0, pa1, pa2, pa3);
#undef W8
#undef W0
}
#define ATT_LAS __attribute__((address_space(3)))
__device__ __forceinline__ void attn_body_v256(const bf16* __restrict__ Qb, const bf16* __restrict__ Kh, const bf16* __restrict__ Vh,
                                               bf16* __restrict__ Ob, int NT, ATT_LAS unsigned char* ldsl) {
  using St = Stage<bf16>;
  int tid_ = threadIdx.x; asm volatile("" : "+v"(tid_));
  const int tid = tid_, wid = __builtin_amdgcn_readfirstlane(tid >> 6), lane = tid & 63, r32 = lane & 31, hi = lane >> 5;
  char* lds = (char*)ldsl;
  char* V_lds = lds; char* K_lds = lds + 65536;
  float* ws = (float*)(lds + 98304) + wid * 64; float* li_l = ws; float* al_l = ws + 32;
  float m_reg = -1e30f, l_reg = 0; f32x16 o[8] = {}; bf16x8 qr[8];
  const bf16* Qw = Qb + (long)(wid * QBLK + r32) * LDQ + hi * 8;
#pragma unroll
  for (int d0 = 0; d0 < 8; ++d0) qr[d0] = St::ld8(Qw + d0 * 16);
  unsigned offK0, offV0;
  { const int row = wid * 4 + (lane >> 4), colB = ((lane & 15) * 16) ^ ((row & 7) << 4); offK0 = (unsigned)row * (LDK * 2) + (unsigned)colB;
    const int sub = wid * 2 + (lane >> 5), kkhi = sub >> 2, cblk = sub & 3, within = (lane & 31) * 16, kk = kkhi * 8 + (within >> 6);
    const int k = (kk & ~0xC) | ((kk & 4) << 1) | ((kk & 8) >> 1), c = cblk * 32 + ((within & 63) >> 1);
    offV0 = (unsigned)k * (LDK * 2) + (unsigned)c * 2; }
  const int vb0 = (int)(uintptr_t)V_lds + v_rd_base(lane);
#define DMA_TILE(j, buf) do { const char* kb_ = (const char*)Kh + (size_t)(j) * (64 * LDK * 2) + offK0; const char* vb_ = (const char*)Vh + (size_t)(j) * (64 * LDK * 2) + offV0; \
    _Pragma("unroll") for (int i_ = 0; i_ < 2; ++i_) __builtin_amdgcn_global_load_lds((const unsigned*)(kb_ + i_ * (32 * LDK * 2)), (ATT_LAS unsigned*)(ldsl + 65536 + (buf) * 16384 + (i_ * 8 + wid) * 1024), 16, 0, 0); \
    _Pragma("unroll") for (int i_ = 0; i_ < 4; ++i_) __builtin_amdgcn_global_load_lds((const unsigned*)(vb_ + (i_ & 1) * (32 * LDK * 2) + (i_ >> 1) * 256), (ATT_LAS unsigned*)(ldsl + (buf) * 32768 + (i_ * 8 + wid) * 1024), 16, 0, 0); } while (0)
#define RESC8(a) do { if (__any((a) < 1.f)) { if (hi == 0) al_l[r32] = (a); asm volatile("s_waitcnt lgkmcnt(0)" ::: "memory"); \
    for (int d = 0; d < 8; ++d) for (int r = 0; r < 16; ++r) o[d][r] *= al_l[crow(r, hi)]; } } while (0)
#define TILE_SYNC() do { asm volatile("s_waitcnt vmcnt(0)" ::: "memory"); __builtin_amdgcn_s_barrier(); asm volatile("" ::: "memory"); } while (0)
  f32x16 p0, p1; float mn, al; bf16x8 pa0, pa1, pa2, pa3;
#pragma unroll
  for (int d0 = 0; d0 < 8; ++d0) asm volatile("" : "+v"(qr[d0]));
  if (wid >= 4) __builtin_amdgcn_s_setprio(2);
  DMA_TILE(0, 0);
  for (int j = 0; j < NT; j += 2) {
    TILE_SYNC(); DMA_TILE(j + 1, 1);
    qkt_pipe(p0, p1, (const bf16*)K_lds, qr, r32, hi); partialSM(p0, p1, m_reg, mn, al); RESC8(al); finishSM(p0, p1, al, l_reg, pa0, pa1, pa2, pa3); SBAR();
    pv_all(o, vb0, pa0, pa1, pa2, pa3);
    TILE_SYNC(); if (j + 2 < NT) DMA_TILE(j + 2, 0);
    qkt_pipe(p0, p1, (const bf16*)(K_lds + 16384), qr, r32, hi); partialSM(p0, p1, m_reg, mn, al); RESC8(al); finishSM(p0, p1, al, l_reg, pa0, pa1, pa2, pa3); SBAR();
    pv_all(o, vb0 + 32768, pa0, pa1, pa2, pa3);
  }
  __builtin_amdgcn_s_setprio(0);
  if (hi == 0) li_l[r32] = l_reg; asm volatile("s_waitcnt lgkmcnt(0)" ::: "memory");
  float rli[16];
#pragma unroll
  for (int r = 0; r < 16; ++r) rli[r] = __builtin_amdgcn_rcpf(li_l[crow(r, hi)]);
  bf16* Ow = Ob + (long)(wid * QBLK) * LDO;
#pragma unroll
  for (int r = 0; r < 16; ++r) { int orow = crow(r, hi);
#pragma unroll
    for (int d0 = 0; d0 < 8; ++d0) { const float v = o[d0][r] * rli[r]; const unsigned u = __builtin_bit_cast(unsigned, v);
      Ow[(long)orow * LDO + d0 * 32 + r32] = (bf16)((u + 0x7fffu + ((u >> 16) & 1u)) >> 16); } }
#undef DMA_TILE
#undef RESC8
#undef TILE_SYNC
}
}

constexpr size_t MiB = 1u << 20;
constexpr size_t SLOT = (size_t)MROWS * DM * 2;
constexpr size_t WS_MOD = 0;
constexpr size_t WS_BAR = 1 * MiB, WS_BAR_BYTES = 16384;
constexpr size_t WS_COS = 2 * MiB, WS_SIN = 4 * MiB;
constexpr size_t WS_CTX1 = 6 * MiB;
constexpr size_t WS_WINT = 16 * MiB;
constexpr size_t WS_WPT = WS_WINT + 68 * MiB;
constexpr size_t WS_PX = WS_WPT + 48 * MiB;
constexpr size_t WS_S0 = WS_PX + (size_t)MROWS * INC * 2;
constexpr size_t WS_END = WS_S0 + 5 * SLOT;
static_assert(WS_END <= 4ull * DEPTH * DM * INC * 4, "workspace map exceeds the guaranteed 4x largest tensor");

constexpr int NWAVES = 8;
constexpr int LDS_BYTES = 147456;

#define GAS __attribute__((address_space(1)))
#define LAS __attribute__((address_space(3)))
typedef unsigned short bf16;
typedef unsigned v4u __attribute__((ext_vector_type(4)));
typedef unsigned v2u __attribute__((ext_vector_type(2)));
typedef float f32x4 __attribute__((ext_vector_type(4)));
#define LDS_WAIT() asm volatile("s_waitcnt lgkmcnt(0)" ::: "memory")
__device__ __forceinline__ unsigned f2bf(float f) { unsigned u = __builtin_bit_cast(unsigned, f); return (u + 0x7fffu + ((u >> 16) & 1u)) >> 16; }
__device__ __forceinline__ unsigned pk2(float lo, float hi) { return f2bf(lo) | (f2bf(hi) << 16); }
__device__ __forceinline__ float bflo(unsigned w) { return __builtin_bit_cast(float, w << 16); }
__device__ __forceinline__ float bfhi(unsigned w) { return __builtin_bit_cast(float, w & 0xffff0000u); }
__device__ __forceinline__ float siluf(float x) { return x / (1.f + __expf(-x)); }
__device__ __forceinline__ float sigmf(float x) { return 1.f / (1.f + __expf(-x)); }

struct Frame {
    LAS unsigned char* lds;
    int vcu, G;
    const float *x, *c, *ctx, *c_ctx, *w_ada, *b_ada, *g_pre, *g_post, *w_in, *sink, *lam_qk, *g_subln, *w_pa, *w_pb, *w_out;
    float* out; unsigned char* ws;
};

#define XB_TMO      128
#define XB_XCNT(j)  (256  + 64 * (j))
#define XB_XSUB(j)  (1280 + 64 * (j))
#define XB_XGEN(j)  (2304 + 64 * (j))
#define XB_TOP      3328
#define XB_TOPGEN   3392
#define XCD_BAR_WORDS 3456
#define XB_SPIN_CAP (1u << 18)

__device__ __forceinline__ unsigned xb_ld(unsigned* p)              { return __hip_atomic_load(p, __ATOMIC_RELAXED, __HIP_MEMORY_SCOPE_AGENT); }
__device__ __forceinline__ unsigned xb_add(unsigned* p, unsigned v) { return __hip_atomic_fetch_add(p, v, __ATOMIC_RELAXED, __HIP_MEMORY_SCOPE_AGENT); }
__device__ __forceinline__ unsigned xb_xcc_id() { return (unsigned)__builtin_amdgcn_s_getreg((3 << 11) | 20) & 0xFu; }
#define XB_SPIN(cond, bar) do { unsigned _sp = 0; while (cond) { __builtin_amdgcn_s_sleep(1); \
    if ((++_sp & 255u) == 0u) { if (xb_ld(&(bar)[XB_TMO])) break; if (_sp > XB_SPIN_CAP) { atomicAdd(&(bar)[XB_TMO], 1u); break; } } } } while (0)

struct XcdBarrier {
    unsigned* bar; unsigned x;
    volatile LAS unsigned* st;
};

__device__ __forceinline__ XcdBarrier xcd_barrier_post(unsigned* bar, volatile LAS unsigned* st) {
    XcdBarrier b; b.bar = bar; b.x = xb_xcc_id(); b.st = st;
    if (threadIdx.x == 0) (void)xb_add(&bar[XB_XCNT(b.x)], 1u);
    return b;
}
__device__ __forceinline__ void xcd_barrier_complete(unsigned* bar, unsigned x, unsigned& nloc, unsigned& nx) {
    const unsigned G = gridDim.x * gridDim.y * gridDim.z;
    unsigned sum, cnt, mine, sp = 0u;
    for (;;) {
        sum = 0u; cnt = 0u; mine = 0u;
#pragma unroll
        for (unsigned j = 0; j < 16; ++j) { const unsigned c = xb_ld(&bar[XB_XCNT(j)]); sum += c; cnt += (c > 0u) ? 1u : 0u; mine = (j == x) ? c : mine; }
        if (sum == G) break;
        __builtin_amdgcn_s_sleep(1);
        if ((++sp & 255u) == 0u) { if (xb_ld(&bar[XB_TMO])) break; if (sp > XB_SPIN_CAP) { atomicAdd(&bar[XB_TMO], 1u); break; } }
    }
    nloc = mine > 0u ? mine : 1u; nx = cnt > 0u ? cnt : 1u;
}

__device__ __forceinline__ void xcd_barrier(const XcdBarrier& b) {
    asm volatile("s_waitcnt vmcnt(0)" ::: "memory");
    __syncthreads();
    if (threadIdx.x == 0) {
        unsigned* bar = b.bar;
        __builtin_amdgcn_s_waitcnt(0);
        unsigned nloc = b.st[0], nx = b.st[1];
        if (nloc == 0u) { xcd_barrier_complete(bar, b.x, nloc, nx); b.st[0] = nloc; b.st[1] = nx; }
        const unsigned old = xb_add(&bar[XB_XSUB(b.x)], 1u);
        const unsigned gen = old / nloc;
        if (old + 1u == (gen + 1u) * nloc) {
            __builtin_amdgcn_fence(__ATOMIC_RELEASE, "agent");
            asm volatile("s_waitcnt vmcnt(0)" ::: "memory");
            const unsigned og = xb_add(&bar[XB_TOP], 1u);
            const unsigned tg = og / nx;
            if (og + 1u == (tg + 1u) * nx) xb_add(&bar[XB_TOPGEN], 1u);
            else XB_SPIN(xb_ld(&bar[XB_TOPGEN]) == tg, bar);
            __builtin_amdgcn_fence(__ATOMIC_ACQUIRE, "agent");
            xb_add(&bar[XB_XGEN(b.x)], 1u);
            asm volatile("s_waitcnt vmcnt(0)" ::: "memory");
        } else {
            XB_SPIN(xb_ld(&bar[XB_XGEN(b.x)]) == gen, bar);
            __builtin_amdgcn_fence(__ATOMIC_ACQUIRE, "agent");
            asm volatile("s_waitcnt vmcnt(0)" ::: "memory");
        }
    }
    __syncthreads();
}

#define FRESH_IDS int tid_ = threadIdx.x; asm volatile("" : "+v"(tid_)); const int tid = tid_, lane = tid & 63, wave = __builtin_amdgcn_readfirstlane(tid >> 6); (void)lane; (void)wave;

__device__ __forceinline__ float wave_sum(float v) {
#pragma unroll
    for (int o = 1; o < 64; o <<= 1) v += __shfl_xor(v, o);
    return v;
}
__device__ __forceinline__ void p0_transpose_item(const float* W, int K, int N, bf16* WT, int row_off, LAS float* scr, int item, int lane) {
    const int nblk = N / 32, kb = item / nblk, nb = item % nblk, k0 = 64 * kb, n0 = 32 * nb;
#pragma unroll
    for (int i = 0; i < 32; ++i) { const int kk = 2 * i + (lane >> 5); scr[kk * 33 + (lane & 31)] = W[(size_t)(k0 + kk) * N + n0 + (lane & 31)]; }
    LDS_WAIT(); asm volatile("" ::: "memory");
    const int c = lane & 7;
#pragma unroll
    for (int j = 0; j < 4; ++j) { const int n = (lane >> 3) + 8 * j; const LAS float* s = scr + (8 * c) * 33 + n;
        v4u o; o.x = pk2(s[0 * 33], s[1 * 33]); o.y = pk2(s[2 * 33], s[3 * 33]); o.z = pk2(s[4 * 33], s[5 * 33]); o.w = pk2(s[6 * 33], s[7 * 33]);
        *(GAS v4u*)(WT + (size_t)(row_off + n0 + n) * K + k0 + 8 * c) = o; }
    LDS_WAIT(); asm volatile("" ::: "memory");
}

#define GW_LOOP(var, n) for (int var = F.vcu * NWAVES + wave; var < (n); var += F.G * NWAVES)

__device__ __forceinline__ int win_row_off(int n0) {
    const int tile = n0 >> 8; const bool rope = tile < 2 || (tile >= 4 && tile < 12) || (tile >= 20 && tile < 28) || (tile >= 36 && tile < 44);
    if (!rope) return 0;
    const int w = n0 & 255, hsel = w >> 7, half = (w >> 6) & 1, i = w & 63;
    return (half * 128 + hsel * 64 + i) - w;
}
__device__ __forceinline__ void ph_prologue(Frame& F) {
    FRESH_IDS
    for (int ait = F.vcu; ait < 192; ait += F.G) {
        const int l = ait / 96, n0 = (ait % 96) * 64;
        LAS float* sv = (LAS float*)F.lds;
        LAS float* red = (LAS float*)(F.lds + 32768);
        for (int k = tid; k < DM; k += NWAVES * 64) { sv[k] = siluf(F.c[k]); sv[DM + k] = siluf(F.c[DM + k]); sv[2 * DM + k] = siluf(F.c_ctx[k]); }
        __syncthreads();
        const float* W = F.w_ada + (size_t)l * DM * 6144 + n0 + lane;
        float a0 = 0.f, a1 = 0.f, a2 = 0.f;
        const int kb = wave * 256;
#pragma unroll 32
        for (int k = 0; k < 256; ++k) { const float w = W[(size_t)(kb + k) * 6144]; a0 += sv[kb + k] * w; a1 += sv[DM + kb + k] * w; a2 += sv[2 * DM + kb + k] * w; }
        red[(wave * 3 + 0) * 64 + lane] = a0; red[(wave * 3 + 1) * 64 + lane] = a1; red[(wave * 3 + 2) * 64 + lane] = a2;
        __syncthreads();
        if (wave < 3) { float s = 0.f;
#pragma unroll
            for (int w = 0; w < 8; ++w) s += red[(w * 3 + wave) * 64 + lane];
            float* mod = (float*)(F.ws + WS_MOD);
            mod[(size_t)(l * 3 + wave) * 6144 + n0 + lane] = s + F.b_ada[(size_t)l * 6144 + n0 + lane]; }
        __syncthreads();
    }
    { float* ct = (float*)(F.ws + WS_COS); float* st = (float*)(F.ws + WS_SIN);
      for (int i = (F.vcu * NWAVES * 64) + tid; i < SEQ * 64; i += F.G * NWAVES * 64) {
          const int t = i >> 6, j = i & 63, f = j & 31; const float pos = (float)((j < 32) ? (t >> 6) : (t & 63));
          const float inv = expf(-(float)f * (9.210340371976184f / 32.f)); const float ang = pos * inv;
          ct[i] = cosf(ang); st[i] = sinf(ang); } }
    LAS float* scr = (LAS float*)(F.lds + wave * 16384);
    constexpr int I_IN = (DM / 64) * (INC / 32), I_P = (DM / 64) * (DM / 32);
    bf16* WinT = (bf16*)(F.ws + WS_WINT); bf16* WpT = (bf16*)(F.ws + WS_WPT);
    GW_LOOP(it, I_IN + 6 * I_P) {
        if (it < I_IN) { p0_transpose_item(F.w_in, DM, INC, WinT, win_row_off(32 * (it % (INC / 32))), scr, it, lane); continue; }
        const int r = it - I_IN, mi = r / I_P, ii = r % I_P, l = mi / 3, w = mi % 3;
        const float* W = (w == 0 ? F.w_pa : (w == 1 ? F.w_pb : F.w_out)) + (size_t)l * DM * DM;
        p0_transpose_item(W, DM, DM, WpT + (size_t)mi * DM * DM, 0, scr, ii, lane);
    }
}

__device__ __forceinline__ void ph_hnorm(Frame& F, int l, const float* xcur, const float* ctxcur) {
    FRESH_IDS
    bf16* H = (bf16*)(F.ws + WS_S0);
    const float* gp = F.g_pre + (size_t)l * DM;
    GW_LOOP(row, MROWS) {
        const int b = row / RPB, rr = row % RPB; const float* src; int v;
        if (rr < CTX) { src = ctxcur + (size_t)(b * CTX + rr) * DM; v = 2; } else { src = xcur + (size_t)(b * SEQ + rr - CTX) * DM; v = b; }
        const float* md = (const float*)(F.ws + WS_MOD) + (size_t)(l * 3 + v) * 6144;
        f32x4 xv[8]; float s = 0.f;
#pragma unroll
        for (int j = 0; j < 8; ++j) { xv[j] = ((const f32x4*)src)[lane + 64 * j]; s += (xv[j].x * xv[j].x + xv[j].y * xv[j].y) + (xv[j].z * xv[j].z + xv[j].w * xv[j].w); }
        const float rs = rsqrtf(wave_sum(s) * (1.f / DM) + EPS);
#pragma unroll
        for (int j = 0; j < 8; ++j) { const int q = lane + 64 * j;
            const f32x4 g = ((const f32x4*)gp)[q], sh = ((const f32x4*)md)[q], sc = ((const f32x4*)(md + DM))[q];
            const f32x4 y = (xv[j] * rs) * g * (sc + 1.f) + sh;
            v2u o; o.x = pk2(y.x, y.y); o.y = pk2(y.z, y.w);
            *(v2u*)(H + (size_t)row * DM + 4 * q) = o; }
    }
}

__device__ __forceinline__ void ph_rope(Frame& F) {
    FRESH_IDS
    bf16* PX = (bf16*)(F.ws + WS_PX);
    const float* ct = (const float*)(F.ws + WS_COS); const float* st = (const float*)(F.ws + WS_SIN);
    const unsigned total = (unsigned)NB * SEQ * 52 * 8;
    for (unsigned idx = (unsigned)(F.vcu * NWAVES * 64 + tid); idx < total; idx += (unsigned)(F.G * NWAVES * 64)) {
        const unsigned ch = idx & 7, hr = idx >> 3, hh = hr % 52, rowL = hr / 52, b = rowL / SEQ, t = rowL % SEQ;
        const int col = (hh < 4) ? (C_KA + hh * 128) : (hh < 20) ? (C_KB + (hh - 4) * 128) : (hh < 36) ? (C_QA + (hh - 20) * 128) : (C_QB + (hh - 36) * 128);
        bf16* p = PX + (size_t)(b * RPB + CTX + t) * INC + col + ch * 8;
        const v4u x1 = *(const v4u*)p, x2 = *(const v4u*)(p + 64);
        const f32x4 c0 = *(const f32x4*)(ct + t * 64 + ch * 8), c1 = *(const f32x4*)(ct + t * 64 + ch * 8 + 4);
        const f32x4 s0 = *(const f32x4*)(st + t * 64 + ch * 8), s1 = *(const f32x4*)(st + t * 64 + ch * 8 + 4);
        v4u y1, y2;
#define ROPE2(W, CA, SA, CB, SB) { const float a0 = bflo(x1.W), a1 = bfhi(x1.W), b0 = bflo(x2.W), b1 = bfhi(x2.W); \
            y1.W = pk2(a0 * CA - b0 * SA, a1 * CB - b1 * SB); y2.W = pk2(b0 * CA + a0 * SA, b1 * CB + a1 * SB); }
        ROPE2(x, c0.x, s0.x, c0.y, s0.y) ROPE2(y, c0.z, s0.z, c0.w, s0.w) ROPE2(z, c1.x, s1.x, c1.y, s1.y) ROPE2(w, c1.z, s1.z, c1.w, s1.w)
#undef ROPE2
        *(v4u*)p = y1; *(v4u*)(p + 64) = y2;
    }
}

__device__ __forceinline__ void ph_convert_win(Frame& F, int l) {
    FRESH_IDS
    LAS float* scr = (LAS float*)(F.lds + wave * 16384);
    constexpr int I_IN = (DM / 64) * (INC / 32);
    bf16* WinT = (bf16*)(F.ws + WS_WINT);
    GW_LOOP(it, I_IN) p0_transpose_item(F.w_in + (size_t)l * DM * INC, DM, INC, WinT, win_row_off(32 * (it % (INC / 32))), scr, it, lane);
}

__device__ __forceinline__ void ph_attn(Frame& F, int l, char* lds) {
    const att::bf16* PX = (const att::bf16*)(F.ws + WS_PX);
    att::bf16* OA = (att::bf16*)(F.ws + WS_S0);
    att::bf16* OB0 = (att::bf16*)(F.ws + WS_S0 + SLOT);
    const float NINF = -INFINITY;
    const int nB = 1024, nA = 1024, nC = (l == 0) ? 64 : 0;
    for (int u = F.vcu; u < nB + nA + nC; u += F.G) {
        if (u < nB) {
            const int hd = u >> 5, qb = u & 31, b = hd >> 4, h8 = (hd >> 1) & 7, m = hd & 1;
            const size_t qrow = (size_t)b * RPB + CTX + qb * 256, krow = (size_t)b * RPB;
            att::attn_body_v256(PX + qrow * INC + C_QB + (h8 * 2 + m) * 128, PX + krow * INC + C_KB + (h8 * 2 + m) * 128, PX + krow * INC + C_VB + h8 * 256,
                                OB0 + (size_t)m * (SLOT / 2) + qrow * DM + h8 * 256, RPB / 64, F.lds);
            __syncthreads();
        } else if (u < nB + nA) {
            const int v = u - nB, b = v >> 9, hq = (v >> 5) & 15, qb = v & 31, kvh = hq >> 2, q0 = qb * 256;
            const int lo = (q0 - 128 > 0) ? q0 - 128 : 0, he = (q0 + 384 < SEQ) ? q0 + 384 : SEQ, nloc = (he - lo) >> 6;
            const size_t qrow = (size_t)b * RPB + CTX + q0, krow = (size_t)b * RPB;
            const float sk = F.sink[l * 16 + hq] * 1.4426950408889634f;
            att::attn_body<true>(PX + qrow * INC + C_QA + hq * 128, PX + krow * INC + C_KA + kvh * 128, PX + krow * INC + C_VA + kvh * 128,
                                 OA + qrow * DM + hq * 128, 4 + nloc, 4, lo, q0, sk, lds);
        } else {
            const int v = u - nB - nA;
            if (v < 32) {
                const int hd = v, b = hd >> 4, h8 = (hd >> 1) & 7, m = hd & 1; const size_t krow = (size_t)b * RPB;
                att::attn_body_v256(PX + krow * INC + C_QB + (h8 * 2 + m) * 128, PX + krow * INC + C_KB + (h8 * 2 + m) * 128, PX + krow * INC + C_VB + h8 * 256,
                                    OB0 + (size_t)m * (SLOT / 2) + krow * DM + h8 * 256, 4, F.lds);
                __syncthreads();
            } else {
                const int w = v - 32, b = w >> 4, hq = w & 15, kvh = hq >> 2; const size_t krow = (size_t)b * RPB;
                const float sk = F.sink[l * 16 + hq] * 1.4426950408889634f;
                att::attn_body<false>(PX + krow * INC + C_QA + hq * 128, PX + krow * INC + C_KA + kvh * 128, PX + krow * INC + C_VA + kvh * 128,
                                      OA + krow * DM + hq * 128, 4, 4, 0, 0, sk, lds);
            }
        }
    }
}

__device__ __forceinline__ void ph_post(Frame& F, int l) {
    FRESH_IDS
    const bf16* PX = (const bf16*)(F.ws + WS_PX);
    const bf16* OA = (const bf16*)(F.ws + WS_S0); const bf16* OB0 = (const bf16*)(F.ws + WS_S0 + SLOT); const bf16* OB1 = (const bf16*)(F.ws + WS_S0 + 2 * SLOT);
    bf16* GA = (bf16*)(F.ws + WS_S0 + 3 * SLOT); bf16* GB = (bf16*)(F.ws + WS_S0 + 4 * SLOT);
    const float lam_init = 0.8f - 0.6f * expf(-0.3f * (float)l);
    const float* lq = F.lam_qk + (size_t)l * 512;
    const float d1 = wave_sum(lq[lane] * lq[128 + lane] + lq[64 + lane] * lq[192 + lane]);
    const float d2 = wave_sum(lq[256 + lane] * lq[384 + lane] + lq[320 + lane] * lq[448 + lane]);
    const float lam = expf(d1) - expf(d2) + lam_init;
    const f32x4 gs = ((const f32x4*)(F.g_subln + (size_t)l * 256))[lane] * (1.f - lam_init);
    GW_LOOP(row, MROWS) {
        if (l != 0 && (row % RPB) < CTX) continue;
        const size_t ro = (size_t)row * DM, rp = (size_t)row * INC;
#pragma unroll
        for (int j = 0; j < 8; ++j) { const int c = 4 * (lane + 64 * j);
            const v2u oa = *(const v2u*)(OA + ro + c), za = *(const v2u*)(PX + rp + C_ZA + c);
            v2u o; o.x = pk2(bflo(oa.x) * siluf(bflo(za.x)), bfhi(oa.x) * siluf(bfhi(za.x))); o.y = pk2(bflo(oa.y) * siluf(bflo(za.y)), bfhi(oa.y) * siluf(bfhi(za.y)));
            *(v2u*)(GA + ro + c) = o; }
#pragma unroll
        for (int j = 0; j < 8; ++j) { const int c = 256 * j + 4 * lane;
            const v2u o0 = *(const v2u*)(OB0 + ro + c), o1 = *(const v2u*)(OB1 + ro + c), zb = *(const v2u*)(PX + rp + C_ZB + c);
            f32x4 d; d.x = bflo(o0.x) - lam * bflo(o1.x); d.y = bfhi(o0.x) - lam * bfhi(o1.x); d.z = bflo(o0.y) - lam * bflo(o1.y); d.w = bfhi(o0.y) - lam * bfhi(o1.y);
            const float ss = wave_sum((d.x * d.x + d.y * d.y) + (d.z * d.z + d.w * d.w));
            const float rs = rsqrtf(ss * (1.f / 256.f) + EPS);
            const f32x4 y = d * rs * gs;
            v2u o; o.x = pk2(y.x * siluf(bflo(zb.x)), y.y * siluf(bfhi(zb.x))); o.y = pk2(y.z * siluf(bflo(zb.y)), y.w * siluf(bfhi(zb.y)));
            *(v2u*)(GB + ro + c) = o; }
    }
}

__device__ __forceinline__ void ph_merge(Frame& F, int l) {
    FRESH_IDS
    const bf16* PX = (const bf16*)(F.ws + WS_PX);
    const bf16* YA = (const bf16*)(F.ws + WS_S0); const bf16* YB = (const bf16*)(F.ws + WS_S0 + SLOT); bf16* MG = (bf16*)(F.ws + WS_S0 + 2 * SLOT);
    const unsigned total = (unsigned)MROWS * (DM / 8);
    for (unsigned i = (unsigned)(F.vcu * NWAVES * 64 + tid); i < total; i += (unsigned)(F.G * NWAVES * 64)) {
        const unsigned row = i >> 8, c = (i & 255) * 8;
        if (l != 0 && (row % RPB) < CTX) continue;
        const v4u ya = *(const v4u*)(YA + (size_t)row * DM + c), yb = *(const v4u*)(YB + (size_t)row * DM + c);
        const v4u ga = *(const v4u*)(PX + (size_t)row * INC + C_GA + c), gb = *(const v4u*)(PX + (size_t)row * INC + C_GB + c);
        v4u o;
#define MRG(W) o.W = pk2(sigmf(bflo(ga.W)) * bflo(ya.W) + sigmf(bflo(gb.W)) * bflo(yb.W), sigmf(bfhi(ga.W)) * bfhi(ya.W) + sigmf(bfhi(gb.W)) * bfhi(yb.W));
        MRG(x) MRG(y) MRG(z) MRG(w)
#undef MRG
        *(v4u*)(MG + (size_t)row * DM + c) = o;
    }
}

__device__ __forceinline__ void ph_res(Frame& F, int l, const float* xcur, const float* ctxcur) {
    FRESH_IDS
    const bf16* OX = (const bf16*)(F.ws + WS_S0 + 3 * SLOT);
    bf16* H = (bf16*)(F.ws + WS_S0);
    const float* gp = F.g_post + (size_t)l * DM;
    const bool nxt = (l + 1 < DEPTH);
    const float* gpn = F.g_pre + (size_t)(l + 1) * DM;
    GW_LOOP(row, MROWS) {
        const int b = row / RPB, rr = row % RPB; const float* src; float* dst; int v;
        if (rr < CTX) { if (!nxt) continue; src = ctxcur + (size_t)(b * CTX + rr) * DM; dst = nullptr; v = 2; }
        else { src = xcur + (size_t)(b * SEQ + rr - CTX) * DM; dst = F.out + (size_t)(b * SEQ + rr - CTX) * DM; v = b; }
        const float* gt = (const float*)(F.ws + WS_MOD) + (size_t)(l * 3 + v) * 6144 + 2 * DM;
        f32x4 ov[8]; float s = 0.f;
#pragma unroll
        for (int j = 0; j < 8; ++j) { const v2u w = *(const v2u*)(OX + (size_t)row * DM + 4 * (lane + 64 * j));
            ov[j] = (f32x4){bflo(w.x), bfhi(w.x), bflo(w.y), bfhi(w.y)}; s += (ov[j].x * ov[j].x + ov[j].y * ov[j].y) + (ov[j].z * ov[j].z + ov[j].w * ov[j].w); }
        const float rs = rsqrtf(wave_sum(s) * (1.f / DM) + EPS);
        float s2 = 0.f;
#pragma unroll
        for (int j = 0; j < 8; ++j) { const int q = lane + 64 * j;
            const f32x4 g = ((const f32x4*)gp)[q], gate = ((const f32x4*)gt)[q], xr = ((const f32x4*)src)[q];
            ov[j] = xr + gate * ((ov[j] * rs) * g);
            if (dst) ((f32x4*)dst)[q] = ov[j];
            s2 += (ov[j].x * ov[j].x + ov[j].y * ov[j].y) + (ov[j].z * ov[j].z + ov[j].w * ov[j].w); }
        if (nxt) {
            const float* md = (const float*)(F.ws + WS_MOD) + (size_t)((l + 1) * 3 + v) * 6144;
            const float rs2 = rsqrtf(wave_sum(s2) * (1.f / DM) + EPS);
#pragma unroll
            for (int j = 0; j < 8; ++j) { const int q = lane + 64 * j;
                const f32x4 g = ((const f32x4*)gpn)[q], sh = ((const f32x4*)md)[q], sc = ((const f32x4*)(md + DM))[q];
                const f32x4 y = (ov[j] * rs2) * g * (sc + 1.f) + sh;
                v2u o; o.x = pk2(y.x, y.y); o.y = pk2(y.z, y.w);
                *(v2u*)(H + (size_t)row * DM + 4 * q) = o; }
        }
    }
}

__device__ __forceinline__ void run_gemm_in(Frame& F, const bf16* A, const bf16* Bt, bf16* O) {
    pg8::Gemm g{A, Bt, MROWS, INC, DM}; pg8::RowSkipOrder S; S.init(INC, F.G, (int)blockIdx.x, false);
    pg8::EpiRope E{O, INC, (const float*)(F.ws + WS_COS), (const float*)(F.ws + WS_SIN)};
    pg8::gemm_phase<pg8::EpiRope, pg8::RowSkipOrder, true, true>(F.lds, g, S, E);
}
__device__ __forceinline__ void run_gemm_skip(Frame& F, const bf16* A, const bf16* Bt, bf16* O, bool skip) {
    pg8::Gemm g{A, Bt, MROWS, DM, DM}; pg8::RowSkipOrder S; S.init(DM, F.G, (int)blockIdx.x, skip);
    pg8::EpiBf16 E{O, DM};
    pg8::gemm_phase<pg8::EpiBf16, pg8::RowSkipOrder, true, true>(F.lds, g, S, E);
}
template <bool ADD>
__device__ __forceinline__ void run_gemm_gate(Frame& F, const bf16* A, const bf16* Bt, bf16* O, const bf16* T, const bf16* G, bool skip) {
    const int cid = ADD ? (int)((blockIdx.x + F.G / 2) % F.G) : (int)blockIdx.x;
    pg8::Gemm g{A, Bt, MROWS, DM, DM}; pg8::RowSkipOrder S; S.init(DM, F.G, cid, skip);
    pg8::EpiGate<ADD> E{O, T, G, DM, INC};
    pg8::gemm_phase<pg8::EpiGate<ADD>, pg8::RowSkipOrder, true, true>(F.lds, g, S, E);
}

struct Args { const float* in[15]; float* out; unsigned char* ws; };
__global__ void __launch_bounds__(NWAVES * 64, 2) fwd_mega(Args args) {
    extern __shared__ __attribute__((aligned(16))) unsigned char lds[];
    cg::grid_group grid = cg::this_grid();
    Frame F;
    F.lds = (LAS unsigned char*)lds;
    F.G = gridDim.x; { const int bx = blockIdx.x; F.vcu = (F.G % 8 == 0) ? (bx % 8) * (F.G / 8) + bx / 8 : bx; }
    F.x = args.in[0]; F.c = args.in[1]; F.ctx = args.in[2]; F.c_ctx = args.in[3]; F.w_ada = args.in[4]; F.b_ada = args.in[5]; F.g_pre = args.in[6]; F.g_post = args.in[7];
    F.w_in = args.in[8]; F.sink = args.in[9]; F.lam_qk = args.in[10]; F.g_subln = args.in[11]; F.w_pa = args.in[12]; F.w_pb = args.in[13]; F.w_out = args.in[14];
    F.out = args.out; F.ws = args.ws;
    volatile LAS unsigned* MISC = (volatile LAS unsigned*)(F.lds + 131072 + 320);
    if (threadIdx.x < 32) MISC[threadIdx.x] = 0u;
    __syncthreads();
    const XcdBarrier bar = xcd_barrier_post((unsigned*)(F.ws + WS_BAR), MISC + 8);
    bf16* WinT = (bf16*)(F.ws + WS_WINT); bf16* WpT = (bf16*)(F.ws + WS_WPT); bf16* PX = (bf16*)(F.ws + WS_PX);
    bf16* S0 = (bf16*)(F.ws + WS_S0); bf16* S1 = (bf16*)(F.ws + WS_S0 + SLOT); bf16* S2 = (bf16*)(F.ws + WS_S0 + 2 * SLOT); bf16* S3 = (bf16*)(F.ws + WS_S0 + 3 * SLOT); bf16* S4 = (bf16*)(F.ws + WS_S0 + 4 * SLOT);

    ph_prologue(F);
    grid.sync();
#pragma unroll 1
    for (int l = 0; l < DEPTH; ++l) {
        const float* xcur = (l == 0) ? F.x : F.out;
        const float* ctxcur = (l == 0) ? F.ctx : (const float*)(F.ws + WS_CTX1);
        if (l == 0) { ph_hnorm(F, l, xcur, ctxcur); xcd_barrier(bar); }
        run_gemm_in(F, S0, WinT, PX);
        xcd_barrier(bar);
        ph_attn(F, l, (char*)lds);
        xcd_barrier(bar);
        ph_post(F, l);
        if (l + 1 < DEPTH) ph_convert_win(F, l + 1);
        xcd_barrier(bar);
        run_gemm_gate<false>(F, S3, WpT + (size_t)(l * 3 + 0) * DM * DM, S0, S0, PX + C_GA, l != 0);
        xcd_barrier(bar);
        run_gemm_gate<true>(F, S4, WpT + (size_t)(l * 3 + 1) * DM * DM, S2, S0, PX + C_GB, l != 0);
        xcd_barrier(bar);
        run_gemm_skip(F, S2, WpT + (size_t)(l * 3 + 2) * DM * DM, S3, l != 0);
        xcd_barrier(bar);
        ph_res(F, l, xcur, ctxcur);
        if (l + 1 < DEPTH) xcd_barrier(bar);
    }
}

extern "C" void kernel_launch(void* const* d_in, const int* in_sizes, int n_in, void* d_out, int out_size, void* d_ws, size_t ws_size, hipStream_t stream) {
    static int grid = 0;
    if (grid == 0) {
        if (n_in != 15 || out_size != NB * SEQ * DM || ws_size < WS_END) { fprintf(stderr, "kernel_launch: unexpected shapes: n_in %d out %d ws %zu (need %zu)\n", n_in, out_size, ws_size, (size_t)WS_END); grid = -1; return; }
        int dev = 0, cus = 0, per_cu = 0;
        if (hipGetDevice(&dev) != hipSuccess || hipDeviceGetAttribute(&cus, hipDeviceAttributeMultiprocessorCount, dev) != hipSuccess) { grid = -1; return; }
        if (hipFuncSetAttribute((const void*)fwd_mega, hipFuncAttributeMaxDynamicSharedMemorySize, LDS_BYTES) != hipSuccess) { fprintf(stderr, "kernel_launch: hipFuncSetAttribute failed\n"); grid = -1; return; }
        if (hipOccupancyMaxActiveBlocksPerMultiprocessor(&per_cu, (const void*)fwd_mega, NWAVES * 64, LDS_BYTES) != hipSuccess || per_cu < 1) { fprintf(stderr, "kernel_launch: occupancy query says %d\n", per_cu); per_cu = 1; }
        (void)hipGetLastError();
        grid = cus * per_cu;
    }
    if (grid < 0) return;
    if (hipMemsetAsync((char*)d_ws + WS_BAR, 0, WS_BAR_BYTES, stream) != hipSuccess) { fprintf(stderr, "kernel_launch: memset of the barrier words failed\n"); return; }
    Args a{};
    for (int i = 0; i < 15; ++i) a.in[i] = (const float*)d_in[i];
    a.out = (float*)d_out; a.ws = (unsigned char*)d_ws;
    void* kargs[] = {&a};
    hipError_t e = hipLaunchCooperativeKernel((const void*)fwd_mega, dim3(grid), dim3(NWAVES * 64), kargs, LDS_BYTES, stream);
    if (e != hipSuccess) fprintf(stderr, "kernel_launch: cooperative launch failed: %s (grid %d)\n", hipGetErrorString(e), grid);
}
```

```cpp
#include <hip/hip_runtime.h>
#include <hip/hip_bf16.h>
#include <hip/hip_cooperative_groups.h>
#include <cstdio>
#include <cstdint>
#include <cmath>
namespace cg = cooperative_groups;

constexpr int DM = 2048, NB = 2, SEQ = 8192, DEPTH = 2, CTX = 256;
constexpr int RPB = CTX + SEQ;
constexpr int MROWS = NB * RPB;
constexpr int INC = 17408;
constexpr int C_KA = 0, C_VA = 512, C_KB = 1024, C_VB = 3072, C_QA = 5120, C_ZA = 7168, C_QB = 9216, C_ZB = 11264, C_GA = 13312, C_GB = 15360;
constexpr float EPS = 1e-6f;

namespace pg8 {
#define PG8_LAS __attribute__((address_space(3)))
typedef unsigned short bf16_t;
typedef short bf16x8 __attribute__((ext_vector_type(8)));
typedef float f32x4 __attribute__((ext_vector_type(4)));
typedef unsigned u32x4 __attribute__((ext_vector_type(4)));
constexpr int BM = 256, BK = 64, HALF = 128, HTB = HALF * BK * 2  , STAGE_BYTES = 8 * HTB, NXCD = 8, WGM = 8;

__host__ __device__ __forceinline__ int lds_byte(int r, int c) { const int st = (r >> 4) * 2 + (c >> 5), rr = r & 15, cc = c & 31, ob = rr * 64 + cc * 2; return st * 1024 + (ob ^ (((ob >> 9) & 1) << 5)); }
__host__ __device__ __forceinline__ void stage_rc(int b, int& R, int& C) { const int st = b / 1024, sb = b % 1024, swz = sb ^ (((sb >> 9) & 1) << 5); R = (st >> 1) * 16 + swz / 64; C = (st & 1) * 32 + (swz % 64) / 2; }
__host__ __device__ __forceinline__ int perm32(int rho) { const int n = rho >> 4, i = rho & 15; return 8 * (i >> 2) + 4 * n + (i & 3); }

struct Unit { int pm, pn; };
struct Gemm { const bf16_t* A; const bf16_t* Bt; int M, N, K; };

struct StaticOrder {
    int nM, nN, nwg, G, c;
    __host__ __device__ void init(int M, int N, int G_, int c_) { nM = M / BM; nN = N / BM; nwg = nM * nN; G = G_; c = c_; }
    __host__ __device__ bool next(int i, Unit& u) const {
        const long L = (long)i * G + c; if (L >= nwg) return false;
        int wgid = (int)L; { const int q = nwg / NXCD, r = nwg % NXCD, xcd = wgid % NXCD, off = wgid / NXCD; wgid = (xcd < r ? xcd * (q + 1) : r * (q + 1) + (xcd - r) * q) + off; }
        const int nig = WGM * nN, gid = wgid / nig, fm = gid * WGM, gsz = (nM - fm) < WGM ? (nM - fm) : WGM;
        u.pm = fm + ((wgid % nig) % gsz); u.pn = (wgid % nig) / gsz; return true;
    }
    __device__ __forceinline__ void a_ready(const Unit&) const {}
    __device__ __forceinline__ void done(const Unit&) const {}
};

__device__ __forceinline__ unsigned cvt_pk_bf16(float lo, float hi) { unsigned r; asm volatile("v_cvt_pk_bf16_f32 %0, %1, %2" : "=v"(r) : "v"(lo), "v"(hi)); return r; }
typedef float f32x2 __attribute__((ext_vector_type(2)));

struct EpiBf16 {
    static constexpr bool PERM = true, AFTER_DRAIN = false;
    bf16_t* O; int ldc;
    __device__ __forceinline__ void operator()(const f32x4 (&acc)[2][2][4][2], const Unit& u, int wr, int wc, int fr, int fq) const {
        const int row0 = u.pm * BM + wr * 64 + fr; const int col0 = u.pn * BM + wc * 32 + 8 * fq;
#pragma unroll
        for (int ai = 0; ai < 2; ++ai)
#pragma unroll
            for (int m = 0; m < 4; ++m) { bf16_t* rowp = O + (size_t)(row0 + ai * HALF + m * 16) * ldc + col0;
#pragma unroll
                for (int bj = 0; bj < 2; ++bj) { const f32x4 v0 = acc[ai][bj][m][0], v1 = acc[ai][bj][m][1];
                    u32x4 w; w.x = cvt_pk_bf16(v0[0], v0[1]); w.y = cvt_pk_bf16(v0[2], v0[3]); w.z = cvt_pk_bf16(v1[0], v1[1]); w.w = cvt_pk_bf16(v1[2], v1[3]);
                    *(u32x4*)(rowp + bj * HALF) = w; } }
    }
};

__device__ __forceinline__ float sigm_(float x) { return 1.f / (1.f + __expf(-x)); }
__device__ __forceinline__ float blo_(unsigned w) { return __builtin_bit_cast(float, w << 16); }
__device__ __forceinline__ float bhi_(unsigned w) { return __builtin_bit_cast(float, w & 0xffff0000u); }
template <bool ADD> struct EpiGate {
    static constexpr bool PERM = true, AFTER_DRAIN = false;
    bf16_t* O; const bf16_t* T; const bf16_t* G; int ldc; int ldg;
    __device__ __forceinline__ void operator()(const f32x4 (&acc)[2][2][4][2], const Unit& u, int wr, int wc, int fr, int fq) const {
        const int row0 = u.pm * BM + wr * 64 + fr; const int col0 = u.pn * BM + wc * 32 + 8 * fq;
#pragma unroll
        for (int ai = 0; ai < 2; ++ai)
#pragma unroll
            for (int m = 0; m < 4; ++m) { const size_t row = (size_t)(row0 + ai * HALF + m * 16);
#pragma unroll
                for (int bj = 0; bj < 2; ++bj) { const f32x4 v0 = acc[ai][bj][m][0], v1 = acc[ai][bj][m][1];
                    const u32x4 g = *(const u32x4*)(G + row * ldg + col0 + bj * HALF);
                    float r0 = sigm_(blo_(g.x)) * v0[0], r1 = sigm_(bhi_(g.x)) * v0[1], r2 = sigm_(blo_(g.y)) * v0[2], r3 = sigm_(bhi_(g.y)) * v0[3];
                    float r4 = sigm_(blo_(g.z)) * v1[0], r5 = sigm_(bhi_(g.z)) * v1[1], r6 = sigm_(blo_(g.w)) * v1[2], r7 = sigm_(bhi_(g.w)) * v1[3];
                    if (ADD) { const u32x4 t = *(const u32x4*)(T + row * ldc + col0 + bj * HALF);
                        r0 += blo_(t.x); r1 += bhi_(t.x); r2 += blo_(t.y); r3 += bhi_(t.y); r4 += blo_(t.z); r5 += bhi_(t.z); r6 += blo_(t.w); r7 += bhi_(t.w); }
                    u32x4 w; w.x = cvt_pk_bf16(r0, r1); w.y = cvt_pk_bf16(r2, r3); w.z = cvt_pk_bf16(r4, r5); w.w = cvt_pk_bf16(r6, r7);
                    *(u32x4*)(O + row * ldc + col0 + bj * HALF) = w; } }
    }
};
struct RowSkipOrder {
    StaticOrder base; bool skip;
    __device__ void init(int N, int G_, int c_, bool skip_) { skip = skip_; base.init(skip_ ? 16384 : 16896, N, G_, c_); }
    __device__ bool next(int i, Unit& u) const { if (!base.next(i, u)) return false; if (skip) u.pm += 1 + (u.pm >= 32 ? 1 : 0); return true; }
    __device__ __forceinline__ void a_ready(const Unit&) const {}
    __device__ __forceinline__ void done(const Unit&) const {}
};

struct EpiRope {
    static constexpr bool PERM = true, AFTER_DRAIN = false;
    bf16_t* O; int ldc; const float* ct; const float* st;
    __device__ __forceinline__ void operator()(const f32x4 (&acc)[2][2][4][2], const Unit& u, int wr, int wc, int fr, int fq) const {
        const int pn = u.pn; const bool rope = pn < 2 || (pn >= 4 && pn < 12) || (pn >= 20 && pn < 28) || (pn >= 36 && pn < 44);
        const int row0 = u.pm * BM + wr * 64 + fr;
        if (!rope) {
            const int col0 = pn * BM + wc * 32 + 8 * fq;
#pragma unroll
            for (int ai = 0; ai < 2; ++ai)
#pragma unroll
                for (int m = 0; m < 4; ++m) { bf16_t* rowp = O + (size_t)(row0 + ai * HALF + m * 16) * ldc + col0;
#pragma unroll
                    for (int bj = 0; bj < 2; ++bj) { const f32x4 v0 = acc[ai][bj][m][0], v1 = acc[ai][bj][m][1];
                        u32x4 w; w.x = cvt_pk_bf16(v0[0], v0[1]); w.y = cvt_pk_bf16(v0[2], v0[3]); w.z = cvt_pk_bf16(v1[0], v1[1]); w.w = cvt_pk_bf16(v1[2], v1[3]);
                        *(u32x4*)(rowp + bj * HALF) = w; } }
            return;
        }
        const bool isctx = (u.pm == 0) || (u.pm == 33);
        const int i0 = 32 * (wc & 1) + 8 * fq, ocol = pn * BM + (wc >> 1) * 128 + i0;
        const int tbase = row0 - (u.pm >= 33 ? 8448 : 0) - 256;
#pragma unroll
        for (int ai = 0; ai < 2; ++ai)
#pragma unroll
            for (int m = 0; m < 4; ++m) { const int t = tbase + ai * HALF + m * 16;
                f32x4 c0 = {1.f, 1.f, 1.f, 1.f}, c1 = c0, s0 = {0.f, 0.f, 0.f, 0.f}, s1 = s0;
                if (!isctx) { const float* cp = ct + (size_t)t * 64 + i0; const float* sp = st + (size_t)t * 64 + i0;
                    c0 = *(const f32x4*)cp; c1 = *(const f32x4*)(cp + 4); s0 = *(const f32x4*)sp; s1 = *(const f32x4*)(sp + 4); }
                const f32x4 a0 = acc[ai][0][m][0], a1 = acc[ai][0][m][1], b0 = acc[ai][1][m][0], b1 = acc[ai][1][m][1];
                const f32x4 y0 = a0 * c0 - b0 * s0, y1 = a1 * c1 - b1 * s1, z0 = b0 * c0 + a0 * s0, z1 = b1 * c1 + a1 * s1;
                bf16_t* rowp = O + (size_t)(row0 + ai * HALF + m * 16) * ldc + ocol;
                u32x4 w; w.x = cvt_pk_bf16(y0[0], y0[1]); w.y = cvt_pk_bf16(y0[2], y0[3]); w.z = cvt_pk_bf16(y1[0], y1[1]); w.w = cvt_pk_bf16(y1[2], y1[3]);
                *(u32x4*)rowp = w;
                u32x4 x; x.x = cvt_pk_bf16(z0[0], z0[1]); x.y = cvt_pk_bf16(z0[2], z0[3]); x.z = cvt_pk_bf16(z1[0], z1[1]); x.w = cvt_pk_bf16(z1[2], z1[3]);
                *(u32x4*)(rowp + 64) = x; }
    }
};

template <class Epi, class Sched, bool ALIGN_EPI = false, bool SP2 = false>
__device__ __forceinline__ void gemm_phase(PG8_LAS unsigned char* lds, const Gemm g, const Sched& S, const Epi& E) {
    int tid_ = threadIdx.x; asm volatile("" : "+v"(tid_));
    const int tid = tid_, wid = __builtin_amdgcn_readfirstlane(tid >> 6), lane = tid & 63, wr = wid >> 2, wc = wid & 3, fr = lane & 15, fq = lane >> 4;
    const int K = g.K, nt = K / BK;
    unsigned voffA[2], voffB[2];
#pragma unroll
    for (int i = 0; i < 2; ++i) { int R, C; stage_rc(tid * 16 + i * 8192, R, C); const int Rb = Epi::PERM ? ((R & ~31) + perm32(R & 31)) : R;
        voffA[i] = (unsigned)(R * K + C) * 2u; voffB[i] = (unsigned)(Rb * K + C) * 2u; }
    const size_t kstep = (size_t)(BK * 2);
    const size_t hstep = (size_t)HALF * K * 2;
    const size_t tstep = 2 * hstep;
    const unsigned ldsw = (unsigned)wid * 1024u;
    const int aoff = lds_byte(wr * 64 + fr, fq * 8), boff = lds_byte(wc * 32 + fr, fq * 8);
#define PG8_SA(b, h) (((b) * 2 + (h)) * HTB)
#define PG8_SB(b, h) ((4 + (b) * 2 + (h)) * HTB)
#define PG8_STAGE(bufoff, gbase, voff) do { _Pragma("unroll") for (int _i = 0; _i < 2; ++_i) \
        __builtin_amdgcn_global_load_lds((const unsigned*)((const char*)(gbase) + (voff)[_i]), (PG8_LAS unsigned*)(lds + (bufoff) + ldsw + _i * 8192), 16, 0, 0); } while (0)
#define PG8_LDA(dst, b, h) do { _Pragma("unroll") for (int m = 0; m < 4; ++m) _Pragma("unroll") for (int k = 0; k < 2; ++k) dst[m][k] = *(const PG8_LAS bf16x8*)(lds + PG8_SA(b, h) + aoff + m * 2048 + k * 1024); } while (0)
#define PG8_LDB(dst, b, h) do { _Pragma("unroll") for (int n = 0; n < 2; ++n) _Pragma("unroll") for (int k = 0; k < 2; ++k) dst[n][k] = *(const PG8_LAS bf16x8*)(lds + PG8_SB(b, h) + boff + n * 2048 + k * 1024); } while (0)
#define PG8_MMA(ai, bj, At, Bt) do { __builtin_amdgcn_s_setprio(1); _Pragma("unroll") for (int m = 0; m < 4; ++m) _Pragma("unroll") for (int n = 0; n < 2; ++n) _Pragma("unroll") for (int k = 0; k < 2; ++k) \
        acc[ai][bj][m][n] = __builtin_amdgcn_mfma_f32_16x16x32_bf16(Bt[n][k], At[m][k], acc[ai][bj][m][n], 0, 0, 0); __builtin_amdgcn_s_setprio(0); } while (0)
#define PG8_WAIT_V(n) asm volatile("s_waitcnt vmcnt(" #n ")" ::: "memory")
#define PG8_WAIT_L(n) asm volatile("s_waitcnt lgkmcnt(" #n ")" ::: "memory")
#define PG8_BAR __builtin_amdgcn_s_barrier()
#define PG8_SCHED __builtin_amdgcn_sched_barrier(0)
    Unit cur, nxt; int ui = 0;
    if (!S.next(0, cur)) return;
    f32x4 acc[2][2][4][2];
#pragma unroll
    for (int a = 0; a < 2; ++a)
#pragma unroll
        for (int b = 0; b < 2; ++b)
#pragma unroll
            for (int m = 0; m < 4; ++m)
#pragma unroll
                for (int n = 0; n < 2; ++n) acc[a][b][m][n] = (f32x4){0.f, 0.f, 0.f, 0.f};
    bf16x8 At[4][2], B0[2][2], B1[2][2];
    const char* cA = (const char*)g.A + (size_t)cur.pm * tstep; const char* cB = (const char*)g.Bt + (size_t)cur.pn * tstep;
    S.a_ready(cur);
    if constexpr (SP2) {
        PG8_STAGE(PG8_SB(0, 0), cB, voffB); PG8_STAGE(PG8_SB(0, 1), cB + hstep, voffB); PG8_STAGE(PG8_SA(0, 0), cA, voffA); PG8_STAGE(PG8_SA(0, 1), cA + hstep, voffA);
        if (wr == 1) PG8_BAR;
        PG8_WAIT_V(2); PG8_BAR;
        PG8_STAGE(PG8_SB(1, 0), cB + kstep, voffB); PG8_STAGE(PG8_SA(1, 0), cA + kstep, voffA); PG8_STAGE(PG8_SB(1, 1), cB + hstep + kstep, voffB);
        PG8_WAIT_V(6); PG8_BAR;
    } else {
        PG8_STAGE(PG8_SB(0, 0), cB, voffB); PG8_STAGE(PG8_SA(0, 0), cA, voffA); PG8_STAGE(PG8_SB(0, 1), cB + hstep, voffB); PG8_STAGE(PG8_SA(0, 1), cA + hstep, voffA);
        if (wr == 1) PG8_BAR;
        PG8_WAIT_V(4); PG8_BAR;
        PG8_STAGE(PG8_SB(1, 0), cB + kstep, voffB); PG8_STAGE(PG8_SA(1, 0), cA + kstep, voffA); PG8_STAGE(PG8_SB(1, 1), cB + hstep + kstep, voffB);
        PG8_WAIT_V(6); PG8_BAR;
    }
    for (;;) {
        const bool has_next = S.next(ui + 1, nxt);
        const char* nA = has_next ? (const char*)g.A + (size_t)nxt.pm * tstep : cA; const char* nB = has_next ? (const char*)g.Bt + (size_t)nxt.pn * tstep : cB;
        for (int t = 0; t < nt; t += 2) {
            const bool last = (t == nt - 2);
            const char* a1 = cA + (size_t)(t + 1) * kstep;
            const char* a2 = last ? nA : cA + (size_t)(t + 2) * kstep; const char* b2 = last ? nB : cB + (size_t)(t + 2) * kstep;
            const char* a3 = a2 + kstep; const char* b3 = b2 + kstep;
            if (last && has_next) S.a_ready(nxt);
            if constexpr (SP2) {
            PG8_LDB(B0, 0, 0); PG8_LDB(B1, 0, 1); PG8_SCHED; PG8_LDA(At, 0, 0); PG8_STAGE(PG8_SA(1, 1), a1 + hstep, voffA);
            PG8_WAIT_V(8); PG8_WAIT_L(0); PG8_BAR; PG8_MMA(0, 0, At, B0); PG8_MMA(0, 1, At, B1); PG8_BAR; PG8_SCHED;
            PG8_LDA(At, 0, 1); PG8_STAGE(PG8_SB(0, 0), b2, voffB); PG8_STAGE(PG8_SB(0, 1), b2 + hstep, voffB); PG8_STAGE(PG8_SA(0, 0), a2, voffA);
            PG8_WAIT_V(8); PG8_WAIT_L(0); PG8_BAR; PG8_MMA(1, 0, At, B0); PG8_MMA(1, 1, At, B1); PG8_BAR; PG8_SCHED;
            PG8_LDB(B0, 1, 0); PG8_LDB(B1, 1, 1); PG8_SCHED; PG8_LDA(At, 1, 0); PG8_STAGE(PG8_SA(0, 1), a2 + hstep, voffA);
            PG8_WAIT_V(8); PG8_WAIT_L(0); PG8_BAR; PG8_MMA(0, 0, At, B0); PG8_MMA(0, 1, At, B1); PG8_BAR; PG8_SCHED;
            PG8_LDA(At, 1, 1); PG8_STAGE(PG8_SB(1, 0), b3, voffB); PG8_STAGE(PG8_SB(1, 1), b3 + hstep, voffB); PG8_STAGE(PG8_SA(1, 0), a3, voffA);
            PG8_WAIT_V(8); PG8_WAIT_L(0); PG8_BAR; PG8_MMA(1, 0, At, B0); PG8_MMA(1, 1, At, B1); PG8_BAR; PG8_SCHED;
            } else {
            PG8_LDB(B0, 0, 0); PG8_SCHED; PG8_LDA(At, 0, 0); PG8_STAGE(PG8_SA(1, 1), a1 + hstep, voffA);
            PG8_WAIT_L(8); PG8_BAR; PG8_WAIT_L(0); PG8_MMA(0, 0, At, B0); PG8_BAR; PG8_SCHED;
            PG8_LDB(B1, 0, 1); PG8_STAGE(PG8_SB(0, 0), b2, voffB);
            PG8_BAR; PG8_WAIT_L(0); PG8_MMA(0, 1, At, B1); PG8_BAR;
            PG8_LDA(At, 0, 1); PG8_STAGE(PG8_SA(0, 0), a2, voffA);
            PG8_BAR; PG8_WAIT_L(0); PG8_MMA(1, 0, At, B0); PG8_BAR; PG8_SCHED;
            PG8_STAGE(PG8_SB(0, 1), b2 + hstep, voffB);
            PG8_WAIT_V(6); PG8_BAR; PG8_MMA(1, 1, At, B1); PG8_BAR;
            PG8_LDB(B0, 1, 0); PG8_SCHED; PG8_LDA(At, 1, 0); PG8_STAGE(PG8_SA(0, 1), a2 + hstep, voffA);
            PG8_WAIT_L(8); PG8_BAR; PG8_WAIT_L(0); PG8_MMA(0, 0, At, B0); PG8_BAR; PG8_SCHED;
            PG8_LDB(B1, 1, 1); PG8_STAGE(PG8_SB(1, 0), b3, voffB);
            PG8_BAR; PG8_WAIT_L(0); PG8_MMA(0, 1, At, B1); PG8_BAR;
            PG8_LDA(At, 1, 1); PG8_STAGE(PG8_SA(1, 0), a3, voffA);
            PG8_BAR; PG8_WAIT_L(0); PG8_MMA(1, 0, At, B0); PG8_BAR; PG8_SCHED;
            PG8_STAGE(PG8_SB(1, 1), b3 + hstep, voffB);
            PG8_WAIT_V(6); PG8_BAR; PG8_MMA(1, 1, At, B1); PG8_BAR;
            }
        }
        if constexpr (ALIGN_EPI) { if (wr == 0) PG8_BAR; }
        if constexpr (!Epi::AFTER_DRAIN) { E(acc, cur, wr, wc, fr, fq); S.done(cur); }
        if (!has_next) break;
#pragma unroll
        for (int a = 0; a < 2; ++a)
#pragma unroll
            for (int b = 0; b < 2; ++b)
#pragma unroll
                for (int m = 0; m < 4; ++m)
#pragma unroll
                    for (int n = 0; n < 2; ++n) acc[a][b][m][n] = (f32x4){0.f, 0.f, 0.f, 0.f};
        cur = nxt; cA = nA; cB = nB; ++ui;
        if constexpr (ALIGN_EPI) { if (wr == 1) PG8_BAR; }
    }
    PG8_WAIT_V(0);
    if constexpr (!ALIGN_EPI) { if (wr == 0) PG8_BAR; }
    PG8_BAR;
    if constexpr (Epi::AFTER_DRAIN) { E.fused(acc, cur, wr, wc, fr, fq, lds, wid, lane); S.done(cur); }
#undef PG8_SA
#undef PG8_SB
#undef PG8_STAGE
#undef PG8_LDA
#undef PG8_LDB
#undef PG8_MMA
#undef PG8_WAIT_V
#undef PG8_WAIT_L
#undef PG8_BAR
#undef PG8_SCHED
}
}

namespace att {
using bf16 = unsigned short;
constexpr int D = 128, NW = 8, QBLK = 32, KVBLK = 64;
constexpr float SCALE = 0.088388347648318440f;
constexpr float THR = 8.f;
constexpr int SDEPTH = 2;
constexpr int LDQ = INC, LDK = INC, LDO = DM;
constexpr size_t SHM_V = KVBLK * D * 2, SHM_K = KVBLK * D * 2, SHM_ATTN = 2 * SHM_V + 2 * SHM_K + NW * 64 * 4;

using bf16x8 = __attribute__((ext_vector_type(8))) short;
using s16x4  = __attribute__((ext_vector_type(4))) short;
using f32x16 = __attribute__((ext_vector_type(16))) float;
using f32x8  = __attribute__((ext_vector_type(8))) float;
using u32x4  = __attribute__((ext_vector_type(4))) unsigned;
#define KSWZ(row, colB) ((row) * 256 + ((colB) ^ (((row) & 7) << 4)))
#define SBAR() __builtin_amdgcn_sched_barrier(0)
__device__ __forceinline__ int crow(int r, int hi) { return (r & 3) + 8 * (r >> 2) + 4 * hi; }
__device__ __forceinline__ unsigned cvtpk(float lo, float hi) {
  unsigned r; asm volatile("v_cvt_pk_bf16_f32 %0, %1, %2" : "=v"(r) : "v"(lo), "v"(hi)); return r;
}
template <typename TIn> struct Stage;
template <> struct Stage<bf16>  { using T = bf16x8;
  __device__ static __forceinline__ T ld8(const bf16* p) { return *reinterpret_cast<const bf16x8*>(p); }
  __device__ static __forceinline__ bf16x8 tobf(T x) { return x; } };
template <> struct Stage<float> { using T = f32x8;
  __device__ static __forceinline__ T ld8(const float* p) { return *reinterpret_cast<const f32x8*>(p); }
  __device__ static __forceinline__ bf16x8 tobf(T x) {
    u32x4 w = {cvtpk(x[0], x[1]), cvtpk(x[2], x[3]), cvtpk(x[4], x[5]), cvtpk(x[6], x[7])}; return *reinterpret_cast<bf16x8*>(&w); } };

__device__ __forceinline__ void partialSM(f32x16& p0, f32x16& p1, float& m_reg, float& mn, float& alpha) {
  constexpr float C = SCALE * 1.4426950408889634f;
  float pmax = p0[0]; for (int r = 1; r < 16; ++r) pmax = fmaxf(pmax, p0[r]); for (int r = 0; r < 16; ++r) pmax = fmaxf(pmax, p1[r]);
  { auto rr = __builtin_amdgcn_permlane32_swap(__float_as_uint(pmax), __float_as_uint(pmax), false, false);
    pmax = fmaxf(__uint_as_float(rr[0]), __uint_as_float(rr[1])); }
  if (__builtin_expect(__all(pmax - m_reg <= THR / SCALE), 1)) { mn = m_reg; alpha = 1.f; }
  else { mn = fmaxf(m_reg, pmax); alpha = __builtin_amdgcn_exp2f((m_reg - mn) * C); m_reg = mn; }
  float mnC = -mn * C;
  for (int r = 0; r < 16; ++r) p0[r] = fmaf(p0[r], C, mnC); for (int r = 0; r < 16; ++r) p1[r] = fmaf(p1[r], C, mnC);
  for (int r = 0; r < 16; ++r) p0[r] = __builtin_amdgcn_exp2f(p0[r]);
}
__device__ __forceinline__ void finishSM(f32x16& p0, f32x16& p1, float alpha, float& l_reg, bf16x8& pa0, bf16x8& pa1, bf16x8& pa2, bf16x8& pa3) {
  for (int r = 0; r < 16; ++r) p1[r] = __builtin_amdgcn_exp2f(p1[r]);
  float ps = 0; for (int r = 0; r < 16; ++r) ps += p0[r]; for (int r = 0; r < 16; ++r) ps += p1[r];
  { auto rr = __builtin_amdgcn_permlane32_swap(__float_as_uint(ps), __float_as_uint(ps), false, false);
    ps = __uint_as_float(rr[0]) + __uint_as_float(rr[1]); }
  l_reg = l_reg * alpha + ps;
#define PK4(P, BASE, OUT) do { unsigned a0 = cvtpk(P[BASE + 0], P[BASE + 1]), a1 = cvtpk(P[BASE + 2], P[BASE + 3]);   \
    unsigned b0 = cvtpk(P[BASE + 4], P[BASE + 5]), b1 = cvtpk(P[BASE + 6], P[BASE + 7]);                              \
    auto r0 = __builtin_amdgcn_permlane32_swap(a0, b0, false, false); auto r1 = __builtin_amdgcn_permlane32_swap(a1, b1, false, false); \
    u32x4 w = {r0[0], r1[0], r0[1], r1[1]}; OUT = *reinterpret_cast<bf16x8*>(&w); } while (0)
  PK4(p0, 0, pa0); PK4(p0, 8, pa1); PK4(p1, 0, pa2); PK4(p1, 8, pa3);
#undef PK4
}
__device__ __forceinline__ void qkt(f32x16& p0, f32x16& p1, const bf16* Ks, const bf16x8* qr, int r32, int hi) {
  p0 = f32x16{}; p1 = f32x16{};
  for (int d0 = 0; d0 < 8; ++d0) { int cb = (d0 * 16 + hi * 8) * 2;
    bf16x8 b0 = *reinterpret_cast<const bf16x8*>((const char*)Ks + KSWZ(r32, cb));
    bf16x8 b1 = *reinterpret_cast<const bf16x8*>((const char*)Ks + KSWZ(32 + r32, cb));
    p0 = __builtin_amdgcn_mfma_f32_32x32x16_bf16(b0, qr[d0], p0, 0, 0, 0);
    p1 = __builtin_amdgcn_mfma_f32_32x32x16_bf16(b1, qr[d0], p1, 0, 0, 0); }
}
__device__ __forceinline__ int v_st(int k, int c) { const int kk = (k & ~0xC) | ((k & 4) << 1) | ((k & 8) >> 1); return ((kk >> 3) * 4 + (c >> 5)) * 512 + ((kk & 7) * 32 + (c & 31)) * 2; }
__device__ __forceinline__ int v_rd_base(int lane) { return ((lane & 3) << 3) | (((lane >> 2) & 3) << 6) | (((lane >> 4) & 1) << 5) | (((lane >> 5) & 1) << 8); }
constexpr int v_rd_off(int d0, int ks, int half) { return d0 * 512 + ks * 4096 + half * 2048; }
template <int OFF> __device__ __forceinline__ s16x4 tr_read(int vb) {
  s16x4 r; asm volatile("ds_read_b64_tr_b16 %0, %1 offset:%2" : "=&v"(r) : "v"(vb), "i"(OFF) : "memory"); return r;
}
template <int D0> __device__ __forceinline__ void pv_one(f32x16& od, int vb, bf16x8 pa0, bf16x8 pa1, bf16x8 pa2, bf16x8 pa3) {
  const s16x4 l0 = tr_read<v_rd_off(D0, 0, 0)>(vb), h0 = tr_read<v_rd_off(D0, 0, 1)>(vb), l1 = tr_read<v_rd_off(D0, 1, 0)>(vb), h1 = tr_read<v_rd_off(D0, 1, 1)>(vb);
  const s16x4 l2 = tr_read<v_rd_off(D0, 2, 0)>(vb), h2 = tr_read<v_rd_off(D0, 2, 1)>(vb), l3 = tr_read<v_rd_off(D0, 3, 0)>(vb), h3 = tr_read<v_rd_off(D0, 3, 1)>(vb);
  asm volatile("s_waitcnt lgkmcnt(0)" ::: "memory"); SBAR();
#define PK(L, H) (bf16x8){L[0], L[1], L[2], L[3], H[0], H[1], H[2], H[3]}
  od = __builtin_amdgcn_mfma_f32_32x32x16_bf16(pa0, PK(l0, h0), od, 0, 0, 0);
  od = __builtin_amdgcn_mfma_f32_32x32x16_bf16(pa1, PK(l1, h1), od, 0, 0, 0);
  od = __builtin_amdgcn_mfma_f32_32x32x16_bf16(pa2, PK(l2, h2), od, 0, 0, 0);
  od = __builtin_amdgcn_mfma_f32_32x32x16_bf16(pa3, PK(l3, h3), od, 0, 0, 0);
#undef PK
}
__device__ __forceinline__ void pv_d0(f32x16* o, int vb, bf16x8 pa0, bf16x8 pa1, bf16x8 pa2, bf16x8 pa3) {
  pv_one<0>(o[0], vb, pa0, pa1, pa2, pa3); pv_one<1>(o[1], vb, pa0, pa1, pa2, pa3); pv_one<2>(o[2], vb, pa0, pa1, pa2, pa3); pv_one<3>(o[3], vb, pa0, pa1, pa2, pa3);
}

__device__ __forceinline__ void band_mask(f32x16& p0, f32x16& p1, int dq  , int hi) {
#pragma unroll
  for (int r = 0; r < 16; ++r) { const int d = dq - crow(r, hi);
    if ((unsigned)(d + 128) > 256u) p0[r] = -1e30f;
    if ((unsigned)(d + 96) > 256u) p1[r] = -1e30f; }
}
template <bool MASK>
__device__ __forceinline__ void attn_body(const bf16* __restrict__ Qb, const bf16* __restrict__ Kh, const bf16* __restrict__ Vh,
                                          bf16* __restrict__ Ob, int NT, int NCT, int lo, int qpos0, float sinkl2, char* lds) {
  using St = Stage<bf16>;
  int tid_ = threadIdx.x; asm volatile("" : "+v"(tid_));
  const int tid = tid_, wid = tid >> 6, lane = tid & 63, r32 = lane & 31, hi = lane >> 5;
  bf16* V_lds = (bf16*)lds; bf16* K_lds = (bf16*)(lds + 2 * SHM_V);
  float* ws = (float*)(lds + 2 * SHM_V + 2 * SHM_K) + wid * 64; float* li_l = ws; float* al_l = ws + 32;
  float m_reg = -1e30f, l_reg = 0; f32x16 o[4] = {}; bf16x8 qr[8];
  const bf16* Qw = Qb + (long)(wid * QBLK + r32) * LDQ + hi * 8;
#pragma unroll
  for (int d0 = 0; d0 < 8; ++d0) qr[d0] = St::ld8(Qw + d0 * 16);
  const int sr = tid >> 4, sc = (tid & 15) * 8, vst0 = v_st(sr, sc), vst1 = v_st(32 + sr, sc);
  const int vb0 = (int)(uintptr_t)V_lds + v_rd_base(lane);
  const int qi = qpos0 + wid * QBLK + r32;
  struct { typename St::T vs0, vs1, ks0, ks1; } sr_[SDEPTH];
#define TROW(j) (64 * (j) + ((j) >= NCT ? lo : 0))
#define SLOAD(i, k0) do { const long k0_ = (k0); sr_[i].vs0 = St::ld8(&Vh[(k0_ + sr) * LDK + sc]); sr_[i].vs1 = St::ld8(&Vh[(k0_ + 32 + sr) * LDK + sc]); \
    sr_[i].ks0 = St::ld8(&Kh[(k0_ + sr) * LDK + sc]); sr_[i].ks1 = St::ld8(&Kh[(k0_ + 32 + sr) * LDK + sc]); } while (0)
#define SWRITE(b, i) do { *(bf16x8*)((char*)V_lds + (b) * SHM_V + vst0) = St::tobf(sr_[i].vs0);          \
    *(bf16x8*)((char*)V_lds + (b) * SHM_V + vst1) = St::tobf(sr_[i].vs1); int kc = sc * 2;               \
    *(bf16x8*)((char*)K_lds + (b) * SHM_K + KSWZ(sr, kc)) = St::tobf(sr_[i].ks0);                       \
    *(bf16x8*)((char*)K_lds + (b) * SHM_K + KSWZ(32 + sr, kc)) = St::tobf(sr_[i].ks1); } while (0)
#define SWAIT() do { if constexpr (SDEPTH == 2) asm volatile("s_waitcnt vmcnt(4)" ::: "memory"); else asm volatile("s_waitcnt vmcnt(0)" ::: "memory"); } while (0)
#define RESC(a) do { if (__any((a) < 1.f)) { if (hi == 0) al_l[r32] = (a); asm volatile("s_waitcnt lgkmcnt(0)" ::: "memory"); \
    for (int d = 0; d < 4; ++d) for (int r = 0; r < 16; ++r) o[d][r] *= al_l[crow(r, hi)]; } } while (0)
#define AMASK(P0, P1, j) do { if constexpr (MASK) { if ((j) >= NCT) band_mask(P0, P1, qi - (lo + 64 * ((j) - NCT)), hi); } } while (0)
  f32x16 pA0, pA1, pB0, pB1; float mnA, mnB, alA, alB; bf16x8 pa0, pa1, pa2, pa3;
  constexpr int SE = 0, SO = SDEPTH - 1;
  SLOAD(SE, TROW(0)); asm volatile("s_waitcnt vmcnt(0)" ::: "memory"); SWRITE(0, SE); __syncthreads();
  qkt(pA0, pA1, K_lds, qr, r32, hi); AMASK(pA0, pA1, 0); partialSM(pA0, pA1, m_reg, mnA, alA);
  SLOAD(SO, TROW(1)); if constexpr (SDEPTH == 2) { if (2 < NT) SLOAD(SE, TROW(2)); }
  SWAIT(); SWRITE(1, SO); __syncthreads();
  for (int j = 1; j + 1 < NT; j += 2) {
    SBAR(); qkt(pB0, pB1, (bf16*)((char*)K_lds + SHM_K), qr, r32, hi); AMASK(pB0, pB1, j);
    finishSM(pA0, pA1, alA, l_reg, pa0, pa1, pa2, pa3); SBAR();
    SLOAD(SO, TROW(j + SDEPTH)); SBAR();
    pv_d0(o, vb0, pa0, pa1, pa2, pa3); partialSM(pB0, pB1, m_reg, mnB, alB);
    __syncthreads(); SWAIT(); SWRITE(0, SE);
    RESC(alB); __syncthreads();
    SBAR(); qkt(pA0, pA1, K_lds, qr, r32, hi); AMASK(pA0, pA1, j + 1);
    finishSM(pB0, pB1, alB, l_reg, pa0, pa1, pa2, pa3); SBAR();
    if (SDEPTH == 1 || j + 3 < NT) SLOAD(SE, TROW(j + 1 + SDEPTH)); SBAR();
    pv_d0(o, vb0 + (int)SHM_V, pa0, pa1, pa2, pa3); partialSM(pA0, pA1, m_reg, mnA, alA);
    __syncthreads(); SWAIT(); SWRITE(1, SO);
    RESC(alA); __syncthreads();
  }
  SBAR(); qkt(pB0, pB1, (bf16*)((char*)K_lds + SHM_K), qr, r32, hi); AMASK(pB0, pB1, NT - 1);
  finishSM(pA0, pA1, alA, l_reg, pa0, pa1, pa2, pa3); SBAR();
  pv_d0(o, vb0, pa0, pa1, pa2, pa3); partialSM(pB0, pB1, m_reg, mnB, alB);
  __syncthreads(); RESC(alB);
  finishSM(pB0, pB1, alB, l_reg, pa0, pa1, pa2, pa3); SBAR();
  pv_d0(o, vb0 + (int)SHM_V, pa0, pa1, pa2, pa3);
  l_reg += __builtin_amdgcn_exp2f(sinkl2 - m_reg * (SCALE * 1.4426950408889634f));
  if (hi == 0) li_l[r32] = l_reg; asm volatile("s_waitcnt lgkmcnt(0)" ::: "memory");
  float rli[16];
#pragma unroll
  for (int r = 0; r < 16; ++r) rli[r] = __builtin_amdgcn_rcpf(li_l[crow(r, hi)]);
  bf16* Ow = Ob + (long)(wid * QBLK) * LDO;
#pragma unroll
  for (int r = 0; r < 16; ++r) { int orow = crow(r, hi);
    for (int d0 = 0; d0 < 4; ++d0) { const float v = o[d0][r] * rli[r]; const unsigned u = __builtin_bit_cast(unsigned, v);
      Ow[(long)orow * LDO + d0 * 32 + r32] = (bf16)((u + 0x7fffu + ((u >> 16) & 1u)) >> 16); } }
  __syncthreads();
#undef TROW
#undef SLOAD
#undef SWRITE
#undef SWAIT
#undef RESC
#undef AMASK
}

template <int OFF> __device__ __forceinline__ bf16x8 k_read(int addr) { bf16x8 r; asm volatile("ds_read_b128 %0, %1 offset:%2" : "=&v"(r) : "v"(addr), "i"(OFF) : "memory"); return r; }
__device__ __forceinline__ void qkt_pipe(f32x16& p0, f32x16& p1, const bf16* Ks, const bf16x8* qr, int r32, int hi) {
  p0 = f32x16{}; p1 = f32x16{};
  const int kb = (int)(uintptr_t)Ks + r32 * 256, sw = (r32 & 7) << 4;
  const int e0 = kb + ((0 * 32 + hi * 16) ^ sw), e1 = kb + ((1 * 32 + hi * 16) ^ sw), e2 = kb + ((2 * 32 + hi * 16) ^ sw), e3 = kb + ((3 * 32 + hi * 16) ^ sw);
  bf16x8 a0, a1, b0, b1;
#define LGK(n) do { asm volatile("s_waitcnt lgkmcnt(" #n ")" ::: "memory"); SBAR(); } while (0)
#define MM(A0, A1, d) do { p0 = __builtin_amdgcn_mfma_f32_32x32x16_bf16(A0, qr[d], p0, 0, 0, 0); p1 = __builtin_amdgcn_mfma_f32_32x32x16_bf16(A1, qr[d], p1, 0, 0, 0); SBAR(); } while (0)
  a0 = k_read<0>(e0); a1 = k_read<8192>(e0); b0 = k_read<0>(e1); b1 = k_read<8192>(e1);
  LGK(2); MM(a0, a1, 0); a0 = k_read<0>(e2); a1 = k_read<8192>(e2);
  LGK(2); MM(b0, b1, 1); b0 = k_read<0>(e3); b1 = k_read<8192>(e3);
  LGK(2); MM(a0, a1, 2); a0 = k_read<128>(e0); a1 = k_read<8320>(e0);
  LGK(2); MM(b0, b1, 3); b0 = k_read<128>(e1); b1 = k_read<8320>(e1);
  LGK(2); MM(a0, a1, 4); a0 = k_read<128>(e2); a1 = k_read<8320>(e2);
  LGK(2); MM(b0, b1, 5); b0 = k_read<128>(e3); b1 = k_read<8320>(e3);
  LGK(2); MM(a0, a1, 6);
  LGK(0); MM(b0, b1, 7);
#undef LGK
#undef MM
}
struct VFr { s16x4 l0, h0, l1, h1, l2, h2, l3, h3; };
template <int DB> __device__ __forceinline__ void pv_ld(VFr& f, int vb) {
  constexpr int I = (DB >> 2) * 16384, D0 = DB & 3;
  f.l0 = tr_read<I + v_rd_off(D0, 0, 0)>(vb); f.h0 = tr_read<I + v_rd_off(D0, 0, 1)>(vb); f.l1 = tr_read<I + v_rd_off(D0, 1, 0)>(vb); f.h1 = tr_read<I + v_rd_off(D0, 1, 1)>(vb);
  f.l2 = tr_read<I + v_rd_off(D0, 2, 0)>(vb); f.h2 = tr_read<I + v_rd_off(D0, 2, 1)>(vb); f.l3 = tr_read<I + v_rd_off(D0, 3, 0)>(vb); f.h3 = tr_read<I + v_rd_off(D0, 3, 1)>(vb);
}
__device__ __forceinline__ void pv_mm(f32x16& od, const VFr& f, bf16x8 pa0, bf16x8 pa1, bf16x8 pa2, bf16x8 pa3) {
#define PK(L, H) (bf16x8){L[0], L[1], L[2], L[3], H[0], H[1], H[2], H[3]}
  od = __builtin_amdgcn_mfma_f32_32x32x16_bf16(pa0, PK(f.l0, f.h0), od, 0, 0, 0);
  od = __builtin_amdgcn_mfma_f32_32x32x16_bf16(pa1, PK(f.l1, f.h1), od, 0, 0, 0);
  od = __builtin_amdgcn_mfma_f32_32x32x16_bf16(pa2, PK(f.l2, f.h2), od, 0, 0, 0);
  od = __builtin_amdgcn_mfma_f32_32x32x16_bf16(pa3, PK(f.l3, f.h3), od, 0, 0, 0);
#undef PK
}
__device__ __forceinline__ void pv_all(f32x16* o, int vb, bf16x8 pa0, bf16x8 pa1, bf16x8 pa2, bf16x8 pa3) {
  VFr fa, fb;
#define W8() do { asm volatile("s_waitcnt lgkmcnt(8)" ::: "memory"); SBAR(); } while (0)
#define W0() do { asm volatile("s_waitcnt lgkmcnt(0)" ::: "memory"); SBAR(); } while (0)
  pv_ld<0>(fa, vb);
  pv_ld<1>(fb, vb); W8(); pv_mm(o[0], fa, pa0, pa1, pa2, pa3); SBAR();
  pv_ld<2>(fa, vb); W8(); pv_mm(o[1], fb, pa0, pa1, pa2, pa3); SBAR();
  pv_ld<3>(fb, vb); W8(); pv_mm(o[2], fa, pa0, pa1, pa2, pa3); SBAR();
  pv_ld<4>(fa, vb); W8(); pv_mm(o[3], fb, pa0, pa1, pa2, pa3); SBAR();
  pv_ld<5>(fb, vb); W8(); pv_mm(o[4], fa, pa0, pa1, pa2, pa3); SBAR();
  pv_ld<6>(fa, vb); W8(); pv_mm(o[5], fb, pa0, pa1, pa2, pa3); SBAR();
  pv_ld<7>(fb, vb); W8(); pv_mm(o[6], fa, pa0, pa1, pa2, pa3); SBAR();
  W0(); pv_mm(o[7], fb, pa0, pa1, pa2, pa3);
#undef W8
#undef W0
}
struct VH { s16x4 l0, h0, l1, h1; };
template <int DB, int KS> __device__ __forceinline__ void pv_ldh(VH& f, int vb) {
  constexpr int I = (DB >> 2) * 16384, D0 = DB & 3;
  f.l0 = tr_read<I + v_rd_off(D0, KS, 0)>(vb); f.h0 = tr_read<I + v_rd_off(D0, KS, 1)>(vb); f.l1 = tr_read<I + v_rd_off(D0, KS + 1, 0)>(vb); f.h1 = tr_read<I + v_rd_off(D0, KS + 1, 1)>(vb);
}
#define PKV(L, H) (bf16x8){L[0], L[1], L[2], L[3], H[0], H[1], H[2], H[3]}
#define PK4S(P, BASE, OUT) do { unsigned a0_ = cvtpk(P[BASE + 0], P[BASE + 1]), a1_ = cvtpk(P[BASE + 2], P[BASE + 3]);   \
    unsigned b0_ = cvtpk(P[BASE + 4], P[BASE + 5]), b1_ = cvtpk(P[BASE + 6], P[BASE + 7]);                              \
    auto r0_ = __builtin_amdgcn_permlane32_swap(a0_, b0_, false, false); auto r1_ = __builtin_amdgcn_permlane32_swap(a1_, b1_, false, false); \
    u32x4 w_ = {r0_[0], r1_[0], r0_[1], r1_[1]}; OUT = *reinterpret_cast<bf16x8*>(&w_); } while (0)
__device__ __forceinline__ void smpv_all(f32x16& p0, f32x16& p1, float alpha, float& l_reg, f32x16* o, int vb) {
  bf16x8 pa0, pa1, pa2, pa3; VH fa, fb; float s0 = 0.f, s1 = 0.f;
  PK4S(p0, 0, pa0); PK4S(p0, 8, pa1);
#define WL(n) do { asm volatile("s_waitcnt lgkmcnt(" #n ")" ::: "memory"); SBAR(); } while (0)
#define P1BLK(B, FC, FN, LAST) do { if (!(LAST)) pv_ldh<((B) + 1) & 7, 0>(FN, vb); if (LAST) WL(0); else WL(4); \
    o[B] = __builtin_amdgcn_mfma_f32_32x32x16_bf16(pa0, PKV(FC.l0, FC.h0), o[B], 0, 0, 0); \
    p1[2 * (B)] = __builtin_amdgcn_exp2f(p1[2 * (B)]); s0 += p0[2 * (B)]; s1 += p0[2 * (B) + 1]; SBAR(); \
    o[B] = __builtin_amdgcn_mfma_f32_32x32x16_bf16(pa1, PKV(FC.l1, FC.h1), o[B], 0, 0, 0); \
    p1[2 * (B) + 1] = __builtin_amdgcn_exp2f(p1[2 * (B) + 1]); if ((B) > 0) { s0 += p1[2 * (B) - 2]; s1 += p1[2 * (B) - 1]; } SBAR(); } while (0)
  pv_ldh<0, 0>(fa, vb);
  P1BLK(0, fa, fb, false); P1BLK(1, fb, fa, false); P1BLK(2, fa, fb, false); P1BLK(3, fb, fa, false);
  P1BLK(4, fa, fb, false); P1BLK(5, fb, fa, false); P1BLK(6, fa, fb, false); P1BLK(7, fb, fa, true);
  pv_ldh<0, 2>(fa, vb);
  s0 += p1[14]; s1 += p1[15];
  float ps = s0 + s1;
  { auto rr = __builtin_amdgcn_permlane32_swap(__float_as_uint(ps), __float_as_uint(ps), false, false); ps = __uint_as_float(rr[0]) + __uint_as_float(rr[1]); }
  l_reg = l_reg * alpha + ps;
  PK4S(p1, 0, pa2); PK4S(p1, 8, pa3); SBAR();
#define P2BLK(B, FC, FN, LAST) do { if (!(LAST)) pv_ldh<((B) + 1) & 7, 2>(FN, vb); if (LAST) WL(0); else WL(4); \
    o[B] = __builtin_amdgcn_mfma_f32_32x32x16_bf16(pa2, PKV(FC.l0, FC.h0), o[B], 0, 0, 0); \
    o[B] = __builtin_amdgcn_mfma_f32_32x32x16_bf16(pa3, PKV(FC.l1, FC.h1), o[B], 0, 0, 0); SBAR(); } while (0)
  P2BLK(0, fa, fb, false); P2BLK(1, fb, fa, false); P2BLK(2, fa, fb, false); P2BLK(3, fb, fa, false);
  P2BLK(4, fa, fb, false); P2BLK(5, fb, fa, false); P2BLK(6, fa, fb, false); P2BLK(7, fb, fa, true);
#undef WL
#undef P1BLK
#undef P2BLK
}
#undef PKV
#undef PK4S
#define ATT_LAS __attribute__((address_space(3)))
__device__ __forceinline__ void attn_body_v256(const bf16* __restrict__ Qb, const bf16* __restrict__ Kh, const bf16* __restrict__ Vh,
                                               bf16* __restrict__ Ob, int NT, ATT_LAS unsigned char* ldsl) {
  using St = Stage<bf16>;
  int tid_ = threadIdx.x; asm volatile("" : "+v"(tid_));
  const int tid = tid_, wid = __builtin_amdgcn_readfirstlane(tid >> 6), lane = tid & 63, r32 = lane & 31, hi = lane >> 5;
  char* lds = (char*)ldsl;
  char* V_lds = lds; char* K_lds = lds + 65536;
  float* ws = (float*)(lds + 98304) + wid * 64; float* li_l = ws; float* al_l = ws + 32;
  float m_reg = -1e30f, l_reg = 0; f32x16 o[8] = {}; bf16x8 qr[8];
  const bf16* Qw = Qb + (long)(wid * QBLK + r32) * LDQ + hi * 8;
#pragma unroll
  for (int d0 = 0; d0 < 8; ++d0) qr[d0] = St::ld8(Qw + d0 * 16);
  unsigned offK0, offV0;
  { const int row = wid * 4 + (lane >> 4), colB = ((lane & 15) * 16) ^ ((row & 7) << 4); offK0 = (unsigned)row * (LDK * 2) + (unsigned)colB;
    const int sub = wid * 2 + (lane >> 5), kkhi = sub >> 2, cblk = sub & 3, within = (lane & 31) * 16, kk = kkhi * 8 + (within >> 6);
    const int k = (kk & ~0xC) | ((kk & 4) << 1) | ((kk & 8) >> 1), c = cblk * 32 + ((within & 63) >> 1);
    offV0 = (unsigned)k * (LDK * 2) + (unsigned)c * 2; }
  const int vb0 = (int)(uintptr_t)V_lds + v_rd_base(lane);
#define DMA_TILE(j, buf) do { const char* kb_ = (const char*)Kh + (size_t)(j) * (64 * LDK * 2) + offK0; const char* vb_ = (const char*)Vh + (size_t)(j) * (64 * LDK * 2) + offV0; \
    _Pragma("unroll") for (int i_ = 0; i_ < 2; ++i_) __builtin_amdgcn_global_load_lds((const unsigned*)(kb_ + i_ * (32 * LDK * 2)), (ATT_LAS unsigned*)(ldsl + 65536 + (buf) * 16384 + (i_ * 8 + wid) * 1024), 16, 0, 0); \
    _Pragma("unroll") for (int i_ = 0; i_ < 4; ++i_) __builtin_amdgcn_global_load_lds((const unsigned*)(vb_ + (i_ & 1) * (32 * LDK * 2) + (i_ >> 1) * 256), (ATT_LAS unsigned*)(ldsl + (buf) * 32768 + (i_ * 8 + wid) * 1024), 16, 0, 0); } while (0)
#define RESC8(a) do { if (__any((a) < 1.f)) { if (hi == 0) al_l[r32] = (a); asm volatile("s_waitcnt lgkmcnt(0)" ::: "memory"); \
    for (int d = 0; d < 8; ++d) for (int r = 0; r < 16; ++r) o[d][r] *= al_l[crow(r, hi)]; } } while (0)
#define TILE_SYNC() do { asm volatile("s_waitcnt vmcnt(0)" ::: "memory"); __builtin_amdgcn_s_barrier(); asm volatile("" ::: "memory"); } while (0)
  f32x16 p0, p1; float mn, al;
#pragma unroll
  for (int d0 = 0; d0 < 8; ++d0) asm volatile("" : "+v"(qr[d0]));
  if (wid >= 4) __builtin_amdgcn_s_setprio(2);
  DMA_TILE(0, 0);
  for (int j = 0; j < NT; j += 2) {
    TILE_SYNC(); DMA_TILE(j + 1, 1);
    qkt_pipe(p0, p1, (const bf16*)K_lds, qr, r32, hi); partialSM(p0, p1, m_reg, mn, al); RESC8(al); SBAR();
    smpv_all(p0, p1, al, l_reg, o, vb0);
    TILE_SYNC(); if (j + 2 < NT) DMA_TILE(j + 2, 0);
    qkt_pipe(p0, p1, (const bf16*)(K_lds + 16384), qr, r32, hi); partialSM(p0, p1, m_reg, mn, al); RESC8(al); SBAR();
    smpv_all(p0, p1, al, l_reg, o, vb0 + 32768);
  }
  __builtin_amdgcn_s_setprio(0);
  if (hi == 0) li_l[r32] = l_reg; asm volatile("s_waitcnt lgkmcnt(0)" ::: "memory");
  float rli[16];
#pragma unroll
  for (int r = 0; r < 16; ++r) rli[r] = __builtin_amdgcn_rcpf(li_l[crow(r, hi)]);
  bf16* Ow = Ob + (long)(wid * QBLK) * LDO;
#pragma unroll
  for (int r = 0; r < 16; ++r) { int orow = crow(r, hi);
#pragma unroll
    for (int d0 = 0; d0 < 8; ++d0) { const float v = o[d0][r] * rli[r]; const unsigned u = __builtin_bit_cast(unsigned, v);
      Ow[(long)orow * LDO + d0 * 32 + r32] = (bf16)((u + 0x7fffu + ((u >> 16) & 1u)) >> 16); } }
#undef DMA_TILE
#undef RESC8
#undef TILE_SYNC
}
__device__ __forceinline__ void attn_body_a(const bf16* __restrict__ Qb, const bf16* __restrict__ Kh, const bf16* __restrict__ Vh, bf16* __restrict__ Ob,
                                            int NT, int NCT, int lo, int qpos0, const float* __restrict__ sk4, ATT_LAS unsigned char* ldsl) {
  using St = Stage<bf16>;
  int tid_ = threadIdx.x; asm volatile("" : "+v"(tid_));
  const int tid = tid_, wid = __builtin_amdgcn_readfirstlane(tid >> 6), lane = tid & 63, r32 = lane & 31, hi = lane >> 5;
  const int g = wid >> 1, rh = wid & 1;
  char* lds = (char*)ldsl;
  float* ws = (float*)(lds + 98304) + wid * 64; float* li_l = ws; float* al_l = ws + 32;
  float m_reg = -1e30f, l_reg = 0; f32x16 o[4] = {}; bf16x8 qr[8];
  const bf16* Qw = Qb + (long)(rh * QBLK + r32) * LDQ + g * 128 + hi * 8;
#pragma unroll
  for (int d0 = 0; d0 < 8; ++d0) qr[d0] = St::ld8(Qw + d0 * 16);
  const float sinkl2 = sk4[g] * 1.4426950408889634f;
  const int qi = qpos0 + rh * QBLK + r32;
  unsigned offK0, offV0;
  { const int row = wid * 4 + (lane >> 4), colB = ((lane & 15) * 16) ^ ((row & 7) << 4); offK0 = (unsigned)row * (LDK * 2) + (unsigned)colB;
    const int sub = wid * 2 + (lane >> 5), kkhi = sub >> 2, cblk = sub & 3, within = (lane & 31) * 16, kk = kkhi * 8 + (within >> 6);
    const int k = (kk & ~0xC) | ((kk & 4) << 1) | ((kk & 8) >> 1), c = cblk * 32 + ((within & 63) >> 1);
    offV0 = (unsigned)k * (LDK * 2) + (unsigned)c * 2; }
  const int vb0 = (int)(uintptr_t)lds + 16384 + v_rd_base(lane);
#define TROWA(j) (64 * (j) + ((j) >= NCT ? lo : 0))
#define DMA_TILE(j, sb) do { const size_t ro_ = (size_t)TROWA(j) * (LDK * 2); const char* kb_ = (const char*)Kh + ro_ + offK0; const char* vb_ = (const char*)Vh + ro_ + offV0; \
    _Pragma("unroll") for (int i_ = 0; i_ < 2; ++i_) { __builtin_amdgcn_global_load_lds((const unsigned*)(kb_ + i_ * (32 * LDK * 2)), (ATT_LAS unsigned*)(ldsl + (sb) + (i_ * 8 + wid) * 1024), 16, 0, 0); \
      __builtin_amdgcn_global_load_lds((const unsigned*)(vb_ + i_ * (32 * LDK * 2)), (ATT_LAS unsigned*)(ldsl + (sb) + 16384 + (i_ * 8 + wid) * 1024), 16, 0, 0); } } while (0)
#define RESC4(a) do { if (__any((a) < 1.f)) { if (hi == 0) al_l[r32] = (a); asm volatile("s_waitcnt lgkmcnt(0)" ::: "memory"); \
    for (int d = 0; d < 4; ++d) for (int r = 0; r < 16; ++r) o[d][r] *= al_l[crow(r, hi)]; } } while (0)
  f32x16 p0, p1; float mn, al; bf16x8 pa0, pa1, pa2, pa3;
#pragma unroll
  for (int d0 = 0; d0 < 8; ++d0) asm volatile("" : "+v"(qr[d0]));
  DMA_TILE(0, 0);
  int sb = 0;
  for (int j = 0; j < NT; ++j) {
    asm volatile("s_waitcnt vmcnt(0)" ::: "memory"); __builtin_amdgcn_s_barrier(); asm volatile("" ::: "memory");
    if (j + 1 < NT) DMA_TILE(j + 1, sb ^ 32768);
    qkt_pipe(p0, p1, (const bf16*)(lds + sb), qr, r32, hi);
    if (j >= NCT) band_mask(p0, p1, qi - (lo + 64 * (j - NCT)), hi);
    partialSM(p0, p1, m_reg, mn, al); RESC4(al); finishSM(p0, p1, al, l_reg, pa0, pa1, pa2, pa3); SBAR();
    pv_d0(o, vb0 + sb, pa0, pa1, pa2, pa3);
    sb ^= 32768;
  }
  l_reg += __builtin_amdgcn_exp2f(sinkl2 - m_reg * (SCALE * 1.4426950408889634f));
  if (hi == 0) li_l[r32] = l_reg; asm volatile("s_waitcnt lgkmcnt(0)" ::: "memory");
  float rli[16];
#pragma unroll
  for (int r = 0; r < 16; ++r) rli[r] = __builtin_amdgcn_rcpf(li_l[crow(r, hi)]);
  bf16* Ow = Ob + (long)(rh * QBLK) * LDO + g * 128;
#pragma unroll
  for (int r = 0; r < 16; ++r) { int orow = crow(r, hi);
#pragma unroll
    for (int d0 = 0; d0 < 4; ++d0) { const float v = o[d0][r] * rli[r]; const unsigned u = __builtin_bit_cast(unsigned, v);
      Ow[(long)orow * LDO + d0 * 32 + r32] = (bf16)((u + 0x7fffu + ((u >> 16) & 1u)) >> 16); } }
#undef TROWA
#undef DMA_TILE
#undef RESC4
}
}

constexpr size_t MiB = 1u << 20;
constexpr size_t SLOT = (size_t)MROWS * DM * 2;
constexpr size_t WS_MOD = 0;
constexpr size_t WS_BAR = 1 * MiB, WS_BAR_BYTES = 16384;
constexpr size_t WS_COS = 2 * MiB, WS_SIN = 4 * MiB;
constexpr size_t WS_CTX1 = 6 * MiB;
constexpr size_t WS_WINT = 16 * MiB;
constexpr size_t WS_WPT = WS_WINT + 68 * MiB;
constexpr size_t WS_PX = WS_WPT + 48 * MiB;
constexpr size_t WS_S0 = WS_PX + (size_t)MROWS * INC * 2;
constexpr size_t WS_END = WS_S0 + 5 * SLOT;
static_assert(WS_END <= 4ull * DEPTH * DM * INC * 4, "workspace map exceeds the guaranteed 4x largest tensor");

constexpr int NWAVES = 8;
constexpr int LDS_BYTES = 147456;

#define GAS __attribute__((address_space(1)))
#define LAS __attribute__((address_space(3)))
typedef unsigned short bf16;
typedef unsigned v4u __attribute__((ext_vector_type(4)));
typedef unsigned v2u __attribute__((ext_vector_type(2)));
typedef float f32x4 __attribute__((ext_vector_type(4)));
#define LDS_WAIT() asm volatile("s_waitcnt lgkmcnt(0)" ::: "memory")
__device__ __forceinline__ unsigned f2bf(float f) { unsigned u = __builtin_bit_cast(unsigned, f); return (u + 0x7fffu + ((u >> 16) & 1u)) >> 16; }
__device__ __forceinline__ unsigned pk2(float lo, float hi) { return f2bf(lo) | (f2bf(hi) << 16); }
__device__ __forceinline__ float bflo(unsigned w) { return __builtin_bit_cast(float, w << 16); }
__device__ __forceinline__ float bfhi(unsigned w) { return __builtin_bit_cast(float, w & 0xffff0000u); }
__device__ __forceinline__ float siluf(float x) { return x / (1.f + __expf(-x)); }
__device__ __forceinline__ float sigmf(float x) { return 1.f / (1.f + __expf(-x)); }

struct Frame {
    LAS unsigned char* lds;
    int vcu, G;
    const float *x, *c, *ctx, *c_ctx, *w_ada, *b_ada, *g_pre, *g_post, *w_in, *sink, *lam_qk, *g_subln, *w_pa, *w_pb, *w_out;
    float* out; unsigned char* ws;
};

#define XB_TMO      128
#define XB_XCNT(j)  (256  + 64 * (j))
#define XB_XSUB(j)  (1280 + 64 * (j))
#define XB_XGEN(j)  (2304 + 64 * (j))
#define XB_TOP      3328
#define XB_TOPGEN   3392
#define XCD_BAR_WORDS 3456
#define XB_SPIN_CAP (1u << 18)

__device__ __forceinline__ unsigned xb_ld(unsigned* p)              { return __hip_atomic_load(p, __ATOMIC_RELAXED, __HIP_MEMORY_SCOPE_AGENT); }
__device__ __forceinline__ unsigned xb_add(unsigned* p, unsigned v) { return __hip_atomic_fetch_add(p, v, __ATOMIC_RELAXED, __HIP_MEMORY_SCOPE_AGENT); }
__device__ __forceinline__ unsigned xb_xcc_id() { return (unsigned)__builtin_amdgcn_s_getreg((3 << 11) | 20) & 0xFu; }
#define XB_SPIN(cond, bar) do { unsigned _sp = 0; while (cond) { __builtin_amdgcn_s_sleep(1); \
    if ((++_sp & 255u) == 0u) { if (xb_ld(&(bar)[XB_TMO])) break; if (_sp > XB_SPIN_CAP) { atomicAdd(&(bar)[XB_TMO], 1u); break; } } } } while (0)

struct XcdBarrier {
    unsigned* bar; unsigned x;
    volatile LAS unsigned* st;
};

__device__ __forceinline__ XcdBarrier xcd_barrier_post(unsigned* bar, volatile LAS unsigned* st) {
    XcdBarrier b; b.bar = bar; b.x = xb_xcc_id(); b.st = st;
    if (threadIdx.x == 0) (void)xb_add(&bar[XB_XCNT(b.x)], 1u);
    return b;
}
__device__ __forceinline__ void xcd_barrier_complete(unsigned* bar, unsigned x, unsigned& nloc, unsigned& nx) {
    const unsigned G = gridDim.x * gridDim.y * gridDim.z;
    unsigned sum, cnt, mine, sp = 0u;
    for (;;) {
        sum = 0u; cnt = 0u; mine = 0u;
#pragma unroll
        for (unsigned j = 0; j < 16; ++j) { const unsigned c = xb_ld(&bar[XB_XCNT(j)]); sum += c; cnt += (c > 0u) ? 1u : 0u; mine = (j == x) ? c : mine; }
        if (sum == G) break;
        __builtin_amdgcn_s_sleep(1);
        if ((++sp & 255u) == 0u) { if (xb_ld(&bar[XB_TMO])) break; if (sp > XB_SPIN_CAP) { atomicAdd(&bar[XB_TMO], 1u); break; } }
    }
    nloc = mine > 0u ? mine : 1u; nx = cnt > 0u ? cnt : 1u;
}

__device__ __forceinline__ void xcd_barrier(const XcdBarrier& b) {
    asm volatile("s_waitcnt vmcnt(0)" ::: "memory");
    __syncthreads();
    if (threadIdx.x == 0) {
        unsigned* bar = b.bar;
        __builtin_amdgcn_s_waitcnt(0);
        unsigned nloc = b.st[0], nx = b.st[1];
        if (nloc == 0u) { xcd_barrier_complete(bar, b.x, nloc, nx); b.st[0] = nloc; b.st[1] = nx; }
        const unsigned old = xb_add(&bar[XB_XSUB(b.x)], 1u);
        const unsigned gen = old / nloc;
        if (old + 1u == (gen + 1u) * nloc) {
            __builtin_amdgcn_fence(__ATOMIC_RELEASE, "agent");
            asm volatile("s_waitcnt vmcnt(0)" ::: "memory");
            const unsigned og = xb_add(&bar[XB_TOP], 1u);
            const unsigned tg = og / nx;
            if (og + 1u == (tg + 1u) * nx) xb_add(&bar[XB_TOPGEN], 1u);
            else XB_SPIN(xb_ld(&bar[XB_TOPGEN]) == tg, bar);
            __builtin_amdgcn_fence(__ATOMIC_ACQUIRE, "agent");
            xb_add(&bar[XB_XGEN(b.x)], 1u);
            asm volatile("s_waitcnt vmcnt(0)" ::: "memory");
        } else {
            XB_SPIN(xb_ld(&bar[XB_XGEN(b.x)]) == gen, bar);
            __builtin_amdgcn_fence(__ATOMIC_ACQUIRE, "agent");
            asm volatile("s_waitcnt vmcnt(0)" ::: "memory");
        }
    }
    __syncthreads();
}

#define FRESH_IDS int tid_ = threadIdx.x; asm volatile("" : "+v"(tid_)); const int tid = tid_, lane = tid & 63, wave = __builtin_amdgcn_readfirstlane(tid >> 6); (void)lane; (void)wave;

__device__ __forceinline__ float wave_sum(float v) {
#pragma unroll
    for (int o = 1; o < 64; o <<= 1) v += __shfl_xor(v, o);
    return v;
}
__device__ __forceinline__ void p0_transpose_item(const float* W, int K, int N, bf16* WT, int row_off, LAS float* scr, int item, int lane) {
    const int nblk = N / 32, kb = item / nblk, nb = item % nblk, k0 = 64 * kb, n0 = 32 * nb;
#pragma unroll
    for (int i = 0; i < 32; ++i) { const int kk = 2 * i + (lane >> 5); scr[kk * 33 + (lane & 31)] = W[(size_t)(k0 + kk) * N + n0 + (lane & 31)]; }
    LDS_WAIT(); asm volatile("" ::: "memory");
    const int c = lane & 7;
#pragma unroll
    for (int j = 0; j < 4; ++j) { const int n = (lane >> 3) + 8 * j; const LAS float* s = scr + (8 * c) * 33 + n;
        v4u o; o.x = pk2(s[0 * 33], s[1 * 33]); o.y = pk2(s[2 * 33], s[3 * 33]); o.z = pk2(s[4 * 33], s[5 * 33]); o.w = pk2(s[6 * 33], s[7 * 33]);
        *(GAS v4u*)(WT + (size_t)(row_off + n0 + n) * K + k0 + 8 * c) = o; }
    LDS_WAIT(); asm volatile("" ::: "memory");
}

#define GW_LOOP(var, n) for (int var = F.vcu * NWAVES + wave; var < (n); var += F.G * NWAVES)

__device__ __forceinline__ int win_row_off(int n0) {
    const int tile = n0 >> 8; const bool rope = tile < 2 || (tile >= 4 && tile < 12) || (tile >= 20 && tile < 28) || (tile >= 36 && tile < 44);
    if (!rope) return 0;
    const int w = n0 & 255, hsel = w >> 7, half = (w >> 6) & 1, i = w & 63;
    return (half * 128 + hsel * 64 + i) - w;
}
__device__ __forceinline__ void ph_prologue(Frame& F) {
    FRESH_IDS
    for (int ait = F.vcu; ait < 192; ait += F.G) {
        const int l = ait / 96, n0 = (ait % 96) * 64;
        LAS float* sv = (LAS float*)F.lds;
        LAS float* red = (LAS float*)(F.lds + 32768);
        for (int k = tid; k < DM; k += NWAVES * 64) { sv[k] = siluf(F.c[k]); sv[DM + k] = siluf(F.c[DM + k]); sv[2 * DM + k] = siluf(F.c_ctx[k]); }
        __syncthreads();
        const float* W = F.w_ada + (size_t)l * DM * 6144 + n0 + lane;
        float a0 = 0.f, a1 = 0.f, a2 = 0.f;
        const int kb = wave * 256;
#pragma unroll 32
        for (int k = 0; k < 256; ++k) { const float w = W[(size_t)(kb + k) * 6144]; a0 += sv[kb + k] * w; a1 += sv[DM + kb + k] * w; a2 += sv[2 * DM + kb + k] * w; }
        red[(wave * 3 + 0) * 64 + lane] = a0; red[(wave * 3 + 1) * 64 + lane] = a1; red[(wave * 3 + 2) * 64 + lane] = a2;
        __syncthreads();
        if (wave < 3) { float s = 0.f;
#pragma unroll
            for (int w = 0; w < 8; ++w) s += red[(w * 3 + wave) * 64 + lane];
            float* mod = (float*)(F.ws + WS_MOD);
            mod[(size_t)(l * 3 + wave) * 6144 + n0 + lane] = s + F.b_ada[(size_t)l * 6144 + n0 + lane]; }
        __syncthreads();
    }
    { float* ct = (float*)(F.ws + WS_COS); float* st = (float*)(F.ws + WS_SIN);
      for (int i = (F.vcu * NWAVES * 64) + tid; i < SEQ * 64; i += F.G * NWAVES * 64) {
          const int t = i >> 6, j = i & 63, f = j & 31; const float pos = (float)((j < 32) ? (t >> 6) : (t & 63));
          const float inv = expf(-(float)f * (9.210340371976184f / 32.f)); const float ang = pos * inv;
          ct[i] = cosf(ang); st[i] = sinf(ang); } }
    LAS float* scr = (LAS float*)(F.lds + wave * 16384);
    constexpr int I_IN = (DM / 64) * (INC / 32), I_P = (DM / 64) * (DM / 32);
    bf16* WinT = (bf16*)(F.ws + WS_WINT); bf16* WpT = (bf16*)(F.ws + WS_WPT);
    GW_LOOP(it, I_IN + 6 * I_P) {
        if (it < I_IN) { p0_transpose_item(F.w_in, DM, INC, WinT, win_row_off(32 * (it % (INC / 32))), scr, it, lane); continue; }
        const int r = it - I_IN, mi = r / I_P, ii = r % I_P, l = mi / 3, w = mi % 3;
        const float* W = (w == 0 ? F.w_pa : (w == 1 ? F.w_pb : F.w_out)) + (size_t)l * DM * DM;
        p0_transpose_item(W, DM, DM, WpT + (size_t)mi * DM * DM, 0, scr, ii, lane);
    }
}

__device__ __forceinline__ void ph_hnorm(Frame& F, int l, const float* xcur, const float* ctxcur) {
    FRESH_IDS
    bf16* H = (bf16*)(F.ws + WS_S0);
    const float* gp = F.g_pre + (size_t)l * DM;
    GW_LOOP(row, MROWS) {
        const int b = row / RPB, rr = row % RPB; const float* src; int v;
        if (rr < CTX) { src = ctxcur + (size_t)(b * CTX + rr) * DM; v = 2; } else { src = xcur + (size_t)(b * SEQ + rr - CTX) * DM; v = b; }
        const float* md = (const float*)(F.ws + WS_MOD) + (size_t)(l * 3 + v) * 6144;
        f32x4 xv[8]; float s = 0.f;
#pragma unroll
        for (int j = 0; j < 8; ++j) { xv[j] = ((const f32x4*)src)[lane + 64 * j]; s += (xv[j].x * xv[j].x + xv[j].y * xv[j].y) + (xv[j].z * xv[j].z + xv[j].w * xv[j].w); }
        const float rs = rsqrtf(wave_sum(s) * (1.f / DM) + EPS);
#pragma unroll
        for (int j = 0; j < 8; ++j) { const int q = lane + 64 * j;
            const f32x4 g = ((const f32x4*)gp)[q], sh = ((const f32x4*)md)[q], sc = ((const f32x4*)(md + DM))[q];
            const f32x4 y = (xv[j] * rs) * g * (sc + 1.f) + sh;
            v2u o; o.x = pk2(y.x, y.y); o.y = pk2(y.z, y.w);
            *(v2u*)(H + (size_t)row * DM + 4 * q) = o; }
    }
}

__device__ __forceinline__ void ph_rope(Frame& F) {
    FRESH_IDS
    bf16* PX = (bf16*)(F.ws + WS_PX);
    const float* ct = (const float*)(F.ws + WS_COS); const float* st = (const float*)(F.ws + WS_SIN);
    const unsigned total = (unsigned)NB * SEQ * 52 * 8;
    for (unsigned idx = (unsigned)(F.vcu * NWAVES * 64 + tid); idx < total; idx += (unsigned)(F.G * NWAVES * 64)) {
        const unsigned ch = idx & 7, hr = idx >> 3, hh = hr % 52, rowL = hr / 52, b = rowL / SEQ, t = rowL % SEQ;
        const int col = (hh < 4) ? (C_KA + hh * 128) : (hh < 20) ? (C_KB + (hh - 4) * 128) : (hh < 36) ? (C_QA + (hh - 20) * 128) : (C_QB + (hh - 36) * 128);
        bf16* p = PX + (size_t)(b * RPB + CTX + t) * INC + col + ch * 8;
        const v4u x1 = *(const v4u*)p, x2 = *(const v4u*)(p + 64);
        const f32x4 c0 = *(const f32x4*)(ct + t * 64 + ch * 8), c1 = *(const f32x4*)(ct + t * 64 + ch * 8 + 4);
        const f32x4 s0 = *(const f32x4*)(st + t * 64 + ch * 8), s1 = *(const f32x4*)(st + t * 64 + ch * 8 + 4);
        v4u y1, y2;
#define ROPE2(W, CA, SA, CB, SB) { const float a0 = bflo(x1.W), a1 = bfhi(x1.W), b0 = bflo(x2.W), b1 = bfhi(x2.W); \
            y1.W = pk2(a0 * CA - b0 * SA, a1 * CB - b1 * SB); y2.W = pk2(b0 * CA + a0 * SA, b1 * CB + a1 * SB); }
        ROPE2(x, c0.x, s0.x, c0.y, s0.y) ROPE2(y, c0.z, s0.z, c0.w, s0.w) ROPE2(z, c1.x, s1.x, c1.y, s1.y) ROPE2(w, c1.z, s1.z, c1.w, s1.w)
#undef ROPE2
        *(v4u*)p = y1; *(v4u*)(p + 64) = y2;
    }
}

__device__ __forceinline__ void ph_convert_win(Frame& F, int l) {
    FRESH_IDS
    LAS float* scr = (LAS float*)(F.lds + wave * 16384);
    constexpr int I_IN = (DM / 64) * (INC / 32);
    bf16* WinT = (bf16*)(F.ws + WS_WINT);
    GW_LOOP(it, I_IN) p0_transpose_item(F.w_in + (size_t)l * DM * INC, DM, INC, WinT, win_row_off(32 * (it % (INC / 32))), scr, it, lane);
}

__device__ __forceinline__ void ph_attn(Frame& F, int l, char* lds) {
    const att::bf16* PX = (const att::bf16*)(F.ws + WS_PX);
    att::bf16* OA = (att::bf16*)(F.ws + WS_S0);
    att::bf16* OB0 = (att::bf16*)(F.ws + WS_S0 + SLOT);
    const float NINF = -INFINITY;
    const int nB = 1024, nA = 1024, nC = (l == 0) ? 64 : 0;
    for (int u = F.vcu; u < nB + nA + nC; u += F.G) {
        if (u < nB) {
            const int hd = u >> 5, qb = u & 31, b = hd >> 4, h8 = (hd >> 1) & 7, m = hd & 1;
            const size_t qrow = (size_t)b * RPB + CTX + qb * 256, krow = (size_t)b * RPB;
            att::attn_body_v256(PX + qrow * INC + C_QB + (h8 * 2 + m) * 128, PX + krow * INC + C_KB + (h8 * 2 + m) * 128, PX + krow * INC + C_VB + h8 * 256,
                                OB0 + (size_t)m * (SLOT / 2) + qrow * DM + h8 * 256, RPB / 64, F.lds);
            __syncthreads();
        } else if (u < nB + nA) {
            const int v = u - nB, b = v >> 9, kvh = (v >> 7) & 3, qb = v & 127, q0 = qb * 64;
            const int lo = (q0 - 128 > 0) ? q0 - 128 : 0, he = (q0 + 192 < SEQ) ? q0 + 192 : SEQ, nloc = (he - lo) >> 6;
            const size_t qrow = (size_t)b * RPB + CTX + q0, krow = (size_t)b * RPB;
            att::attn_body_a(PX + qrow * INC + C_QA + kvh * 512, PX + krow * INC + C_KA + kvh * 128, PX + krow * INC + C_VA + kvh * 128,
                             OA + qrow * DM + kvh * 512, 4 + nloc, 4, lo, q0, F.sink + l * 16 + kvh * 4, F.lds);
            __syncthreads();
        } else {
            const int v = u - nB - nA;
            if (v < 32) {
                const int hd = v, b = hd >> 4, h8 = (hd >> 1) & 7, m = hd & 1; const size_t krow = (size_t)b * RPB;
                att::attn_body_v256(PX + krow * INC + C_QB + (h8 * 2 + m) * 128, PX + krow * INC + C_KB + (h8 * 2 + m) * 128, PX + krow * INC + C_VB + h8 * 256,
                                    OB0 + (size_t)m * (SLOT / 2) + krow * DM + h8 * 256, 4, F.lds);
                __syncthreads();
            } else {
                const int w = v - 32, b = w >> 4, kvh = (w >> 2) & 3, cb = w & 3; const size_t krow = (size_t)b * RPB, qrow = krow + cb * 64;
                att::attn_body_a(PX + qrow * INC + C_QA + kvh * 512, PX + krow * INC + C_KA + kvh * 128, PX + krow * INC + C_VA + kvh * 128,
                                 OA + qrow * DM + kvh * 512, 4, 4, 0, 0, F.sink + l * 16 + kvh * 4, F.lds);
                __syncthreads();
            }
        }
    }
}

__device__ __forceinline__ void ph_post(Frame& F, int l) {
    FRESH_IDS
    const bf16* PX = (const bf16*)(F.ws + WS_PX);
    const bf16* OA = (const bf16*)(F.ws + WS_S0); const bf16* OB0 = (const bf16*)(F.ws + WS_S0 + SLOT); const bf16* OB1 = (const bf16*)(F.ws + WS_S0 + 2 * SLOT);
    bf16* GA = (bf16*)(F.ws + WS_S0 + 3 * SLOT); bf16* GB = (bf16*)(F.ws + WS_S0 + 4 * SLOT);
    const float lam_init = 0.8f - 0.6f * expf(-0.3f * (float)l);
    const float* lq = F.lam_qk + (size_t)l * 512;
    const float d1 = wave_sum(lq[lane] * lq[128 + lane] + lq[64 + lane] * lq[192 + lane]);
    const float d2 = wave_sum(lq[256 + lane] * lq[384 + lane] + lq[320 + lane] * lq[448 + lane]);
    const float lam = expf(d1) - expf(d2) + lam_init;
    const f32x4 gs = ((const f32x4*)(F.g_subln + (size_t)l * 256))[lane] * (1.f - lam_init);
    GW_LOOP(row, MROWS) {
        if (l != 0 && (row % RPB) < CTX) continue;
        const size_t ro = (size_t)row * DM, rp = (size_t)row * INC;
#pragma unroll
        for (int j = 0; j < 8; ++j) { const int c = 4 * (lane + 64 * j);
            const v2u oa = *(const v2u*)(OA + ro + c), za = *(const v2u*)(PX + rp + C_ZA + c);
            v2u o; o.x = pk2(bflo(oa.x) * siluf(bflo(za.x)), bfhi(oa.x) * siluf(bfhi(za.x))); o.y = pk2(bflo(oa.y) * siluf(bflo(za.y)), bfhi(oa.y) * siluf(bfhi(za.y)));
            *(v2u*)(GA + ro + c) = o; }
#pragma unroll
        for (int j = 0; j < 8; ++j) { const int c = 256 * j + 4 * lane;
            const v2u o0 = *(const v2u*)(OB0 + ro + c), o1 = *(const v2u*)(OB1 + ro + c), zb = *(const v2u*)(PX + rp + C_ZB + c);
            f32x4 d; d.x = bflo(o0.x) - lam * bflo(o1.x); d.y = bfhi(o0.x) - lam * bfhi(o1.x); d.z = bflo(o0.y) - lam * bflo(o1.y); d.w = bfhi(o0.y) - lam * bfhi(o1.y);
            const float ss = wave_sum((d.x * d.x + d.y * d.y) + (d.z * d.z + d.w * d.w));
            const float rs = rsqrtf(ss * (1.f / 256.f) + EPS);
            const f32x4 y = d * rs * gs;
            v2u o; o.x = pk2(y.x * siluf(bflo(zb.x)), y.y * siluf(bfhi(zb.x))); o.y = pk2(y.z * siluf(bflo(zb.y)), y.w * siluf(bfhi(zb.y)));
            *(v2u*)(GB + ro + c) = o; }
    }
}

__device__ __forceinline__ void ph_merge(Frame& F, int l) {
    FRESH_IDS
    const bf16* PX = (const bf16*)(F.ws + WS_PX);
    const bf16* YA = (const bf16*)(F.ws + WS_S0); const bf16* YB = (const bf16*)(F.ws + WS_S0 + SLOT); bf16* MG = (bf16*)(F.ws + WS_S0 + 2 * SLOT);
    const unsigned total = (unsigned)MROWS * (DM / 8);
    for (unsigned i = (unsigned)(F.vcu * NWAVES * 64 + tid); i < total; i += (unsigned)(F.G * NWAVES * 64)) {
        const unsigned row = i >> 8, c = (i & 255) * 8;
        if (l != 0 && (row % RPB) < CTX) continue;
        const v4u ya = *(const v4u*)(YA + (size_t)row * DM + c), yb = *(const v4u*)(YB + (size_t)row * DM + c);
        const v4u ga = *(const v4u*)(PX + (size_t)row * INC + C_GA + c), gb = *(const v4u*)(PX + (size_t)row * INC + C_GB + c);
        v4u o;
#define MRG(W) o.W = pk2(sigmf(bflo(ga.W)) * bflo(ya.W) + sigmf(bflo(gb.W)) * bflo(yb.W), sigmf(bfhi(ga.W)) * bfhi(ya.W) + sigmf(bfhi(gb.W)) * bfhi(yb.W));
        MRG(x) MRG(y) MRG(z) MRG(w)
#undef MRG
        *(v4u*)(MG + (size_t)row * DM + c) = o;
    }
}

__device__ __forceinline__ void ph_res(Frame& F, int l, const float* xcur, const float* ctxcur) {
    FRESH_IDS
    const bf16* OX = (const bf16*)(F.ws + WS_S0 + 3 * SLOT);
    bf16* H = (bf16*)(F.ws + WS_S0);
    const float* gp = F.g_post + (size_t)l * DM;
    const bool nxt = (l + 1 < DEPTH);
    const float* gpn = F.g_pre + (size_t)(l + 1) * DM;
    GW_LOOP(row, MROWS) {
        const int b = row / RPB, rr = row % RPB; const float* src; float* dst; int v;
        if (rr < CTX) { if (!nxt) continue; src = ctxcur + (size_t)(b * CTX + rr) * DM; dst = nullptr; v = 2; }
        else { src = xcur + (size_t)(b * SEQ + rr - CTX) * DM; dst = F.out + (size_t)(b * SEQ + rr - CTX) * DM; v = b; }
        const float* gt = (const float*)(F.ws + WS_MOD) + (size_t)(l * 3 + v) * 6144 + 2 * DM;
        f32x4 ov[8]; float s = 0.f;
#pragma unroll
        for (int j = 0; j < 8; ++j) { const v2u w = *(const v2u*)(OX + (size_t)row * DM + 4 * (lane + 64 * j));
            ov[j] = (f32x4){bflo(w.x), bfhi(w.x), bflo(w.y), bfhi(w.y)}; s += (ov[j].x * ov[j].x + ov[j].y * ov[j].y) + (ov[j].z * ov[j].z + ov[j].w * ov[j].w); }
        const float rs = rsqrtf(wave_sum(s) * (1.f / DM) + EPS);
        float s2 = 0.f;
#pragma unroll
        for (int j = 0; j < 8; ++j) { const int q = lane + 64 * j;
            const f32x4 g = ((const f32x4*)gp)[q], gate = ((const f32x4*)gt)[q], xr = ((const f32x4*)src)[q];
            ov[j] = xr + gate * ((ov[j] * rs) * g);
            if (dst) ((f32x4*)dst)[q] = ov[j];
            s2 += (ov[j].x * ov[j].x + ov[j].y * ov[j].y) + (ov[j].z * ov[j].z + ov[j].w * ov[j].w); }
        if (nxt) {
            const float* md = (const float*)(F.ws + WS_MOD) + (size_t)((l + 1) * 3 + v) * 6144;
            const float rs2 = rsqrtf(wave_sum(s2) * (1.f / DM) + EPS);
#pragma unroll
            for (int j = 0; j < 8; ++j) { const int q = lane + 64 * j;
                const f32x4 g = ((const f32x4*)gpn)[q], sh = ((const f32x4*)md)[q], sc = ((const f32x4*)(md + DM))[q];
                const f32x4 y = (ov[j] * rs2) * g * (sc + 1.f) + sh;
                v2u o; o.x = pk2(y.x, y.y); o.y = pk2(y.z, y.w);
                *(v2u*)(H + (size_t)row * DM + 4 * q) = o; }
        }
    }
}

__device__ __forceinline__ void run_gemm_in(Frame& F, const bf16* A, const bf16* Bt, bf16* O) {
    pg8::Gemm g{A, Bt, MROWS, INC, DM}; pg8::RowSkipOrder S; S.init(INC, F.G, (int)blockIdx.x, false);
    pg8::EpiRope E{O, INC, (const float*)(F.ws + WS_COS), (const float*)(F.ws + WS_SIN)};
    pg8::gemm_phase<pg8::EpiRope, pg8::RowSkipOrder, true, true>(F.lds, g, S, E);
}
__device__ __forceinline__ void run_gemm_skip(Frame& F, const bf16* A, const bf16* Bt, bf16* O, bool skip) {
    pg8::Gemm g{A, Bt, MROWS, DM, DM}; pg8::RowSkipOrder S; S.init(DM, F.G, (int)blockIdx.x, skip);
    pg8::EpiBf16 E{O, DM};
    pg8::gemm_phase<pg8::EpiBf16, pg8::RowSkipOrder, true, true>(F.lds, g, S, E);
}
template <bool ADD>
__device__ __forceinline__ void run_gemm_gate(Frame& F, const bf16* A, const bf16* Bt, bf16* O, const bf16* T, const bf16* G, bool skip) {
    const int cid = ADD ? (int)((blockIdx.x + F.G / 2) % F.G) : (int)blockIdx.x;
    pg8::Gemm g{A, Bt, MROWS, DM, DM}; pg8::RowSkipOrder S; S.init(DM, F.G, cid, skip);
    pg8::EpiGate<ADD> E{O, T, G, DM, INC};
    pg8::gemm_phase<pg8::EpiGate<ADD>, pg8::RowSkipOrder, true, true>(F.lds, g, S, E);
}

struct Args { const float* in[15]; float* out; unsigned char* ws; };
__global__ void __launch_bounds__(NWAVES * 64, 2) fwd_mega(Args args) {
    extern __shared__ __attribute__((aligned(16))) unsigned char lds[];
    cg::grid_group grid = cg::this_grid();
    Frame F;
    F.lds = (LAS unsigned char*)lds;
    F.G = gridDim.x; { const int bx = blockIdx.x; F.vcu = (F.G % 8 == 0) ? (bx % 8) * (F.G / 8) + bx / 8 : bx; }
    F.x = args.in[0]; F.c = args.in[1]; F.ctx = args.in[2]; F.c_ctx = args.in[3]; F.w_ada = args.in[4]; F.b_ada = args.in[5]; F.g_pre = args.in[6]; F.g_post = args.in[7];
    F.w_in = args.in[8]; F.sink = args.in[9]; F.lam_qk = args.in[10]; F.g_subln = args.in[11]; F.w_pa = args.in[12]; F.w_pb = args.in[13]; F.w_out = args.in[14];
    F.out = args.out; F.ws = args.ws;
    volatile LAS unsigned* MISC = (volatile LAS unsigned*)(F.lds + 131072 + 320);
    if (threadIdx.x < 32) MISC[threadIdx.x] = 0u;
    __syncthreads();
    const XcdBarrier bar = xcd_barrier_post((unsigned*)(F.ws + WS_BAR), MISC + 8);
    bf16* WinT = (bf16*)(F.ws + WS_WINT); bf16* WpT = (bf16*)(F.ws + WS_WPT); bf16* PX = (bf16*)(F.ws + WS_PX);
    bf16* S0 = (bf16*)(F.ws + WS_S0); bf16* S1 = (bf16*)(F.ws + WS_S0 + SLOT); bf16* S2 = (bf16*)(F.ws + WS_S0 + 2 * SLOT); bf16* S3 = (bf16*)(F.ws + WS_S0 + 3 * SLOT); bf16* S4 = (bf16*)(F.ws + WS_S0 + 4 * SLOT);

    ph_prologue(F);
    grid.sync();
#pragma unroll 1
    for (int l = 0; l < DEPTH; ++l) {
        const float* xcur = (l == 0) ? F.x : F.out;
        const float* ctxcur = (l == 0) ? F.ctx : (const float*)(F.ws + WS_CTX1);
        if (l == 0) { ph_hnorm(F, l, xcur, ctxcur); xcd_barrier(bar); }
        run_gemm_in(F, S0, WinT, PX);
        xcd_barrier(bar);
        ph_attn(F, l, (char*)lds);
        xcd_barrier(bar);
        ph_post(F, l);
        if (l + 1 < DEPTH) ph_convert_win(F, l + 1);
        xcd_barrier(bar);
        run_gemm_gate<false>(F, S3, WpT + (size_t)(l * 3 + 0) * DM * DM, S0, S0, PX + C_GA, l != 0);
        xcd_barrier(bar);
        run_gemm_gate<true>(F, S4, WpT + (size_t)(l * 3 + 1) * DM * DM, S2, S0, PX + C_GB, l != 0);
        xcd_barrier(bar);
        run_gemm_skip(F, S2, WpT + (size_t)(l * 3 + 2) * DM * DM, S3, l != 0);
        xcd_barrier(bar);
        ph_res(F, l, xcur, ctxcur);
        if (l + 1 < DEPTH) xcd_barrier(bar);
    }
}

extern "C" void kernel_launch(void* const* d_in, const int* in_sizes, int n_in, void* d_out, int out_size, void* d_ws, size_t ws_size, hipStream_t stream) {
    static int grid = 0;
    if (grid == 0) {
        if (n_in != 15 || out_size != NB * SEQ * DM || ws_size < WS_END) { fprintf(stderr, "kernel_launch: unexpected shapes: n_in %d out %d ws %zu (need %zu)\n", n_in, out_size, ws_size, (size_t)WS_END); grid = -1; return; }
        int dev = 0, cus = 0, per_cu = 0;
        if (hipGetDevice(&dev) != hipSuccess || hipDeviceGetAttribute(&cus, hipDeviceAttributeMultiprocessorCount, dev) != hipSuccess) { grid = -1; return; }
        if (hipFuncSetAttribute((const void*)fwd_mega, hipFuncAttributeMaxDynamicSharedMemorySize, LDS_BYTES) != hipSuccess) { fprintf(stderr, "kernel_launch: hipFuncSetAttribute failed\n"); grid = -1; return; }
        if (hipOccupancyMaxActiveBlocksPerMultiprocessor(&per_cu, (const void*)fwd_mega, NWAVES * 64, LDS_BYTES) != hipSuccess || per_cu < 1) { fprintf(stderr, "kernel_launch: occupancy query says %d\n", per_cu); per_cu = 1; }
        (void)hipGetLastError();
        grid = cus * per_cu;
    }
    if (grid < 0) return;
    if (hipMemsetAsync((char*)d_ws + WS_BAR, 0, WS_BAR_BYTES, stream) != hipSuccess) { fprintf(stderr, "kernel_launch: memset of the barrier words failed\n"); return; }
    Args a{};
    for (int i = 0; i < 15; ++i) a.in[i] = (const float*)d_in[i];
    a.out = (float*)d_out; a.ws = (unsigned char*)d_ws;
    void* kargs[] = {&a};
    hipError_t e = hipLaunchCooperativeKernel((const void*)fwd_mega, dim3(grid), dim3(NWAVES * 64), kargs, LDS_BYTES, stream);
    if (e != hipSuccess) fprintf(stderr, "kernel_launch: cooperative launch failed: %s (grid %d)\n", hipGetErrorString(e), grid);
}
```

```cpp
#include <hip/hip_runtime.h>
#include <hip/hip_bf16.h>
#include <hip/hip_cooperative_groups.h>
#include <cstdio>
#include <cstdint>
#include <cmath>
namespace cg = cooperative_groups;

constexpr int DM = 2048, NB = 2, SEQ = 8192, DEPTH = 2, CTX = 256;
constexpr int RPB = CTX + SEQ;
constexpr int MROWS = NB * RPB;
constexpr int INC = 17408;
constexpr int C_KA = 0, C_VA = 512, C_KB = 1024, C_VB = 3072, C_QA = 5120, C_ZA = 7168, C_QB = 9216, C_ZB = 11264, C_GA = 13312, C_GB = 15360;
constexpr float EPS = 1e-6f;

namespace pg8 {
#define PG8_LAS __attribute__((address_space(3)))
typedef unsigned short bf16_t;
typedef short bf16x8 __attribute__((ext_vector_type(8)));
typedef float f32x4 __attribute__((ext_vector_type(4)));
typedef unsigned u32x4 __attribute__((ext_vector_type(4)));
constexpr int BM = 256, BK = 64, HALF = 128, HTB = HALF * BK * 2  , STAGE_BYTES = 8 * HTB, NXCD = 8, WGM = 8;

__host__ __device__ __forceinline__ int lds_byte(int r, int c) { const int st = (r >> 4) * 2 + (c >> 5), rr = r & 15, cc = c & 31, ob = rr * 64 + cc * 2; return st * 1024 + (ob ^ (((ob >> 9) & 1) << 5)); }
__host__ __device__ __forceinline__ void stage_rc(int b, int& R, int& C) { const int st = b / 1024, sb = b % 1024, swz = sb ^ (((sb >> 9) & 1) << 5); R = (st >> 1) * 16 + swz / 64; C = (st & 1) * 32 + (swz % 64) / 2; }
__host__ __device__ __forceinline__ int perm32(int rho) { const int n = rho >> 4, i = rho & 15; return 8 * (i >> 2) + 4 * n + (i & 3); }

struct Unit { int pm, pn; };
struct Gemm { const bf16_t* A; const bf16_t* Bt; int M, N, K; };

struct StaticOrder {
    int nM, nN, nwg, G, c;
    __host__ __device__ void init(int M, int N, int G_, int c_) { nM = M / BM; nN = N / BM; nwg = nM * nN; G = G_; c = c_; }
    __host__ __device__ bool next(int i, Unit& u) const {
        const long L = (long)i * G + c; if (L >= nwg) return false;
        int wgid = (int)L; { const int q = nwg / NXCD, r = nwg % NXCD, xcd = wgid % NXCD, off = wgid / NXCD; wgid = (xcd < r ? xcd * (q + 1) : r * (q + 1) + (xcd - r) * q) + off; }
        const int nig = WGM * nN, gid = wgid / nig, fm = gid * WGM, gsz = (nM - fm) < WGM ? (nM - fm) : WGM;
        u.pm = fm + ((wgid % nig) % gsz); u.pn = (wgid % nig) / gsz; return true;
    }
    __device__ __forceinline__ void a_ready(const Unit&) const {}
    __device__ __forceinline__ void done(const Unit&) const {}
};

__device__ __forceinline__ unsigned cvt_pk_bf16(float lo, float hi) { unsigned r; asm volatile("v_cvt_pk_bf16_f32 %0, %1, %2" : "=v"(r) : "v"(lo), "v"(hi)); return r; }
typedef float f32x2 __attribute__((ext_vector_type(2)));

struct EpiBf16 {
    static constexpr bool PERM = true, AFTER_DRAIN = false;
    bf16_t* O; int ldc;
    __device__ __forceinline__ void operator()(const f32x4 (&acc)[2][2][4][2], const Unit& u, int wr, int wc, int fr, int fq) const {
        const int row0 = u.pm * BM + wr * 64 + fr; const int col0 = u.pn * BM + wc * 32 + 8 * fq;
#pragma unroll
        for (int ai = 0; ai < 2; ++ai)
#pragma unroll
            for (int m = 0; m < 4; ++m) { bf16_t* rowp = O + (size_t)(row0 + ai * HALF + m * 16) * ldc + col0;
#pragma unroll
                for (int bj = 0; bj < 2; ++bj) { const f32x4 v0 = acc[ai][bj][m][0], v1 = acc[ai][bj][m][1];
                    u32x4 w; w.x = cvt_pk_bf16(v0[0], v0[1]); w.y = cvt_pk_bf16(v0[2], v0[3]); w.z = cvt_pk_bf16(v1[0], v1[1]); w.w = cvt_pk_bf16(v1[2], v1[3]);
                    *(u32x4*)(rowp + bj * HALF) = w; } }
    }
};

__device__ __forceinline__ float sigm_(float x) { return 1.f / (1.f + __expf(-x)); }
__device__ __forceinline__ float blo_(unsigned w) { return __builtin_bit_cast(float, w << 16); }
__device__ __forceinline__ float bhi_(unsigned w) { return __builtin_bit_cast(float, w & 0xffff0000u); }
template <bool ADD> struct EpiGate {
    static constexpr bool PERM = true, AFTER_DRAIN = false;
    bf16_t* O; const bf16_t* T; const bf16_t* G; int ldc; int ldg;
    __device__ __forceinline__ void operator()(const f32x4 (&acc)[2][2][4][2], const Unit& u, int wr, int wc, int fr, int fq) const {
        const int row0 = u.pm * BM + wr * 64 + fr; const int col0 = u.pn * BM + wc * 32 + 8 * fq;
#pragma unroll
        for (int ai = 0; ai < 2; ++ai)
#pragma unroll
            for (int m = 0; m < 4; ++m) { const size_t row = (size_t)(row0 + ai * HALF + m * 16);
#pragma unroll
                for (int bj = 0; bj < 2; ++bj) { const f32x4 v0 = acc[ai][bj][m][0], v1 = acc[ai][bj][m][1];
                    const u32x4 g = *(const u32x4*)(G + row * ldg + col0 + bj * HALF);
                    float r0 = sigm_(blo_(g.x)) * v0[0], r1 = sigm_(bhi_(g.x)) * v0[1], r2 = sigm_(blo_(g.y)) * v0[2], r3 = sigm_(bhi_(g.y)) * v0[3];
                    float r4 = sigm_(blo_(g.z)) * v1[0], r5 = sigm_(bhi_(g.z)) * v1[1], r6 = sigm_(blo_(g.w)) * v1[2], r7 = sigm_(bhi_(g.w)) * v1[3];
                    if (ADD) { const u32x4 t = *(const u32x4*)(T + row * ldc + col0 + bj * HALF);
                        r0 += blo_(t.x); r1 += bhi_(t.x); r2 += blo_(t.y); r3 += bhi_(t.y); r4 += blo_(t.z); r5 += bhi_(t.z); r6 += blo_(t.w); r7 += bhi_(t.w); }
                    u32x4 w; w.x = cvt_pk_bf16(r0, r1); w.y = cvt_pk_bf16(r2, r3); w.z = cvt_pk_bf16(r4, r5); w.w = cvt_pk_bf16(r6, r7);
                    *(u32x4*)(O + row * ldc + col0 + bj * HALF) = w; } }
    }
};
struct RowSkipOrder {
    StaticOrder base; bool skip;
    __device__ void init(int N, int G_, int c_, bool skip_) { skip = skip_; base.init(skip_ ? 16384 : 16896, N, G_, c_); }
    __device__ bool next(int i, Unit& u) const { if (!base.next(i, u)) return false; if (skip) u.pm += 1 + (u.pm >= 32 ? 1 : 0); return true; }
    __device__ __forceinline__ void a_ready(const Unit&) const {}
    __device__ __forceinline__ void done(const Unit&) const {}
};

struct EpiRope {
    static constexpr bool PERM = true, AFTER_DRAIN = false;
    bf16_t* O; int ldc; const float* ct; const float* st;
    __device__ __forceinline__ void operator()(const f32x4 (&acc)[2][2][4][2], const Unit& u, int wr, int wc, int fr, int fq) const {
        const int pn = u.pn; const bool rope = pn < 2 || (pn >= 4 && pn < 12) || (pn >= 20 && pn < 28) || (pn >= 36 && pn < 44);
        const int row0 = u.pm * BM + wr * 64 + fr;
        if (!rope) {
            const int col0 = pn * BM + wc * 32 + 8 * fq;
#pragma unroll
            for (int ai = 0; ai < 2; ++ai)
#pragma unroll
                for (int m = 0; m < 4; ++m) { bf16_t* rowp = O + (size_t)(row0 + ai * HALF + m * 16) * ldc + col0;
#pragma unroll
                    for (int bj = 0; bj < 2; ++bj) { const f32x4 v0 = acc[ai][bj][m][0], v1 = acc[ai][bj][m][1];
                        u32x4 w; w.x = cvt_pk_bf16(v0[0], v0[1]); w.y = cvt_pk_bf16(v0[2], v0[3]); w.z = cvt_pk_bf16(v1[0], v1[1]); w.w = cvt_pk_bf16(v1[2], v1[3]);
                        *(u32x4*)(rowp + bj * HALF) = w; } }
            return;
        }
        const bool isctx = (u.pm == 0) || (u.pm == 33);
        const int i0 = 32 * (wc & 1) + 8 * fq, ocol = pn * BM + (wc >> 1) * 128 + i0;
        const int tbase = row0 - (u.pm >= 33 ? 8448 : 0) - 256;
#pragma unroll
        for (int ai = 0; ai < 2; ++ai)
#pragma unroll
            for (int m = 0; m < 4; ++m) { const int t = tbase + ai * HALF + m * 16;
                f32x4 c0 = {1.f, 1.f, 1.f, 1.f}, c1 = c0, s0 = {0.f, 0.f, 0.f, 0.f}, s1 = s0;
                if (!isctx) { const float* cp = ct + (size_t)t * 64 + i0; const float* sp = st + (size_t)t * 64 + i0;
                    c0 = *(const f32x4*)cp; c1 = *(const f32x4*)(cp + 4); s0 = *(const f32x4*)sp; s1 = *(const f32x4*)(sp + 4); }
                const f32x4 a0 = acc[ai][0][m][0], a1 = acc[ai][0][m][1], b0 = acc[ai][1][m][0], b1 = acc[ai][1][m][1];
                const f32x4 y0 = a0 * c0 - b0 * s0, y1 = a1 * c1 - b1 * s1, z0 = b0 * c0 + a0 * s0, z1 = b1 * c1 + a1 * s1;
                bf16_t* rowp = O + (size_t)(row0 + ai * HALF + m * 16) * ldc + ocol;
                u32x4 w; w.x = cvt_pk_bf16(y0[0], y0[1]); w.y = cvt_pk_bf16(y0[2], y0[3]); w.z = cvt_pk_bf16(y1[0], y1[1]); w.w = cvt_pk_bf16(y1[2], y1[3]);
                *(u32x4*)rowp = w;
                u32x4 x; x.x = cvt_pk_bf16(z0[0], z0[1]); x.y = cvt_pk_bf16(z0[2], z0[3]); x.z = cvt_pk_bf16(z1[0], z1[1]); x.w = cvt_pk_bf16(z1[2], z1[3]);
                *(u32x4*)(rowp + 64) = x; }
    }
};

template <class Epi, class Sched, bool ALIGN_EPI = false, bool SP2 = false>
__device__ __forceinline__ void gemm_phase(PG8_LAS unsigned char* lds, const Gemm g, const Sched& S, const Epi& E) {
    int tid_ = threadIdx.x; asm volatile("" : "+v"(tid_));
    const int tid = tid_, wid = __builtin_amdgcn_readfirstlane(tid >> 6), lane = tid & 63, wr = wid >> 2, wc = wid & 3, fr = lane & 15, fq = lane >> 4;
    const int K = g.K, nt = K / BK;
    unsigned voffA[2], voffB[2];
#pragma unroll
    for (int i = 0; i < 2; ++i) { int R, C; stage_rc(tid * 16 + i * 8192, R, C); const int Rb = Epi::PERM ? ((R & ~31) + perm32(R & 31)) : R;
        voffA[i] = (unsigned)(R * K + C) * 2u; voffB[i] = (unsigned)(Rb * K + C) * 2u; }
    const size_t kstep = (size_t)(BK * 2);
    const size_t hstep = (size_t)HALF * K * 2;
    const size_t tstep = 2 * hstep;
    const unsigned ldsw = (unsigned)wid * 1024u;
    const int aoff = lds_byte(wr * 64 + fr, fq * 8), boff = lds_byte(wc * 32 + fr, fq * 8);
#define PG8_SA(b, h) (((b) * 2 + (h)) * HTB)
#define PG8_SB(b, h) ((4 + (b) * 2 + (h)) * HTB)
#define PG8_STAGE(bufoff, gbase, voff) do { _Pragma("unroll") for (int _i = 0; _i < 2; ++_i) \
        __builtin_amdgcn_global_load_lds((const unsigned*)((const char*)(gbase) + (voff)[_i]), (PG8_LAS unsigned*)(lds + (bufoff) + ldsw + _i * 8192), 16, 0, 0); } while (0)
#define PG8_LDA(dst, b, h) do { _Pragma("unroll") for (int m = 0; m < 4; ++m) _Pragma("unroll") for (int k = 0; k < 2; ++k) dst[m][k] = *(const PG8_LAS bf16x8*)(lds + PG8_SA(b, h) + aoff + m * 2048 + k * 1024); } while (0)
#define PG8_LDB(dst, b, h) do { _Pragma("unroll") for (int n = 0; n < 2; ++n) _Pragma("unroll") for (int k = 0; k < 2; ++k) dst[n][k] = *(const PG8_LAS bf16x8*)(lds + PG8_SB(b, h) + boff + n * 2048 + k * 1024); } while (0)
#define PG8_MMA(ai, bj, At, Bt) do { __builtin_amdgcn_s_setprio(1); _Pragma("unroll") for (int m = 0; m < 4; ++m) _Pragma("unroll") for (int n = 0; n < 2; ++n) _Pragma("unroll") for (int k = 0; k < 2; ++k) \
        acc[ai][bj][m][n] = __builtin_amdgcn_mfma_f32_16x16x32_bf16(Bt[n][k], At[m][k], acc[ai][bj][m][n], 0, 0, 0); __builtin_amdgcn_s_setprio(0); } while (0)
#define PG8_WAIT_V(n) asm volatile("s_waitcnt vmcnt(" #n ")" ::: "memory")
#define PG8_WAIT_L(n) asm volatile("s_waitcnt lgkmcnt(" #n ")" ::: "memory")
#define PG8_BAR __builtin_amdgcn_s_barrier()
#define PG8_SCHED __builtin_amdgcn_sched_barrier(0)
    Unit cur, nxt; int ui = 0;
    if (!S.next(0, cur)) return;
    f32x4 acc[2][2][4][2];
#pragma unroll
    for (int a = 0; a < 2; ++a)
#pragma unroll
        for (int b = 0; b < 2; ++b)
#pragma unroll
            for (int m = 0; m < 4; ++m)
#pragma unroll
                for (int n = 0; n < 2; ++n) acc[a][b][m][n] = (f32x4){0.f, 0.f, 0.f, 0.f};
    bf16x8 At[4][2], B0[2][2], B1[2][2];
    const char* cA = (const char*)g.A + (size_t)cur.pm * tstep; const char* cB = (const char*)g.Bt + (size_t)cur.pn * tstep;
    S.a_ready(cur);
    if constexpr (SP2) {
        PG8_STAGE(PG8_SB(0, 0), cB, voffB); PG8_STAGE(PG8_SB(0, 1), cB + hstep, voffB); PG8_STAGE(PG8_SA(0, 0), cA, voffA); PG8_STAGE(PG8_SA(0, 1), cA + hstep, voffA);
        if (wr == 1) PG8_BAR;
        PG8_WAIT_V(2); PG8_BAR;
        PG8_STAGE(PG8_SB(1, 0), cB + kstep, voffB); PG8_STAGE(PG8_SA(1, 0), cA + kstep, voffA); PG8_STAGE(PG8_SB(1, 1), cB + hstep + kstep, voffB);
        PG8_WAIT_V(6); PG8_BAR;
    } else {
        PG8_STAGE(PG8_SB(0, 0), cB, voffB); PG8_STAGE(PG8_SA(0, 0), cA, voffA); PG8_STAGE(PG8_SB(0, 1), cB + hstep, voffB); PG8_STAGE(PG8_SA(0, 1), cA + hstep, voffA);
        if (wr == 1) PG8_BAR;
        PG8_WAIT_V(4); PG8_BAR;
        PG8_STAGE(PG8_SB(1, 0), cB + kstep, voffB); PG8_STAGE(PG8_SA(1, 0), cA + kstep, voffA); PG8_STAGE(PG8_SB(1, 1), cB + hstep + kstep, voffB);
        PG8_WAIT_V(6); PG8_BAR;
    }
    for (;;) {
        const bool has_next = S.next(ui + 1, nxt);
        const char* nA = has_next ? (const char*)g.A + (size_t)nxt.pm * tstep : cA; const char* nB = has_next ? (const char*)g.Bt + (size_t)nxt.pn * tstep : cB;
        for (int t = 0; t < nt; t += 2) {
            const bool last = (t == nt - 2);
            const char* a1 = cA + (size_t)(t + 1) * kstep;
            const char* a2 = last ? nA : cA + (size_t)(t + 2) * kstep; const char* b2 = last ? nB : cB + (size_t)(t + 2) * kstep;
            const char* a3 = a2 + kstep; const char* b3 = b2 + kstep;
            if (last && has_next) S.a_ready(nxt);
            if constexpr (SP2) {
            PG8_LDB(B0, 0, 0); PG8_LDB(B1, 0, 1); PG8_SCHED; PG8_LDA(At, 0, 0); PG8_STAGE(PG8_SA(1, 1), a1 + hstep, voffA);
            PG8_WAIT_V(8); PG8_WAIT_L(0); PG8_BAR; PG8_MMA(0, 0, At, B0); PG8_MMA(0, 1, At, B1); PG8_BAR; PG8_SCHED;
            PG8_LDA(At, 0, 1); PG8_STAGE(PG8_SB(0, 0), b2, voffB); PG8_STAGE(PG8_SB(0, 1), b2 + hstep, voffB); PG8_STAGE(PG8_SA(0, 0), a2, voffA);
            PG8_WAIT_V(8); PG8_WAIT_L(0); PG8_BAR; PG8_MMA(1, 0, At, B0); PG8_MMA(1, 1, At, B1); PG8_BAR; PG8_SCHED;
            PG8_LDB(B0, 1, 0); PG8_LDB(B1, 1, 1); PG8_SCHED; PG8_LDA(At, 1, 0); PG8_STAGE(PG8_SA(0, 1), a2 + hstep, voffA);
            PG8_WAIT_V(8); PG8_WAIT_L(0); PG8_BAR; PG8_MMA(0, 0, At, B0); PG8_MMA(0, 1, At, B1); PG8_BAR; PG8_SCHED;
            PG8_LDA(At, 1, 1); PG8_STAGE(PG8_SB(1, 0), b3, voffB); PG8_STAGE(PG8_SB(1, 1), b3 + hstep, voffB); PG8_STAGE(PG8_SA(1, 0), a3, voffA);
            PG8_WAIT_V(8); PG8_WAIT_L(0); PG8_BAR; PG8_MMA(1, 0, At, B0); PG8_MMA(1, 1, At, B1); PG8_BAR; PG8_SCHED;
            } else {
            PG8_LDB(B0, 0, 0); PG8_SCHED; PG8_LDA(At, 0, 0); PG8_STAGE(PG8_SA(1, 1), a1 + hstep, voffA);
            PG8_WAIT_L(8); PG8_BAR; PG8_WAIT_L(0); PG8_MMA(0, 0, At, B0); PG8_BAR; PG8_SCHED;
            PG8_LDB(B1, 0, 1); PG8_STAGE(PG8_SB(0, 0), b2, voffB);
            PG8_BAR; PG8_WAIT_L(0); PG8_MMA(0, 1, At, B1); PG8_BAR;
            PG8_LDA(At, 0, 1); PG8_STAGE(PG8_SA(0, 0), a2, voffA);
            PG8_BAR; PG8_WAIT_L(0); PG8_MMA(1, 0, At, B0); PG8_BAR; PG8_SCHED;
            PG8_STAGE(PG8_SB(0, 1), b2 + hstep, voffB);
            PG8_WAIT_V(6); PG8_BAR; PG8_MMA(1, 1, At, B1); PG8_BAR;
            PG8_LDB(B0, 1, 0); PG8_SCHED; PG8_LDA(At, 1, 0); PG8_STAGE(PG8_SA(0, 1), a2 + hstep, voffA);
            PG8_WAIT_L(8); PG8_BAR; PG8_WAIT_L(0); PG8_MMA(0, 0, At, B0); PG8_BAR; PG8_SCHED;
            PG8_LDB(B1, 1, 1); PG8_STAGE(PG8_SB(1, 0), b3, voffB);
            PG8_BAR; PG8_WAIT_L(0); PG8_MMA(0, 1, At, B1); PG8_BAR;
            PG8_LDA(At, 1, 1); PG8_STAGE(PG8_SA(1, 0), a3, voffA);
            PG8_BAR; PG8_WAIT_L(0); PG8_MMA(1, 0, At, B0); PG8_BAR; PG8_SCHED;
            PG8_STAGE(PG8_SB(1, 1), b3 + hstep, voffB);
            PG8_WAIT_V(6); PG8_BAR; PG8_MMA(1, 1, At, B1); PG8_BAR;
            }
        }
        if constexpr (ALIGN_EPI) { if (wr == 0) PG8_BAR; }
        if constexpr (!Epi::AFTER_DRAIN) { E(acc, cur, wr, wc, fr, fq); S.done(cur); }
        if (!has_next) break;
#pragma unroll
        for (int a = 0; a < 2; ++a)
#pragma unroll
            for (int b = 0; b < 2; ++b)
#pragma unroll
                for (int m = 0; m < 4; ++m)
#pragma unroll
                    for (int n = 0; n < 2; ++n) acc[a][b][m][n] = (f32x4){0.f, 0.f, 0.f, 0.f};
        cur = nxt; cA = nA; cB = nB; ++ui;
        if constexpr (ALIGN_EPI) { if (wr == 1) PG8_BAR; }
    }
    PG8_WAIT_V(0);
    if constexpr (!ALIGN_EPI) { if (wr == 0) PG8_BAR; }
    PG8_BAR;
    if constexpr (Epi::AFTER_DRAIN) { E.fused(acc, cur, wr, wc, fr, fq, lds, wid, lane); S.done(cur); }
#undef PG8_SA
#undef PG8_SB
#undef PG8_STAGE
#undef PG8_LDA
#undef PG8_LDB
#undef PG8_MMA
#undef PG8_WAIT_V
#undef PG8_WAIT_L
#undef PG8_BAR
#undef PG8_SCHED
}
}

namespace att {
using bf16 = unsigned short;
constexpr int D = 128, NW = 8, QBLK = 32, KVBLK = 64;
constexpr float SCALE = 0.088388347648318440f;
constexpr float THR = 8.f;
constexpr int SDEPTH = 2;
constexpr int LDQ = INC, LDK = INC, LDO = DM;
constexpr size_t SHM_V = KVBLK * D * 2, SHM_K = KVBLK * D * 2, SHM_ATTN = 2 * SHM_V + 2 * SHM_K + NW * 64 * 4;

using bf16x8 = __attribute__((ext_vector_type(8))) short;
using s16x4  = __attribute__((ext_vector_type(4))) short;
using f32x16 = __attribute__((ext_vector_type(16))) float;
using f32x8  = __attribute__((ext_vector_type(8))) float;
using u32x4  = __attribute__((ext_vector_type(4))) unsigned;
#define KSWZ(row, colB) ((row) * 256 + ((colB) ^ (((row) & 7) << 4)))
#define SBAR() __builtin_amdgcn_sched_barrier(0)
__device__ __forceinline__ int crow(int r, int hi) { return (r & 3) + 8 * (r >> 2) + 4 * hi; }
__device__ __forceinline__ unsigned cvtpk(float lo, float hi) {
  unsigned r; asm volatile("v_cvt_pk_bf16_f32 %0, %1, %2" : "=v"(r) : "v"(lo), "v"(hi)); return r;
}
template <typename TIn> struct Stage;
template <> struct Stage<bf16>  { using T = bf16x8;
  __device__ static __forceinline__ T ld8(const bf16* p) { return *reinterpret_cast<const bf16x8*>(p); }
  __device__ static __forceinline__ bf16x8 tobf(T x) { return x; } };
template <> struct Stage<float> { using T = f32x8;
  __device__ static __forceinline__ T ld8(const float* p) { return *reinterpret_cast<const f32x8*>(p); }
  __device__ static __forceinline__ bf16x8 tobf(T x) {
    u32x4 w = {cvtpk(x[0], x[1]), cvtpk(x[2], x[3]), cvtpk(x[4], x[5]), cvtpk(x[6], x[7])}; return *reinterpret_cast<bf16x8*>(&w); } };

__device__ __forceinline__ void partialSM(f32x16& p0, f32x16& p1, float& m_reg, float& mn, float& alpha) {
  constexpr float C = SCALE * 1.4426950408889634f;
  float pmax = p0[0]; for (int r = 1; r < 16; ++r) pmax = fmaxf(pmax, p0[r]); for (int r = 0; r < 16; ++r) pmax = fmaxf(pmax, p1[r]);
  { auto rr = __builtin_amdgcn_permlane32_swap(__float_as_uint(pmax), __float_as_uint(pmax), false, false);
    pmax = fmaxf(__uint_as_float(rr[0]), __uint_as_float(rr[1])); }
  if (__builtin_expect(__all(pmax - m_reg <= THR / SCALE), 1)) { mn = m_reg; alpha = 1.f; }
  else { mn = fmaxf(m_reg, pmax); alpha = __builtin_amdgcn_exp2f((m_reg - mn) * C); m_reg = mn; }
  float mnC = -mn * C;
  for (int r = 0; r < 16; ++r) p0[r] = fmaf(p0[r], C, mnC); for (int r = 0; r < 16; ++r) p1[r] = fmaf(p1[r], C, mnC);
  for (int r = 0; r < 16; ++r) p0[r] = __builtin_amdgcn_exp2f(p0[r]);
}
__device__ __forceinline__ void finishSM(f32x16& p0, f32x16& p1, float alpha, float& l_reg, bf16x8& pa0, bf16x8& pa1, bf16x8& pa2, bf16x8& pa3) {
  for (int r = 0; r < 16; ++r) p1[r] = __builtin_amdgcn_exp2f(p1[r]);
  float ps = 0; for (int r = 0; r < 16; ++r) ps += p0[r]; for (int r = 0; r < 16; ++r) ps += p1[r];
  { auto rr = __builtin_amdgcn_permlane32_swap(__float_as_uint(ps), __float_as_uint(ps), false, false);
    ps = __uint_as_float(rr[0]) + __uint_as_float(rr[1]); }
  l_reg = l_reg * alpha + ps;
#define PK4(P, BASE, OUT) do { unsigned a0 = cvtpk(P[BASE + 0], P[BASE + 1]), a1 = cvtpk(P[BASE + 2], P[BASE + 3]);   \
    unsigned b0 = cvtpk(P[BASE + 4], P[BASE + 5]), b1 = cvtpk(P[BASE + 6], P[BASE + 7]);                              \
    auto r0 = __builtin_amdgcn_permlane32_swap(a0, b0, false, false); auto r1 = __builtin_amdgcn_permlane32_swap(a1, b1, false, false); \
    u32x4 w = {r0[0], r1[0], r0[1], r1[1]}; OUT = *reinterpret_cast<bf16x8*>(&w); } while (0)
  PK4(p0, 0, pa0); PK4(p0, 8, pa1); PK4(p1, 0, pa2); PK4(p1, 8, pa3);
#undef PK4
}
__device__ __forceinline__ void qkt(f32x16& p0, f32x16& p1, const bf16* Ks, const bf16x8* qr, int r32, int hi) {
  p0 = f32x16{}; p1 = f32x16{};
  for (int d0 = 0; d0 < 8; ++d0) { int cb = (d0 * 16 + hi * 8) * 2;
    bf16x8 b0 = *reinterpret_cast<const bf16x8*>((const char*)Ks + KSWZ(r32, cb));
    bf16x8 b1 = *reinterpret_cast<const bf16x8*>((const char*)Ks + KSWZ(32 + r32, cb));
    p0 = __builtin_amdgcn_mfma_f32_32x32x16_bf16(b0, qr[d0], p0, 0, 0, 0);
    p1 = __builtin_amdgcn_mfma_f32_32x32x16_bf16(b1, qr[d0], p1, 0, 0, 0); }
}
__device__ __forceinline__ int v_st(int k, int c) { const int kk = (k & ~0xC) | ((k & 4) << 1) | ((k & 8) >> 1); return ((kk >> 3) * 4 + (c >> 5)) * 512 + ((kk & 7) * 32 + (c & 31)) * 2; }
__device__ __forceinline__ int v_rd_base(int lane) { return ((lane & 3) << 3) | (((lane >> 2) & 3) << 6) | (((lane >> 4) & 1) << 5) | (((lane >> 5) & 1) << 8); }
constexpr int v_rd_off(int d0, int ks, int half) { return d0 * 512 + ks * 4096 + half * 2048; }
template <int OFF> __device__ __forceinline__ s16x4 tr_read(int vb) {
  s16x4 r; asm volatile("ds_read_b64_tr_b16 %0, %1 offset:%2" : "=&v"(r) : "v"(vb), "i"(OFF) : "memory"); return r;
}
template <int D0> __device__ __forceinline__ void pv_one(f32x16& od, int vb, bf16x8 pa0, bf16x8 pa1, bf16x8 pa2, bf16x8 pa3) {
  const s16x4 l0 = tr_read<v_rd_off(D0, 0, 0)>(vb), h0 = tr_read<v_rd_off(D0, 0, 1)>(vb), l1 = tr_read<v_rd_off(D0, 1, 0)>(vb), h1 = tr_read<v_rd_off(D0, 1, 1)>(vb);
  const s16x4 l2 = tr_read<v_rd_off(D0, 2, 0)>(vb), h2 = tr_read<v_rd_off(D0, 2, 1)>(vb), l3 = tr_read<v_rd_off(D0, 3, 0)>(vb), h3 = tr_read<v_rd_off(D0, 3, 1)>(vb);
  asm volatile("s_waitcnt lgkmcnt(0)" ::: "memory"); SBAR();
#define PK(L, H) (bf16x8){L[0], L[1], L[2], L[3], H[0], H[1], H[2], H[3]}
  od = __builtin_amdgcn_mfma_f32_32x32x16_bf16(pa0, PK(l0, h0), od, 0, 0, 0);
  od = __builtin_amdgcn_mfma_f32_32x32x16_bf16(pa1, PK(l1, h1), od, 0, 0, 0);
  od = __builtin_amdgcn_mfma_f32_32x32x16_bf16(pa2, PK(l2, h2), od, 0, 0, 0);
  od = __builtin_amdgcn_mfma_f32_32x32x16_bf16(pa3, PK(l3, h3), od, 0, 0, 0);
#undef PK
}
__device__ __forceinline__ void pv_d0(f32x16* o, int vb, bf16x8 pa0, bf16x8 pa1, bf16x8 pa2, bf16x8 pa3) {
  pv_one<0>(o[0], vb, pa0, pa1, pa2, pa3); pv_one<1>(o[1], vb, pa0, pa1, pa2, pa3); pv_one<2>(o[2], vb, pa0, pa1, pa2, pa3); pv_one<3>(o[3], vb, pa0, pa1, pa2, pa3);
}

__device__ __forceinline__ void band_mask(f32x16& p0, f32x16& p1, int dq  , int hi) {
#pragma unroll
  for (int r = 0; r < 16; ++r) { const int d = dq - crow(r, hi);
    if ((unsigned)(d + 128) > 256u) p0[r] = -1e30f;
    if ((unsigned)(d + 96) > 256u) p1[r] = -1e30f; }
}
template <bool MASK>
__device__ __forceinline__ void attn_body(const bf16* __restrict__ Qb, const bf16* __restrict__ Kh, const bf16* __restrict__ Vh,
                                          bf16* __restrict__ Ob, int NT, int NCT, int lo, int qpos0, float sinkl2, char* lds) {
  using St = Stage<bf16>;
  int tid_ = threadIdx.x; asm volatile("" : "+v"(tid_));
  const int tid = tid_, wid = tid >> 6, lane = tid & 63, r32 = lane & 31, hi = lane >> 5;
  bf16* V_lds = (bf16*)lds; bf16* K_lds = (bf16*)(lds + 2 * SHM_V);
  float* ws = (float*)(lds + 2 * SHM_V + 2 * SHM_K) + wid * 64; float* li_l = ws; float* al_l = ws + 32;
  float m_reg = -1e30f, l_reg = 0; f32x16 o[4] = {}; bf16x8 qr[8];
  const bf16* Qw = Qb + (long)(wid * QBLK + r32) * LDQ + hi * 8;
#pragma unroll
  for (int d0 = 0; d0 < 8; ++d0) qr[d0] = St::ld8(Qw + d0 * 16);
  const int sr = tid >> 4, sc = (tid & 15) * 8, vst0 = v_st(sr, sc), vst1 = v_st(32 + sr, sc);
  const int vb0 = (int)(uintptr_t)V_lds + v_rd_base(lane);
  const int qi = qpos0 + wid * QBLK + r32;
  struct { typename St::T vs0, vs1, ks0, ks1; } sr_[SDEPTH];
#define TROW(j) (64 * (j) + ((j) >= NCT ? lo : 0))
#define SLOAD(i, k0) do { const long k0_ = (k0); sr_[i].vs0 = St::ld8(&Vh[(k0_ + sr) * LDK + sc]); sr_[i].vs1 = St::ld8(&Vh[(k0_ + 32 + sr) * LDK + sc]); \
    sr_[i].ks0 = St::ld8(&Kh[(k0_ + sr) * LDK + sc]); sr_[i].ks1 = St::ld8(&Kh[(k0_ + 32 + sr) * LDK + sc]); } while (0)
#define SWRITE(b, i) do { *(bf16x8*)((char*)V_lds + (b) * SHM_V + vst0) = St::tobf(sr_[i].vs0);          \
    *(bf16x8*)((char*)V_lds + (b) * SHM_V + vst1) = St::tobf(sr_[i].vs1); int kc = sc * 2;               \
    *(bf16x8*)((char*)K_lds + (b) * SHM_K + KSWZ(sr, kc)) = St::tobf(sr_[i].ks0);                       \
    *(bf16x8*)((char*)K_lds + (b) * SHM_K + KSWZ(32 + sr, kc)) = St::tobf(sr_[i].ks1); } while (0)
#define SWAIT() do { if constexpr (SDEPTH == 2) asm volatile("s_waitcnt vmcnt(4)" ::: "memory"); else asm volatile("s_waitcnt vmcnt(0)" ::: "memory"); } while (0)
#define RESC(a) do { if (__any((a) < 1.f)) { if (hi == 0) al_l[r32] = (a); asm volatile("s_waitcnt lgkmcnt(0)" ::: "memory"); \
    for (int d = 0; d < 4; ++d) for (int r = 0; r < 16; ++r) o[d][r] *= al_l[crow(r, hi)]; } } while (0)
#define AMASK(P0, P1, j) do { if constexpr (MASK) { if ((j) >= NCT) band_mask(P0, P1, qi - (lo + 64 * ((j) - NCT)), hi); } } while (0)
  f32x16 pA0, pA1, pB0, pB1; float mnA, mnB, alA, alB; bf16x8 pa0, pa1, pa2, pa3;
  constexpr int SE = 0, SO = SDEPTH - 1;
  SLOAD(SE, TROW(0)); asm volatile("s_waitcnt vmcnt(0)" ::: "memory"); SWRITE(0, SE); __syncthreads();
  qkt(pA0, pA1, K_lds, qr, r32, hi); AMASK(pA0, pA1, 0); partialSM(pA0, pA1, m_reg, mnA, alA);
  SLOAD(SO, TROW(1)); if constexpr (SDEPTH == 2) { if (2 < NT) SLOAD(SE, TROW(2)); }
  SWAIT(); SWRITE(1, SO); __syncthreads();
  for (int j = 1; j + 1 < NT; j += 2) {
    SBAR(); qkt(pB0, pB1, (bf16*)((char*)K_lds + SHM_K), qr, r32, hi); AMASK(pB0, pB1, j);
    finishSM(pA0, pA1, alA, l_reg, pa0, pa1, pa2, pa3); SBAR();
    SLOAD(SO, TROW(j + SDEPTH)); SBAR();
    pv_d0(o, vb0, pa0, pa1, pa2, pa3); partialSM(pB0, pB1, m_reg, mnB, alB);
    __syncthreads(); SWAIT(); SWRITE(0, SE);
    RESC(alB); __syncthreads();
    SBAR(); qkt(pA0, pA1, K_lds, qr, r32, hi); AMASK(pA0, pA1, j + 1);
    finishSM(pB0, pB1, alB, l_reg, pa0, pa1, pa2, pa3); SBAR();
    if (SDEPTH == 1 || j + 3 < NT) SLOAD(SE, TROW(j + 1 + SDEPTH)); SBAR();
    pv_d0(o, vb0 + (int)SHM_V, pa0, pa1, pa2, pa3); partialSM(pA0, pA1, m_reg, mnA, alA);
    __syncthreads(); SWAIT(); SWRITE(1, SO);
    RESC(alA); __syncthreads();
  }
  SBAR(); qkt(pB0, pB1, (bf16*)((char*)K_lds + SHM_K), qr, r32, hi); AMASK(pB0, pB1, NT - 1);
  finishSM(pA0, pA1, alA, l_reg, pa0, pa1, pa2, pa3); SBAR();
  pv_d0(o, vb0, pa0, pa1, pa2, pa3); partialSM(pB0, pB1, m_reg, mnB, alB);
  __syncthreads(); RESC(alB);
  finishSM(pB0, pB1, alB, l_reg, pa0, pa1, pa2, pa3); SBAR();
  pv_d0(o, vb0 + (int)SHM_V, pa0, pa1, pa2, pa3);
  l_reg += __builtin_amdgcn_exp2f(sinkl2 - m_reg * (SCALE * 1.4426950408889634f));
  if (hi == 0) li_l[r32] = l_reg; asm volatile("s_waitcnt lgkmcnt(0)" ::: "memory");
  float rli[16];
#pragma unroll
  for (int r = 0; r < 16; ++r) rli[r] = __builtin_amdgcn_rcpf(li_l[crow(r, hi)]);
  bf16* Ow = Ob + (long)(wid * QBLK) * LDO;
#pragma unroll
  for (int r = 0; r < 16; ++r) { int orow = crow(r, hi);
    for (int d0 = 0; d0 < 4; ++d0) { const float v = o[d0][r] * rli[r]; const unsigned u = __builtin_bit_cast(unsigned, v);
      Ow[(long)orow * LDO + d0 * 32 + r32] = (bf16)((u + 0x7fffu + ((u >> 16) & 1u)) >> 16); } }
  __syncthreads();
#undef TROW
#undef SLOAD
#undef SWRITE
#undef SWAIT
#undef RESC
#undef AMASK
}

template <int OFF> __device__ __forceinline__ bf16x8 k_read(int addr) { bf16x8 r; asm volatile("ds_read_b128 %0, %1 offset:%2" : "=&v"(r) : "v"(addr), "i"(OFF) : "memory"); return r; }
__device__ __forceinline__ void qkt_pipe(f32x16& p0, f32x16& p1, const bf16* Ks, const bf16x8* qr, int r32, int hi) {
  p0 = f32x16{}; p1 = f32x16{};
  const int kb = (int)(uintptr_t)Ks + r32 * 256, sw = (r32 & 7) << 4;
  const int e0 = kb + ((0 * 32 + hi * 16) ^ sw), e1 = kb + ((1 * 32 + hi * 16) ^ sw), e2 = kb + ((2 * 32 + hi * 16) ^ sw), e3 = kb + ((3 * 32 + hi * 16) ^ sw);
  bf16x8 a0, a1, b0, b1;
#define LGK(n) do { asm volatile("s_waitcnt lgkmcnt(" #n ")" ::: "memory"); SBAR(); } while (0)
#define MM(A0, A1, d) do { p0 = __builtin_amdgcn_mfma_f32_32x32x16_bf16(A0, qr[d], p0, 0, 0, 0); p1 = __builtin_amdgcn_mfma_f32_32x32x16_bf16(A1, qr[d], p1, 0, 0, 0); SBAR(); } while (0)
  a0 = k_read<0>(e0); a1 = k_read<8192>(e0); b0 = k_read<0>(e1); b1 = k_read<8192>(e1);
  LGK(2); MM(a0, a1, 0); a0 = k_read<0>(e2); a1 = k_read<8192>(e2);
  LGK(2); MM(b0, b1, 1); b0 = k_read<0>(e3); b1 = k_read<8192>(e3);
  LGK(2); MM(a0, a1, 2); a0 = k_read<128>(e0); a1 = k_read<8320>(e0);
  LGK(2); MM(b0, b1, 3); b0 = k_read<128>(e1); b1 = k_read<8320>(e1);
  LGK(2); MM(a0, a1, 4); a0 = k_read<128>(e2); a1 = k_read<8320>(e2);
  LGK(2); MM(b0, b1, 5); b0 = k_read<128>(e3); b1 = k_read<8320>(e3);
  LGK(2); MM(a0, a1, 6);
  LGK(0); MM(b0, b1, 7);
#undef LGK
#undef MM
}
struct VFr { s16x4 l0, h0, l1, h1, l2, h2, l3, h3; };
template <int DB> __device__ __forceinline__ void pv_ld(VFr& f, int vb) {
  constexpr int I = (DB >> 2) * 16384, D0 = DB & 3;
  f.l0 = tr_read<I + v_rd_off(D0, 0, 0)>(vb); f.h0 = tr_read<I + v_rd_off(D0, 0, 1)>(vb); f.l1 = tr_read<I + v_rd_off(D0, 1, 0)>(vb); f.h1 = tr_read<I + v_rd_off(D0, 1, 1)>(vb);
  f.l2 = tr_read<I + v_rd_off(D0, 2, 0)>(vb); f.h2 = tr_read<I + v_rd_off(D0, 2, 1)>(vb); f.l3 = tr_read<I + v_rd_off(D0, 3, 0)>(vb); f.h3 = tr_read<I + v_rd_off(D0, 3, 1)>(vb);
}
__device__ __forceinline__ void pv_mm(f32x16& od, const VFr& f, bf16x8 pa0, bf16x8 pa1, bf16x8 pa2, bf16x8 pa3) {
#define PK(L, H) (bf16x8){L[0], L[1], L[2], L[3], H[0], H[1], H[2], H[3]}
  od = __builtin_amdgcn_mfma_f32_32x32x16_bf16(pa0, PK(f.l0, f.h0), od, 0, 0, 0);
  od = __builtin_amdgcn_mfma_f32_32x32x16_bf16(pa1, PK(f.l1, f.h1), od, 0, 0, 0);
  od = __builtin_amdgcn_mfma_f32_32x32x16_bf16(pa2, PK(f.l2, f.h2), od, 0, 0, 0);
  od = __builtin_amdgcn_mfma_f32_32x32x16_bf16(pa3, PK(f.l3, f.h3), od, 0, 0, 0);
#undef PK
}
__device__ __forceinline__ void pv_all(f32x16* o, int vb, bf16x8 pa0, bf16x8 pa1, bf16x8 pa2, bf16x8 pa3) {
  VFr fa, fb;
#define W8() do { asm volatile("s_waitcnt lgkmcnt(8)" ::: "memory"); SBAR(); } while (0)
#define W0() do { asm volatile("s_waitcnt lgkmcnt(0)" ::: "memory"); SBAR(); } while (0)
  pv_ld<0>(fa, vb);
  pv_ld<1>(fb, vb); W8(); pv_mm(o[0], fa, pa0, pa1, pa2, pa3); SBAR();
  pv_ld<2>(fa, vb); W8(); pv_mm(o[1], fb, pa0, pa1, pa2, pa3); SBAR();
  pv_ld<3>(fb, vb); W8(); pv_mm(o[2], fa, pa0, pa1, pa2, pa3); SBAR();
  pv_ld<4>(fa, vb); W8(); pv_mm(o[3], fb, pa0, pa1, pa2, pa3); SBAR();
  pv_ld<5>(fb, vb); W8(); pv_mm(o[4], fa, pa0, pa1, pa2, pa3); SBAR();
  pv_ld<6>(fa, vb); W8(); pv_mm(o[5], fb, pa0, pa1, pa2, pa3); SBAR();
  pv_ld<7>(fb, vb); W8(); pv_mm(o[6], fa, pa0, pa1, pa2, pa3); SBAR();
  W0(); pv_mm(o[7], fb, pa0, pa1, pa2, pa3);
#undef W8
#undef W0
}
#define ATT_LAS __attribute__((address_space(3)))
struct VH { s16x4 l0, h0, l1, h1; };
template <int DB, int KS> __device__ __forceinline__ void pv_ldh(VH& f, int vb) {
  constexpr int I = (DB >> 2) * 16384, D0 = DB & 3;
  f.l0 = tr_read<I + v_rd_off(D0, KS, 0)>(vb); f.h0 = tr_read<I + v_rd_off(D0, KS, 1)>(vb); f.l1 = tr_read<I + v_rd_off(D0, KS + 1, 0)>(vb); f.h1 = tr_read<I + v_rd_off(D0, KS + 1, 1)>(vb);
}
#define PKV(L, H) (bf16x8){L[0], L[1], L[2], L[3], H[0], H[1], H[2], H[3]}
#define PK4S(P, BASE, OUT) do { unsigned a0_ = cvtpk(P[BASE + 0], P[BASE + 1]), a1_ = cvtpk(P[BASE + 2], P[BASE + 3]);   \
    unsigned b0_ = cvtpk(P[BASE + 4], P[BASE + 5]), b1_ = cvtpk(P[BASE + 6], P[BASE + 7]);                              \
    auto r0_ = __builtin_amdgcn_permlane32_swap(a0_, b0_, false, false); auto r1_ = __builtin_amdgcn_permlane32_swap(a1_, b1_, false, false); \
    u32x4 w_ = {r0_[0], r1_[0], r0_[1], r1_[1]}; OUT = *reinterpret_cast<bf16x8*>(&w_); } while (0)
__device__ __forceinline__ void smpv_all(f32x16& p0, f32x16& p1, float alpha, float& l_reg, f32x16* o, int vb,
                                         const char* kb, const char* vbg, ATT_LAS unsigned char* kdst, ATT_LAS unsigned char* vdst, bool dma) {
  bf16x8 pa0, pa1, pa2, pa3; VH fa, fb; float s0 = 0.f, s1 = 0.f;
  PK4S(p0, 0, pa0); PK4S(p0, 8, pa1);
#define WL(n) do { asm volatile("s_waitcnt lgkmcnt(" #n ")" ::: "memory"); SBAR(); } while (0)
#define P1BLK(B, FC, FN, LAST) do { if (!(LAST)) pv_ldh<((B) + 1) & 7, 0>(FN, vb); if (LAST) WL(0); else WL(4); \
    o[B] = __builtin_amdgcn_mfma_f32_32x32x16_bf16(pa0, PKV(FC.l0, FC.h0), o[B], 0, 0, 0); \
    p1[2 * (B)] = __builtin_amdgcn_exp2f(p1[2 * (B)]); s0 += p0[2 * (B)]; s1 += p0[2 * (B) + 1]; SBAR(); \
    o[B] = __builtin_amdgcn_mfma_f32_32x32x16_bf16(pa1, PKV(FC.l1, FC.h1), o[B], 0, 0, 0); \
    p1[2 * (B) + 1] = __builtin_amdgcn_exp2f(p1[2 * (B) + 1]); if ((B) > 0) { s0 += p1[2 * (B) - 2]; s1 += p1[2 * (B) - 1]; } SBAR(); } while (0)
  pv_ldh<0, 0>(fa, vb);
  P1BLK(0, fa, fb, false); P1BLK(1, fb, fa, false); P1BLK(2, fa, fb, false); P1BLK(3, fb, fa, false);
  P1BLK(4, fa, fb, false); P1BLK(5, fb, fa, false); P1BLK(6, fa, fb, false); P1BLK(7, fb, fa, true);
  pv_ldh<0, 2>(fa, vb);
  s0 += p1[14]; s1 += p1[15];
  float ps = s0 + s1;
  { auto rr = __builtin_amdgcn_permlane32_swap(__float_as_uint(ps), __float_as_uint(ps), false, false); ps = __uint_as_float(rr[0]) + __uint_as_float(rr[1]); }
  l_reg = l_reg * alpha + ps;
  PK4S(p1, 0, pa2); PK4S(p1, 8, pa3); SBAR();
#define DMAP(B) do { if (dma) { if ((B) < 2) __builtin_amdgcn_global_load_lds((const unsigned*)(kb + (B) * (32 * LDK * 2)), (ATT_LAS unsigned*)(kdst + (B) * 8192), 16, 0, 0); \
      else if ((B) < 6) __builtin_amdgcn_global_load_lds((const unsigned*)(vbg + (((B) - 2) & 1) * (32 * LDK * 2) + (((B) - 2) >> 1) * 256), (ATT_LAS unsigned*)(vdst + ((B) - 2) * 8192), 16, 0, 0); } } while (0)
#define P2BLK(B, FC, FN, LAST) do { if (!(LAST)) pv_ldh<((B) + 1) & 7, 2>(FN, vb); if (LAST) WL(0); else WL(4); \
    o[B] = __builtin_amdgcn_mfma_f32_32x32x16_bf16(pa2, PKV(FC.l0, FC.h0), o[B], 0, 0, 0); DMAP(B); \
    o[B] = __builtin_amdgcn_mfma_f32_32x32x16_bf16(pa3, PKV(FC.l1, FC.h1), o[B], 0, 0, 0); SBAR(); } while (0)
  P2BLK(0, fa, fb, false); P2BLK(1, fb, fa, false); P2BLK(2, fa, fb, false); P2BLK(3, fb, fa, false);
  P2BLK(4, fa, fb, false); P2BLK(5, fb, fa, false); P2BLK(6, fa, fb, false); P2BLK(7, fb, fa, true);
#undef WL
#undef P1BLK
#undef P2BLK
#undef DMAP
}
#undef PKV
#undef PK4S
__device__ __forceinline__ void attn_body_v256(const bf16* __restrict__ Qb, const bf16* __restrict__ Kh, const bf16* __restrict__ Vh,
                                               bf16* __restrict__ Ob, int NT, ATT_LAS unsigned char* ldsl) {
  using St = Stage<bf16>;
  int tid_ = threadIdx.x; asm volatile("" : "+v"(tid_));
  const int tid = tid_, wid = __builtin_amdgcn_readfirstlane(tid >> 6), lane = tid & 63, r32 = lane & 31, hi = lane >> 5;
  char* lds = (char*)ldsl;
  float* ws = (float*)(lds + 147456) + wid * 64; float* li_l = ws; float* al_l = ws + 32;
  float m_reg = -1e30f, l_reg = 0; f32x16 o[8] = {}; bf16x8 qr[8];
  const bf16* Qw = Qb + (long)(wid * QBLK + r32) * LDQ + hi * 8;
#pragma unroll
  for (int d0 = 0; d0 < 8; ++d0) qr[d0] = St::ld8(Qw + d0 * 16);
  unsigned offK0, offV0;
  { const int row = wid * 4 + (lane >> 4), colB = ((lane & 15) * 16) ^ ((row & 7) << 4); offK0 = (unsigned)row * (LDK * 2) + (unsigned)colB;
    const int sub = wid * 2 + (lane >> 5), kkhi = sub >> 2, cblk = sub & 3, within = (lane & 31) * 16, kk = kkhi * 8 + (within >> 6);
    const int k = (kk & ~0xC) | ((kk & 4) << 1) | ((kk & 8) >> 1), c = cblk * 32 + ((within & 63) >> 1);
    offV0 = (unsigned)k * (LDK * 2) + (unsigned)c * 2; }
  const int vb0 = (int)(uintptr_t)lds + 16384 + v_rd_base(lane);
#define DMA_TILE(j, sbo) do { const char* kb_ = (const char*)Kh + (size_t)(j) * (64 * LDK * 2) + offK0; const char* vb_ = (const char*)Vh + (size_t)(j) * (64 * LDK * 2) + offV0; \
    _Pragma("unroll") for (int i_ = 0; i_ < 2; ++i_) __builtin_amdgcn_global_load_lds((const unsigned*)(kb_ + i_ * (32 * LDK * 2)), (ATT_LAS unsigned*)(ldsl + (sbo) + (i_ * 8 + wid) * 1024), 16, 0, 0); \
    _Pragma("unroll") for (int i_ = 0; i_ < 4; ++i_) __builtin_amdgcn_global_load_lds((const unsigned*)(vb_ + (i_ & 1) * (32 * LDK * 2) + (i_ >> 1) * 256), (ATT_LAS unsigned*)(ldsl + (sbo) + 16384 + (i_ * 8 + wid) * 1024), 16, 0, 0); } while (0)
#define RESC8(a) do { if (__any((a) < 1.f)) { if (hi == 0) al_l[r32] = (a); asm volatile("s_waitcnt lgkmcnt(0)" ::: "memory"); \
    for (int d = 0; d < 8; ++d) for (int r = 0; r < 16; ++r) o[d][r] *= al_l[crow(r, hi)]; } } while (0)
#define TILE_SYNC() do { asm volatile("s_waitcnt vmcnt(0)" ::: "memory"); __builtin_amdgcn_s_barrier(); asm volatile("" ::: "memory"); } while (0)
  f32x16 p0, p1; float mn, al;
#pragma unroll
  for (int d0 = 0; d0 < 8; ++d0) asm volatile("" : "+v"(qr[d0]));
  if (wid >= 4) __builtin_amdgcn_s_setprio(2);
  DMA_TILE(0, 0); DMA_TILE(1, 49152);
  int sb = 0, sb2 = 98304;
  for (int j = 0; j < NT; ++j) {
    if (j + 1 < NT) asm volatile("s_waitcnt vmcnt(6)" ::: "memory"); else asm volatile("s_waitcnt vmcnt(0)" ::: "memory");
    __builtin_amdgcn_s_barrier(); asm volatile("" ::: "memory");
    qkt_pipe(p0, p1, (const bf16*)(lds + sb), qr, r32, hi); partialSM(p0, p1, m_reg, mn, al); RESC8(al); SBAR();
    smpv_all(p0, p1, al, l_reg, o, vb0 + sb, (const char*)Kh + (size_t)(j + 2) * (64 * LDK * 2) + offK0, (const char*)Vh + (size_t)(j + 2) * (64 * LDK * 2) + offV0,
             ldsl + sb2 + wid * 1024, ldsl + sb2 + 16384 + wid * 1024, j + 2 < NT);
    sb = (sb == 98304) ? 0 : sb + 49152; sb2 = (sb2 == 98304) ? 0 : sb2 + 49152;
  }
  __builtin_amdgcn_s_setprio(0);
  if (hi == 0) li_l[r32] = l_reg; asm volatile("s_waitcnt lgkmcnt(0)" ::: "memory");
  float rli[16];
#pragma unroll
  for (int r = 0; r < 16; ++r) rli[r] = __builtin_amdgcn_rcpf(li_l[crow(r, hi)]);
  bf16* Ow = Ob + (long)(wid * QBLK) * LDO;
#pragma unroll
  for (int r = 0; r < 16; ++r) { int orow = crow(r, hi);
#pragma unroll
    for (int d0 = 0; d0 < 8; ++d0) { const float v = o[d0][r] * rli[r]; const unsigned u = __builtin_bit_cast(unsigned, v);
      Ow[(long)orow * LDO + d0 * 32 + r32] = (bf16)((u + 0x7fffu + ((u >> 16) & 1u)) >> 16); } }
#undef DMA_TILE
#undef RESC8
#undef TILE_SYNC
}
__device__ __forceinline__ void attn_body_a(const bf16* __restrict__ Qb, const bf16* __restrict__ Kh, const bf16* __restrict__ Vh, bf16* __restrict__ Ob,
                                            int NT, int NCT, int lo, int qpos0, const float* __restrict__ sk4, ATT_LAS unsigned char* ldsl) {
  using St = Stage<bf16>;
  int tid_ = threadIdx.x; asm volatile("" : "+v"(tid_));
  const int tid = tid_, wid = __builtin_amdgcn_readfirstlane(tid >> 6), lane = tid & 63, r32 = lane & 31, hi = lane >> 5;
  const int g = wid >> 1, rh = wid & 1;
  char* lds = (char*)ldsl;
  float* ws = (float*)(lds + 98304) + wid * 64; float* li_l = ws; float* al_l = ws + 32;
  float m_reg = -1e30f, l_reg = 0; f32x16 o[4] = {}; bf16x8 qr[8];
  const bf16* Qw = Qb + (long)(rh * QBLK + r32) * LDQ + g * 128 + hi * 8;
#pragma unroll
  for (int d0 = 0; d0 < 8; ++d0) qr[d0] = St::ld8(Qw + d0 * 16);
  const float sinkl2 = sk4[g] * 1.4426950408889634f;
  const int qi = qpos0 + rh * QBLK + r32;
  unsigned offK0, offV0;
  { const int row = wid * 4 + (lane >> 4), colB = ((lane & 15) * 16) ^ ((row & 7) << 4); offK0 = (unsigned)row * (LDK * 2) + (unsigned)colB;
    const int sub = wid * 2 + (lane >> 5), kkhi = sub >> 2, cblk = sub & 3, within = (lane & 31) * 16, kk = kkhi * 8 + (within >> 6);
    const int k = (kk & ~0xC) | ((kk & 4) << 1) | ((kk & 8) >> 1), c = cblk * 32 + ((within & 63) >> 1);
    offV0 = (unsigned)k * (LDK * 2) + (unsigned)c * 2; }
  const int vb0 = (int)(uintptr_t)lds + 16384 + v_rd_base(lane);
#define TROWA(j) (64 * (j) + ((j) >= NCT ? lo : 0))
#define DMA_TILE(j, sb) do { const size_t ro_ = (size_t)TROWA(j) * (LDK * 2); const char* kb_ = (const char*)Kh + ro_ + offK0; const char* vb_ = (const char*)Vh + ro_ + offV0; \
    _Pragma("unroll") for (int i_ = 0; i_ < 2; ++i_) { __builtin_amdgcn_global_load_lds((const unsigned*)(kb_ + i_ * (32 * LDK * 2)), (ATT_LAS unsigned*)(ldsl + (sb) + (i_ * 8 + wid) * 1024), 16, 0, 0); \
      __builtin_amdgcn_global_load_lds((const unsigned*)(vb_ + i_ * (32 * LDK * 2)), (ATT_LAS unsigned*)(ldsl + (sb) + 16384 + (i_ * 8 + wid) * 1024), 16, 0, 0); } } while (0)
#define RESC4(a) do { if (__any((a) < 1.f)) { if (hi == 0) al_l[r32] = (a); asm volatile("s_waitcnt lgkmcnt(0)" ::: "memory"); \
    for (int d = 0; d < 4; ++d) for (int r = 0; r < 16; ++r) o[d][r] *= al_l[crow(r, hi)]; } } while (0)
  f32x16 p0, p1; float mn, al; bf16x8 pa0, pa1, pa2, pa3;
#pragma unroll
  for (int d0 = 0; d0 < 8; ++d0) asm volatile("" : "+v"(qr[d0]));
  DMA_TILE(0, 0);
  int sb = 0;
  for (int j = 0; j < NT; ++j) {
    asm volatile("s_waitcnt vmcnt(0)" ::: "memory"); __builtin_amdgcn_s_barrier(); asm volatile("" ::: "memory");
    if (j + 1 < NT) DMA_TILE(j + 1, sb ^ 32768);
    qkt_pipe(p0, p1, (const bf16*)(lds + sb), qr, r32, hi);
    if (j >= NCT) band_mask(p0, p1, qi - (lo + 64 * (j - NCT)), hi);
    partialSM(p0, p1, m_reg, mn, al); RESC4(al); finishSM(p0, p1, al, l_reg, pa0, pa1, pa2, pa3); SBAR();
    pv_d0(o, vb0 + sb, pa0, pa1, pa2, pa3);
    sb ^= 32768;
  }
  l_reg += __builtin_amdgcn_exp2f(sinkl2 - m_reg * (SCALE * 1.4426950408889634f));
  if (hi == 0) li_l[r32] = l_reg; asm volatile("s_waitcnt lgkmcnt(0)" ::: "memory");
  float rli[16];
#pragma unroll
  for (int r = 0; r < 16; ++r) rli[r] = __builtin_amdgcn_rcpf(li_l[crow(r, hi)]);
  bf16* Ow = Ob + (long)(rh * QBLK) * LDO + g * 128;
#pragma unroll
  for (int r = 0; r < 16; ++r) { int orow = crow(r, hi);
#pragma unroll
    for (int d0 = 0; d0 < 4; ++d0) { const float v = o[d0][r] * rli[r]; const unsigned u = __builtin_bit_cast(unsigned, v);
      Ow[(long)orow * LDO + d0 * 32 + r32] = (bf16)((u + 0x7fffu + ((u >> 16) & 1u)) >> 16); } }
#undef TROWA
#undef DMA_TILE
#undef RESC4
}
}

constexpr size_t MiB = 1u << 20;
constexpr size_t SLOT = (size_t)MROWS * DM * 2;
constexpr size_t WS_MOD = 0;
constexpr size_t WS_BAR = 1 * MiB, WS_BAR_BYTES = 16384;
constexpr size_t WS_COS = 2 * MiB, WS_SIN = 4 * MiB;
constexpr size_t WS_CTX1 = 6 * MiB;
constexpr size_t WS_WINT = 16 * MiB;
constexpr size_t WS_WPT = WS_WINT + 68 * MiB;
constexpr size_t WS_PX = WS_WPT + 48 * MiB;
constexpr size_t WS_S0 = WS_PX + (size_t)MROWS * INC * 2;
constexpr size_t WS_END = WS_S0 + 5 * SLOT;
static_assert(WS_END <= 4ull * DEPTH * DM * INC * 4, "workspace map exceeds the guaranteed 4x largest tensor");

constexpr int NWAVES = 8;
constexpr int LDS_BYTES = 149760;

#define GAS __attribute__((address_space(1)))
#define LAS __attribute__((address_space(3)))
typedef unsigned short bf16;
typedef unsigned v4u __attribute__((ext_vector_type(4)));
typedef unsigned v2u __attribute__((ext_vector_type(2)));
typedef float f32x4 __attribute__((ext_vector_type(4)));
#define LDS_WAIT() asm volatile("s_waitcnt lgkmcnt(0)" ::: "memory")
__device__ __forceinline__ unsigned f2bf(float f) { unsigned u = __builtin_bit_cast(unsigned, f); return (u + 0x7fffu + ((u >> 16) & 1u)) >> 16; }
__device__ __forceinline__ unsigned pk2(float lo, float hi) { return f2bf(lo) | (f2bf(hi) << 16); }
__device__ __forceinline__ float bflo(unsigned w) { return __builtin_bit_cast(float, w << 16); }
__device__ __forceinline__ float bfhi(unsigned w) { return __builtin_bit_cast(float, w & 0xffff0000u); }
__device__ __forceinline__ float siluf(float x) { return x / (1.f + __expf(-x)); }
__device__ __forceinline__ float sigmf(float x) { return 1.f / (1.f + __expf(-x)); }

struct Frame {
    LAS unsigned char* lds;
    int vcu, G;
    const float *x, *c, *ctx, *c_ctx, *w_ada, *b_ada, *g_pre, *g_post, *w_in, *sink, *lam_qk, *g_subln, *w_pa, *w_pb, *w_out;
    float* out; unsigned char* ws;
};

#define XB_TMO      128
#define XB_XCNT(j)  (256  + 64 * (j))
#define XB_XSUB(j)  (1280 + 64 * (j))
#define XB_XGEN(j)  (2304 + 64 * (j))
#define XB_TOP      3328
#define XB_TOPGEN   3392
#define XCD_BAR_WORDS 3456
#define XB_SPIN_CAP (1u << 18)

__device__ __forceinline__ unsigned xb_ld(unsigned* p)              { return __hip_atomic_load(p, __ATOMIC_RELAXED, __HIP_MEMORY_SCOPE_AGENT); }
__device__ __forceinline__ unsigned xb_add(unsigned* p, unsigned v) { return __hip_atomic_fetch_add(p, v, __ATOMIC_RELAXED, __HIP_MEMORY_SCOPE_AGENT); }
__device__ __forceinline__ unsigned xb_xcc_id() { return (unsigned)__builtin_amdgcn_s_getreg((3 << 11) | 20) & 0xFu; }
#define XB_SPIN(cond, bar) do { unsigned _sp = 0; while (cond) { __builtin_amdgcn_s_sleep(1); \
    if ((++_sp & 255u) == 0u) { if (xb_ld(&(bar)[XB_TMO])) break; if (_sp > XB_SPIN_CAP) { atomicAdd(&(bar)[XB_TMO], 1u); break; } } } } while (0)

struct XcdBarrier {
    unsigned* bar; unsigned x;
    volatile LAS unsigned* st;
};

__device__ __forceinline__ XcdBarrier xcd_barrier_post(unsigned* bar, volatile LAS unsigned* st) {
    XcdBarrier b; b.bar = bar; b.x = xb_xcc_id(); b.st = st;
    if (threadIdx.x == 0) (void)xb_add(&bar[XB_XCNT(b.x)], 1u);
    return b;
}
__device__ __forceinline__ void xcd_barrier_complete(unsigned* bar, unsigned x, unsigned& nloc, unsigned& nx) {
    const unsigned G = gridDim.x * gridDim.y * gridDim.z;
    unsigned sum, cnt, mine, sp = 0u;
    for (;;) {
        sum = 0u; cnt = 0u; mine = 0u;
#pragma unroll
        for (unsigned j = 0; j < 16; ++j) { const unsigned c = xb_ld(&bar[XB_XCNT(j)]); sum += c; cnt += (c > 0u) ? 1u : 0u; mine = (j == x) ? c : mine; }
        if (sum == G) break;
        __builtin_amdgcn_s_sleep(1);
        if ((++sp & 255u) == 0u) { if (xb_ld(&bar[XB_TMO])) break; if (sp > XB_SPIN_CAP) { atomicAdd(&bar[XB_TMO], 1u); break; } }
    }
    nloc = mine > 0u ? mine : 1u; nx = cnt > 0u ? cnt : 1u;
}

__device__ __forceinline__ void xcd_barrier(const XcdBarrier& b) {
    asm volatile("s_waitcnt vmcnt(0)" ::: "memory");
    __syncthreads();
    if (threadIdx.x == 0) {
        unsigned* bar = b.bar;
        __builtin_amdgcn_s_waitcnt(0);
        unsigned nloc = b.st[0], nx = b.st[1];
        if (nloc == 0u) { xcd_barrier_complete(bar, b.x, nloc, nx); b.st[0] = nloc; b.st[1] = nx; }
        const unsigned old = xb_add(&bar[XB_XSUB(b.x)], 1u);
        const unsigned gen = old / nloc;
        if (old + 1u == (gen + 1u) * nloc) {
            __builtin_amdgcn_fence(__ATOMIC_RELEASE, "agent");
            asm volatile("s_waitcnt vmcnt(0)" ::: "memory");
            const unsigned og = xb_add(&bar[XB_TOP], 1u);
            const unsigned tg = og / nx;
            if (og + 1u == (tg + 1u) * nx) xb_add(&bar[XB_TOPGEN], 1u);
            else XB_SPIN(xb_ld(&bar[XB_TOPGEN]) == tg, bar);
            __builtin_amdgcn_fence(__ATOMIC_ACQUIRE, "agent");
            xb_add(&bar[XB_XGEN(b.x)], 1u);
            asm volatile("s_waitcnt vmcnt(0)" ::: "memory");
        } else {
            XB_SPIN(xb_ld(&bar[XB_XGEN(b.x)]) == gen, bar);
            __builtin_amdgcn_fence(__ATOMIC_ACQUIRE, "agent");
            asm volatile("s_waitcnt vmcnt(0)" ::: "memory");
        }
    }
    __syncthreads();
}

#define FRESH_IDS int tid_ = threadIdx.x; asm volatile("" : "+v"(tid_)); const int tid = tid_, lane = tid & 63, wave = __builtin_amdgcn_readfirstlane(tid >> 6); (void)lane; (void)wave;

__device__ __forceinline__ float wave_sum(float v) {
#pragma unroll
    for (int o = 1; o < 64; o <<= 1) v += __shfl_xor(v, o);
    return v;
}
__device__ __forceinline__ void p0_transpose_item(const float* W, int K, int N, bf16* WT, int row_off, LAS float* scr, int item, int lane) {
    const int nblk = N / 32, kb = item / nblk, nb = item % nblk, k0 = 64 * kb, n0 = 32 * nb;
#pragma unroll
    for (int i = 0; i < 32; ++i) { const int kk = 2 * i + (lane >> 5); scr[kk * 33 + (lane & 31)] = W[(size_t)(k0 + kk) * N + n0 + (lane & 31)]; }
    LDS_WAIT(); asm volatile("" ::: "memory");
    const int c = lane & 7;
#pragma unroll
    for (int j = 0; j < 4; ++j) { const int n = (lane >> 3) + 8 * j; const LAS float* s = scr + (8 * c) * 33 + n;
        v4u o; o.x = pk2(s[0 * 33], s[1 * 33]); o.y = pk2(s[2 * 33], s[3 * 33]); o.z = pk2(s[4 * 33], s[5 * 33]); o.w = pk2(s[6 * 33], s[7 * 33]);
        *(GAS v4u*)(WT + (size_t)(row_off + n0 + n) * K + k0 + 8 * c) = o; }
    LDS_WAIT(); asm volatile("" ::: "memory");
}

#define GW_LOOP(var, n) for (int var = F.vcu * NWAVES + wave; var < (n); var += F.G * NWAVES)

__device__ __forceinline__ int win_row_off(int n0) {
    const int tile = n0 >> 8; const bool rope = tile < 2 || (tile >= 4 && tile < 12) || (tile >= 20 && tile < 28) || (tile >= 36 && tile < 44);
    if (!rope) return 0;
    const int w = n0 & 255, hsel = w >> 7, half = (w >> 6) & 1, i = w & 63;
    return (half * 128 + hsel * 64 + i) - w;
}
__device__ __forceinline__ void ph_prologue(Frame& F) {
    FRESH_IDS
    for (int ait = F.vcu; ait < 192; ait += F.G) {
        const int l = ait / 96, n0 = (ait % 96) * 64;
        LAS float* sv = (LAS float*)F.lds;
        LAS float* red = (LAS float*)(F.lds + 32768);
        for (int k = tid; k < DM; k += NWAVES * 64) { sv[k] = siluf(F.c[k]); sv[DM + k] = siluf(F.c[DM + k]); sv[2 * DM + k] = siluf(F.c_ctx[k]); }
        __syncthreads();
        const float* W = F.w_ada + (size_t)l * DM * 6144 + n0 + lane;
        float a0 = 0.f, a1 = 0.f, a2 = 0.f;
        const int kb = wave * 256;
#pragma unroll 32
        for (int k = 0; k < 256; ++k) { const float w = W[(size_t)(kb + k) * 6144]; a0 += sv[kb + k] * w; a1 += sv[DM + kb + k] * w; a2 += sv[2 * DM + kb + k] * w; }
        red[(wave * 3 + 0) * 64 + lane] = a0; red[(wave * 3 + 1) * 64 + lane] = a1; red[(wave * 3 + 2) * 64 + lane] = a2;
        __syncthreads();
        if (wave < 3) { float s = 0.f;
#pragma unroll
            for (int w = 0; w < 8; ++w) s += red[(w * 3 + wave) * 64 + lane];
            float* mod = (float*)(F.ws + WS_MOD);
            mod[(size_t)(l * 3 + wave) * 6144 + n0 + lane] = s + F.b_ada[(size_t)l * 6144 + n0 + lane]; }
        __syncthreads();
    }
    { float* ct = (float*)(F.ws + WS_COS); float* st = (float*)(F.ws + WS_SIN);
      for (int i = (F.vcu * NWAVES * 64) + tid; i < SEQ * 64; i += F.G * NWAVES * 64) {
          const int t = i >> 6, j = i & 63, f = j & 31; const float pos = (float)((j < 32) ? (t >> 6) : (t & 63));
          const float inv = expf(-(float)f * (9.210340371976184f / 32.f)); const float ang = pos * inv;
          ct[i] = cosf(ang); st[i] = sinf(ang); } }
    LAS float* scr = (LAS float*)(F.lds + wave * 16384);
    constexpr int I_IN = (DM / 64) * (INC / 32), I_P = (DM / 64) * (DM / 32);
    bf16* WinT = (bf16*)(F.ws + WS_WINT); bf16* WpT = (bf16*)(F.ws + WS_WPT);
    GW_LOOP(it, I_IN + 6 * I_P) {
        if (it < I_IN) { p0_transpose_item(F.w_in, DM, INC, WinT, win_row_off(32 * (it % (INC / 32))), scr, it, lane); continue; }
        const int r = it - I_IN, mi = r / I_P, ii = r % I_P, l = mi / 3, w = mi % 3;
        const float* W = (w == 0 ? F.w_pa : (w == 1 ? F.w_pb : F.w_out)) + (size_t)l * DM * DM;
        p0_transpose_item(W, DM, DM, WpT + (size_t)mi * DM * DM, 0, scr, ii, lane);
    }
}

__device__ __forceinline__ void ph_hnorm(Frame& F, int l, const float* xcur, const float* ctxcur) {
    FRESH_IDS
    bf16* H = (bf16*)(F.ws + WS_S0);
    const float* gp = F.g_pre + (size_t)l * DM;
    GW_LOOP(row, MROWS) {
        const int b = row / RPB, rr = row % RPB; const float* src; int v;
        if (rr < CTX) { src = ctxcur + (size_t)(b * CTX + rr) * DM; v = 2; } else { src = xcur + (size_t)(b * SEQ + rr - CTX) * DM; v = b; }
        const float* md = (const float*)(F.ws + WS_MOD) + (size_t)(l * 3 + v) * 6144;
        f32x4 xv[8]; float s = 0.f;
#pragma unroll
        for (int j = 0; j < 8; ++j) { xv[j] = ((const f32x4*)src)[lane + 64 * j]; s += (xv[j].x * xv[j].x + xv[j].y * xv[j].y) + (xv[j].z * xv[j].z + xv[j].w * xv[j].w); }
        const float rs = rsqrtf(wave_sum(s) * (1.f / DM) + EPS);
#pragma unroll
        for (int j = 0; j < 8; ++j) { const int q = lane + 64 * j;
            const f32x4 g = ((const f32x4*)gp)[q], sh = ((const f32x4*)md)[q], sc = ((const f32x4*)(md + DM))[q];
            const f32x4 y = (xv[j] * rs) * g * (sc + 1.f) + sh;
            v2u o; o.x = pk2(y.x, y.y); o.y = pk2(y.z, y.w);
            *(v2u*)(H + (size_t)row * DM + 4 * q) = o; }
    }
}

__device__ __forceinline__ void ph_rope(Frame& F) {
    FRESH_IDS
    bf16* PX = (bf16*)(F.ws + WS_PX);
    const float* ct = (const float*)(F.ws + WS_COS); const float* st = (const float*)(F.ws + WS_SIN);
    const unsigned total = (unsigned)NB * SEQ * 52 * 8;
    for (unsigned idx = (unsigned)(F.vcu * NWAVES * 64 + tid); idx < total; idx += (unsigned)(F.G * NWAVES * 64)) {
        const unsigned ch = idx & 7, hr = idx >> 3, hh = hr % 52, rowL = hr / 52, b = rowL / SEQ, t = rowL % SEQ;
        const int col = (hh < 4) ? (C_KA + hh * 128) : (hh < 20) ? (C_KB + (hh - 4) * 128) : (hh < 36) ? (C_QA + (hh - 20) * 128) : (C_QB + (hh - 36) * 128);
        bf16* p = PX + (size_t)(b * RPB + CTX + t) * INC + col + ch * 8;
        const v4u x1 = *(const v4u*)p, x2 = *(const v4u*)(p + 64);
        const f32x4 c0 = *(const f32x4*)(ct + t * 64 + ch * 8), c1 = *(const f32x4*)(ct + t * 64 + ch * 8 + 4);
        const f32x4 s0 = *(const f32x4*)(st + t * 64 + ch * 8), s1 = *(const f32x4*)(st + t * 64 + ch * 8 + 4);
        v4u y1, y2;
#define ROPE2(W, CA, SA, CB, SB) { const float a0 = bflo(x1.W), a1 = bfhi(x1.W), b0 = bflo(x2.W), b1 = bfhi(x2.W); \
            y1.W = pk2(a0 * CA - b0 * SA, a1 * CB - b1 * SB); y2.W = pk2(b0 * CA + a0 * SA, b1 * CB + a1 * SB); }
        ROPE2(x, c0.x, s0.x, c0.y, s0.y) ROPE2(y, c0.z, s0.z, c0.w, s0.w) ROPE2(z, c1.x, s1.x, c1.y, s1.y) ROPE2(w, c1.z, s1.z, c1.w, s1.w)
#undef ROPE2
        *(v4u*)p = y1; *(v4u*)(p + 64) = y2;
    }
}

__device__ __forceinline__ void ph_convert_win(Frame& F, int l) {
    FRESH_IDS
    LAS float* scr = (LAS float*)(F.lds + wave * 16384);
    constexpr int I_IN = (DM / 64) * (INC / 32);
    bf16* WinT = (bf16*)(F.ws + WS_WINT);
    GW_LOOP(it, I_IN) p0_transpose_item(F.w_in + (size_t)l * DM * INC, DM, INC, WinT, win_row_off(32 * (it % (INC / 32))), scr, it, lane);
}

__device__ __forceinline__ void ph_attn(Frame& F, int l, char* lds) {
    const att::bf16* PX = (const att::bf16*)(F.ws + WS_PX);
    att::bf16* OA = (att::bf16*)(F.ws + WS_S0);
    att::bf16* OB0 = (att::bf16*)(F.ws + WS_S0 + SLOT);
    const float NINF = -INFINITY;
    const int nB = 1024, nA = 1024, nC = (l == 0) ? 64 : 0;
    for (int u = F.vcu; u < nB + nA + nC; u += F.G) {
        if (u < nB) {
            const int hd = u >> 5, qb = u & 31, b = hd >> 4, h8 = (hd >> 1) & 7, m = hd & 1;
            const size_t qrow = (size_t)b * RPB + CTX + qb * 256, krow = (size_t)b * RPB;
            att::attn_body_v256(PX + qrow * INC + C_QB + (h8 * 2 + m) * 128, PX + krow * INC + C_KB + (h8 * 2 + m) * 128, PX + krow * INC + C_VB + h8 * 256,
                                OB0 + (size_t)m * (SLOT / 2) + qrow * DM + h8 * 256, RPB / 64, F.lds);
            __syncthreads();
        } else if (u < nB + nA) {
            const int v = u - nB, b = v >> 9, kvh = (v >> 7) & 3, qb = v & 127, q0 = qb * 64;
            const int lo = (q0 - 128 > 0) ? q0 - 128 : 0, he = (q0 + 192 < SEQ) ? q0 + 192 : SEQ, nloc = (he - lo) >> 6;
            const size_t qrow = (size_t)b * RPB + CTX + q0, krow = (size_t)b * RPB;
            att::attn_body_a(PX + qrow * INC + C_QA + kvh * 512, PX + krow * INC + C_KA + kvh * 128, PX + krow * INC + C_VA + kvh * 128,
                             OA + qrow * DM + kvh * 512, 4 + nloc, 4, lo, q0, F.sink + l * 16 + kvh * 4, F.lds);
            __syncthreads();
        } else {
            const int v = u - nB - nA;
            if (v < 32) {
                const int hd = v, b = hd >> 4, h8 = (hd >> 1) & 7, m = hd & 1; const size_t krow = (size_t)b * RPB;
                att::attn_body_v256(PX + krow * INC + C_QB + (h8 * 2 + m) * 128, PX + krow * INC + C_KB + (h8 * 2 + m) * 128, PX + krow * INC + C_VB + h8 * 256,
                                    OB0 + (size_t)m * (SLOT / 2) + krow * DM + h8 * 256, 4, F.lds);
                __syncthreads();
            } else {
                const int w = v - 32, b = w >> 4, kvh = (w >> 2) & 3, cb = w & 3; const size_t krow = (size_t)b * RPB, qrow = krow + cb * 64;
                att::attn_body_a(PX + qrow * INC + C_QA + kvh * 512, PX + krow * INC + C_KA + kvh * 128, PX + krow * INC + C_VA + kvh * 128,
                                 OA + qrow * DM + kvh * 512, 4, 4, 0, 0, F.sink + l * 16 + kvh * 4, F.lds);
                __syncthreads();
            }
        }
    }
}

__device__ __forceinline__ void ph_post(Frame& F, int l) {
    FRESH_IDS
    const bf16* PX = (const bf16*)(F.ws + WS_PX);
    const bf16* OA = (const bf16*)(F.ws + WS_S0); const bf16* OB0 = (const bf16*)(F.ws + WS_S0 + SLOT); const bf16* OB1 = (const bf16*)(F.ws + WS_S0 + 2 * SLOT);
    bf16* GA = (bf16*)(F.ws + WS_S0 + 3 * SLOT); bf16* GB = (bf16*)(F.ws + WS_S0 + 4 * SLOT);
    const float lam_init = 0.8f - 0.6f * expf(-0.3f * (float)l);
    const float* lq = F.lam_qk + (size_t)l * 512;
    const float d1 = wave_sum(lq[lane] * lq[128 + lane] + lq[64 + lane] * lq[192 + lane]);
    const float d2 = wave_sum(lq[256 + lane] * lq[384 + lane] + lq[320 + lane] * lq[448 + lane]);
    const float lam = expf(d1) - expf(d2) + lam_init;
    const f32x4 gs = ((const f32x4*)(F.g_subln + (size_t)l * 256))[lane] * (1.f - lam_init);
    GW_LOOP(row, MROWS) {
        if (l != 0 && (row % RPB) < CTX) continue;
        const size_t ro = (size_t)row * DM, rp = (size_t)row * INC;
#pragma unroll
        for (int j = 0; j < 8; ++j) { const int c = 4 * (lane + 64 * j);
            const v2u oa = *(const v2u*)(OA + ro + c), za = *(const v2u*)(PX + rp + C_ZA + c);
            v2u o; o.x = pk2(bflo(oa.x) * siluf(bflo(za.x)), bfhi(oa.x) * siluf(bfhi(za.x))); o.y = pk2(bflo(oa.y) * siluf(bflo(za.y)), bfhi(oa.y) * siluf(bfhi(za.y)));
            *(v2u*)(GA + ro + c) = o; }
#pragma unroll
        for (int j = 0; j < 8; ++j) { const int c = 256 * j + 4 * lane;
            const v2u o0 = *(const v2u*)(OB0 + ro + c), o1 = *(const v2u*)(OB1 + ro + c), zb = *(const v2u*)(PX + rp + C_ZB + c);
            f32x4 d; d.x = bflo(o0.x) - lam * bflo(o1.x); d.y = bfhi(o0.x) - lam * bfhi(o1.x); d.z = bflo(o0.y) - lam * bflo(o1.y); d.w = bfhi(o0.y) - lam * bfhi(o1.y);
            const float ss = wave_sum((d.x * d.x + d.y * d.y) + (d.z * d.z + d.w * d.w));
            const float rs = rsqrtf(ss * (1.f / 256.f) + EPS);
            const f32x4 y = d * rs * gs;
            v2u o; o.x = pk2(y.x * siluf(bflo(zb.x)), y.y * siluf(bfhi(zb.x))); o.y = pk2(y.z * siluf(bflo(zb.y)), y.w * siluf(bfhi(zb.y)));
            *(v2u*)(GB + ro + c) = o; }
    }
}

__device__ __forceinline__ void ph_merge(Frame& F, int l) {
    FRESH_IDS
    const bf16* PX = (const bf16*)(F.ws + WS_PX);
    const bf16* YA = (const bf16*)(F.ws + WS_S0); const bf16* YB = (const bf16*)(F.ws + WS_S0 + SLOT); bf16* MG = (bf16*)(F.ws + WS_S0 + 2 * SLOT);
    const unsigned total = (unsigned)MROWS * (DM / 8);
    for (unsigned i = (unsigned)(F.vcu * NWAVES * 64 + tid); i < total; i += (unsigned)(F.G * NWAVES * 64)) {
        const unsigned row = i >> 8, c = (i & 255) * 8;
        if (l != 0 && (row % RPB) < CTX) continue;
        const v4u ya = *(const v4u*)(YA + (size_t)row * DM + c), yb = *(const v4u*)(YB + (size_t)row * DM + c);
        const v4u ga = *(const v4u*)(PX + (size_t)row * INC + C_GA + c), gb = *(const v4u*)(PX + (size_t)row * INC + C_GB + c);
        v4u o;
#define MRG(W) o.W = pk2(sigmf(bflo(ga.W)) * bflo(ya.W) + sigmf(bflo(gb.W)) * bflo(yb.W), sigmf(bfhi(ga.W)) * bfhi(ya.W) + sigmf(bfhi(gb.W)) * bfhi(yb.W));
        MRG(x) MRG(y) MRG(z) MRG(w)
#undef MRG
        *(v4u*)(MG + (size_t)row * DM + c) = o;
    }
}

__device__ __forceinline__ void ph_res(Frame& F, int l, const float* xcur, const float* ctxcur) {
    FRESH_IDS
    const bf16* OX = (const bf16*)(F.ws + WS_S0 + 3 * SLOT);
    bf16* H = (bf16*)(F.ws + WS_S0);
    const float* gp = F.g_post + (size_t)l * DM;
    const bool nxt = (l + 1 < DEPTH);
    const float* gpn = F.g_pre + (size_t)(l + 1) * DM;
    GW_LOOP(row, MROWS) {
        const int b = row / RPB, rr = row % RPB; const float* src; float* dst; int v;
        if (rr < CTX) { if (!nxt) continue; src = ctxcur + (size_t)(b * CTX + rr) * DM; dst = nullptr; v = 2; }
        else { src = xcur + (size_t)(b * SEQ + rr - CTX) * DM; dst = F.out + (size_t)(b * SEQ + rr - CTX) * DM; v = b; }
        const float* gt = (const float*)(F.ws + WS_MOD) + (size_t)(l * 3 + v) * 6144 + 2 * DM;
        f32x4 ov[8]; float s = 0.f;
#pragma unroll
        for (int j = 0; j < 8; ++j) { const v2u w = *(const v2u*)(OX + (size_t)row * DM + 4 * (lane + 64 * j));
            ov[j] = (f32x4){bflo(w.x), bfhi(w.x), bflo(w.y), bfhi(w.y)}; s += (ov[j].x * ov[j].x + ov[j].y * ov[j].y) + (ov[j].z * ov[j].z + ov[j].w * ov[j].w); }
        const float rs = rsqrtf(wave_sum(s) * (1.f / DM) + EPS);
        float s2 = 0.f;
#pragma unroll
        for (int j = 0; j < 8; ++j) { const int q = lane + 64 * j;
            const f32x4 g = ((const f32x4*)gp)[q], gate = ((const f32x4*)gt)[q], xr = ((const f32x4*)src)[q];
            ov[j] = xr + gate * ((ov[j] * rs) * g);
            if (dst) ((f32x4*)dst)[q] = ov[j];
            s2 += (ov[j].x * ov[j].x + ov[j].y * ov[j].y) + (ov[j].z * ov[j].z + ov[j].w * ov[j].w); }
        if (nxt) {
            const float* md = (const float*)(F.ws + WS_MOD) + (size_t)((l + 1) * 3 + v) * 6144;
            const float rs2 = rsqrtf(wave_sum(s2) * (1.f / DM) + EPS);
#pragma unroll
            for (int j = 0; j < 8; ++j) { const int q = lane + 64 * j;
                const f32x4 g = ((const f32x4*)gpn)[q], sh = ((const f32x4*)md)[q], sc = ((const f32x4*)(md + DM))[q];
                const f32x4 y = (ov[j] * rs2) * g * (sc + 1.f) + sh;
                v2u o; o.x = pk2(y.x, y.y); o.y = pk2(y.z, y.w);
                *(v2u*)(H + (size_t)row * DM + 4 * q) = o; }
        }
    }
}

__device__ __forceinline__ void run_gemm_in(Frame& F, const bf16* A, const bf16* Bt, bf16* O) {
    pg8::Gemm g{A, Bt, MROWS, INC, DM}; pg8::RowSkipOrder S; S.init(INC, F.G, (int)blockIdx.x, false);
    pg8::EpiRope E{O, INC, (const float*)(F.ws + WS_COS), (const float*)(F.ws + WS_SIN)};
    pg8::gemm_phase<pg8::EpiRope, pg8::RowSkipOrder, true, true>(F.lds, g, S, E);
}
__device__ __forceinline__ void run_gemm_skip(Frame& F, const bf16* A, const bf16* Bt, bf16* O, bool skip) {
    pg8::Gemm g{A, Bt, MROWS, DM, DM}; pg8::RowSkipOrder S; S.init(DM, F.G, (int)blockIdx.x, skip);
    pg8::EpiBf16 E{O, DM};
    pg8::gemm_phase<pg8::EpiBf16, pg8::RowSkipOrder, true, true>(F.lds, g, S, E);
}
template <bool ADD>
__device__ __forceinline__ void run_gemm_gate(Frame& F, const bf16* A, const bf16* Bt, bf16* O, const bf16* T, const bf16* G, bool skip) {
    const int cid = ADD ? (int)((blockIdx.x + F.G / 2) % F.G) : (int)blockIdx.x;
    pg8::Gemm g{A, Bt, MROWS, DM, DM}; pg8::RowSkipOrder S; S.init(DM, F.G, cid, skip);
    pg8::EpiGate<ADD> E{O, T, G, DM, INC};
    pg8::gemm_phase<pg8::EpiGate<ADD>, pg8::RowSkipOrder, true, true>(F.lds, g, S, E);
}

struct Args { const float* in[15]; float* out; unsigned char* ws; };
__global__ void __launch_bounds__(NWAVES * 64, 2) fwd_mega(Args args) {
    extern __shared__ __attribute__((aligned(16))) unsigned char lds[];
    cg::grid_group grid = cg::this_grid();
    Frame F;
    F.lds = (LAS unsigned char*)lds;
    F.G = gridDim.x; { const int bx = blockIdx.x; F.vcu = (F.G % 8 == 0) ? (bx % 8) * (F.G / 8) + bx / 8 : bx; }
    F.x = args.in[0]; F.c = args.in[1]; F.ctx = args.in[2]; F.c_ctx = args.in[3]; F.w_ada = args.in[4]; F.b_ada = args.in[5]; F.g_pre = args.in[6]; F.g_post = args.in[7];
    F.w_in = args.in[8]; F.sink = args.in[9]; F.lam_qk = args.in[10]; F.g_subln = args.in[11]; F.w_pa = args.in[12]; F.w_pb = args.in[13]; F.w_out = args.in[14];
    F.out = args.out; F.ws = args.ws;
    volatile LAS unsigned* MISC = (volatile LAS unsigned*)(F.lds + 149504);
    if (threadIdx.x < 32) MISC[threadIdx.x] = 0u;
    __syncthreads();
    const XcdBarrier bar = xcd_barrier_post((unsigned*)(F.ws + WS_BAR), MISC + 8);
    bf16* WinT = (bf16*)(F.ws + WS_WINT); bf16* WpT = (bf16*)(F.ws + WS_WPT); bf16* PX = (bf16*)(F.ws + WS_PX);
    bf16* S0 = (bf16*)(F.ws + WS_S0); bf16* S1 = (bf16*)(F.ws + WS_S0 + SLOT); bf16* S2 = (bf16*)(F.ws + WS_S0 + 2 * SLOT); bf16* S3 = (bf16*)(F.ws + WS_S0 + 3 * SLOT); bf16* S4 = (bf16*)(F.ws + WS_S0 + 4 * SLOT);

    ph_prologue(F);
    grid.sync();
#pragma unroll 1
    for (int l = 0; l < DEPTH; ++l) {
        const float* xcur = (l == 0) ? F.x : F.out;
        const float* ctxcur = (l == 0) ? F.ctx : (const float*)(F.ws + WS_CTX1);
        if (l == 0) { ph_hnorm(F, l, xcur, ctxcur); xcd_barrier(bar); }
        run_gemm_in(F, S0, WinT, PX);
        xcd_barrier(bar);
        ph_attn(F, l, (char*)lds);
        xcd_barrier(bar);
        ph_post(F, l);
        if (l + 1 < DEPTH) ph_convert_win(F, l + 1);
        xcd_barrier(bar);
        run_gemm_gate<false>(F, S3, WpT + (size_t)(l * 3 + 0) * DM * DM, S0, S0, PX + C_GA, l != 0);
        xcd_barrier(bar);
        run_gemm_gate<true>(F, S4, WpT + (size_t)(l * 3 + 1) * DM * DM, S2, S0, PX + C_GB, l != 0);
        xcd_barrier(bar);
        run_gemm_skip(F, S2, WpT + (size_t)(l * 3 + 2) * DM * DM, S3, l != 0);
        xcd_barrier(bar);
        ph_res(F, l, xcur, ctxcur);
        if (l + 1 < DEPTH) xcd_barrier(bar);
    }
}

extern "C" void kernel_launch(void* const* d_in, const int* in_sizes, int n_in, void* d_out, int out_size, void* d_ws, size_t ws_size, hipStream_t stream) {
    static int grid = 0;
    if (grid == 0) {
        if (n_in != 15 || out_size != NB * SEQ * DM || ws_size < WS_END) { fprintf(stderr, "kernel_launch: unexpected shapes: n_in %d out %d ws %zu (need %zu)\n", n_in, out_size, ws_size, (size_t)WS_END); grid = -1; return; }
        int dev = 0, cus = 0, per_cu = 0;
        if (hipGetDevice(&dev) != hipSuccess || hipDeviceGetAttribute(&cus, hipDeviceAttributeMultiprocessorCount, dev) != hipSuccess) { grid = -1; return; }
        if (hipFuncSetAttribute((const void*)fwd_mega, hipFuncAttributeMaxDynamicSharedMemorySize, LDS_BYTES) != hipSuccess) { fprintf(stderr, "kernel_launch: hipFuncSetAttribute failed\n"); grid = -1; return; }
        if (hipOccupancyMaxActiveBlocksPerMultiprocessor(&per_cu, (const void*)fwd_mega, NWAVES * 64, LDS_BYTES) != hipSuccess || per_cu < 1) { fprintf(stderr, "kernel_launch: occupancy query says %d\n", per_cu); per_cu = 1; }
        (void)hipGetLastError();
        grid = cus * per_cu;
    }
    if (grid < 0) return;
    if (hipMemsetAsync((char*)d_ws + WS_BAR, 0, WS_BAR_BYTES, stream) != hipSuccess) { fprintf(stderr, "kernel_launch: memset of the barrier words failed\n"); return; }
    Args a{};
    for (int i = 0; i < 15; ++i) a.in[i] = (const float*)d_in[i];
    a.out = (float*)d_out; a.ws = (unsigned char*)d_ws;
    void* kargs[] = {&a};
    hipError_t e = hipLaunchCooperativeKernel((const void*)fwd_mega, dim3(grid), dim3(NWAVES * 64), kargs, LDS_BYTES, stream);
    if (e != hipSuccess) fprintf(stderr, "kernel_launch: cooperative launch failed: %s (grid %d)\n", hipGetErrorString(e), grid);
}
```

```cpp
#include <hip/hip_runtime.h>
#include <hip/hip_bf16.h>
#include <hip/hip_cooperative_groups.h>
#include <cstdio>
#include <cstdint>
#include <cmath>
namespace cg = cooperative_groups;

constexpr int DM = 2048, NB = 2, SEQ = 8192, DEPTH = 2, CTX = 256;
constexpr int RPB = CTX + SEQ;
constexpr int MROWS = NB * RPB;
constexpr int INC = 17408;
constexpr int C_KA = 0, C_VA = 512, C_KB = 1024, C_VB = 3072, C_QA = 5120, C_ZA = 7168, C_QB = 9216, C_ZB = 11264, C_GA = 13312, C_GB = 15360;
constexpr float EPS = 1e-6f;

namespace pg8 {
#define PG8_LAS __attribute__((address_space(3)))
typedef unsigned short bf16_t;
typedef short bf16x8 __attribute__((ext_vector_type(8)));
typedef float f32x4 __attribute__((ext_vector_type(4)));
typedef unsigned u32x4 __attribute__((ext_vector_type(4)));
constexpr int BM = 256, BK = 64, HALF = 128, HTB = HALF * BK * 2  , STAGE_BYTES = 8 * HTB, NXCD = 8, WGM = 8;

__host__ __device__ __forceinline__ int lds_byte(int r, int c) { const int st = (r >> 4) * 2 + (c >> 5), rr = r & 15, cc = c & 31, ob = rr * 64 + cc * 2; return st * 1024 + (ob ^ (((ob >> 9) & 1) << 5)); }
__host__ __device__ __forceinline__ void stage_rc(int b, int& R, int& C) { const int st = b / 1024, sb = b % 1024, swz = sb ^ (((sb >> 9) & 1) << 5); R = (st >> 1) * 16 + swz / 64; C = (st & 1) * 32 + (swz % 64) / 2; }
__host__ __device__ __forceinline__ int perm32(int rho) { const int n = rho >> 4, i = rho & 15; return 8 * (i >> 2) + 4 * n + (i & 3); }

struct Unit { int pm, pn; };
struct Gemm { const bf16_t* A; const bf16_t* Bt; int M, N, K; };

struct StaticOrder {
    int nM, nN, nwg, G, c;
    __host__ __device__ void init(int M, int N, int G_, int c_) { nM = M / BM; nN = N / BM; nwg = nM * nN; G = G_; c = c_; }
    __host__ __device__ bool next(int i, Unit& u) const {
        const long L = (long)i * G + c; if (L >= nwg) return false;
        int wgid = (int)L; { const int q = nwg / NXCD, r = nwg % NXCD, xcd = wgid % NXCD, off = wgid / NXCD; wgid = (xcd < r ? xcd * (q + 1) : r * (q + 1) + (xcd - r) * q) + off; }
        const int nig = WGM * nN, gid = wgid / nig, fm = gid * WGM, gsz = (nM - fm) < WGM ? (nM - fm) : WGM;
        u.pm = fm + ((wgid % nig) % gsz); u.pn = (wgid % nig) / gsz; return true;
    }
    __device__ __forceinline__ void a_ready(const Unit&) const {}
    __device__ __forceinline__ void done(const Unit&) const {}
};

__device__ __forceinline__ unsigned cvt_pk_bf16(float lo, float hi) { unsigned r; asm volatile("v_cvt_pk_bf16_f32 %0, %1, %2" : "=v"(r) : "v"(lo), "v"(hi)); return r; }
typedef float f32x2 __attribute__((ext_vector_type(2)));

struct EpiBf16 {
    static constexpr bool PERM = true, AFTER_DRAIN = false;
    bf16_t* O; int ldc;
    __device__ __forceinline__ void operator()(const f32x4 (&acc)[2][2][4][2], const Unit& u, int wr, int wc, int fr, int fq) const {
        const int row0 = u.pm * BM + wr * 64 + fr; const int col0 = u.pn * BM + wc * 32 + 8 * fq;
#pragma unroll
        for (int ai = 0; ai < 2; ++ai)
#pragma unroll
            for (int m = 0; m < 4; ++m) { bf16_t* rowp = O + (size_t)(row0 + ai * HALF + m * 16) * ldc + col0;
#pragma unroll
                for (int bj = 0; bj < 2; ++bj) { const f32x4 v0 = acc[ai][bj][m][0], v1 = acc[ai][bj][m][1];
                    u32x4 w; w.x = cvt_pk_bf16(v0[0], v0[1]); w.y = cvt_pk_bf16(v0[2], v0[3]); w.z = cvt_pk_bf16(v1[0], v1[1]); w.w = cvt_pk_bf16(v1[2], v1[3]);
                    *(u32x4*)(rowp + bj * HALF) = w; } }
    }
};

__device__ __forceinline__ float sigm_(float x) { return 1.f / (1.f + __expf(-x)); }
__device__ __forceinline__ float blo_(unsigned w) { return __builtin_bit_cast(float, w << 16); }
__device__ __forceinline__ float bhi_(unsigned w) { return __builtin_bit_cast(float, w & 0xffff0000u); }
template <bool ADD> struct EpiGate {
    static constexpr bool PERM = true, AFTER_DRAIN = false;
    bf16_t* O; const bf16_t* T; const bf16_t* G; int ldc; int ldg;
    __device__ __forceinline__ void operator()(const f32x4 (&acc)[2][2][4][2], const Unit& u, int wr, int wc, int fr, int fq) const {
        const int row0 = u.pm * BM + wr * 64 + fr; const int col0 = u.pn * BM + wc * 32 + 8 * fq;
#pragma unroll
        for (int ai = 0; ai < 2; ++ai)
#pragma unroll
            for (int m = 0; m < 4; ++m) { const size_t row = (size_t)(row0 + ai * HALF + m * 16);
#pragma unroll
                for (int bj = 0; bj < 2; ++bj) { const f32x4 v0 = acc[ai][bj][m][0], v1 = acc[ai][bj][m][1];
                    const u32x4 g = *(const u32x4*)(G + row * ldg + col0 + bj * HALF);
                    float r0 = sigm_(blo_(g.x)) * v0[0], r1 = sigm_(bhi_(g.x)) * v0[1], r2 = sigm_(blo_(g.y)) * v0[2], r3 = sigm_(bhi_(g.y)) * v0[3];
                    float r4 = sigm_(blo_(g.z)) * v1[0], r5 = sigm_(bhi_(g.z)) * v1[1], r6 = sigm_(blo_(g.w)) * v1[2], r7 = sigm_(bhi_(g.w)) * v1[3];
                    if (ADD) { const u32x4 t = *(const u32x4*)(T + row * ldc + col0 + bj * HALF);
                        r0 += blo_(t.x); r1 += bhi_(t.x); r2 += blo_(t.y); r3 += bhi_(t.y); r4 += blo_(t.z); r5 += bhi_(t.z); r6 += blo_(t.w); r7 += bhi_(t.w); }
                    u32x4 w; w.x = cvt_pk_bf16(r0, r1); w.y = cvt_pk_bf16(r2, r3); w.z = cvt_pk_bf16(r4, r5); w.w = cvt_pk_bf16(r6, r7);
                    *(u32x4*)(O + row * ldc + col0 + bj * HALF) = w; } }
    }
};
struct RowSkipOrder {
    StaticOrder base; bool skip;
    __device__ void init(int N, int G_, int c_, bool skip_) { skip = skip_; base.init(skip_ ? 16384 : 16896, N, G_, c_); }
    __device__ bool next(int i, Unit& u) const { if (!base.next(i, u)) return false; if (skip) u.pm += 1 + (u.pm >= 32 ? 1 : 0); return true; }
    __device__ __forceinline__ void a_ready(const Unit&) const {}
    __device__ __forceinline__ void done(const Unit&) const {}
};

struct EpiRope {
    static constexpr bool PERM = true, AFTER_DRAIN = false;
    bf16_t* O; int ldc; const float* ct; const float* st;
    __device__ __forceinline__ void operator()(const f32x4 (&acc)[2][2][4][2], const Unit& u, int wr, int wc, int fr, int fq) const {
        const int pn = u.pn; const bool rope = pn < 2 || (pn >= 4 && pn < 12) || (pn >= 20 && pn < 28) || (pn >= 36 && pn < 44);
        const int row0 = u.pm * BM + wr * 64 + fr;
        if (!rope) {
            const int col0 = pn * BM + wc * 32 + 8 * fq;
#pragma unroll
            for (int ai = 0; ai < 2; ++ai)
#pragma unroll
                for (int m = 0; m < 4; ++m) { bf16_t* rowp = O + (size_t)(row0 + ai * HALF + m * 16) * ldc + col0;
#pragma unroll
                    for (int bj = 0; bj < 2; ++bj) { const f32x4 v0 = acc[ai][bj][m][0], v1 = acc[ai][bj][m][1];
                        u32x4 w; w.x = cvt_pk_bf16(v0[0], v0[1]); w.y = cvt_pk_bf16(v0[2], v0[3]); w.z = cvt_pk_bf16(v1[0], v1[1]); w.w = cvt_pk_bf16(v1[2], v1[3]);
                        *(u32x4*)(rowp + bj * HALF) = w; } }
            return;
        }
        const bool isctx = (u.pm == 0) || (u.pm == 33);
        const int i0 = 32 * (wc & 1) + 8 * fq, ocol = pn * BM + (wc >> 1) * 128 + i0;
        const int tbase = row0 - (u.pm >= 33 ? 8448 : 0) - 256;
#pragma unroll
        for (int ai = 0; ai < 2; ++ai)
#pragma unroll
            for (int m = 0; m < 4; ++m) { const int t = tbase + ai * HALF + m * 16;
                f32x4 c0 = {1.f, 1.f, 1.f, 1.f}, c1 = c0, s0 = {0.f, 0.f, 0.f, 0.f}, s1 = s0;
                if (!isctx) { const float* cp = ct + (size_t)t * 64 + i0; const float* sp = st + (size_t)t * 64 + i0;
                    c0 = *(const f32x4*)cp; c1 = *(const f32x4*)(cp + 4); s0 = *(const f32x4*)sp; s1 = *(const f32x4*)(sp + 4); }
                const f32x4 a0 = acc[ai][0][m][0], a1 = acc[ai][0][m][1], b0 = acc[ai][1][m][0], b1 = acc[ai][1][m][1];
                const f32x4 y0 = a0 * c0 - b0 * s0, y1 = a1 * c1 - b1 * s1, z0 = b0 * c0 + a0 * s0, z1 = b1 * c1 + a1 * s1;
                bf16_t* rowp = O + (size_t)(row0 + ai * HALF + m * 16) * ldc + ocol;
                u32x4 w; w.x = cvt_pk_bf16(y0[0], y0[1]); w.y = cvt_pk_bf16(y0[2], y0[3]); w.z = cvt_pk_bf16(y1[0], y1[1]); w.w = cvt_pk_bf16(y1[2], y1[3]);
                *(u32x4*)rowp = w;
                u32x4 x; x.x = cvt_pk_bf16(z0[0], z0[1]); x.y = cvt_pk_bf16(z0[2], z0[3]); x.z = cvt_pk_bf16(z1[0], z1[1]); x.w = cvt_pk_bf16(z1[2], z1[3]);
                *(u32x4*)(rowp + 64) = x; }
    }
};

template <class Epi, class Sched, bool ALIGN_EPI = false, bool SP2 = false>
__device__ __forceinline__ void gemm_phase(PG8_LAS unsigned char* lds, const Gemm g, const Sched& S, const Epi& E) {
    int tid_ = threadIdx.x; asm volatile("" : "+v"(tid_));
    const int tid = tid_, wid = __builtin_amdgcn_readfirstlane(tid >> 6), lane = tid & 63, wr = wid >> 2, wc = wid & 3, fr = lane & 15, fq = lane >> 4;
    const int K = g.K, nt = K / BK;
    unsigned voffA[2], voffB[2];
#pragma unroll
    for (int i = 0; i < 2; ++i) { int R, C; stage_rc(tid * 16 + i * 8192, R, C); const int Rb = Epi::PERM ? ((R & ~31) + perm32(R & 31)) : R;
        voffA[i] = (unsigned)(R * K + C) * 2u; voffB[i] = (unsigned)(Rb * K + C) * 2u; }
    const size_t kstep = (size_t)(BK * 2);
    const size_t hstep = (size_t)HALF * K * 2;
    const size_t tstep = 2 * hstep;
    const unsigned ldsw = (unsigned)wid * 1024u;
    const int aoff = lds_byte(wr * 64 + fr, fq * 8), boff = lds_byte(wc * 32 + fr, fq * 8);
#define PG8_SA(b, h) (((b) * 2 + (h)) * HTB)
#define PG8_SB(b, h) ((4 + (b) * 2 + (h)) * HTB)
#define PG8_STAGE(bufoff, gbase, voff) do { _Pragma("unroll") for (int _i = 0; _i < 2; ++_i) \
        __builtin_amdgcn_global_load_lds((const unsigned*)((const char*)(gbase) + (voff)[_i]), (PG8_LAS unsigned*)(lds + (bufoff) + ldsw + _i * 8192), 16, 0, 0); } while (0)
#define PG8_LDA(dst, b, h) do { _Pragma("unroll") for (int m = 0; m < 4; ++m) _Pragma("unroll") for (int k = 0; k < 2; ++k) dst[m][k] = *(const PG8_LAS bf16x8*)(lds + PG8_SA(b, h) + aoff + m * 2048 + k * 1024); } while (0)
#define PG8_LDB(dst, b, h) do { _Pragma("unroll") for (int n = 0; n < 2; ++n) _Pragma("unroll") for (int k = 0; k < 2; ++k) dst[n][k] = *(const PG8_LAS bf16x8*)(lds + PG8_SB(b, h) + boff + n * 2048 + k * 1024); } while (0)
#define PG8_MMA(ai, bj, At, Bt) do { __builtin_amdgcn_s_setprio(1); _Pragma("unroll") for (int m = 0; m < 4; ++m) _Pragma("unroll") for (int n = 0; n < 2; ++n) _Pragma("unroll") for (int k = 0; k < 2; ++k) \
        acc[ai][bj][m][n] = __builtin_amdgcn_mfma_f32_16x16x32_bf16(Bt[n][k], At[m][k], acc[ai][bj][m][n], 0, 0, 0); __builtin_amdgcn_s_setprio(0); } while (0)
#define PG8_WAIT_V(n) asm volatile("s_waitcnt vmcnt(" #n ")" ::: "memory")
#define PG8_WAIT_L(n) asm volatile("s_waitcnt lgkmcnt(" #n ")" ::: "memory")
#define PG8_BAR __builtin_amdgcn_s_barrier()
#define PG8_SCHED __builtin_amdgcn_sched_barrier(0)
    Unit cur, nxt; int ui = 0;
    if (!S.next(0, cur)) return;
    f32x4 acc[2][2][4][2];
#pragma unroll
    for (int a = 0; a < 2; ++a)
#pragma unroll
        for (int b = 0; b < 2; ++b)
#pragma unroll
            for (int m = 0; m < 4; ++m)
#pragma unroll
                for (int n = 0; n < 2; ++n) acc[a][b][m][n] = (f32x4){0.f, 0.f, 0.f, 0.f};
    bf16x8 At[4][2], B0[2][2], B1[2][2];
    const char* cA = (const char*)g.A + (size_t)cur.pm * tstep; const char* cB = (const char*)g.Bt + (size_t)cur.pn * tstep;
    S.a_ready(cur);
    if constexpr (SP2) {
        PG8_STAGE(PG8_SB(0, 0), cB, voffB); PG8_STAGE(PG8_SB(0, 1), cB + hstep, voffB); PG8_STAGE(PG8_SA(0, 0), cA, voffA); PG8_STAGE(PG8_SA(0, 1), cA + hstep, voffA);
        if (wr == 1) PG8_BAR;
        PG8_WAIT_V(2); PG8_BAR;
        PG8_STAGE(PG8_SB(1, 0), cB + kstep, voffB); PG8_STAGE(PG8_SA(1, 0), cA + kstep, voffA); PG8_STAGE(PG8_SB(1, 1), cB + hstep + kstep, voffB);
        PG8_WAIT_V(6); PG8_BAR;
    } else {
        PG8_STAGE(PG8_SB(0, 0), cB, voffB); PG8_STAGE(PG8_SA(0, 0), cA, voffA); PG8_STAGE(PG8_SB(0, 1), cB + hstep, voffB); PG8_STAGE(PG8_SA(0, 1), cA + hstep, voffA);
        if (wr == 1) PG8_BAR;
        PG8_WAIT_V(4); PG8_BAR;
        PG8_STAGE(PG8_SB(1, 0), cB + kstep, voffB); PG8_STAGE(PG8_SA(1, 0), cA + kstep, voffA); PG8_STAGE(PG8_SB(1, 1), cB + hstep + kstep, voffB);
        PG8_WAIT_V(6); PG8_BAR;
    }
    for (;;) {
        const bool has_next = S.next(ui + 1, nxt);
        const char* nA = has_next ? (const char*)g.A + (size_t)nxt.pm * tstep : cA; const char* nB = has_next ? (const char*)g.Bt + (size_t)nxt.pn * tstep : cB;
        for (int t = 0; t < nt; t += 2) {
            const bool last = (t == nt - 2);
            const char* a1 = cA + (size_t)(t + 1) * kstep;
            const char* a2 = last ? nA : cA + (size_t)(t + 2) * kstep; const char* b2 = last ? nB : cB + (size_t)(t + 2) * kstep;
            const char* a3 = a2 + kstep; const char* b3 = b2 + kstep;
            if (last && has_next) S.a_ready(nxt);
            if constexpr (SP2) {
            PG8_LDB(B0, 0, 0); PG8_LDB(B1, 0, 1); PG8_SCHED; PG8_LDA(At, 0, 0); PG8_STAGE(PG8_SA(1, 1), a1 + hstep, voffA);
            PG8_WAIT_V(8); PG8_WAIT_L(0); PG8_BAR; PG8_MMA(0, 0, At, B0); PG8_MMA(0, 1, At, B1); PG8_BAR; PG8_SCHED;
            PG8_LDA(At, 0, 1); PG8_STAGE(PG8_SB(0, 0), b2, voffB); PG8_STAGE(PG8_SB(0, 1), b2 + hstep, voffB); PG8_STAGE(PG8_SA(0, 0), a2, voffA);
            PG8_WAIT_V(8); PG8_WAIT_L(0); PG8_BAR; PG8_MMA(1, 0, At, B0); PG8_MMA(1, 1, At, B1); PG8_BAR; PG8_SCHED;
            PG8_LDB(B0, 1, 0); PG8_LDB(B1, 1, 1); PG8_SCHED; PG8_LDA(At, 1, 0); PG8_STAGE(PG8_SA(0, 1), a2 + hstep, voffA);
            PG8_WAIT_V(8); PG8_WAIT_L(0); PG8_BAR; PG8_MMA(0, 0, At, B0); PG8_MMA(0, 1, At, B1); PG8_BAR; PG8_SCHED;
            PG8_LDA(At, 1, 1); PG8_STAGE(PG8_SB(1, 0), b3, voffB); PG8_STAGE(PG8_SB(1, 1), b3 + hstep, voffB); PG8_STAGE(PG8_SA(1, 0), a3, voffA);
            PG8_WAIT_V(8); PG8_WAIT_L(0); PG8_BAR; PG8_MMA(1, 0, At, B0); PG8_MMA(1, 1, At, B1); PG8_BAR; PG8_SCHED;
            } else {
            PG8_LDB(B0, 0, 0); PG8_SCHED; PG8_LDA(At, 0, 0); PG8_STAGE(PG8_SA(1, 1), a1 + hstep, voffA);
            PG8_WAIT_L(8); PG8_BAR; PG8_WAIT_L(0); PG8_MMA(0, 0, At, B0); PG8_BAR; PG8_SCHED;
            PG8_LDB(B1, 0, 1); PG8_STAGE(PG8_SB(0, 0), b2, voffB);
            PG8_BAR; PG8_WAIT_L(0); PG8_MMA(0, 1, At, B1); PG8_BAR;
            PG8_LDA(At, 0, 1); PG8_STAGE(PG8_SA(0, 0), a2, voffA);
            PG8_BAR; PG8_WAIT_L(0); PG8_MMA(1, 0, At, B0); PG8_BAR; PG8_SCHED;
            PG8_STAGE(PG8_SB(0, 1), b2 + hstep, voffB);
            PG8_WAIT_V(6); PG8_BAR; PG8_MMA(1, 1, At, B1); PG8_BAR;
            PG8_LDB(B0, 1, 0); PG8_SCHED; PG8_LDA(At, 1, 0); PG8_STAGE(PG8_SA(0, 1), a2 + hstep, voffA);
            PG8_WAIT_L(8); PG8_BAR; PG8_WAIT_L(0); PG8_MMA(0, 0, At, B0); PG8_BAR; PG8_SCHED;
            PG8_LDB(B1, 1, 1); PG8_STAGE(PG8_SB(1, 0), b3, voffB);
            PG8_BAR; PG8_WAIT_L(0); PG8_MMA(0, 1, At, B1); PG8_BAR;
            PG8_LDA(At, 1, 1); PG8_STAGE(PG8_SA(1, 0), a3, voffA);
            PG8_BAR; PG8_WAIT_L(0); PG8_MMA(1, 0, At, B0); PG8_BAR; PG8_SCHED;
            PG8_STAGE(PG8_SB(1, 1), b3 + hstep, voffB);
            PG8_WAIT_V(6); PG8_BAR; PG8_MMA(1, 1, At, B1); PG8_BAR;
            }
        }
        if constexpr (ALIGN_EPI) { if (wr == 0) PG8_BAR; }
        if constexpr (!Epi::AFTER_DRAIN) { E(acc, cur, wr, wc, fr, fq); S.done(cur); }
        if (!has_next) break;
#pragma unroll
        for (int a = 0; a < 2; ++a)
#pragma unroll
            for (int b = 0; b < 2; ++b)
#pragma unroll
                for (int m = 0; m < 4; ++m)
#pragma unroll
                    for (int n = 0; n < 2; ++n) acc[a][b][m][n] = (f32x4){0.f, 0.f, 0.f, 0.f};
        cur = nxt; cA = nA; cB = nB; ++ui;
        if constexpr (ALIGN_EPI) { if (wr == 1) PG8_BAR; }
    }
    PG8_WAIT_V(0);
    if constexpr (!ALIGN_EPI) { if (wr == 0) PG8_BAR; }
    PG8_BAR;
    if constexpr (Epi::AFTER_DRAIN) { E.fused(acc, cur, wr, wc, fr, fq, lds, wid, lane); S.done(cur); }
#undef PG8_SA
#undef PG8_SB
#undef PG8_STAGE
#undef PG8_LDA
#undef PG8_LDB
#undef PG8_MMA
#undef PG8_WAIT_V
#undef PG8_WAIT_L
#undef PG8_BAR
#undef PG8_SCHED
}
}

namespace att {
using bf16 = unsigned short;
constexpr int D = 128, NW = 8, QBLK = 32, KVBLK = 64;
constexpr float SCALE = 0.088388347648318440f;
constexpr float THR = 8.f;
constexpr int SDEPTH = 2;
constexpr int LDQ = INC, LDK = INC, LDO = DM;
constexpr size_t SHM_V = KVBLK * D * 2, SHM_K = KVBLK * D * 2, SHM_ATTN = 2 * SHM_V + 2 * SHM_K + NW * 64 * 4;

using bf16x8 = __attribute__((ext_vector_type(8))) short;
using s16x4  = __attribute__((ext_vector_type(4))) short;
using f32x16 = __attribute__((ext_vector_type(16))) float;
using f32x8  = __attribute__((ext_vector_type(8))) float;
using u32x4  = __attribute__((ext_vector_type(4))) unsigned;
#define KSWZ(row, colB) ((row) * 256 + ((colB) ^ (((row) & 7) << 4)))
#define SBAR() __builtin_amdgcn_sched_barrier(0)
__device__ __forceinline__ int crow(int r, int hi) { return (r & 3) + 8 * (r >> 2) + 4 * hi; }
__device__ __forceinline__ unsigned cvtpk(float lo, float hi) {
  unsigned r; asm volatile("v_cvt_pk_bf16_f32 %0, %1, %2" : "=v"(r) : "v"(lo), "v"(hi)); return r;
}
template <typename TIn> struct Stage;
template <> struct Stage<bf16>  { using T = bf16x8;
  __device__ static __forceinline__ T ld8(const bf16* p) { return *reinterpret_cast<const bf16x8*>(p); }
  __device__ static __forceinline__ bf16x8 tobf(T x) { return x; } };
template <> struct Stage<float> { using T = f32x8;
  __device__ static __forceinline__ T ld8(const float* p) { return *reinterpret_cast<const f32x8*>(p); }
  __device__ static __forceinline__ bf16x8 tobf(T x) {
    u32x4 w = {cvtpk(x[0], x[1]), cvtpk(x[2], x[3]), cvtpk(x[4], x[5]), cvtpk(x[6], x[7])}; return *reinterpret_cast<bf16x8*>(&w); } };

__device__ __forceinline__ void partialSM(f32x16& p0, f32x16& p1, float& m_reg, float& mn, float& alpha) {
  constexpr float C = SCALE * 1.4426950408889634f;
  float pmax = p0[0]; for (int r = 1; r < 16; ++r) pmax = fmaxf(pmax, p0[r]); for (int r = 0; r < 16; ++r) pmax = fmaxf(pmax, p1[r]);
  { auto rr = __builtin_amdgcn_permlane32_swap(__float_as_uint(pmax), __float_as_uint(pmax), false, false);
    pmax = fmaxf(__uint_as_float(rr[0]), __uint_as_float(rr[1])); }
  if (__builtin_expect(__all(pmax - m_reg <= THR / SCALE), 1)) { mn = m_reg; alpha = 1.f; }
  else { mn = fmaxf(m_reg, pmax); alpha = __builtin_amdgcn_exp2f((m_reg - mn) * C); m_reg = mn; }
  float mnC = -mn * C;
  for (int r = 0; r < 16; ++r) p0[r] = fmaf(p0[r], C, mnC); for (int r = 0; r < 16; ++r) p1[r] = fmaf(p1[r], C, mnC);
  for (int r = 0; r < 16; ++r) p0[r] = __builtin_amdgcn_exp2f(p0[r]);
}
__device__ __forceinline__ void finishSM(f32x16& p0, f32x16& p1, float alpha, float& l_reg, bf16x8& pa0, bf16x8& pa1, bf16x8& pa2, bf16x8& pa3) {
  for (int r = 0; r < 16; ++r) p1[r] = __builtin_amdgcn_exp2f(p1[r]);
  float ps = 0; for (int r = 0; r < 16; ++r) ps += p0[r]; for (int r = 0; r < 16; ++r) ps += p1[r];
  { auto rr = __builtin_amdgcn_permlane32_swap(__float_as_uint(ps), __float_as_uint(ps), false, false);
    ps = __uint_as_float(rr[0]) + __uint_as_float(rr[1]); }
  l_reg = l_reg * alpha + ps;
#define PK4(P, BASE, OUT) do { unsigned a0 = cvtpk(P[BASE + 0], P[BASE + 1]), a1 = cvtpk(P[BASE + 2], P[BASE + 3]);   \
    unsigned b0 = cvtpk(P[BASE + 4], P[BASE + 5]), b1 = cvtpk(P[BASE + 6], P[BASE + 7]);                              \
    auto r0 = __builtin_amdgcn_permlane32_swap(a0, b0, false, false); auto r1 = __builtin_amdgcn_permlane32_swap(a1, b1, false, false); \
    u32x4 w = {r0[0], r1[0], r0[1], r1[1]}; OUT = *reinterpret_cast<bf16x8*>(&w); } while (0)
  PK4(p0, 0, pa0); PK4(p0, 8, pa1); PK4(p1, 0, pa2); PK4(p1, 8, pa3);
#undef PK4
}
__device__ __forceinline__ void qkt(f32x16& p0, f32x16& p1, const bf16* Ks, const bf16x8* qr, int r32, int hi) {
  p0 = f32x16{}; p1 = f32x16{};
  for (int d0 = 0; d0 < 8; ++d0) { int cb = (d0 * 16 + hi * 8) * 2;
    bf16x8 b0 = *reinterpret_cast<const bf16x8*>((const char*)Ks + KSWZ(r32, cb));
    bf16x8 b1 = *reinterpret_cast<const bf16x8*>((const char*)Ks + KSWZ(32 + r32, cb));
    p0 = __builtin_amdgcn_mfma_f32_32x32x16_bf16(b0, qr[d0], p0, 0, 0, 0);
    p1 = __builtin_amdgcn_mfma_f32_32x32x16_bf16(b1, qr[d0], p1, 0, 0, 0); }
}
__device__ __forceinline__ int v_st(int k, int c) { const int kk = (k & ~0xC) | ((k & 4) << 1) | ((k & 8) >> 1); return ((kk >> 3) * 4 + (c >> 5)) * 512 + ((kk & 7) * 32 + (c & 31)) * 2; }
__device__ __forceinline__ int v_rd_base(int lane) { return ((lane & 3) << 3) | (((lane >> 2) & 3) << 6) | (((lane >> 4) & 1) << 5) | (((lane >> 5) & 1) << 8); }
constexpr int v_rd_off(int d0, int ks, int half) { return d0 * 512 + ks * 4096 + half * 2048; }
template <int OFF> __device__ __forceinline__ s16x4 tr_read(int vb) {
  s16x4 r; asm volatile("ds_read_b64_tr_b16 %0, %1 offset:%2" : "=&v"(r) : "v"(vb), "i"(OFF) : "memory"); return r;
}
template <int D0> __device__ __forceinline__ void pv_one(f32x16& od, int vb, bf16x8 pa0, bf16x8 pa1, bf16x8 pa2, bf16x8 pa3) {
  const s16x4 l0 = tr_read<v_rd_off(D0, 0, 0)>(vb), h0 = tr_read<v_rd_off(D0, 0, 1)>(vb), l1 = tr_read<v_rd_off(D0, 1, 0)>(vb), h1 = tr_read<v_rd_off(D0, 1, 1)>(vb);
  const s16x4 l2 = tr_read<v_rd_off(D0, 2, 0)>(vb), h2 = tr_read<v_rd_off(D0, 2, 1)>(vb), l3 = tr_read<v_rd_off(D0, 3, 0)>(vb), h3 = tr_read<v_rd_off(D0, 3, 1)>(vb);
  asm volatile("s_waitcnt lgkmcnt(0)" ::: "memory"); SBAR();
#define PK(L, H) (bf16x8){L[0], L[1], L[2], L[3], H[0], H[1], H[2], H[3]}
  od = __builtin_amdgcn_mfma_f32_32x32x16_bf16(pa0, PK(l0, h0), od, 0, 0, 0);
  od = __builtin_amdgcn_mfma_f32_32x32x16_bf16(pa1, PK(l1, h1), od, 0, 0, 0);
  od = __builtin_amdgcn_mfma_f32_32x32x16_bf16(pa2, PK(l2, h2), od, 0, 0, 0);
  od = __builtin_amdgcn_mfma_f32_32x32x16_bf16(pa3, PK(l3, h3), od, 0, 0, 0);
#undef PK
}
__device__ __forceinline__ void pv_d0(f32x16* o, int vb, bf16x8 pa0, bf16x8 pa1, bf16x8 pa2, bf16x8 pa3) {
  pv_one<0>(o[0], vb, pa0, pa1, pa2, pa3); pv_one<1>(o[1], vb, pa0, pa1, pa2, pa3); pv_one<2>(o[2], vb, pa0, pa1, pa2, pa3); pv_one<3>(o[3], vb, pa0, pa1, pa2, pa3);
}

__device__ __forceinline__ void band_mask(f32x16& p0, f32x16& p1, int dq  , int hi) {
#pragma unroll
  for (int r = 0; r < 16; ++r) { const int d = dq - crow(r, hi);
    if ((unsigned)(d + 128) > 256u) p0[r] = -1e30f;
    if ((unsigned)(d + 96) > 256u) p1[r] = -1e30f; }
}
template <bool MASK>
__device__ __forceinline__ void attn_body(const bf16* __restrict__ Qb, const bf16* __restrict__ Kh, const bf16* __restrict__ Vh,
                                          bf16* __restrict__ Ob, int NT, int NCT, int lo, int qpos0, float sinkl2, char* lds) {
  using St = Stage<bf16>;
  int tid_ = threadIdx.x; asm volatile("" : "+v"(tid_));
  const int tid = tid_, wid = tid >> 6, lane = tid & 63, r32 = lane & 31, hi = lane >> 5;
  bf16* V_lds = (bf16*)lds; bf16* K_lds = (bf16*)(lds + 2 * SHM_V);
  float* ws = (float*)(lds + 2 * SHM_V + 2 * SHM_K) + wid * 64; float* li_l = ws; float* al_l = ws + 32;
  float m_reg = -1e30f, l_reg = 0; f32x16 o[4] = {}; bf16x8 qr[8];
  const bf16* Qw = Qb + (long)(wid * QBLK + r32) * LDQ + hi * 8;
#pragma unroll
  for (int d0 = 0; d0 < 8; ++d0) qr[d0] = St::ld8(Qw + d0 * 16);
  const int sr = tid >> 4, sc = (tid & 15) * 8, vst0 = v_st(sr, sc), vst1 = v_st(32 + sr, sc);
  const int vb0 = (int)(uintptr_t)V_lds + v_rd_base(lane);
  const int qi = qpos0 + wid * QBLK + r32;
  struct { typename St::T vs0, vs1, ks0, ks1; } sr_[SDEPTH];
#define TROW(j) (64 * (j) + ((j) >= NCT ? lo : 0))
#define SLOAD(i, k0) do { const long k0_ = (k0); sr_[i].vs0 = St::ld8(&Vh[(k0_ + sr) * LDK + sc]); sr_[i].vs1 = St::ld8(&Vh[(k0_ + 32 + sr) * LDK + sc]); \
    sr_[i].ks0 = St::ld8(&Kh[(k0_ + sr) * LDK + sc]); sr_[i].ks1 = St::ld8(&Kh[(k0_ + 32 + sr) * LDK + sc]); } while (0)
#define SWRITE(b, i) do { *(bf16x8*)((char*)V_lds + (b) * SHM_V + vst0) = St::tobf(sr_[i].vs0);          \
    *(bf16x8*)((char*)V_lds + (b) * SHM_V + vst1) = St::tobf(sr_[i].vs1); int kc = sc * 2;               \
    *(bf16x8*)((char*)K_lds + (b) * SHM_K + KSWZ(sr, kc)) = St::tobf(sr_[i].ks0);                       \
    *(bf16x8*)((char*)K_lds + (b) * SHM_K + KSWZ(32 + sr, kc)) = St::tobf(sr_[i].ks1); } while (0)
#define SWAIT() do { if constexpr (SDEPTH == 2) asm volatile("s_waitcnt vmcnt(4)" ::: "memory"); else asm volatile("s_waitcnt vmcnt(0)" ::: "memory"); } while (0)
#define RESC(a) do { if (__any((a) < 1.f)) { if (hi == 0) al_l[r32] = (a); asm volatile("s_waitcnt lgkmcnt(0)" ::: "memory"); \
    for (int d = 0; d < 4; ++d) for (int r = 0; r < 16; ++r) o[d][r] *= al_l[crow(r, hi)]; } } while (0)
#define AMASK(P0, P1, j) do { if constexpr (MASK) { if ((j) >= NCT) band_mask(P0, P1, qi - (lo + 64 * ((j) - NCT)), hi); } } while (0)
  f32x16 pA0, pA1, pB0, pB1; float mnA, mnB, alA, alB; bf16x8 pa0, pa1, pa2, pa3;
  constexpr int SE = 0, SO = SDEPTH - 1;
  SLOAD(SE, TROW(0)); asm volatile("s_waitcnt vmcnt(0)" ::: "memory"); SWRITE(0, SE); __syncthreads();
  qkt(pA0, pA1, K_lds, qr, r32, hi); AMASK(pA0, pA1, 0); partialSM(pA0, pA1, m_reg, mnA, alA);
  SLOAD(SO, TROW(1)); if constexpr (SDEPTH == 2) { if (2 < NT) SLOAD(SE, TROW(2)); }
  SWAIT(); SWRITE(1, SO); __syncthreads();
  for (int j = 1; j + 1 < NT; j += 2) {
    SBAR(); qkt(pB0, pB1, (bf16*)((char*)K_lds + SHM_K), qr, r32, hi); AMASK(pB0, pB1, j);
    finishSM(pA0, pA1, alA, l_reg, pa0, pa1, pa2, pa3); SBAR();
    SLOAD(SO, TROW(j + SDEPTH)); SBAR();
    pv_d0(o, vb0, pa0, pa1, pa2, pa3); partialSM(pB0, pB1, m_reg, mnB, alB);
    __syncthreads(); SWAIT(); SWRITE(0, SE);
    RESC(alB); __syncthreads();
    SBAR(); qkt(pA0, pA1, K_lds, qr, r32, hi); AMASK(pA0, pA1, j + 1);
    finishSM(pB0, pB1, alB, l_reg, pa0, pa1, pa2, pa3); SBAR();
    if (SDEPTH == 1 || j + 3 < NT) SLOAD(SE, TROW(j + 1 + SDEPTH)); SBAR();
    pv_d0(o, vb0 + (int)SHM_V, pa0, pa1, pa2, pa3); partialSM(pA0, pA1, m_reg, mnA, alA);
    __syncthreads(); SWAIT(); SWRITE(1, SO);
    RESC(alA); __syncthreads();
  }
  SBAR(); qkt(pB0, pB1, (bf16*)((char*)K_lds + SHM_K), qr, r32, hi); AMASK(pB0, pB1, NT - 1);
  finishSM(pA0, pA1, alA, l_reg, pa0, pa1, pa2, pa3); SBAR();
  pv_d0(o, vb0, pa0, pa1, pa2, pa3); partialSM(pB0, pB1, m_reg, mnB, alB);
  __syncthreads(); RESC(alB);
  finishSM(pB0, pB1, alB, l_reg, pa0, pa1, pa2, pa3); SBAR();
  pv_d0(o, vb0 + (int)SHM_V, pa0, pa1, pa2, pa3);
  l_reg += __builtin_amdgcn_exp2f(sinkl2 - m_reg * (SCALE * 1.4426950408889634f));
  if (hi == 0) li_l[r32] = l_reg; asm volatile("s_waitcnt lgkmcnt(0)" ::: "memory");
  float rli[16];
#pragma unroll
  for (int r = 0; r < 16; ++r) rli[r] = __builtin_amdgcn_rcpf(li_l[crow(r, hi)]);
  bf16* Ow = Ob + (long)(wid * QBLK) * LDO;
#pragma unroll
  for (int r = 0; r < 16; ++r) { int orow = crow(r, hi);
    for (int d0 = 0; d0 < 4; ++d0) { const float v = o[d0][r] * rli[r]; const unsigned u = __builtin_bit_cast(unsigned, v);
      Ow[(long)orow * LDO + d0 * 32 + r32] = (bf16)((u + 0x7fffu + ((u >> 16) & 1u)) >> 16); } }
  __syncthreads();
#undef TROW
#undef SLOAD
#undef SWRITE
#undef SWAIT
#undef RESC
#undef AMASK
}

template <int OFF> __device__ __forceinline__ bf16x8 k_read(int addr) { bf16x8 r; asm volatile("ds_read_b128 %0, %1 offset:%2" : "=&v"(r) : "v"(addr), "i"(OFF) : "memory"); return r; }
__device__ __forceinline__ void qkt_pipe(f32x16& p0, f32x16& p1, const bf16* Ks, const bf16x8* qr, int r32, int hi) {
  p0 = f32x16{}; p1 = f32x16{};
  const int kb = (int)(uintptr_t)Ks + r32 * 256, sw = (r32 & 7) << 4;
  const int e0 = kb + ((0 * 32 + hi * 16) ^ sw), e1 = kb + ((1 * 32 + hi * 16) ^ sw), e2 = kb + ((2 * 32 + hi * 16) ^ sw), e3 = kb + ((3 * 32 + hi * 16) ^ sw);
  bf16x8 a0, a1, b0, b1;
#define LGK(n) do { asm volatile("s_waitcnt lgkmcnt(" #n ")" ::: "memory"); SBAR(); } while (0)
#define MM(A0, A1, d) do { p0 = __builtin_amdgcn_mfma_f32_32x32x16_bf16(A0, qr[d], p0, 0, 0, 0); p1 = __builtin_amdgcn_mfma_f32_32x32x16_bf16(A1, qr[d], p1, 0, 0, 0); SBAR(); } while (0)
  a0 = k_read<0>(e0); a1 = k_read<8192>(e0); b0 = k_read<0>(e1); b1 = k_read<8192>(e1);
  LGK(2); MM(a0, a1, 0); a0 = k_read<0>(e2); a1 = k_read<8192>(e2);
  LGK(2); MM(b0, b1, 1); b0 = k_read<0>(e3); b1 = k_read<8192>(e3);
  LGK(2); MM(a0, a1, 2); a0 = k_read<128>(e0); a1 = k_read<8320>(e0);
  LGK(2); MM(b0, b1, 3); b0 = k_read<128>(e1); b1 = k_read<8320>(e1);
  LGK(2); MM(a0, a1, 4); a0 = k_read<128>(e2); a1 = k_read<8320>(e2);
  LGK(2); MM(b0, b1, 5); b0 = k_read<128>(e3); b1 = k_read<8320>(e3);
  LGK(2); MM(a0, a1, 6);
  LGK(0); MM(b0, b1, 7);
#undef LGK
#undef MM
}
struct VFr { s16x4 l0, h0, l1, h1, l2, h2, l3, h3; };
template <int DB> __device__ __forceinline__ void pv_ld(VFr& f, int vb) {
  constexpr int I = (DB >> 2) * 16384, D0 = DB & 3;
  f.l0 = tr_read<I + v_rd_off(D0, 0, 0)>(vb); f.h0 = tr_read<I + v_rd_off(D0, 0, 1)>(vb); f.l1 = tr_read<I + v_rd_off(D0, 1, 0)>(vb); f.h1 = tr_read<I + v_rd_off(D0, 1, 1)>(vb);
  f.l2 = tr_read<I + v_rd_off(D0, 2, 0)>(vb); f.h2 = tr_read<I + v_rd_off(D0, 2, 1)>(vb); f.l3 = tr_read<I + v_rd_off(D0, 3, 0)>(vb); f.h3 = tr_read<I + v_rd_off(D0, 3, 1)>(vb);
}
__device__ __forceinline__ void pv_mm(f32x16& od, const VFr& f, bf16x8 pa0, bf16x8 pa1, bf16x8 pa2, bf16x8 pa3) {
#define PK(L, H) (bf16x8){L[0], L[1], L[2], L[3], H[0], H[1], H[2], H[3]}
  od = __builtin_amdgcn_mfma_f32_32x32x16_bf16(pa0, PK(f.l0, f.h0), od, 0, 0, 0);
  od = __builtin_amdgcn_mfma_f32_32x32x16_bf16(pa1, PK(f.l1, f.h1), od, 0, 0, 0);
  od = __builtin_amdgcn_mfma_f32_32x32x16_bf16(pa2, PK(f.l2, f.h2), od, 0, 0, 0);
  od = __builtin_amdgcn_mfma_f32_32x32x16_bf16(pa3, PK(f.l3, f.h3), od, 0, 0, 0);
#undef PK
}
__device__ __forceinline__ void pv_all(f32x16* o, int vb, bf16x8 pa0, bf16x8 pa1, bf16x8 pa2, bf16x8 pa3) {
  VFr fa, fb;
#define W8() do { asm volatile("s_waitcnt lgkmcnt(8)" ::: "memory"); SBAR(); } while (0)
#define W0() do { asm volatile("s_waitcnt lgkmcnt(0)" ::: "memory"); SBAR(); } while (0)
  pv_ld<0>(fa, vb);
  pv_ld<1>(fb, vb); W8(); pv_mm(o[0], fa, pa0, pa1, pa2, pa3); SBAR();
  pv_ld<2>(fa, vb); W8(); pv_mm(o[1], fb, pa0, pa1, pa2, pa3); SBAR();
  pv_ld<3>(fb, vb); W8(); pv_mm(o[2], fa, pa0, pa1, pa2, pa3); SBAR();
  pv_ld<4>(fa, vb); W8(); pv_mm(o[3], fb, pa0, pa1, pa2, pa3); SBAR();
  pv_ld<5>(fb, vb); W8(); pv_mm(o[4], fa, pa0, pa1, pa2, pa3); SBAR();
  pv_ld<6>(fa, vb); W8(); pv_mm(o[5], fb, pa0, pa1, pa2, pa3); SBAR();
  pv_ld<7>(fb, vb); W8(); pv_mm(o[6], fa, pa0, pa1, pa2, pa3); SBAR();
  W0(); pv_mm(o[7], fb, pa0, pa1, pa2, pa3);
#undef W8
#undef W0
}
#define ATT_LAS __attribute__((address_space(3)))
struct VH { s16x4 l0, h0, l1, h1; };
template <int DB, int KS> __device__ __forceinline__ void pv_ldh(VH& f, int vb) {
  constexpr int I = (DB >> 2) * 16384, D0 = DB & 3;
  f.l0 = tr_read<I + v_rd_off(D0, KS, 0)>(vb); f.h0 = tr_read<I + v_rd_off(D0, KS, 1)>(vb); f.l1 = tr_read<I + v_rd_off(D0, KS + 1, 0)>(vb); f.h1 = tr_read<I + v_rd_off(D0, KS + 1, 1)>(vb);
}
#define PKV(L, H) (bf16x8){L[0], L[1], L[2], L[3], H[0], H[1], H[2], H[3]}
#define PK4S(P, BASE, OUT) do { unsigned a0_ = cvtpk(P[BASE + 0], P[BASE + 1]), a1_ = cvtpk(P[BASE + 2], P[BASE + 3]);   \
    unsigned b0_ = cvtpk(P[BASE + 4], P[BASE + 5]), b1_ = cvtpk(P[BASE + 6], P[BASE + 7]);                              \
    auto r0_ = __builtin_amdgcn_permlane32_swap(a0_, b0_, false, false); auto r1_ = __builtin_amdgcn_permlane32_swap(a1_, b1_, false, false); \
    u32x4 w_ = {r0_[0], r1_[0], r0_[1], r1_[1]}; OUT = *reinterpret_cast<bf16x8*>(&w_); } while (0)
__device__ __forceinline__ void smpv_all(f32x16& p0, f32x16& p1, float alpha, float& l_reg, f32x16* o, int vb,
                                         const char* kb, const char* vbg, ATT_LAS unsigned char* kdst, ATT_LAS unsigned char* vdst, bool dma) {
  bf16x8 pa0, pa1, pa2, pa3; VH fa, fb; float s0 = 0.f, s1 = 0.f;
  PK4S(p0, 0, pa0); PK4S(p0, 8, pa1);
#define WL(n) do { asm volatile("s_waitcnt lgkmcnt(" #n ")" ::: "memory"); SBAR(); } while (0)
#define P1BLK(B, FC, FN, LAST) do { if (!(LAST)) pv_ldh<((B) + 1) & 7, 0>(FN, vb); if (LAST) WL(0); else WL(4); \
    o[B] = __builtin_amdgcn_mfma_f32_32x32x16_bf16(pa0, PKV(FC.l0, FC.h0), o[B], 0, 0, 0); \
    p1[2 * (B)] = __builtin_amdgcn_exp2f(p1[2 * (B)]); s0 += p0[2 * (B)]; s1 += p0[2 * (B) + 1]; SBAR(); \
    o[B] = __builtin_amdgcn_mfma_f32_32x32x16_bf16(pa1, PKV(FC.l1, FC.h1), o[B], 0, 0, 0); \
    p1[2 * (B) + 1] = __builtin_amdgcn_exp2f(p1[2 * (B) + 1]); if ((B) > 0) { s0 += p1[2 * (B) - 2]; s1 += p1[2 * (B) - 1]; } SBAR(); } while (0)
  pv_ldh<0, 0>(fa, vb);
  P1BLK(0, fa, fb, false); P1BLK(1, fb, fa, false); P1BLK(2, fa, fb, false); P1BLK(3, fb, fa, false);
  P1BLK(4, fa, fb, false); P1BLK(5, fb, fa, false); P1BLK(6, fa, fb, false); P1BLK(7, fb, fa, true);
  pv_ldh<0, 2>(fa, vb);
  s0 += p1[14]; s1 += p1[15];
  float ps = s0 + s1;
  { auto rr = __builtin_amdgcn_permlane32_swap(__float_as_uint(ps), __float_as_uint(ps), false, false); ps = __uint_as_float(rr[0]) + __uint_as_float(rr[1]); }
  l_reg = l_reg * alpha + ps;
  PK4S(p1, 0, pa2); PK4S(p1, 8, pa3); SBAR();
#define DMAP(B) do { if (dma) { if ((B) < 2) __builtin_amdgcn_global_load_lds((const unsigned*)(kb + (B) * (32 * LDK * 2)), (ATT_LAS unsigned*)(kdst + (B) * 8192), 16, 0, 0); \
      else if ((B) < 6) __builtin_amdgcn_global_load_lds((const unsigned*)(vbg + (((B) - 2) & 1) * (32 * LDK * 2) + (((B) - 2) >> 1) * 256), (ATT_LAS unsigned*)(vdst + ((B) - 2) * 8192), 16, 0, 0); } } while (0)
#define P2BLK(B, FC, FN, LAST) do { if (!(LAST)) pv_ldh<((B) + 1) & 7, 2>(FN, vb); if (LAST) WL(0); else WL(4); \
    o[B] = __builtin_amdgcn_mfma_f32_32x32x16_bf16(pa2, PKV(FC.l0, FC.h0), o[B], 0, 0, 0); DMAP(B); \
    o[B] = __builtin_amdgcn_mfma_f32_32x32x16_bf16(pa3, PKV(FC.l1, FC.h1), o[B], 0, 0, 0); SBAR(); } while (0)
  P2BLK(0, fa, fb, false); P2BLK(1, fb, fa, false); P2BLK(2, fa, fb, false); P2BLK(3, fb, fa, false);
  P2BLK(4, fa, fb, false); P2BLK(5, fb, fa, false); P2BLK(6, fa, fb, false); P2BLK(7, fb, fa, true);
#undef WL
#undef P1BLK
#undef P2BLK
#undef DMAP
}
#undef PKV
#undef PK4S
__device__ __forceinline__ void attn_body_v256(const bf16* __restrict__ Qb, const bf16* __restrict__ Kh, const bf16* __restrict__ Vh,
                                               bf16* __restrict__ Ob, int NT, ATT_LAS unsigned char* ldsl) {
  using St = Stage<bf16>;
  int tid_ = threadIdx.x; asm volatile("" : "+v"(tid_));
  const int tid = tid_, wid = __builtin_amdgcn_readfirstlane(tid >> 6), lane = tid & 63, r32 = lane & 31, hi = lane >> 5;
  char* lds = (char*)ldsl;
  float* ws = (float*)(lds + 147456) + wid * 64; float* li_l = ws; float* al_l = ws + 32;
  float m_reg = -1e30f, l_reg = 0; f32x16 o[8] = {}; bf16x8 qr[8];
  const bf16* Qw = Qb + (long)(wid * QBLK + r32) * LDQ + hi * 8;
#pragma unroll
  for (int d0 = 0; d0 < 8; ++d0) qr[d0] = St::ld8(Qw + d0 * 16);
  unsigned offK0, offV0;
  { const int row = wid * 4 + (lane >> 4), colB = ((lane & 15) * 16) ^ ((row & 7) << 4); offK0 = (unsigned)row * (LDK * 2) + (unsigned)colB;
    const int sub = wid * 2 + (lane >> 5), kkhi = sub >> 2, cblk = sub & 3, within = (lane & 31) * 16, kk = kkhi * 8 + (within >> 6);
    const int k = (kk & ~0xC) | ((kk & 4) << 1) | ((kk & 8) >> 1), c = cblk * 32 + ((within & 63) >> 1);
    offV0 = (unsigned)k * (LDK * 2) + (unsigned)c * 2; }
  const int vb0 = (int)(uintptr_t)lds + 16384 + v_rd_base(lane);
#define DMA_TILE(j, sbo) do { const char* kb_ = (const char*)Kh + (size_t)(j) * (64 * LDK * 2) + offK0; const char* vb_ = (const char*)Vh + (size_t)(j) * (64 * LDK * 2) + offV0; \
    _Pragma("unroll") for (int i_ = 0; i_ < 2; ++i_) __builtin_amdgcn_global_load_lds((const unsigned*)(kb_ + i_ * (32 * LDK * 2)), (ATT_LAS unsigned*)(ldsl + (sbo) + (i_ * 8 + wid) * 1024), 16, 0, 0); \
    _Pragma("unroll") for (int i_ = 0; i_ < 4; ++i_) __builtin_amdgcn_global_load_lds((const unsigned*)(vb_ + (i_ & 1) * (32 * LDK * 2) + (i_ >> 1) * 256), (ATT_LAS unsigned*)(ldsl + (sbo) + 16384 + (i_ * 8 + wid) * 1024), 16, 0, 0); } while (0)
#define RESC8(a) do { if (__any((a) < 1.f)) { if (hi == 0) al_l[r32] = (a); asm volatile("s_waitcnt lgkmcnt(0)" ::: "memory"); \
    for (int d = 0; d < 8; ++d) for (int r = 0; r < 16; ++r) o[d][r] *= al_l[crow(r, hi)]; } } while (0)
#define TILE_SYNC() do { asm volatile("s_waitcnt vmcnt(0)" ::: "memory"); __builtin_amdgcn_s_barrier(); asm volatile("" ::: "memory"); } while (0)
  f32x16 p0, p1; float mn, al;
#pragma unroll
  for (int d0 = 0; d0 < 8; ++d0) asm volatile("" : "+v"(qr[d0]));
  if (wid >= 4) __builtin_amdgcn_s_setprio(2);
  DMA_TILE(0, 0); DMA_TILE(1, 49152);
  int sb = 0, sb2 = 98304;
  for (int j = 0; j < NT; ++j) {
    if (j + 1 < NT) asm volatile("s_waitcnt vmcnt(6)" ::: "memory"); else asm volatile("s_waitcnt vmcnt(0)" ::: "memory");
    __builtin_amdgcn_s_barrier(); asm volatile("" ::: "memory");
    qkt_pipe(p0, p1, (const bf16*)(lds + sb), qr, r32, hi); partialSM(p0, p1, m_reg, mn, al); RESC8(al); SBAR();
    smpv_all(p0, p1, al, l_reg, o, vb0 + sb, (const char*)Kh + (size_t)(j + 2) * (64 * LDK * 2) + offK0, (const char*)Vh + (size_t)(j + 2) * (64 * LDK * 2) + offV0,
             ldsl + sb2 + wid * 1024, ldsl + sb2 + 16384 + wid * 1024, j + 2 < NT);
    sb = (sb == 98304) ? 0 : sb + 49152; sb2 = (sb2 == 98304) ? 0 : sb2 + 49152;
  }
  __builtin_amdgcn_s_setprio(0);
  if (hi == 0) li_l[r32] = l_reg; asm volatile("s_waitcnt lgkmcnt(0)" ::: "memory");
  float rli[16];
#pragma unroll
  for (int r = 0; r < 16; ++r) rli[r] = __builtin_amdgcn_rcpf(li_l[crow(r, hi)]);
  bf16* Ow = Ob + (long)(wid * QBLK) * LDO;
#pragma unroll
  for (int r = 0; r < 16; ++r) { int orow = crow(r, hi);
#pragma unroll
    for (int d0 = 0; d0 < 8; ++d0) { const float v = o[d0][r] * rli[r]; const unsigned u = __builtin_bit_cast(unsigned, v);
      Ow[(long)orow * LDO + d0 * 32 + r32] = (bf16)((u + 0x7fffu + ((u >> 16) & 1u)) >> 16); } }
#undef DMA_TILE
#undef RESC8
#undef TILE_SYNC
}
__device__ __forceinline__ void attn_body_a(const bf16* __restrict__ Qb, const bf16* __restrict__ Kh, const bf16* __restrict__ Vh, bf16* __restrict__ Ob,
                                            int NT, int NCT, int lo, int qpos0, const float* __restrict__ sk4, ATT_LAS unsigned char* ldsl) {
  using St = Stage<bf16>;
  int tid_ = threadIdx.x; asm volatile("" : "+v"(tid_));
  const int tid = tid_, wid = __builtin_amdgcn_readfirstlane(tid >> 6), lane = tid & 63, r32 = lane & 31, hi = lane >> 5;
  const int g = wid >> 1, rh = wid & 1;
  char* lds = (char*)ldsl;
  float* ws = (float*)(lds + 98304) + wid * 64; float* li_l = ws; float* al_l = ws + 32;
  float m_reg = -1e30f, l_reg = 0; f32x16 o[4] = {}; bf16x8 qr[8];
  const bf16* Qw = Qb + (long)(rh * QBLK + r32) * LDQ + g * 128 + hi * 8;
#pragma unroll
  for (int d0 = 0; d0 < 8; ++d0) qr[d0] = St::ld8(Qw + d0 * 16);
  const float sinkl2 = sk4[g] * 1.4426950408889634f;
  const int qi = qpos0 + rh * QBLK + r32;
  unsigned offK0, offV0;
  { const int row = wid * 4 + (lane >> 4), colB = ((lane & 15) * 16) ^ ((row & 7) << 4); offK0 = (unsigned)row * (LDK * 2) + (unsigned)colB;
    const int sub = wid * 2 + (lane >> 5), kkhi = sub >> 2, cblk = sub & 3, within = (lane & 31) * 16, kk = kkhi * 8 + (within >> 6);
    const int k = (kk & ~0xC) | ((kk & 4) << 1) | ((kk & 8) >> 1), c = cblk * 32 + ((within & 63) >> 1);
    offV0 = (unsigned)k * (LDK * 2) + (unsigned)c * 2; }
  const int vb0 = (int)(uintptr_t)lds + 16384 + v_rd_base(lane);
#define TROWA(j) (64 * (j) + ((j) >= NCT ? lo : 0))
#define DMA_TILE(j, sb) do { const size_t ro_ = (size_t)TROWA(j) * (LDK * 2); const char* kb_ = (const char*)Kh + ro_ + offK0; const char* vb_ = (const char*)Vh + ro_ + offV0; \
    _Pragma("unroll") for (int i_ = 0; i_ < 2; ++i_) { __builtin_amdgcn_global_load_lds((const unsigned*)(kb_ + i_ * (32 * LDK * 2)), (ATT_LAS unsigned*)(ldsl + (sb) + (i_ * 8 + wid) * 1024), 16, 0, 0); \
      __builtin_amdgcn_global_load_lds((const unsigned*)(vb_ + i_ * (32 * LDK * 2)), (ATT_LAS unsigned*)(ldsl + (sb) + 16384 + (i_ * 8 + wid) * 1024), 16, 0, 0); } } while (0)
#define RESC4(a) do { if (__any((a) < 1.f)) { if (hi == 0) al_l[r32] = (a); asm volatile("s_waitcnt lgkmcnt(0)" ::: "memory"); \
    for (int d = 0; d < 4; ++d) for (int r = 0; r < 16; ++r) o[d][r] *= al_l[crow(r, hi)]; } } while (0)
  f32x16 p0, p1; float mn, al; bf16x8 pa0, pa1, pa2, pa3;
#pragma unroll
  for (int d0 = 0; d0 < 8; ++d0) asm volatile("" : "+v"(qr[d0]));
  DMA_TILE(0, 0);
  int sb = 0;
  for (int j = 0; j < NT; ++j) {
    asm volatile("s_waitcnt vmcnt(0)" ::: "memory"); __builtin_amdgcn_s_barrier(); asm volatile("" ::: "memory");
    if (j + 1 < NT) DMA_TILE(j + 1, sb ^ 32768);
    qkt_pipe(p0, p1, (const bf16*)(lds + sb), qr, r32, hi);
    if (j >= NCT) band_mask(p0, p1, qi - (lo + 64 * (j - NCT)), hi);
    partialSM(p0, p1, m_reg, mn, al); RESC4(al); finishSM(p0, p1, al, l_reg, pa0, pa1, pa2, pa3); SBAR();
    pv_d0(o, vb0 + sb, pa0, pa1, pa2, pa3);
    sb ^= 32768;
  }
  l_reg += __builtin_amdgcn_exp2f(sinkl2 - m_reg * (SCALE * 1.4426950408889634f));
  if (hi == 0) li_l[r32] = l_reg; asm volatile("s_waitcnt lgkmcnt(0)" ::: "memory");
  float rli[16];
#pragma unroll
  for (int r = 0; r < 16; ++r) rli[r] = __builtin_amdgcn_rcpf(li_l[crow(r, hi)]);
  bf16* Ow = Ob + (long)(rh * QBLK) * LDO + g * 128;
#pragma unroll
  for (int r = 0; r < 16; ++r) { int orow = crow(r, hi);
#pragma unroll
    for (int d0 = 0; d0 < 4; ++d0) { const float v = o[d0][r] * rli[r]; const unsigned u = __builtin_bit_cast(unsigned, v);
      Ow[(long)orow * LDO + d0 * 32 + r32] = (bf16)((u + 0x7fffu + ((u >> 16) & 1u)) >> 16); } }
#undef TROWA
#undef DMA_TILE
#undef RESC4
}
}

constexpr size_t MiB = 1u << 20;
constexpr size_t SLOT = (size_t)MROWS * DM * 2;
constexpr size_t WS_MOD = 0;
constexpr size_t WS_BAR = 1 * MiB, WS_BAR_BYTES = 16384;
constexpr size_t WS_COS = 2 * MiB, WS_SIN = 4 * MiB;
constexpr size_t WS_CTX1 = 6 * MiB;
constexpr size_t WS_WINT = 16 * MiB;
constexpr size_t WS_WPT = WS_WINT + 68 * MiB;
constexpr size_t WS_PX = WS_WPT + 48 * MiB;
constexpr size_t WS_S0 = WS_PX + (size_t)MROWS * INC * 2;
constexpr size_t WS_END = WS_S0 + 5 * SLOT;
static_assert(WS_END <= 4ull * DEPTH * DM * INC * 4, "workspace map exceeds the guaranteed 4x largest tensor");

constexpr int NWAVES = 8;
constexpr int LDS_BYTES = 149760;

#define GAS __attribute__((address_space(1)))
#define LAS __attribute__((address_space(3)))
typedef unsigned short bf16;
typedef unsigned v4u __attribute__((ext_vector_type(4)));
typedef unsigned v2u __attribute__((ext_vector_type(2)));
typedef float f32x4 __attribute__((ext_vector_type(4)));
#define LDS_WAIT() asm volatile("s_waitcnt lgkmcnt(0)" ::: "memory")
__device__ __forceinline__ unsigned f2bf(float f) { unsigned u = __builtin_bit_cast(unsigned, f); return (u + 0x7fffu + ((u >> 16) & 1u)) >> 16; }
__device__ __forceinline__ unsigned pk2(float lo, float hi) { return f2bf(lo) | (f2bf(hi) << 16); }
__device__ __forceinline__ float bflo(unsigned w) { return __builtin_bit_cast(float, w << 16); }
__device__ __forceinline__ float bfhi(unsigned w) { return __builtin_bit_cast(float, w & 0xffff0000u); }
__device__ __forceinline__ float siluf(float x) { return x / (1.f + __expf(-x)); }
__device__ __forceinline__ float sigmf(float x) { return 1.f / (1.f + __expf(-x)); }

struct Frame {
    LAS unsigned char* lds;
    int vcu, G;
    const float *x, *c, *ctx, *c_ctx, *w_ada, *b_ada, *g_pre, *g_post, *w_in, *sink, *lam_qk, *g_subln, *w_pa, *w_pb, *w_out;
    float* out; unsigned char* ws;
};

#define XB_TMO      128
#define XB_XCNT(j)  (256  + 64 * (j))
#define XB_XSUB(j)  (1280 + 64 * (j))
#define XB_XGEN(j)  (2304 + 64 * (j))
#define XB_TOP      3328
#define XB_TOPGEN   3392
#define XCD_BAR_WORDS 3456
#define XB_SPIN_CAP (1u << 18)

__device__ __forceinline__ unsigned xb_ld(unsigned* p)              { return __hip_atomic_load(p, __ATOMIC_RELAXED, __HIP_MEMORY_SCOPE_AGENT); }
__device__ __forceinline__ unsigned xb_add(unsigned* p, unsigned v) { return __hip_atomic_fetch_add(p, v, __ATOMIC_RELAXED, __HIP_MEMORY_SCOPE_AGENT); }
__device__ __forceinline__ unsigned xb_xcc_id() { return (unsigned)__builtin_amdgcn_s_getreg((3 << 11) | 20) & 0xFu; }
#define XB_SPIN(cond, bar) do { unsigned _sp = 0; while (cond) { __builtin_amdgcn_s_sleep(1); \
    if ((++_sp & 255u) == 0u) { if (xb_ld(&(bar)[XB_TMO])) break; if (_sp > XB_SPIN_CAP) { atomicAdd(&(bar)[XB_TMO], 1u); break; } } } } while (0)

struct XcdBarrier {
    unsigned* bar; unsigned x;
    volatile LAS unsigned* st;
};

__device__ __forceinline__ XcdBarrier xcd_barrier_post(unsigned* bar, volatile LAS unsigned* st) {
    XcdBarrier b; b.bar = bar; b.x = xb_xcc_id(); b.st = st;
    if (threadIdx.x == 0) (void)xb_add(&bar[XB_XCNT(b.x)], 1u);
    return b;
}
__device__ __forceinline__ void xcd_barrier_complete(unsigned* bar, unsigned x, unsigned& nloc, unsigned& nx) {
    const unsigned G = gridDim.x * gridDim.y * gridDim.z;
    unsigned sum, cnt, mine, sp = 0u;
    for (;;) {
        sum = 0u; cnt = 0u; mine = 0u;
#pragma unroll
        for (unsigned j = 0; j < 16; ++j) { const unsigned c = xb_ld(&bar[XB_XCNT(j)]); sum += c; cnt += (c > 0u) ? 1u : 0u; mine = (j == x) ? c : mine; }
        if (sum == G) break;
        __builtin_amdgcn_s_sleep(1);
        if ((++sp & 255u) == 0u) { if (xb_ld(&bar[XB_TMO])) break; if (sp > XB_SPIN_CAP) { atomicAdd(&bar[XB_TMO], 1u); break; } }
    }
    nloc = mine > 0u ? mine : 1u; nx = cnt > 0u ? cnt : 1u;
}

__device__ __forceinline__ void xcd_barrier(const XcdBarrier& b) {
    asm volatile("s_waitcnt vmcnt(0)" ::: "memory");
    __syncthreads();
    if (threadIdx.x == 0) {
        unsigned* bar = b.bar;
        __builtin_amdgcn_s_waitcnt(0);
        unsigned nloc = b.st[0], nx = b.st[1];
        if (nloc == 0u) { xcd_barrier_complete(bar, b.x, nloc, nx); b.st[0] = nloc; b.st[1] = nx; }
        const unsigned old = xb_add(&bar[XB_XSUB(b.x)], 1u);
        const unsigned gen = old / nloc;
        if (old + 1u == (gen + 1u) * nloc) {
            __builtin_amdgcn_fence(__ATOMIC_RELEASE, "agent");
            asm volatile("s_waitcnt vmcnt(0)" ::: "memory");
            const unsigned og = xb_add(&bar[XB_TOP], 1u);
            const unsigned tg = og / nx;
            if (og + 1u == (tg + 1u) * nx) xb_add(&bar[XB_TOPGEN], 1u);
            else XB_SPIN(xb_ld(&bar[XB_TOPGEN]) == tg, bar);
            __builtin_amdgcn_fence(__ATOMIC_ACQUIRE, "agent");
            xb_add(&bar[XB_XGEN(b.x)], 1u);
            asm volatile("s_waitcnt vmcnt(0)" ::: "memory");
        } else {
            XB_SPIN(xb_ld(&bar[XB_XGEN(b.x)]) == gen, bar);
            __builtin_amdgcn_fence(__ATOMIC_ACQUIRE, "agent");
            asm volatile("s_waitcnt vmcnt(0)" ::: "memory");
        }
    }
    __syncthreads();
}

#define FRESH_IDS int tid_ = threadIdx.x; asm volatile("" : "+v"(tid_)); const int tid = tid_, lane = tid & 63, wave = __builtin_amdgcn_readfirstlane(tid >> 6); (void)lane; (void)wave;

__device__ __forceinline__ float wave_sum(float v) {
#pragma unroll
    for (int o = 1; o < 64; o <<= 1) v += __shfl_xor(v, o);
    return v;
}
__device__ __forceinline__ void p0_transpose_item(const float* W, int K, int N, bf16* WT, int row_off, LAS float* scr, int item, int lane) {
    const int nblk = N / 32, kb = item / nblk, nb = item % nblk, k0 = 64 * kb, n0 = 32 * nb;
#pragma unroll
    for (int i = 0; i < 32; ++i) { const int kk = 2 * i + (lane >> 5); scr[kk * 33 + (lane & 31)] = W[(size_t)(k0 + kk) * N + n0 + (lane & 31)]; }
    LDS_WAIT(); asm volatile("" ::: "memory");
    const int c = lane & 7;
#pragma unroll
    for (int j = 0; j < 4; ++j) { const int n = (lane >> 3) + 8 * j; const LAS float* s = scr + (8 * c) * 33 + n;
        v4u o; o.x = pk2(s[0 * 33], s[1 * 33]); o.y = pk2(s[2 * 33], s[3 * 33]); o.z = pk2(s[4 * 33], s[5 * 33]); o.w = pk2(s[6 * 33], s[7 * 33]);
        *(GAS v4u*)(WT + (size_t)(row_off + n0 + n) * K + k0 + 8 * c) = o; }
    LDS_WAIT(); asm volatile("" ::: "memory");
}

#define GW_LOOP(var, n) for (int var = F.vcu * NWAVES + wave; var < (n); var += F.G * NWAVES)

__device__ __forceinline__ int win_row_off(int n0) {
    const int tile = n0 >> 8; const bool rope = tile < 2 || (tile >= 4 && tile < 12) || (tile >= 20 && tile < 28) || (tile >= 36 && tile < 44);
    if (!rope) return 0;
    const int w = n0 & 255, hsel = w >> 7, half = (w >> 6) & 1, i = w & 63;
    return (half * 128 + hsel * 64 + i) - w;
}
__device__ __forceinline__ void ph_prologue(Frame& F) {
    FRESH_IDS
    for (int ait = F.vcu; ait < 192; ait += F.G) {
        const int l = ait / 96, n0 = (ait % 96) * 64;
        LAS float* sv = (LAS float*)F.lds;
        LAS float* red = (LAS float*)(F.lds + 32768);
        for (int k = tid; k < DM; k += NWAVES * 64) { sv[k] = siluf(F.c[k]); sv[DM + k] = siluf(F.c[DM + k]); sv[2 * DM + k] = siluf(F.c_ctx[k]); }
        __syncthreads();
        const float* W = F.w_ada + (size_t)l * DM * 6144 + n0 + lane;
        float a0 = 0.f, a1 = 0.f, a2 = 0.f;
        const int kb = wave * 256;
#pragma unroll 32
        for (int k = 0; k < 256; ++k) { const float w = W[(size_t)(kb + k) * 6144]; a0 += sv[kb + k] * w; a1 += sv[DM + kb + k] * w; a2 += sv[2 * DM + kb + k] * w; }
        red[(wave * 3 + 0) * 64 + lane] = a0; red[(wave * 3 + 1) * 64 + lane] = a1; red[(wave * 3 + 2) * 64 + lane] = a2;
        __syncthreads();
        if (wave < 3) { float s = 0.f;
#pragma unroll
            for (int w = 0; w < 8; ++w) s += red[(w * 3 + wave) * 64 + lane];
            float* mod = (float*)(F.ws + WS_MOD);
            mod[(size_t)(l * 3 + wave) * 6144 + n0 + lane] = s + F.b_ada[(size_t)l * 6144 + n0 + lane]; }
        __syncthreads();
    }
    { float* ct = (float*)(F.ws + WS_COS); float* st = (float*)(F.ws + WS_SIN);
      for (int i = (F.vcu * NWAVES * 64) + tid; i < SEQ * 64; i += F.G * NWAVES * 64) {
          const int t = i >> 6, j = i & 63, f = j & 31; const float pos = (float)((j < 32) ? (t >> 6) : (t & 63));
          const float inv = expf(-(float)f * (9.210340371976184f / 32.f)); const float ang = pos * inv;
          ct[i] = cosf(ang); st[i] = sinf(ang); } }
    LAS float* scr = (LAS float*)(F.lds + wave * 16384);
    constexpr int I_IN = (DM / 64) * (INC / 32), I_P = (DM / 64) * (DM / 32);
    bf16* WinT = (bf16*)(F.ws + WS_WINT); bf16* WpT = (bf16*)(F.ws + WS_WPT);
    GW_LOOP(it, I_IN + 6 * I_P) {
        if (it < I_IN) { p0_transpose_item(F.w_in, DM, INC, WinT, win_row_off(32 * (it % (INC / 32))), scr, it, lane); continue; }
        const int r = it - I_IN, mi = r / I_P, ii = r % I_P, l = mi / 3, w = mi % 3;
        const float* W = (w == 0 ? F.w_pa : (w == 1 ? F.w_pb : F.w_out)) + (size_t)l * DM * DM;
        p0_transpose_item(W, DM, DM, WpT + (size_t)mi * DM * DM, 0, scr, ii, lane);
    }
}

__device__ __forceinline__ void ph_hnorm(Frame& F, int l, const float* xcur, const float* ctxcur) {
    FRESH_IDS
    bf16* H = (bf16*)(F.ws + WS_S0);
    const float* gp = F.g_pre + (size_t)l * DM;
    GW_LOOP(row, MROWS) {
        const int b = row / RPB, rr = row % RPB; const float* src; int v;
        if (rr < CTX) { src = ctxcur + (size_t)(b * CTX + rr) * DM; v = 2; } else { src = xcur + (size_t)(b * SEQ + rr - CTX) * DM; v = b; }
        const float* md = (const float*)(F.ws + WS_MOD) + (size_t)(l * 3 + v) * 6144;
        f32x4 xv[8]; float s = 0.f;
#pragma unroll
        for (int j = 0; j < 8; ++j) { xv[j] = ((const f32x4*)src)[lane + 64 * j]; s += (xv[j].x * xv[j].x + xv[j].y * xv[j].y) + (xv[j].z * xv[j].z + xv[j].w * xv[j].w); }
        const float rs = rsqrtf(wave_sum(s) * (1.f / DM) + EPS);
#pragma unroll
        for (int j = 0; j < 8; ++j) { const int q = lane + 64 * j;
            const f32x4 g = ((const f32x4*)gp)[q], sh = ((const f32x4*)md)[q], sc = ((const f32x4*)(md + DM))[q];
            const f32x4 y = (xv[j] * rs) * g * (sc + 1.f) + sh;
            v2u o; o.x = pk2(y.x, y.y); o.y = pk2(y.z, y.w);
            *(v2u*)(H + (size_t)row * DM + 4 * q) = o; }
    }
}

__device__ __forceinline__ void ph_rope(Frame& F) {
    FRESH_IDS
    bf16* PX = (bf16*)(F.ws + WS_PX);
    const float* ct = (const float*)(F.ws + WS_COS); const float* st = (const float*)(F.ws + WS_SIN);
    const unsigned total = (unsigned)NB * SEQ * 52 * 8;
    for (unsigned idx = (unsigned)(F.vcu * NWAVES * 64 + tid); idx < total; idx += (unsigned)(F.G * NWAVES * 64)) {
        const unsigned ch = idx & 7, hr = idx >> 3, hh = hr % 52, rowL = hr / 52, b = rowL / SEQ, t = rowL % SEQ;
        const int col = (hh < 4) ? (C_KA + hh * 128) : (hh < 20) ? (C_KB + (hh - 4) * 128) : (hh < 36) ? (C_QA + (hh - 20) * 128) : (C_QB + (hh - 36) * 128);
        bf16* p = PX + (size_t)(b * RPB + CTX + t) * INC + col + ch * 8;
        const v4u x1 = *(const v4u*)p, x2 = *(const v4u*)(p + 64);
        const f32x4 c0 = *(const f32x4*)(ct + t * 64 + ch * 8), c1 = *(const f32x4*)(ct + t * 64 + ch * 8 + 4);
        const f32x4 s0 = *(const f32x4*)(st + t * 64 + ch * 8), s1 = *(const f32x4*)(st + t * 64 + ch * 8 + 4);
        v4u y1, y2;
#define ROPE2(W, CA, SA, CB, SB) { const float a0 = bflo(x1.W), a1 = bfhi(x1.W), b0 = bflo(x2.W), b1 = bfhi(x2.W); \
            y1.W = pk2(a0 * CA - b0 * SA, a1 * CB - b1 * SB); y2.W = pk2(b0 * CA + a0 * SA, b1 * CB + a1 * SB); }
        ROPE2(x, c0.x, s0.x, c0.y, s0.y) ROPE2(y, c0.z, s0.z, c0.w, s0.w) ROPE2(z, c1.x, s1.x, c1.y, s1.y) ROPE2(w, c1.z, s1.z, c1.w, s1.w)
#undef ROPE2
        *(v4u*)p = y1; *(v4u*)(p + 64) = y2;
    }
}

__device__ __forceinline__ void ph_convert_win(Frame& F, int l) {
    FRESH_IDS
    LAS float* scr = (LAS float*)(F.lds + wave * 16384);
    constexpr int I_IN = (DM / 64) * (INC / 32);
    bf16* WinT = (bf16*)(F.ws + WS_WINT);
    GW_LOOP(it, I_IN) p0_transpose_item(F.w_in + (size_t)l * DM * INC, DM, INC, WinT, win_row_off(32 * (it % (INC / 32))), scr, it, lane);
}

__device__ __forceinline__ void ph_attn(Frame& F, int l, char* lds) {
    const att::bf16* PX = (const att::bf16*)(F.ws + WS_PX);
    att::bf16* OA = (att::bf16*)(F.ws + WS_S0);
    att::bf16* OB0 = (att::bf16*)(F.ws + WS_S0 + SLOT);
    const float NINF = -INFINITY;
    const int nB = 1024, nA = 1024, nC = (l == 0) ? 64 : 0;
    for (int u = F.vcu; u < nB + nA + nC; u += F.G) {
        if (u < nB) {
            const int hd = u >> 5, qb = u & 31, b = hd >> 4, h8 = (hd >> 1) & 7, m = hd & 1;
            const size_t qrow = (size_t)b * RPB + CTX + qb * 256, krow = (size_t)b * RPB;
            att::attn_body_v256(PX + qrow * INC + C_QB + (h8 * 2 + m) * 128, PX + krow * INC + C_KB + (h8 * 2 + m) * 128, PX + krow * INC + C_VB + h8 * 256,
                                OB0 + (size_t)m * (SLOT / 2) + qrow * DM + h8 * 256, RPB / 64, F.lds);
            __syncthreads();
        } else if (u < nB + nA) {
            const int v = u - nB, b = v >> 9, kvh = (v >> 7) & 3, qb = v & 127, q0 = qb * 64;
            const int lo = (q0 - 128 > 0) ? q0 - 128 : 0, he = (q0 + 192 < SEQ) ? q0 + 192 : SEQ, nloc = (he - lo) >> 6;
            const size_t qrow = (size_t)b * RPB + CTX + q0, krow = (size_t)b * RPB;
            att::attn_body_a(PX + qrow * INC + C_QA + kvh * 512, PX + krow * INC + C_KA + kvh * 128, PX + krow * INC + C_VA + kvh * 128,
                             OA + qrow * DM + kvh * 512, 4 + nloc, 4, lo, q0, F.sink + l * 16 + kvh * 4, F.lds);
            __syncthreads();
        } else {
            const int v = u - nB - nA;
            if (v < 32) {
                const int hd = v, b = hd >> 4, h8 = (hd >> 1) & 7, m = hd & 1; const size_t krow = (size_t)b * RPB;
                att::attn_body_v256(PX + krow * INC + C_QB + (h8 * 2 + m) * 128, PX + krow * INC + C_KB + (h8 * 2 + m) * 128, PX + krow * INC + C_VB + h8 * 256,
                                    OB0 + (size_t)m * (SLOT / 2) + krow * DM + h8 * 256, 4, F.lds);
                __syncthreads();
            } else {
                const int w = v - 32, b = w >> 4, kvh = (w >> 2) & 3, cb = w & 3; const size_t krow = (size_t)b * RPB, qrow = krow + cb * 64;
                att::attn_body_a(PX + qrow * INC + C_QA + kvh * 512, PX + krow * INC + C_KA + kvh * 128, PX + krow * INC + C_VA + kvh * 128,
                                 OA + qrow * DM + kvh * 512, 4, 4, 0, 0, F.sink + l * 16 + kvh * 4, F.lds);
                __syncthreads();
            }
        }
    }
}

__device__ __forceinline__ void ph_post(Frame& F, int l) {
    FRESH_IDS
    const bf16* PX = (const bf16*)(F.ws + WS_PX);
    const bf16* OA = (const bf16*)(F.ws + WS_S0); const bf16* OB0 = (const bf16*)(F.ws + WS_S0 + SLOT); const bf16* OB1 = (const bf16*)(F.ws + WS_S0 + 2 * SLOT);
    bf16* GA = (bf16*)(F.ws + WS_S0 + 3 * SLOT); bf16* GB = (bf16*)(F.ws + WS_S0 + 4 * SLOT);
    const float lam_init = 0.8f - 0.6f * expf(-0.3f * (float)l);
    const float* lq = F.lam_qk + (size_t)l * 512;
    const float d1 = wave_sum(lq[lane] * lq[128 + lane] + lq[64 + lane] * lq[192 + lane]);
    const float d2 = wave_sum(lq[256 + lane] * lq[384 + lane] + lq[320 + lane] * lq[448 + lane]);
    const float lam = expf(d1) - expf(d2) + lam_init;
    const f32x4 gs0 = ((const f32x4*)(F.g_subln + (size_t)l * 256))[2 * (lane & 31)] * (1.f - lam_init), gs1 = ((const f32x4*)(F.g_subln + (size_t)l * 256))[2 * (lane & 31) + 1] * (1.f - lam_init);
    GW_LOOP(row, MROWS) {
        if (l != 0 && (row % RPB) < CTX) continue;
        const size_t ro = (size_t)row * DM + 8 * lane, rp = (size_t)row * INC + 8 * lane;
        v4u oa[4], za[4], o0[4], o1[4], zb[4];
#pragma unroll
        for (int j = 0; j < 4; ++j) { oa[j] = *(const v4u*)(OA + ro + 512 * j); za[j] = *(const v4u*)(PX + rp + C_ZA + 512 * j);
            o0[j] = *(const v4u*)(OB0 + ro + 512 * j); o1[j] = *(const v4u*)(OB1 + ro + 512 * j); zb[j] = *(const v4u*)(PX + rp + C_ZB + 512 * j); }
#pragma unroll
        for (int j = 0; j < 4; ++j) { v4u o;
#define GA2(W) o.W = pk2(bflo(oa[j].W) * siluf(bflo(za[j].W)), bfhi(oa[j].W) * siluf(bfhi(za[j].W)));
            GA2(x) GA2(y) GA2(z) GA2(w)
#undef GA2
            *(v4u*)(GA + ro + 512 * j) = o; }
#pragma unroll
        for (int j = 0; j < 4; ++j) {
            f32x4 da, db;
            da.x = bflo(o0[j].x) - lam * bflo(o1[j].x); da.y = bfhi(o0[j].x) - lam * bfhi(o1[j].x); da.z = bflo(o0[j].y) - lam * bflo(o1[j].y); da.w = bfhi(o0[j].y) - lam * bfhi(o1[j].y);
            db.x = bflo(o0[j].z) - lam * bflo(o1[j].z); db.y = bfhi(o0[j].z) - lam * bfhi(o1[j].z); db.z = bflo(o0[j].w) - lam * bflo(o1[j].w); db.w = bfhi(o0[j].w) - lam * bfhi(o1[j].w);
            float ss = ((da.x * da.x + da.y * da.y) + (da.z * da.z + da.w * da.w)) + ((db.x * db.x + db.y * db.y) + (db.z * db.z + db.w * db.w));
#pragma unroll
            for (int o_ = 1; o_ < 32; o_ <<= 1) ss += __shfl_xor(ss, o_);
            const float rs = rsqrtf(ss * (1.f / 256.f) + EPS);
            const f32x4 ya = da * rs * gs0, yb = db * rs * gs1;
            v4u o; o.x = pk2(ya.x * siluf(bflo(zb[j].x)), ya.y * siluf(bfhi(zb[j].x))); o.y = pk2(ya.z * siluf(bflo(zb[j].y)), ya.w * siluf(bfhi(zb[j].y)));
            o.z = pk2(yb.x * siluf(bflo(zb[j].z)), yb.y * siluf(bfhi(zb[j].z))); o.w = pk2(yb.z * siluf(bflo(zb[j].w)), yb.w * siluf(bfhi(zb[j].w)));
            *(v4u*)(GB + ro + 512 * j) = o; }
    }
}

__device__ __forceinline__ void ph_merge(Frame& F, int l) {
    FRESH_IDS
    const bf16* PX = (const bf16*)(F.ws + WS_PX);
    const bf16* YA = (const bf16*)(F.ws + WS_S0); const bf16* YB = (const bf16*)(F.ws + WS_S0 + SLOT); bf16* MG = (bf16*)(F.ws + WS_S0 + 2 * SLOT);
    const unsigned total = (unsigned)MROWS * (DM / 8);
    for (unsigned i = (unsigned)(F.vcu * NWAVES * 64 + tid); i < total; i += (unsigned)(F.G * NWAVES * 64)) {
        const unsigned row = i >> 8, c = (i & 255) * 8;
        if (l != 0 && (row % RPB) < CTX) continue;
        const v4u ya = *(const v4u*)(YA + (size_t)row * DM + c), yb = *(const v4u*)(YB + (size_t)row * DM + c);
        const v4u ga = *(const v4u*)(PX + (size_t)row * INC + C_GA + c), gb = *(const v4u*)(PX + (size_t)row * INC + C_GB + c);
        v4u o;
#define MRG(W) o.W = pk2(sigmf(bflo(ga.W)) * bflo(ya.W) + sigmf(bflo(gb.W)) * bflo(yb.W), sigmf(bfhi(ga.W)) * bfhi(ya.W) + sigmf(bfhi(gb.W)) * bfhi(yb.W));
        MRG(x) MRG(y) MRG(z) MRG(w)
#undef MRG
        *(v4u*)(MG + (size_t)row * DM + c) = o;
    }
}

__device__ __forceinline__ void ph_res(Frame& F, int l, const float* xcur, const float* ctxcur) {
    FRESH_IDS
    const bf16* OX = (const bf16*)(F.ws + WS_S0 + 3 * SLOT);
    bf16* H = (bf16*)(F.ws + WS_S0);
    const float* gp = F.g_post + (size_t)l * DM;
    const bool nxt = (l + 1 < DEPTH);
    const float* gpn = F.g_pre + (size_t)(l + 1) * DM;
    GW_LOOP(row, MROWS) {
        const int b = row / RPB, rr = row % RPB; const float* src; float* dst; int v;
        if (rr < CTX) { if (!nxt) continue; src = ctxcur + (size_t)(b * CTX + rr) * DM; dst = nullptr; v = 2; }
        else { src = xcur + (size_t)(b * SEQ + rr - CTX) * DM; dst = F.out + (size_t)(b * SEQ + rr - CTX) * DM; v = b; }
        const float* gt = (const float*)(F.ws + WS_MOD) + (size_t)(l * 3 + v) * 6144 + 2 * DM;
        f32x4 ov[8]; float s = 0.f;
#pragma unroll
        for (int j = 0; j < 8; ++j) { const v2u w = *(const v2u*)(OX + (size_t)row * DM + 4 * (lane + 64 * j));
            ov[j] = (f32x4){bflo(w.x), bfhi(w.x), bflo(w.y), bfhi(w.y)}; s += (ov[j].x * ov[j].x + ov[j].y * ov[j].y) + (ov[j].z * ov[j].z + ov[j].w * ov[j].w); }
        const float rs = rsqrtf(wave_sum(s) * (1.f / DM) + EPS);
        float s2 = 0.f;
#pragma unroll
        for (int j = 0; j < 8; ++j) { const int q = lane + 64 * j;
            const f32x4 g = ((const f32x4*)gp)[q], gate = ((const f32x4*)gt)[q], xr = ((const f32x4*)src)[q];
            ov[j] = xr + gate * ((ov[j] * rs) * g);
            if (dst) ((f32x4*)dst)[q] = ov[j];
            s2 += (ov[j].x * ov[j].x + ov[j].y * ov[j].y) + (ov[j].z * ov[j].z + ov[j].w * ov[j].w); }
        if (nxt) {
            const float* md = (const float*)(F.ws + WS_MOD) + (size_t)((l + 1) * 3 + v) * 6144;
            const float rs2 = rsqrtf(wave_sum(s2) * (1.f / DM) + EPS);
#pragma unroll
            for (int j = 0; j < 8; ++j) { const int q = lane + 64 * j;
                const f32x4 g = ((const f32x4*)gpn)[q], sh = ((const f32x4*)md)[q], sc = ((const f32x4*)(md + DM))[q];
                const f32x4 y = (ov[j] * rs2) * g * (sc + 1.f) + sh;
                v2u o; o.x = pk2(y.x, y.y); o.y = pk2(y.z, y.w);
                *(v2u*)(H + (size_t)row * DM + 4 * q) = o; }
        }
    }
}

__device__ __forceinline__ void run_gemm_in(Frame& F, const bf16* A, const bf16* Bt, bf16* O) {
    pg8::Gemm g{A, Bt, MROWS, INC, DM}; pg8::RowSkipOrder S; S.init(INC, F.G, (int)blockIdx.x, false);
    pg8::EpiRope E{O, INC, (const float*)(F.ws + WS_COS), (const float*)(F.ws + WS_SIN)};
    pg8::gemm_phase<pg8::EpiRope, pg8::RowSkipOrder, true, true>(F.lds, g, S, E);
}
__device__ __forceinline__ void run_gemm_skip(Frame& F, const bf16* A, const bf16* Bt, bf16* O, bool skip) {
    pg8::Gemm g{A, Bt, MROWS, DM, DM}; pg8::RowSkipOrder S; S.init(DM, F.G, (int)blockIdx.x, skip);
    pg8::EpiBf16 E{O, DM};
    pg8::gemm_phase<pg8::EpiBf16, pg8::RowSkipOrder, true, true>(F.lds, g, S, E);
}
template <bool ADD>
__device__ __forceinline__ void run_gemm_gate(Frame& F, const bf16* A, const bf16* Bt, bf16* O, const bf16* T, const bf16* G, bool skip) {
    const int cid = ADD ? (int)((blockIdx.x + F.G / 2) % F.G) : (int)blockIdx.x;
    pg8::Gemm g{A, Bt, MROWS, DM, DM}; pg8::RowSkipOrder S; S.init(DM, F.G, cid, skip);
    pg8::EpiGate<ADD> E{O, T, G, DM, INC};
    pg8::gemm_phase<pg8::EpiGate<ADD>, pg8::RowSkipOrder, true, true>(F.lds, g, S, E);
}

struct Args { const float* in[15]; float* out; unsigned char* ws; };
__global__ void __launch_bounds__(NWAVES * 64, 2) fwd_mega(Args args) {
    extern __shared__ __attribute__((aligned(16))) unsigned char lds[];
    cg::grid_group grid = cg::this_grid();
    Frame F;
    F.lds = (LAS unsigned char*)lds;
    F.G = gridDim.x; { const int bx = blockIdx.x; F.vcu = (F.G % 8 == 0) ? (bx % 8) * (F.G / 8) + bx / 8 : bx; }
    F.x = args.in[0]; F.c = args.in[1]; F.ctx = args.in[2]; F.c_ctx = args.in[3]; F.w_ada = args.in[4]; F.b_ada = args.in[5]; F.g_pre = args.in[6]; F.g_post = args.in[7];
    F.w_in = args.in[8]; F.sink = args.in[9]; F.lam_qk = args.in[10]; F.g_subln = args.in[11]; F.w_pa = args.in[12]; F.w_pb = args.in[13]; F.w_out = args.in[14];
    F.out = args.out; F.ws = args.ws;
    volatile LAS unsigned* MISC = (volatile LAS unsigned*)(F.lds + 149504);
    if (threadIdx.x < 32) MISC[threadIdx.x] = 0u;
    __syncthreads();
    const XcdBarrier bar = xcd_barrier_post((unsigned*)(F.ws + WS_BAR), MISC + 8);
    bf16* WinT = (bf16*)(F.ws + WS_WINT); bf16* WpT = (bf16*)(F.ws + WS_WPT); bf16* PX = (bf16*)(F.ws + WS_PX);
    bf16* S0 = (bf16*)(F.ws + WS_S0); bf16* S1 = (bf16*)(F.ws + WS_S0 + SLOT); bf16* S2 = (bf16*)(F.ws + WS_S0 + 2 * SLOT); bf16* S3 = (bf16*)(F.ws + WS_S0 + 3 * SLOT); bf16* S4 = (bf16*)(F.ws + WS_S0 + 4 * SLOT);

    ph_prologue(F);
    grid.sync();
#pragma unroll 1
    for (int l = 0; l < DEPTH; ++l) {
        const float* xcur = (l == 0) ? F.x : F.out;
        const float* ctxcur = (l == 0) ? F.ctx : (const float*)(F.ws + WS_CTX1);
        if (l == 0) { ph_hnorm(F, l, xcur, ctxcur); xcd_barrier(bar); }
        run_gemm_in(F, S0, WinT, PX);
        xcd_barrier(bar);
        ph_attn(F, l, (char*)lds);
        xcd_barrier(bar);
        ph_post(F, l);
        if (l + 1 < DEPTH) ph_convert_win(F, l + 1);
        xcd_barrier(bar);
        run_gemm_gate<false>(F, S3, WpT + (size_t)(l * 3 + 0) * DM * DM, S0, S0, PX + C_GA, l != 0);
        xcd_barrier(bar);
        run_gemm_gate<true>(F, S4, WpT + (size_t)(l * 3 + 1) * DM * DM, S2, S0, PX + C_GB, l != 0);
        xcd_barrier(bar);
        run_gemm_skip(F, S2, WpT + (size_t)(l * 3 + 2) * DM * DM, S3, l != 0);
        xcd_barrier(bar);
        ph_res(F, l, xcur, ctxcur);
        if (l + 1 < DEPTH) xcd_barrier(bar);
    }
}

extern "C" void kernel_launch(void* const* d_in, const int* in_sizes, int n_in, void* d_out, int out_size, void* d_ws, size_t ws_size, hipStream_t stream) {
    static int grid = 0;
    if (grid == 0) {
        if (n_in != 15 || out_size != NB * SEQ * DM || ws_size < WS_END) { fprintf(stderr, "kernel_launch: unexpected shapes: n_in %d out %d ws %zu (need %zu)\n", n_in, out_size, ws_size, (size_t)WS_END); grid = -1; return; }
        int dev = 0, cus = 0, per_cu = 0;
        if (hipGetDevice(&dev) != hipSuccess || hipDeviceGetAttribute(&cus, hipDeviceAttributeMultiprocessorCount, dev) != hipSuccess) { grid = -1; return; }
        if (hipFuncSetAttribute((const void*)fwd_mega, hipFuncAttributeMaxDynamicSharedMemorySize, LDS_BYTES) != hipSuccess) { fprintf(stderr, "kernel_launch: hipFuncSetAttribute failed\n"); grid = -1; return; }
        if (hipOccupancyMaxActiveBlocksPerMultiprocessor(&per_cu, (const void*)fwd_mega, NWAVES * 64, LDS_BYTES) != hipSuccess || per_cu < 1) { fprintf(stderr, "kernel_launch: occupancy query says %d\n", per_cu); per_cu = 1; }
        (void)hipGetLastError();
        grid = cus * per_cu;
    }
    if (grid < 0) return;
    if (hipMemsetAsync((char*)d_ws + WS_BAR, 0, WS_BAR_BYTES, stream) != hipSuccess) { fprintf(stderr, "kernel_launch: memset of the barrier words failed\n"); return; }
    Args a{};
    for (int i = 0; i < 15; ++i) a.in[i] = (const float*)d_in[i];
    a.out = (float*)d_out; a.ws = (unsigned char*)d_ws;
    void* kargs[] = {&a};
    hipError_t e = hipLaunchCooperativeKernel((const void*)fwd_mega, dim3(grid), dim3(NWAVES * 64), kargs, LDS_BYTES, stream);
    if (e != hipSuccess) fprintf(stderr, "kernel_launch: cooperative launch failed: %s (grid %d)\n", hipGetErrorString(e), grid);
}
```

```cpp
#include <hip/hip_runtime.h>
#include <hip/hip_bf16.h>
#include <hip/hip_cooperative_groups.h>
#include <cstdio>
#include <cstdint>
#include <cmath>
namespace cg = cooperative_groups;

constexpr int DM = 2048, NB = 2, SEQ = 8192, DEPTH = 2, CTX = 256;
constexpr int RPB = CTX + SEQ;
constexpr int MROWS = NB * RPB;
constexpr int INC = 17408;
constexpr int C_KA = 0, C_VA = 512, C_KB = 1024, C_VB = 3072, C_QA = 5120, C_ZA = 7168, C_QB = 9216, C_ZB = 11264, C_GA = 13312, C_GB = 15360;
constexpr float EPS = 1e-6f;

namespace pg8 {
#define PG8_LAS __attribute__((address_space(3)))
typedef unsigned short bf16_t;
typedef short bf16x8 __attribute__((ext_vector_type(8)));
typedef float f32x4 __attribute__((ext_vector_type(4)));
typedef unsigned u32x4 __attribute__((ext_vector_type(4)));
constexpr int BM = 256, BK = 64, HALF = 128, HTB = HALF * BK * 2  , STAGE_BYTES = 8 * HTB, NXCD = 8, WGM = 8;

__host__ __device__ __forceinline__ int lds_byte(int r, int c) { const int st = (r >> 4) * 2 + (c >> 5), rr = r & 15, cc = c & 31, ob = rr * 64 + cc * 2; return st * 1024 + (ob ^ (((ob >> 9) & 1) << 5)); }
__host__ __device__ __forceinline__ void stage_rc(int b, int& R, int& C) { const int st = b / 1024, sb = b % 1024, swz = sb ^ (((sb >> 9) & 1) << 5); R = (st >> 1) * 16 + swz / 64; C = (st & 1) * 32 + (swz % 64) / 2; }
__host__ __device__ __forceinline__ int perm32(int rho) { const int n = rho >> 4, i = rho & 15; return 8 * (i >> 2) + 4 * n + (i & 3); }

struct Unit { int pm, pn; };
struct Gemm { const bf16_t* A; const bf16_t* Bt; int M, N, K; };

struct StaticOrder {
    int nM, nN, nwg, G, c;
    __host__ __device__ void init(int M, int N, int G_, int c_) { nM = M / BM; nN = N / BM; nwg = nM * nN; G = G_; c = c_; }
    __host__ __device__ bool next(int i, Unit& u) const {
        const long L = (long)i * G + c; if (L >= nwg) return false;
        int wgid = (int)L; { const int q = nwg / NXCD, r = nwg % NXCD, xcd = wgid % NXCD, off = wgid / NXCD; wgid = (xcd < r ? xcd * (q + 1) : r * (q + 1) + (xcd - r) * q) + off; }
        const int nig = WGM * nN, gid = wgid / nig, fm = gid * WGM, gsz = (nM - fm) < WGM ? (nM - fm) : WGM;
        u.pm = fm + ((wgid % nig) % gsz); u.pn = (wgid % nig) / gsz; return true;
    }
    __device__ __forceinline__ void a_ready(const Unit&) const {}
    __device__ __forceinline__ void done(const Unit&) const {}
};

__device__ __forceinline__ unsigned cvt_pk_bf16(float lo, float hi) { unsigned r; asm volatile("v_cvt_pk_bf16_f32 %0, %1, %2" : "=v"(r) : "v"(lo), "v"(hi)); return r; }
typedef float f32x2 __attribute__((ext_vector_type(2)));

struct EpiBf16 {
    static constexpr bool PERM = true, AFTER_DRAIN = false;
    bf16_t* O; int ldc;
    __device__ __forceinline__ void operator()(const f32x4 (&acc)[2][2][4][2], const Unit& u, int wr, int wc, int fr, int fq) const {
        const int row0 = u.pm * BM + wr * 64 + fr; const int col0 = u.pn * BM + wc * 32 + 8 * fq;
#pragma unroll
        for (int ai = 0; ai < 2; ++ai)
#pragma unroll
            for (int m = 0; m < 4; ++m) { bf16_t* rowp = O + (size_t)(row0 + ai * HALF + m * 16) * ldc + col0;
#pragma unroll
                for (int bj = 0; bj < 2; ++bj) { const f32x4 v0 = acc[ai][bj][m][0], v1 = acc[ai][bj][m][1];
                    u32x4 w; w.x = cvt_pk_bf16(v0[0], v0[1]); w.y = cvt_pk_bf16(v0[2], v0[3]); w.z = cvt_pk_bf16(v1[0], v1[1]); w.w = cvt_pk_bf16(v1[2], v1[3]);
                    *(u32x4*)(rowp + bj * HALF) = w; } }
    }
};

__device__ __forceinline__ float sigm_(float x) { return 1.f / (1.f + __expf(-x)); }
__device__ __forceinline__ float blo_(unsigned w) { return __builtin_bit_cast(float, w << 16); }
__device__ __forceinline__ float bhi_(unsigned w) { return __builtin_bit_cast(float, w & 0xffff0000u); }
template <bool ADD> struct EpiGate {
    static constexpr bool PERM = true, AFTER_DRAIN = false;
    bf16_t* O; const bf16_t* T; const bf16_t* G; int ldc; int ldg;
    __device__ __forceinline__ void operator()(const f32x4 (&acc)[2][2][4][2], const Unit& u, int wr, int wc, int fr, int fq) const {
        const int row0 = u.pm * BM + wr * 64 + fr; const int col0 = u.pn * BM + wc * 32 + 8 * fq;
#pragma unroll
        for (int ai = 0; ai < 2; ++ai)
#pragma unroll
            for (int m = 0; m < 4; ++m) { const size_t row = (size_t)(row0 + ai * HALF + m * 16);
#pragma unroll
                for (int bj = 0; bj < 2; ++bj) { const f32x4 v0 = acc[ai][bj][m][0], v1 = acc[ai][bj][m][1];
                    const u32x4 g = *(const u32x4*)(G + row * ldg + col0 + bj * HALF);
                    float r0 = sigm_(blo_(g.x)) * v0[0], r1 = sigm_(bhi_(g.x)) * v0[1], r2 = sigm_(blo_(g.y)) * v0[2], r3 = sigm_(bhi_(g.y)) * v0[3];
                    float r4 = sigm_(blo_(g.z)) * v1[0], r5 = sigm_(bhi_(g.z)) * v1[1], r6 = sigm_(blo_(g.w)) * v1[2], r7 = sigm_(bhi_(g.w)) * v1[3];
                    if (ADD) { const u32x4 t = *(const u32x4*)(T + row * ldc + col0 + bj * HALF);
                        r0 += blo_(t.x); r1 += bhi_(t.x); r2 += blo_(t.y); r3 += bhi_(t.y); r4 += blo_(t.z); r5 += bhi_(t.z); r6 += blo_(t.w); r7 += bhi_(t.w); }
                    u32x4 w; w.x = cvt_pk_bf16(r0, r1); w.y = cvt_pk_bf16(r2, r3); w.z = cvt_pk_bf16(r4, r5); w.w = cvt_pk_bf16(r6, r7);
                    *(u32x4*)(O + row * ldc + col0 + bj * HALF) = w; } }
    }
};
struct RowSkipOrder {
    StaticOrder base; bool skip;
    __device__ void init(int N, int G_, int c_, bool skip_) { skip = skip_; base.init(skip_ ? 16384 : 16896, N, G_, c_); }
    __device__ bool next(int i, Unit& u) const { if (!base.next(i, u)) return false; if (skip) u.pm += 1 + (u.pm >= 32 ? 1 : 0); return true; }
    __device__ __forceinline__ void a_ready(const Unit&) const {}
    __device__ __forceinline__ void done(const Unit&) const {}
};

struct EpiRope {
    static constexpr bool PERM = true, AFTER_DRAIN = false;
    bf16_t* O; int ldc; const float* ct; const float* st;
    __device__ __forceinline__ void operator()(const f32x4 (&acc)[2][2][4][2], const Unit& u, int wr, int wc, int fr, int fq) const {
        const int pn = u.pn; const bool rope = pn < 2 || (pn >= 4 && pn < 12) || (pn >= 20 && pn < 28) || (pn >= 36 && pn < 44);
        const int row0 = u.pm * BM + wr * 64 + fr;
        if (!rope) {
            const int col0 = pn * BM + wc * 32 + 8 * fq;
#pragma unroll
            for (int ai = 0; ai < 2; ++ai)
#pragma unroll
                for (int m = 0; m < 4; ++m) { bf16_t* rowp = O + (size_t)(row0 + ai * HALF + m * 16) * ldc + col0;
#pragma unroll
                    for (int bj = 0; bj < 2; ++bj) { const f32x4 v0 = acc[ai][bj][m][0], v1 = acc[ai][bj][m][1];
                        u32x4 w; w.x = cvt_pk_bf16(v0[0], v0[1]); w.y = cvt_pk_bf16(v0[2], v0[3]); w.z = cvt_pk_bf16(v1[0], v1[1]); w.w = cvt_pk_bf16(v1[2], v1[3]);
                        *(u32x4*)(rowp + bj * HALF) = w; } }
            return;
        }
        const bool isctx = (u.pm == 0) || (u.pm == 33);
        const int i0 = 32 * (wc & 1) + 8 * fq, ocol = pn * BM + (wc >> 1) * 128 + i0;
        const int tbase = row0 - (u.pm >= 33 ? 8448 : 0) - 256;
#pragma unroll
        for (int ai = 0; ai < 2; ++ai)
#pragma unroll
            for (int m = 0; m < 4; ++m) { const int t = tbase + ai * HALF + m * 16;
                f32x4 c0 = {1.f, 1.f, 1.f, 1.f}, c1 = c0, s0 = {0.f, 0.f, 0.f, 0.f}, s1 = s0;
                if (!isctx) { const float* cp = ct + (size_t)t * 64 + i0; const float* sp = st + (size_t)t * 64 + i0;
                    c0 = *(const f32x4*)cp; c1 = *(const f32x4*)(cp + 4); s0 = *(const f32x4*)sp; s1 = *(const f32x4*)(sp + 4); }
                const f32x4 a0 = acc[ai][0][m][0], a1 = acc[ai][0][m][1], b0 = acc[ai][1][m][0], b1 = acc[ai][1][m][1];
                const f32x4 y0 = a0 * c0 - b0 * s0, y1 = a1 * c1 - b1 * s1, z0 = b0 * c0 + a0 * s0, z1 = b1 * c1 + a1 * s1;
                bf16_t* rowp = O + (size_t)(row0 + ai * HALF + m * 16) * ldc + ocol;
                u32x4 w; w.x = cvt_pk_bf16(y0[0], y0[1]); w.y = cvt_pk_bf16(y0[2], y0[3]); w.z = cvt_pk_bf16(y1[0], y1[1]); w.w = cvt_pk_bf16(y1[2], y1[3]);
                *(u32x4*)rowp = w;
                u32x4 x; x.x = cvt_pk_bf16(z0[0], z0[1]); x.y = cvt_pk_bf16(z0[2], z0[3]); x.z = cvt_pk_bf16(z1[0], z1[1]); x.w = cvt_pk_bf16(z1[2], z1[3]);
                *(u32x4*)(rowp + 64) = x; }
    }
};

template <class Epi, class Sched, bool ALIGN_EPI = false, bool SP2 = false>
__device__ __forceinline__ void gemm_phase(PG8_LAS unsigned char* lds, const Gemm g, const Sched& S, const Epi& E) {
    int tid_ = threadIdx.x; asm volatile("" : "+v"(tid_));
    const int tid = tid_, wid = __builtin_amdgcn_readfirstlane(tid >> 6), lane = tid & 63, wr = wid >> 2, wc = wid & 3, fr = lane & 15, fq = lane >> 4;
    const int K = g.K, nt = K / BK;
    unsigned voffA[2], voffB[2];
#pragma unroll
    for (int i = 0; i < 2; ++i) { int R, C; stage_rc(tid * 16 + i * 8192, R, C); const int Rb = Epi::PERM ? ((R & ~31) + perm32(R & 31)) : R;
        voffA[i] = (unsigned)(R * K + C) * 2u; voffB[i] = (unsigned)(Rb * K + C) * 2u; }
    const size_t kstep = (size_t)(BK * 2);
    const size_t hstep = (size_t)HALF * K * 2;
    const size_t tstep = 2 * hstep;
    const unsigned ldsw = (unsigned)wid * 1024u;
    const int aoff = lds_byte(wr * 64 + fr, fq * 8), boff = lds_byte(wc * 32 + fr, fq * 8);
#define PG8_SA(b, h) (((b) * 2 + (h)) * HTB)
#define PG8_SB(b, h) ((4 + (b) * 2 + (h)) * HTB)
#define PG8_STAGE(bufoff, gbase, voff) do { _Pragma("unroll") for (int _i = 0; _i < 2; ++_i) \
        __builtin_amdgcn_global_load_lds((const unsigned*)((const char*)(gbase) + (voff)[_i]), (PG8_LAS unsigned*)(lds + (bufoff) + ldsw + _i * 8192), 16, 0, 0); } while (0)
#define PG8_LDA(dst, b, h) do { _Pragma("unroll") for (int m = 0; m < 4; ++m) _Pragma("unroll") for (int k = 0; k < 2; ++k) dst[m][k] = *(const PG8_LAS bf16x8*)(lds + PG8_SA(b, h) + aoff + m * 2048 + k * 1024); } while (0)
#define PG8_LDB(dst, b, h) do { _Pragma("unroll") for (int n = 0; n < 2; ++n) _Pragma("unroll") for (int k = 0; k < 2; ++k) dst[n][k] = *(const PG8_LAS bf16x8*)(lds + PG8_SB(b, h) + boff + n * 2048 + k * 1024); } while (0)
#define PG8_MMA(ai, bj, At, Bt) do { __builtin_amdgcn_s_setprio(1); _Pragma("unroll") for (int m = 0; m < 4; ++m) _Pragma("unroll") for (int n = 0; n < 2; ++n) _Pragma("unroll") for (int k = 0; k < 2; ++k) \
        acc[ai][bj][m][n] = __builtin_amdgcn_mfma_f32_16x16x32_bf16(Bt[n][k], At[m][k], acc[ai][bj][m][n], 0, 0, 0); __builtin_amdgcn_s_setprio(0); } while (0)
#define PG8_WAIT_V(n) asm volatile("s_waitcnt vmcnt(" #n ")" ::: "memory")
#define PG8_WAIT_L(n) asm volatile("s_waitcnt lgkmcnt(" #n ")" ::: "memory")
#define PG8_BAR __builtin_amdgcn_s_barrier()
#define PG8_SCHED __builtin_amdgcn_sched_barrier(0)
    Unit cur, nxt; int ui = 0;
    if (!S.next(0, cur)) return;
    f32x4 acc[2][2][4][2];
#pragma unroll
    for (int a = 0; a < 2; ++a)
#pragma unroll
        for (int b = 0; b < 2; ++b)
#pragma unroll
            for (int m = 0; m < 4; ++m)
#pragma unroll
                for (int n = 0; n < 2; ++n) acc[a][b][m][n] = (f32x4){0.f, 0.f, 0.f, 0.f};
    bf16x8 At[4][2], B0[2][2], B1[2][2];
    const char* cA = (const char*)g.A + (size_t)cur.pm * tstep; const char* cB = (const char*)g.Bt + (size_t)cur.pn * tstep;
    S.a_ready(cur);
    if constexpr (SP2) {
        PG8_STAGE(PG8_SB(0, 0), cB, voffB); PG8_STAGE(PG8_SB(0, 1), cB + hstep, voffB); PG8_STAGE(PG8_SA(0, 0), cA, voffA); PG8_STAGE(PG8_SA(0, 1), cA + hstep, voffA);
        if (wr == 1) PG8_BAR;
        PG8_WAIT_V(2); PG8_BAR;
        PG8_STAGE(PG8_SB(1, 0), cB + kstep, voffB); PG8_STAGE(PG8_SA(1, 0), cA + kstep, voffA); PG8_STAGE(PG8_SB(1, 1), cB + hstep + kstep, voffB);
        PG8_WAIT_V(6); PG8_BAR;
    } else {
        PG8_STAGE(PG8_SB(0, 0), cB, voffB); PG8_STAGE(PG8_SA(0, 0), cA, voffA); PG8_STAGE(PG8_SB(0, 1), cB + hstep, voffB); PG8_STAGE(PG8_SA(0, 1), cA + hstep, voffA);
        if (wr == 1) PG8_BAR;
        PG8_WAIT_V(4); PG8_BAR;
        PG8_STAGE(PG8_SB(1, 0), cB + kstep, voffB); PG8_STAGE(PG8_SA(1, 0), cA + kstep, voffA); PG8_STAGE(PG8_SB(1, 1), cB + hstep + kstep, voffB);
        PG8_WAIT_V(6); PG8_BAR;
    }
    for (;;) {
        const bool has_next = S.next(ui + 1, nxt);
        const char* nA = has_next ? (const char*)g.A + (size_t)nxt.pm * tstep : cA; const char* nB = has_next ? (const char*)g.Bt + (size_t)nxt.pn * tstep : cB;
        for (int t = 0; t < nt; t += 2) {
            const bool last = (t == nt - 2);
            const char* a1 = cA + (size_t)(t + 1) * kstep;
            const char* a2 = last ? nA : cA + (size_t)(t + 2) * kstep; const char* b2 = last ? nB : cB + (size_t)(t + 2) * kstep;
            const char* a3 = a2 + kstep; const char* b3 = b2 + kstep;
            if (last && has_next) S.a_ready(nxt);
            if constexpr (SP2) {
            PG8_LDB(B0, 0, 0); PG8_LDB(B1, 0, 1); PG8_SCHED; PG8_LDA(At, 0, 0); PG8_STAGE(PG8_SA(1, 1), a1 + hstep, voffA);
            PG8_WAIT_V(8); PG8_WAIT_L(0); PG8_BAR; PG8_MMA(0, 0, At, B0); PG8_MMA(0, 1, At, B1); PG8_BAR; PG8_SCHED;
            PG8_LDA(At, 0, 1); PG8_STAGE(PG8_SB(0, 0), b2, voffB); PG8_STAGE(PG8_SB(0, 1), b2 + hstep, voffB); PG8_STAGE(PG8_SA(0, 0), a2, voffA);
            PG8_WAIT_V(8); PG8_WAIT_L(0); PG8_BAR; PG8_MMA(1, 0, At, B0); PG8_MMA(1, 1, At, B1); PG8_BAR; PG8_SCHED;
            PG8_LDB(B0, 1, 0); PG8_LDB(B1, 1, 1); PG8_SCHED; PG8_LDA(At, 1, 0); PG8_STAGE(PG8_SA(0, 1), a2 + hstep, voffA);
            PG8_WAIT_V(8); PG8_WAIT_L(0); PG8_BAR; PG8_MMA(0, 0, At, B0); PG8_MMA(0, 1, At, B1); PG8_BAR; PG8_SCHED;
            PG8_LDA(At, 1, 1); PG8_STAGE(PG8_SB(1, 0), b3, voffB); PG8_STAGE(PG8_SB(1, 1), b3 + hstep, voffB); PG8_STAGE(PG8_SA(1, 0), a3, voffA);
            PG8_WAIT_V(8); PG8_WAIT_L(0); PG8_BAR; PG8_MMA(1, 0, At, B0); PG8_MMA(1, 1, At, B1); PG8_BAR; PG8_SCHED;
            } else {
            PG8_LDB(B0, 0, 0); PG8_SCHED; PG8_LDA(At, 0, 0); PG8_STAGE(PG8_SA(1, 1), a1 + hstep, voffA);
            PG8_WAIT_L(8); PG8_BAR; PG8_WAIT_L(0); PG8_MMA(0, 0, At, B0); PG8_BAR; PG8_SCHED;
            PG8_LDB(B1, 0, 1); PG8_STAGE(PG8_SB(0, 0), b2, voffB);
            PG8_BAR; PG8_WAIT_L(0); PG8_MMA(0, 1, At, B1); PG8_BAR;
            PG8_LDA(At, 0, 1); PG8_STAGE(PG8_SA(0, 0), a2, voffA);
            PG8_BAR; PG8_WAIT_L(0); PG8_MMA(1, 0, At, B0); PG8_BAR; PG8_SCHED;
            PG8_STAGE(PG8_SB(0, 1), b2 + hstep, voffB);
            PG8_WAIT_V(6); PG8_BAR; PG8_MMA(1, 1, At, B1); PG8_BAR;
            PG8_LDB(B0, 1, 0); PG8_SCHED; PG8_LDA(At, 1, 0); PG8_STAGE(PG8_SA(0, 1), a2 + hstep, voffA);
            PG8_WAIT_L(8); PG8_BAR; PG8_WAIT_L(0); PG8_MMA(0, 0, At, B0); PG8_BAR; PG8_SCHED;
            PG8_LDB(B1, 1, 1); PG8_STAGE(PG8_SB(1, 0), b3, voffB);
            PG8_BAR; PG8_WAIT_L(0); PG8_MMA(0, 1, At, B1); PG8_BAR;
            PG8_LDA(At, 1, 1); PG8_STAGE(PG8_SA(1, 0), a3, voffA);
            PG8_BAR; PG8_WAIT_L(0); PG8_MMA(1, 0, At, B0); PG8_BAR; PG8_SCHED;
            PG8_STAGE(PG8_SB(1, 1), b3 + hstep, voffB);
            PG8_WAIT_V(6); PG8_BAR; PG8_MMA(1, 1, At, B1); PG8_BAR;
            }
        }
        if constexpr (ALIGN_EPI) { if (wr == 0) PG8_BAR; }
        if constexpr (!Epi::AFTER_DRAIN) { E(acc, cur, wr, wc, fr, fq); S.done(cur); }
        if (!has_next) break;
#pragma unroll
        for (int a = 0; a < 2; ++a)
#pragma unroll
            for (int b = 0; b < 2; ++b)
#pragma unroll
                for (int m = 0; m < 4; ++m)
#pragma unroll
                    for (int n = 0; n < 2; ++n) acc[a][b][m][n] = (f32x4){0.f, 0.f, 0.f, 0.f};
        cur = nxt; cA = nA; cB = nB; ++ui;
        if constexpr (ALIGN_EPI) { if (wr == 1) PG8_BAR; }
    }
    PG8_WAIT_V(0);
    if constexpr (!ALIGN_EPI) { if (wr == 0) PG8_BAR; }
    PG8_BAR;
    if constexpr (Epi::AFTER_DRAIN) { E.fused(acc, cur, wr, wc, fr, fq, lds, wid, lane); S.done(cur); }
#undef PG8_SA
#undef PG8_SB
#undef PG8_STAGE
#undef PG8_LDA
#undef PG8_LDB
#undef PG8_MMA
#undef PG8_WAIT_V
#undef PG8_WAIT_L
#undef PG8_BAR
#undef PG8_SCHED
}
}

namespace att {
using bf16 = unsigned short;
constexpr int D = 128, NW = 8, QBLK = 32, KVBLK = 64;
constexpr float SCALE = 0.088388347648318440f;
constexpr float THR = 8.f;
constexpr int SDEPTH = 2;
constexpr int LDQ = INC, LDK = INC, LDO = DM;
constexpr size_t SHM_V = KVBLK * D * 2, SHM_K = KVBLK * D * 2, SHM_ATTN = 2 * SHM_V + 2 * SHM_K + NW * 64 * 4;

using bf16x8 = __attribute__((ext_vector_type(8))) short;
using s16x4  = __attribute__((ext_vector_type(4))) short;
using f32x16 = __attribute__((ext_vector_type(16))) float;
using f32x8  = __attribute__((ext_vector_type(8))) float;
using u32x4  = __attribute__((ext_vector_type(4))) unsigned;
#define KSWZ(row, colB) ((row) * 256 + ((colB) ^ (((row) & 7) << 4)))
#define SBAR() __builtin_amdgcn_sched_barrier(0)
__device__ __forceinline__ int crow(int r, int hi) { return (r & 3) + 8 * (r >> 2) + 4 * hi; }
__device__ __forceinline__ unsigned cvtpk(float lo, float hi) {
  unsigned r; asm volatile("v_cvt_pk_bf16_f32 %0, %1, %2" : "=v"(r) : "v"(lo), "v"(hi)); return r;
}
template <typename TIn> struct Stage;
template <> struct Stage<bf16>  { using T = bf16x8;
  __device__ static __forceinline__ T ld8(const bf16* p) { return *reinterpret_cast<const bf16x8*>(p); }
  __device__ static __forceinline__ bf16x8 tobf(T x) { return x; } };
template <> struct Stage<float> { using T = f32x8;
  __device__ static __forceinline__ T ld8(const float* p) { return *reinterpret_cast<const f32x8*>(p); }
  __device__ static __forceinline__ bf16x8 tobf(T x) {
    u32x4 w = {cvtpk(x[0], x[1]), cvtpk(x[2], x[3]), cvtpk(x[4], x[5]), cvtpk(x[6], x[7])}; return *reinterpret_cast<bf16x8*>(&w); } };

__device__ __forceinline__ void partialSM(f32x16& p0, f32x16& p1, float& m_reg, float& mn, float& alpha) {
  constexpr float C = SCALE * 1.4426950408889634f;
  float pmax = p0[0]; for (int r = 1; r < 16; ++r) pmax = fmaxf(pmax, p0[r]); for (int r = 0; r < 16; ++r) pmax = fmaxf(pmax, p1[r]);
  { auto rr = __builtin_amdgcn_permlane32_swap(__float_as_uint(pmax), __float_as_uint(pmax), false, false);
    pmax = fmaxf(__uint_as_float(rr[0]), __uint_as_float(rr[1])); }
  if (__builtin_expect(__all(pmax - m_reg <= THR / SCALE), 1)) { mn = m_reg; alpha = 1.f; }
  else { mn = fmaxf(m_reg, pmax); alpha = __builtin_amdgcn_exp2f((m_reg - mn) * C); m_reg = mn; }
  float mnC = -mn * C;
  for (int r = 0; r < 16; ++r) p0[r] = fmaf(p0[r], C, mnC); for (int r = 0; r < 16; ++r) p1[r] = fmaf(p1[r], C, mnC);
  for (int r = 0; r < 16; ++r) p0[r] = __builtin_amdgcn_exp2f(p0[r]);
}
__device__ __forceinline__ void finishSM(f32x16& p0, f32x16& p1, float alpha, float& l_reg, bf16x8& pa0, bf16x8& pa1, bf16x8& pa2, bf16x8& pa3) {
  for (int r = 0; r < 16; ++r) p1[r] = __builtin_amdgcn_exp2f(p1[r]);
  float ps = 0; for (int r = 0; r < 16; ++r) ps += p0[r]; for (int r = 0; r < 16; ++r) ps += p1[r];
  { auto rr = __builtin_amdgcn_permlane32_swap(__float_as_uint(ps), __float_as_uint(ps), false, false);
    ps = __uint_as_float(rr[0]) + __uint_as_float(rr[1]); }
  l_reg = l_reg * alpha + ps;
#define PK4(P, BASE, OUT) do { unsigned a0 = cvtpk(P[BASE + 0], P[BASE + 1]), a1 = cvtpk(P[BASE + 2], P[BASE + 3]);   \
    unsigned b0 = cvtpk(P[BASE + 4], P[BASE + 5]), b1 = cvtpk(P[BASE + 6], P[BASE + 7]);                              \
    auto r0 = __builtin_amdgcn_permlane32_swap(a0, b0, false, false); auto r1 = __builtin_amdgcn_permlane32_swap(a1, b1, false, false); \
    u32x4 w = {r0[0], r1[0], r0[1], r1[1]}; OUT = *reinterpret_cast<bf16x8*>(&w); } while (0)
  PK4(p0, 0, pa0); PK4(p0, 8, pa1); PK4(p1, 0, pa2); PK4(p1, 8, pa3);
#undef PK4
}
__device__ __forceinline__ void qkt(f32x16& p0, f32x16& p1, const bf16* Ks, const bf16x8* qr, int r32, int hi) {
  p0 = f32x16{}; p1 = f32x16{};
  for (int d0 = 0; d0 < 8; ++d0) { int cb = (d0 * 16 + hi * 8) * 2;
    bf16x8 b0 = *reinterpret_cast<const bf16x8*>((const char*)Ks + KSWZ(r32, cb));
    bf16x8 b1 = *reinterpret_cast<const bf16x8*>((const char*)Ks + KSWZ(32 + r32, cb));
    p0 = __builtin_amdgcn_mfma_f32_32x32x16_bf16(b0, qr[d0], p0, 0, 0, 0);
    p1 = __builtin_amdgcn_mfma_f32_32x32x16_bf16(b1, qr[d0], p1, 0, 0, 0); }
}
__device__ __forceinline__ int v_st(int k, int c) { const int kk = (k & ~0xC) | ((k & 4) << 1) | ((k & 8) >> 1); return ((kk >> 3) * 4 + (c >> 5)) * 512 + ((kk & 7) * 32 + (c & 31)) * 2; }
__device__ __forceinline__ int v_rd_base(int lane) { return ((lane & 3) << 3) | (((lane >> 2) & 3) << 6) | (((lane >> 4) & 1) << 5) | (((lane >> 5) & 1) << 8); }
constexpr int v_rd_off(int d0, int ks, int half) { return d0 * 512 + ks * 4096 + half * 2048; }
template <int OFF> __device__ __forceinline__ s16x4 tr_read(int vb) {
  s16x4 r; asm volatile("ds_read_b64_tr_b16 %0, %1 offset:%2" : "=&v"(r) : "v"(vb), "i"(OFF) : "memory"); return r;
}
template <int D0> __device__ __forceinline__ void pv_one(f32x16& od, int vb, bf16x8 pa0, bf16x8 pa1, bf16x8 pa2, bf16x8 pa3) {
  const s16x4 l0 = tr_read<v_rd_off(D0, 0, 0)>(vb), h0 = tr_read<v_rd_off(D0, 0, 1)>(vb), l1 = tr_read<v_rd_off(D0, 1, 0)>(vb), h1 = tr_read<v_rd_off(D0, 1, 1)>(vb);
  const s16x4 l2 = tr_read<v_rd_off(D0, 2, 0)>(vb), h2 = tr_read<v_rd_off(D0, 2, 1)>(vb), l3 = tr_read<v_rd_off(D0, 3, 0)>(vb), h3 = tr_read<v_rd_off(D0, 3, 1)>(vb);
  asm volatile("s_waitcnt lgkmcnt(0)" ::: "memory"); SBAR();
#define PK(L, H) (bf16x8){L[0], L[1], L[2], L[3], H[0], H[1], H[2], H[3]}
  od = __builtin_amdgcn_mfma_f32_32x32x16_bf16(pa0, PK(l0, h0), od, 0, 0, 0);
  od = __builtin_amdgcn_mfma_f32_32x32x16_bf16(pa1, PK(l1, h1), od, 0, 0, 0);
  od = __builtin_amdgcn_mfma_f32_32x32x16_bf16(pa2, PK(l2, h2), od, 0, 0, 0);
  od = __builtin_amdgcn_mfma_f32_32x32x16_bf16(pa3, PK(l3, h3), od, 0, 0, 0);
#undef PK
}
__device__ __forceinline__ void pv_d0(f32x16* o, int vb, bf16x8 pa0, bf16x8 pa1, bf16x8 pa2, bf16x8 pa3) {
  pv_one<0>(o[0], vb, pa0, pa1, pa2, pa3); pv_one<1>(o[1], vb, pa0, pa1, pa2, pa3); pv_one<2>(o[2], vb, pa0, pa1, pa2, pa3); pv_one<3>(o[3], vb, pa0, pa1, pa2, pa3);
}

__device__ __forceinline__ void band_mask(f32x16& p0, f32x16& p1, int dq  , int hi) {
#pragma unroll
  for (int r = 0; r < 16; ++r) { const int d = dq - crow(r, hi);
    if ((unsigned)(d + 128) > 256u) p0[r] = -1e30f;
    if ((unsigned)(d + 96) > 256u) p1[r] = -1e30f; }
}
template <bool MASK>
__device__ __forceinline__ void attn_body(const bf16* __restrict__ Qb, const bf16* __restrict__ Kh, const bf16* __restrict__ Vh,
                                          bf16* __restrict__ Ob, int NT, int NCT, int lo, int qpos0, float sinkl2, char* lds) {
  using St = Stage<bf16>;
  int tid_ = threadIdx.x; asm volatile("" : "+v"(tid_));
  const int tid = tid_, wid = tid >> 6, lane = tid & 63, r32 = lane & 31, hi = lane >> 5;
  bf16* V_lds = (bf16*)lds; bf16* K_lds = (bf16*)(lds + 2 * SHM_V);
  float* ws = (float*)(lds + 2 * SHM_V + 2 * SHM_K) + wid * 64; float* li_l = ws; float* al_l = ws + 32;
  float m_reg = -1e30f, l_reg = 0; f32x16 o[4] = {}; bf16x8 qr[8];
  const bf16* Qw = Qb + (long)(wid * QBLK + r32) * LDQ + hi * 8;
#pragma unroll
  for (int d0 = 0; d0 < 8; ++d0) qr[d0] = St::ld8(Qw + d0 * 16);
  const int sr = tid >> 4, sc = (tid & 15) * 8, vst0 = v_st(sr, sc), vst1 = v_st(32 + sr, sc);
  const int vb0 = (int)(uintptr_t)V_lds + v_rd_base(lane);
  const int qi = qpos0 + wid * QBLK + r32;
  struct { typename St::T vs0, vs1, ks0, ks1; } sr_[SDEPTH];
#define TROW(j) (64 * (j) + ((j) >= NCT ? lo : 0))
#define SLOAD(i, k0) do { const long k0_ = (k0); sr_[i].vs0 = St::ld8(&Vh[(k0_ + sr) * LDK + sc]); sr_[i].vs1 = St::ld8(&Vh[(k0_ + 32 + sr) * LDK + sc]); \
    sr_[i].ks0 = St::ld8(&Kh[(k0_ + sr) * LDK + sc]); sr_[i].ks1 = St::ld8(&Kh[(k0_ + 32 + sr) * LDK + sc]); } while (0)
#define SWRITE(b, i) do { *(bf16x8*)((char*)V_lds + (b) * SHM_V + vst0) = St::tobf(sr_[i].vs0);          \
    *(bf16x8*)((char*)V_lds + (b) * SHM_V + vst1) = St::tobf(sr_[i].vs1); int kc = sc * 2;               \
    *(bf16x8*)((char*)K_lds + (b) * SHM_K + KSWZ(sr, kc)) = St::tobf(sr_[i].ks0);                       \
    *(bf16x8*)((char*)K_lds + (b) * SHM_K + KSWZ(32 + sr, kc)) = St::tobf(sr_[i].ks1); } while (0)
#define SWAIT() do { if constexpr (SDEPTH == 2) asm volatile("s_waitcnt vmcnt(4)" ::: "memory"); else asm volatile("s_waitcnt vmcnt(0)" ::: "memory"); } while (0)
#define RESC(a) do { if (__any((a) < 1.f)) { if (hi == 0) al_l[r32] = (a); asm volatile("s_waitcnt lgkmcnt(0)" ::: "memory"); \
    for (int d = 0; d < 4; ++d) for (int r = 0; r < 16; ++r) o[d][r] *= al_l[crow(r, hi)]; } } while (0)
#define AMASK(P0, P1, j) do { if constexpr (MASK) { if ((j) >= NCT) band_mask(P0, P1, qi - (lo + 64 * ((j) - NCT)), hi); } } while (0)
  f32x16 pA0, pA1, pB0, pB1; float mnA, mnB, alA, alB; bf16x8 pa0, pa1, pa2, pa3;
  constexpr int SE = 0, SO = SDEPTH - 1;
  SLOAD(SE, TROW(0)); asm volatile("s_waitcnt vmcnt(0)" ::: "memory"); SWRITE(0, SE); __syncthreads();
  qkt(pA0, pA1, K_lds, qr, r32, hi); AMASK(pA0, pA1, 0); partialSM(pA0, pA1, m_reg, mnA, alA);
  SLOAD(SO, TROW(1)); if constexpr (SDEPTH == 2) { if (2 < NT) SLOAD(SE, TROW(2)); }
  SWAIT(); SWRITE(1, SO); __syncthreads();
  for (int j = 1; j + 1 < NT; j += 2) {
    SBAR(); qkt(pB0, pB1, (bf16*)((char*)K_lds + SHM_K), qr, r32, hi); AMASK(pB0, pB1, j);
    finishSM(pA0, pA1, alA, l_reg, pa0, pa1, pa2, pa3); SBAR();
    SLOAD(SO, TROW(j + SDEPTH)); SBAR();
    pv_d0(o, vb0, pa0, pa1, pa2, pa3); partialSM(pB0, pB1, m_reg, mnB, alB);
    __syncthreads(); SWAIT(); SWRITE(0, SE);
    RESC(alB); __syncthreads();
    SBAR(); qkt(pA0, pA1, K_lds, qr, r32, hi); AMASK(pA0, pA1, j + 1);
    finishSM(pB0, pB1, alB, l_reg, pa0, pa1, pa2, pa3); SBAR();
    if (SDEPTH == 1 || j + 3 < NT) SLOAD(SE, TROW(j + 1 + SDEPTH)); SBAR();
    pv_d0(o, vb0 + (int)SHM_V, pa0, pa1, pa2, pa3); partialSM(pA0, pA1, m_reg, mnA, alA);
    __syncthreads(); SWAIT(); SWRITE(1, SO);
    RESC(alA); __syncthreads();
  }
  SBAR(); qkt(pB0, pB1, (bf16*)((char*)K_lds + SHM_K), qr, r32, hi); AMASK(pB0, pB1, NT - 1);
  finishSM(pA0, pA1, alA, l_reg, pa0, pa1, pa2, pa3); SBAR();
  pv_d0(o, vb0, pa0, pa1, pa2, pa3); partialSM(pB0, pB1, m_reg, mnB, alB);
  __syncthreads(); RESC(alB);
  finishSM(pB0, pB1, alB, l_reg, pa0, pa1, pa2, pa3); SBAR();
  pv_d0(o, vb0 + (int)SHM_V, pa0, pa1, pa2, pa3);
  l_reg += __builtin_amdgcn_exp2f(sinkl2 - m_reg * (SCALE * 1.4426950408889634f));
  if (hi == 0) li_l[r32] = l_reg; asm volatile("s_waitcnt lgkmcnt(0)" ::: "memory");
  float rli[16];
#pragma unroll
  for (int r = 0; r < 16; ++r) rli[r] = __builtin_amdgcn_rcpf(li_l[crow(r, hi)]);
  bf16* Ow = Ob + (long)(wid * QBLK) * LDO;
#pragma unroll
  for (int r = 0; r < 16; ++r) { int orow = crow(r, hi);
    for (int d0 = 0; d0 < 4; ++d0) { const float v = o[d0][r] * rli[r]; const unsigned u = __builtin_bit_cast(unsigned, v);
      Ow[(long)orow * LDO + d0 * 32 + r32] = (bf16)((u + 0x7fffu + ((u >> 16) & 1u)) >> 16); } }
  __syncthreads();
#undef TROW
#undef SLOAD
#undef SWRITE
#undef SWAIT
#undef RESC
#undef AMASK
}

template <int OFF> __device__ __forceinline__ bf16x8 k_read(int addr) { bf16x8 r; asm volatile("ds_read_b128 %0, %1 offset:%2" : "=&v"(r) : "v"(addr), "i"(OFF) : "memory"); return r; }
__device__ __forceinline__ void qkt_pipe(f32x16& p0, f32x16& p1, const bf16* Ks, const bf16x8* qr, int r32, int hi) {
  p0 = f32x16{}; p1 = f32x16{};
  const int kb = (int)(uintptr_t)Ks + r32 * 256, sw = (r32 & 7) << 4;
  const int e0 = kb + ((0 * 32 + hi * 16) ^ sw), e1 = kb + ((1 * 32 + hi * 16) ^ sw), e2 = kb + ((2 * 32 + hi * 16) ^ sw), e3 = kb + ((3 * 32 + hi * 16) ^ sw);
  bf16x8 a0, a1, b0, b1;
#define LGK(n) do { asm volatile("s_waitcnt lgkmcnt(" #n ")" ::: "memory"); SBAR(); } while (0)
#define MM(A0, A1, d) do { p0 = __builtin_amdgcn_mfma_f32_32x32x16_bf16(A0, qr[d], p0, 0, 0, 0); p1 = __builtin_amdgcn_mfma_f32_32x32x16_bf16(A1, qr[d], p1, 0, 0, 0); SBAR(); } while (0)
  a0 = k_read<0>(e0); a1 = k_read<8192>(e0); b0 = k_read<0>(e1); b1 = k_read<8192>(e1);
  LGK(2); MM(a0, a1, 0); a0 = k_read<0>(e2); a1 = k_read<8192>(e2);
  LGK(2); MM(b0, b1, 1); b0 = k_read<0>(e3); b1 = k_read<8192>(e3);
  LGK(2); MM(a0, a1, 2); a0 = k_read<128>(e0); a1 = k_read<8320>(e0);
  LGK(2); MM(b0, b1, 3); b0 = k_read<128>(e1); b1 = k_read<8320>(e1);
  LGK(2); MM(a0, a1, 4); a0 = k_read<128>(e2); a1 = k_read<8320>(e2);
  LGK(2); MM(b0, b1, 5); b0 = k_read<128>(e3); b1 = k_read<8320>(e3);
  LGK(2); MM(a0, a1, 6);
  LGK(0); MM(b0, b1, 7);
#undef LGK
#undef MM
}
struct VFr { s16x4 l0, h0, l1, h1, l2, h2, l3, h3; };
template <int DB> __device__ __forceinline__ void pv_ld(VFr& f, int vb) {
  constexpr int I = (DB >> 2) * 16384, D0 = DB & 3;
  f.l0 = tr_read<I + v_rd_off(D0, 0, 0)>(vb); f.h0 = tr_read<I + v_rd_off(D0, 0, 1)>(vb); f.l1 = tr_read<I + v_rd_off(D0, 1, 0)>(vb); f.h1 = tr_read<I + v_rd_off(D0, 1, 1)>(vb);
  f.l2 = tr_read<I + v_rd_off(D0, 2, 0)>(vb); f.h2 = tr_read<I + v_rd_off(D0, 2, 1)>(vb); f.l3 = tr_read<I + v_rd_off(D0, 3, 0)>(vb); f.h3 = tr_read<I + v_rd_off(D0, 3, 1)>(vb);
}
__device__ __forceinline__ void pv_mm(f32x16& od, const VFr& f, bf16x8 pa0, bf16x8 pa1, bf16x8 pa2, bf16x8 pa3) {
#define PK(L, H) (bf16x8){L[0], L[1], L[2], L[3], H[0], H[1], H[2], H[3]}
  od = __builtin_amdgcn_mfma_f32_32x32x16_bf16(pa0, PK(f.l0, f.h0), od, 0, 0, 0);
  od = __builtin_amdgcn_mfma_f32_32x32x16_bf16(pa1, PK(f.l1, f.h1), od, 0, 0, 0);
  od = __builtin_amdgcn_mfma_f32_32x32x16_bf16(pa2, PK(f.l2, f.h2), od, 0, 0, 0);
  od = __builtin_amdgcn_mfma_f32_32x32x16_bf16(pa3, PK(f.l3, f.h3), od, 0, 0, 0);
#undef PK
}
__device__ __forceinline__ void pv_all(f32x16* o, int vb, bf16x8 pa0, bf16x8 pa1, bf16x8 pa2, bf16x8 pa3) {
  VFr fa, fb;
#define W8() do { asm volatile("s_waitcnt lgkmcnt(8)" ::: "memory"); SBAR(); } while (0)
#define W0() do { asm volatile("s_waitcnt lgkmcnt(0)" ::: "memory"); SBAR(); } while (0)
  pv_ld<0>(fa, vb);
  pv_ld<1>(fb, vb); W8(); pv_mm(o[0], fa, pa0, pa1, pa2, pa3); SBAR();
  pv_ld<2>(fa, vb); W8(); pv_mm(o[1], fb, pa0, pa1, pa2, pa3); SBAR();
  pv_ld<3>(fb, vb); W8(); pv_mm(o[2], fa, pa0, pa1, pa2, pa3); SBAR();
  pv_ld<4>(fa, vb); W8(); pv_mm(o[3], fb, pa0, pa1, pa2, pa3); SBAR();
  pv_ld<5>(fb, vb); W8(); pv_mm(o[4], fa, pa0, pa1, pa2, pa3); SBAR();
  pv_ld<6>(fa, vb); W8(); pv_mm(o[5], fb, pa0, pa1, pa2, pa3); SBAR();
  pv_ld<7>(fb, vb); W8(); pv_mm(o[6], fa, pa0, pa1, pa2, pa3); SBAR();
  W0(); pv_mm(o[7], fb, pa0, pa1, pa2, pa3);
#undef W8
#undef W0
}
#define ATT_LAS __attribute__((address_space(3)))
struct VH { s16x4 l0, h0, l1, h1; };
template <int DB, int KS> __device__ __forceinline__ void pv_ldh(VH& f, int vb) {
  constexpr int I = (DB >> 2) * 16384, D0 = DB & 3;
  f.l0 = tr_read<I + v_rd_off(D0, KS, 0)>(vb); f.h0 = tr_read<I + v_rd_off(D0, KS, 1)>(vb); f.l1 = tr_read<I + v_rd_off(D0, KS + 1, 0)>(vb); f.h1 = tr_read<I + v_rd_off(D0, KS + 1, 1)>(vb);
}
#define PKV(L, H) (bf16x8){L[0], L[1], L[2], L[3], H[0], H[1], H[2], H[3]}
#define PK4S(P, BASE, OUT) do { unsigned a0_ = cvtpk(P[BASE + 0], P[BASE + 1]), a1_ = cvtpk(P[BASE + 2], P[BASE + 3]);   \
    unsigned b0_ = cvtpk(P[BASE + 4], P[BASE + 5]), b1_ = cvtpk(P[BASE + 6], P[BASE + 7]);                              \
    auto r0_ = __builtin_amdgcn_permlane32_swap(a0_, b0_, false, false); auto r1_ = __builtin_amdgcn_permlane32_swap(a1_, b1_, false, false); \
    u32x4 w_ = {r0_[0], r1_[0], r0_[1], r1_[1]}; OUT = *reinterpret_cast<bf16x8*>(&w_); } while (0)
__device__ __forceinline__ void smpv_all(f32x16& p0, f32x16& p1, float alpha, float& l_reg, f32x16* o, int vb,
                                         const char* kb, const char* vbg, ATT_LAS unsigned char* kdst, ATT_LAS unsigned char* vdst, bool dma) {
  bf16x8 pa0, pa1, pa2, pa3; VH fa, fb; float s0 = 0.f, s1 = 0.f;
  PK4S(p0, 0, pa0); PK4S(p0, 8, pa1);
#define WL(n) do { asm volatile("s_waitcnt lgkmcnt(" #n ")" ::: "memory"); SBAR(); } while (0)
#define P1BLK(B, FC, FN, LAST) do { if (!(LAST)) pv_ldh<((B) + 1) & 7, 0>(FN, vb); if (LAST) WL(0); else WL(4); \
    o[B] = __builtin_amdgcn_mfma_f32_32x32x16_bf16(pa0, PKV(FC.l0, FC.h0), o[B], 0, 0, 0); \
    p1[2 * (B)] = __builtin_amdgcn_exp2f(p1[2 * (B)]); s0 += p0[2 * (B)]; s1 += p0[2 * (B) + 1]; SBAR(); \
    o[B] = __builtin_amdgcn_mfma_f32_32x32x16_bf16(pa1, PKV(FC.l1, FC.h1), o[B], 0, 0, 0); \
    p1[2 * (B) + 1] = __builtin_amdgcn_exp2f(p1[2 * (B) + 1]); if ((B) > 0) { s0 += p1[2 * (B) - 2]; s1 += p1[2 * (B) - 1]; } SBAR(); } while (0)
  pv_ldh<0, 0>(fa, vb);
  P1BLK(0, fa, fb, false); P1BLK(1, fb, fa, false); P1BLK(2, fa, fb, false); P1BLK(3, fb, fa, false);
  P1BLK(4, fa, fb, false); P1BLK(5, fb, fa, false); P1BLK(6, fa, fb, false); P1BLK(7, fb, fa, true);
  pv_ldh<0, 2>(fa, vb);
  s0 += p1[14]; s1 += p1[15];
  float ps = s0 + s1;
  { auto rr = __builtin_amdgcn_permlane32_swap(__float_as_uint(ps), __float_as_uint(ps), false, false); ps = __uint_as_float(rr[0]) + __uint_as_float(rr[1]); }
  l_reg = l_reg * alpha + ps;
  PK4S(p1, 0, pa2); PK4S(p1, 8, pa3); SBAR();
#define DMAP(B) do { if (dma) { if ((B) < 2) __builtin_amdgcn_global_load_lds((const unsigned*)(kb + (B) * (32 * LDK * 2)), (ATT_LAS unsigned*)(kdst + (B) * 8192), 16, 0, 0); \
      else if ((B) < 6) __builtin_amdgcn_global_load_lds((const unsigned*)(vbg + (((B) - 2) & 1) * (32 * LDK * 2) + (((B) - 2) >> 1) * 256), (ATT_LAS unsigned*)(vdst + ((B) - 2) * 8192), 16, 0, 0); } } while (0)
#define P2BLK(B, FC, FN, LAST) do { if (!(LAST)) pv_ldh<((B) + 1) & 7, 2>(FN, vb); if (LAST) WL(0); else WL(4); \
    o[B] = __builtin_amdgcn_mfma_f32_32x32x16_bf16(pa2, PKV(FC.l0, FC.h0), o[B], 0, 0, 0); DMAP(B); \
    o[B] = __builtin_amdgcn_mfma_f32_32x32x16_bf16(pa3, PKV(FC.l1, FC.h1), o[B], 0, 0, 0); SBAR(); } while (0)
  P2BLK(0, fa, fb, false); P2BLK(1, fb, fa, false); P2BLK(2, fa, fb, false); P2BLK(3, fb, fa, false);
  P2BLK(4, fa, fb, false); P2BLK(5, fb, fa, false); P2BLK(6, fa, fb, false); P2BLK(7, fb, fa, true);
#undef WL
#undef P1BLK
#undef P2BLK
#undef DMAP
}
#undef PKV
#undef PK4S
__device__ __forceinline__ void attn_body_v256(const bf16* __restrict__ Qb, const bf16* __restrict__ Kh, const bf16* __restrict__ Vh,
                                               bf16* __restrict__ Ob, int NT, ATT_LAS unsigned char* ldsl) {
  using St = Stage<bf16>;
  int tid_ = threadIdx.x; asm volatile("" : "+v"(tid_));
  const int tid = tid_, wid = __builtin_amdgcn_readfirstlane(tid >> 6), lane = tid & 63, r32 = lane & 31, hi = lane >> 5;
  char* lds = (char*)ldsl;
  float* ws = (float*)(lds + 147456) + wid * 64; float* li_l = ws; float* al_l = ws + 32;
  float m_reg = -1e30f, l_reg = 0; f32x16 o[8] = {}; bf16x8 qr[8];
  const bf16* Qw = Qb + (long)(wid * QBLK + r32) * LDQ + hi * 8;
#pragma unroll
  for (int d0 = 0; d0 < 8; ++d0) qr[d0] = St::ld8(Qw + d0 * 16);
  unsigned offK0, offV0;
  { const int row = wid * 4 + (lane >> 4), colB = ((lane & 15) * 16) ^ ((row & 7) << 4); offK0 = (unsigned)row * (LDK * 2) + (unsigned)colB;
    const int sub = wid * 2 + (lane >> 5), kkhi = sub >> 2, cblk = sub & 3, within = (lane & 31) * 16, kk = kkhi * 8 + (within >> 6);
    const int k = (kk & ~0xC) | ((kk & 4) << 1) | ((kk & 8) >> 1), c = cblk * 32 + ((within & 63) >> 1);
    offV0 = (unsigned)k * (LDK * 2) + (unsigned)c * 2; }
  const int vb0 = (int)(uintptr_t)lds + 16384 + v_rd_base(lane);
#define DMA_TILE(j, sbo) do { const char* kb_ = (const char*)Kh + (size_t)(j) * (64 * LDK * 2) + offK0; const char* vb_ = (const char*)Vh + (size_t)(j) * (64 * LDK * 2) + offV0; \
    _Pragma("unroll") for (int i_ = 0; i_ < 2; ++i_) __builtin_amdgcn_global_load_lds((const unsigned*)(kb_ + i_ * (32 * LDK * 2)), (ATT_LAS unsigned*)(ldsl + (sbo) + (i_ * 8 + wid) * 1024), 16, 0, 0); \
    _Pragma("unroll") for (int i_ = 0; i_ < 4; ++i_) __builtin_amdgcn_global_load_lds((const unsigned*)(vb_ + (i_ & 1) * (32 * LDK * 2) + (i_ >> 1) * 256), (ATT_LAS unsigned*)(ldsl + (sbo) + 16384 + (i_ * 8 + wid) * 1024), 16, 0, 0); } while (0)
#define RESC8(a) do { if (__any((a) < 1.f)) { if (hi == 0) al_l[r32] = (a); asm volatile("s_waitcnt lgkmcnt(0)" ::: "memory"); \
    for (int d = 0; d < 8; ++d) for (int r = 0; r < 16; ++r) o[d][r] *= al_l[crow(r, hi)]; } } while (0)
#define TILE_SYNC() do { asm volatile("s_waitcnt vmcnt(0)" ::: "memory"); __builtin_amdgcn_s_barrier(); asm volatile("" ::: "memory"); } while (0)
  f32x16 p0, p1; float mn, al;
#pragma unroll
  for (int d0 = 0; d0 < 8; ++d0) asm volatile("" : "+v"(qr[d0]));
  if (wid >= 4) __builtin_amdgcn_s_setprio(2);
  DMA_TILE(0, 0); DMA_TILE(1, 49152);
  int sb = 0, sb2 = 98304;
  for (int j = 0; j < NT; ++j) {
    if (j + 1 < NT) asm volatile("s_waitcnt vmcnt(6)" ::: "memory"); else asm volatile("s_waitcnt vmcnt(0)" ::: "memory");
    __builtin_amdgcn_s_barrier(); asm volatile("" ::: "memory");
    qkt_pipe(p0, p1, (const bf16*)(lds + sb), qr, r32, hi); partialSM(p0, p1, m_reg, mn, al); RESC8(al); SBAR();
    smpv_all(p0, p1, al, l_reg, o, vb0 + sb, (const char*)Kh + (size_t)(j + 2) * (64 * LDK * 2) + offK0, (const char*)Vh + (size_t)(j + 2) * (64 * LDK * 2) + offV0,
             ldsl + sb2 + wid * 1024, ldsl + sb2 + 16384 + wid * 1024, j + 2 < NT);
    sb = (sb == 98304) ? 0 : sb + 49152; sb2 = (sb2 == 98304) ? 0 : sb2 + 49152;
  }
  __builtin_amdgcn_s_setprio(0);
  if (hi == 0) li_l[r32] = l_reg; asm volatile("s_waitcnt lgkmcnt(0)" ::: "memory");
  float rli[16];
#pragma unroll
  for (int r = 0; r < 16; ++r) rli[r] = __builtin_amdgcn_rcpf(li_l[crow(r, hi)]);
  bf16* Ow = Ob + (long)(wid * QBLK) * LDO;
#pragma unroll
  for (int r = 0; r < 16; ++r) { int orow = crow(r, hi);
#pragma unroll
    for (int d0 = 0; d0 < 8; ++d0) { const float v = o[d0][r] * rli[r]; const unsigned u = __builtin_bit_cast(unsigned, v);
      Ow[(long)orow * LDO + d0 * 32 + r32] = (bf16)((u + 0x7fffu + ((u >> 16) & 1u)) >> 16); } }
#undef DMA_TILE
#undef RESC8
#undef TILE_SYNC
}
__device__ __forceinline__ void attn_body_a(const bf16* __restrict__ Qb, const bf16* __restrict__ Kh, const bf16* __restrict__ Vh, bf16* __restrict__ Ob,
                                            int NT, int NCT, int lo, int qpos0, const float* __restrict__ sk4, ATT_LAS unsigned char* ldsl) {
  using St = Stage<bf16>;
  int tid_ = threadIdx.x; asm volatile("" : "+v"(tid_));
  const int tid = tid_, wid = __builtin_amdgcn_readfirstlane(tid >> 6), lane = tid & 63, r32 = lane & 31, hi = lane >> 5;
  const int g = wid >> 1, rh = wid & 1;
  char* lds = (char*)ldsl;
  float* ws = (float*)(lds + 98304) + wid * 64; float* li_l = ws; float* al_l = ws + 32;
  float m_reg = -1e30f, l_reg = 0; f32x16 o[4] = {}; bf16x8 qr[8];
  const bf16* Qw = Qb + (long)(rh * QBLK + r32) * LDQ + g * 128 + hi * 8;
#pragma unroll
  for (int d0 = 0; d0 < 8; ++d0) qr[d0] = St::ld8(Qw + d0 * 16);
  const float sinkl2 = sk4[g] * 1.4426950408889634f;
  const int qi = qpos0 + rh * QBLK + r32;
  unsigned offK0, offV0;
  { const int row = wid * 4 + (lane >> 4), colB = ((lane & 15) * 16) ^ ((row & 7) << 4); offK0 = (unsigned)row * (LDK * 2) + (unsigned)colB;
    const int sub = wid * 2 + (lane >> 5), kkhi = sub >> 2, cblk = sub & 3, within = (lane & 31) * 16, kk = kkhi * 8 + (within >> 6);
    const int k = (kk & ~0xC) | ((kk & 4) << 1) | ((kk & 8) >> 1), c = cblk * 32 + ((within & 63) >> 1);
    offV0 = (unsigned)k * (LDK * 2) + (unsigned)c * 2; }
  const int vb0 = (int)(uintptr_t)lds + 16384 + v_rd_base(lane);
#define TROWA(j) (64 * (j) + ((j) >= NCT ? lo : 0))
#define DMA_TILE(j, sb) do { const size_t ro_ = (size_t)TROWA(j) * (LDK * 2); const char* kb_ = (const char*)Kh + ro_ + offK0; const char* vb_ = (const char*)Vh + ro_ + offV0; \
    _Pragma("unroll") for (int i_ = 0; i_ < 2; ++i_) { __builtin_amdgcn_global_load_lds((const unsigned*)(kb_ + i_ * (32 * LDK * 2)), (ATT_LAS unsigned*)(ldsl + (sb) + (i_ * 8 + wid) * 1024), 16, 0, 0); \
      __builtin_amdgcn_global_load_lds((const unsigned*)(vb_ + i_ * (32 * LDK * 2)), (ATT_LAS unsigned*)(ldsl + (sb) + 16384 + (i_ * 8 + wid) * 1024), 16, 0, 0); } } while (0)
#define RESC4(a) do { if (__any((a) < 1.f)) { if (hi == 0) al_l[r32] = (a); asm volatile("s_waitcnt lgkmcnt(0)" ::: "memory"); \
    for (int d = 0; d < 4; ++d) for (int r = 0; r < 16; ++r) o[d][r] *= al_l[crow(r, hi)]; } } while (0)
  f32x16 p0, p1; float mn, al; bf16x8 pa0, pa1, pa2, pa3;
#pragma unroll
  for (int d0 = 0; d0 < 8; ++d0) asm volatile("" : "+v"(qr[d0]));
  DMA_TILE(0, 0);
  int sb = 0;
  for (int j = 0; j < NT; ++j) {
    asm volatile("s_waitcnt vmcnt(0)" ::: "memory"); __builtin_amdgcn_s_barrier(); asm volatile("" ::: "memory");
    if (j + 1 < NT) DMA_TILE(j + 1, sb ^ 32768);
    qkt_pipe(p0, p1, (const bf16*)(lds + sb), qr, r32, hi);
    if (j >= NCT) band_mask(p0, p1, qi - (lo + 64 * (j - NCT)), hi);
    partialSM(p0, p1, m_reg, mn, al); RESC4(al); finishSM(p0, p1, al, l_reg, pa0, pa1, pa2, pa3); SBAR();
    pv_d0(o, vb0 + sb, pa0, pa1, pa2, pa3);
    sb ^= 32768;
  }
  l_reg += __builtin_amdgcn_exp2f(sinkl2 - m_reg * (SCALE * 1.4426950408889634f));
  if (hi == 0) li_l[r32] = l_reg; asm volatile("s_waitcnt lgkmcnt(0)" ::: "memory");
  float rli[16];
#pragma unroll
  for (int r = 0; r < 16; ++r) rli[r] = __builtin_amdgcn_rcpf(li_l[crow(r, hi)]);
  bf16* Ow = Ob + (long)(rh * QBLK) * LDO + g * 128;
#pragma unroll
  for (int r = 0; r < 16; ++r) { int orow = crow(r, hi);
#pragma unroll
    for (int d0 = 0; d0 < 4; ++d0) { const float v = o[d0][r] * rli[r]; const unsigned u = __builtin_bit_cast(unsigned, v);
      Ow[(long)orow * LDO + d0 * 32 + r32] = (bf16)((u + 0x7fffu + ((u >> 16) & 1u)) >> 16); } }
#undef TROWA
#undef DMA_TILE
#undef RESC4
}
}

constexpr size_t MiB = 1u << 20;
constexpr size_t SLOT = (size_t)MROWS * DM * 2;
constexpr size_t WS_MOD = 0;
constexpr size_t WS_BAR = 1 * MiB, WS_BAR_BYTES = 16384;
constexpr size_t WS_COS = 2 * MiB, WS_SIN = 4 * MiB;
constexpr size_t WS_CTX1 = 6 * MiB;
constexpr size_t WS_WINT = 16 * MiB;
constexpr size_t WS_WPT = WS_WINT + 68 * MiB;
constexpr size_t WS_PX = WS_WPT + 48 * MiB;
constexpr size_t WS_S0 = WS_PX + (size_t)MROWS * INC * 2;
constexpr size_t WS_END = WS_S0 + 5 * SLOT;
static_assert(WS_END <= 4ull * DEPTH * DM * INC * 4, "workspace map exceeds the guaranteed 4x largest tensor");

constexpr int NWAVES = 8;
constexpr int LDS_BYTES = 149760;

#define GAS __attribute__((address_space(1)))
#define LAS __attribute__((address_space(3)))
typedef unsigned short bf16;
typedef unsigned v4u __attribute__((ext_vector_type(4)));
typedef unsigned v2u __attribute__((ext_vector_type(2)));
typedef float f32x4 __attribute__((ext_vector_type(4)));
#define LDS_WAIT() asm volatile("s_waitcnt lgkmcnt(0)" ::: "memory")
__device__ __forceinline__ unsigned f2bf(float f) { unsigned u = __builtin_bit_cast(unsigned, f); return (u + 0x7fffu + ((u >> 16) & 1u)) >> 16; }
__device__ __forceinline__ unsigned pk2(float lo, float hi) { return f2bf(lo) | (f2bf(hi) << 16); }
__device__ __forceinline__ float bflo(unsigned w) { return __builtin_bit_cast(float, w << 16); }
__device__ __forceinline__ float bfhi(unsigned w) { return __builtin_bit_cast(float, w & 0xffff0000u); }
__device__ __forceinline__ float siluf(float x) { return x / (1.f + __expf(-x)); }
__device__ __forceinline__ float sigmf(float x) { return 1.f / (1.f + __expf(-x)); }

struct Frame {
    LAS unsigned char* lds;
    int vcu, G;
    const float *x, *c, *ctx, *c_ctx, *w_ada, *b_ada, *g_pre, *g_post, *w_in, *sink, *lam_qk, *g_subln, *w_pa, *w_pb, *w_out;
    float* out; unsigned char* ws;
};

#define XB_TMO      128
#define XB_XCNT(j)  (256  + 64 * (j))
#define XB_XSUB(j)  (1280 + 64 * (j))
#define XB_XGEN(j)  (2304 + 64 * (j))
#define XB_TOP      3328
#define XB_TOPGEN   3392
#define XCD_BAR_WORDS 3456
#define XB_SPIN_CAP (1u << 18)

__device__ __forceinline__ unsigned xb_ld(unsigned* p)              { return __hip_atomic_load(p, __ATOMIC_RELAXED, __HIP_MEMORY_SCOPE_AGENT); }
__device__ __forceinline__ unsigned xb_add(unsigned* p, unsigned v) { return __hip_atomic_fetch_add(p, v, __ATOMIC_RELAXED, __HIP_MEMORY_SCOPE_AGENT); }
__device__ __forceinline__ unsigned xb_xcc_id() { return (unsigned)__builtin_amdgcn_s_getreg((3 << 11) | 20) & 0xFu; }
#define XB_SPIN(cond, bar) do { unsigned _sp = 0; while (cond) { __builtin_amdgcn_s_sleep(1); \
    if ((++_sp & 255u) == 0u) { if (xb_ld(&(bar)[XB_TMO])) break; if (_sp > XB_SPIN_CAP) { atomicAdd(&(bar)[XB_TMO], 1u); break; } } } } while (0)

struct XcdBarrier {
    unsigned* bar; unsigned x;
    volatile LAS unsigned* st;
};

__device__ __forceinline__ XcdBarrier xcd_barrier_post(unsigned* bar, volatile LAS unsigned* st) {
    XcdBarrier b; b.bar = bar; b.x = xb_xcc_id(); b.st = st;
    if (threadIdx.x == 0) (void)xb_add(&bar[XB_XCNT(b.x)], 1u);
    return b;
}
__device__ __forceinline__ void xcd_barrier_complete(unsigned* bar, unsigned x, unsigned& nloc, unsigned& nx) {
    const unsigned G = gridDim.x * gridDim.y * gridDim.z;
    unsigned sum, cnt, mine, sp = 0u;
    for (;;) {
        sum = 0u; cnt = 0u; mine = 0u;
#pragma unroll
        for (unsigned j = 0; j < 16; ++j) { const unsigned c = xb_ld(&bar[XB_XCNT(j)]); sum += c; cnt += (c > 0u) ? 1u : 0u; mine = (j == x) ? c : mine; }
        if (sum == G) break;
        __builtin_amdgcn_s_sleep(1);
        if ((++sp & 255u) == 0u) { if (xb_ld(&bar[XB_TMO])) break; if (sp > XB_SPIN_CAP) { atomicAdd(&bar[XB_TMO], 1u); break; } }
    }
    nloc = mine > 0u ? mine : 1u; nx = cnt > 0u ? cnt : 1u;
}

__device__ __forceinline__ void xcd_barrier(const XcdBarrier& b) {
    asm volatile("s_waitcnt vmcnt(0)" ::: "memory");
    __syncthreads();
    if (threadIdx.x == 0) {
        unsigned* bar = b.bar;
        __builtin_amdgcn_s_waitcnt(0);
        unsigned nloc = b.st[0], nx = b.st[1];
        if (nloc == 0u) { xcd_barrier_complete(bar, b.x, nloc, nx); b.st[0] = nloc; b.st[1] = nx; }
        const unsigned old = xb_add(&bar[XB_XSUB(b.x)], 1u);
        const unsigned gen = old / nloc;
        if (old + 1u == (gen + 1u) * nloc) {
            __builtin_amdgcn_fence(__ATOMIC_RELEASE, "agent");
            asm volatile("s_waitcnt vmcnt(0)" ::: "memory");
            const unsigned og = xb_add(&bar[XB_TOP], 1u);
            const unsigned tg = og / nx;
            if (og + 1u == (tg + 1u) * nx) xb_add(&bar[XB_TOPGEN], 1u);
            else XB_SPIN(xb_ld(&bar[XB_TOPGEN]) == tg, bar);
            __builtin_amdgcn_fence(__ATOMIC_ACQUIRE, "agent");
            xb_add(&bar[XB_XGEN(b.x)], 1u);
            asm volatile("s_waitcnt vmcnt(0)" ::: "memory");
        } else {
            XB_SPIN(xb_ld(&bar[XB_XGEN(b.x)]) == gen, bar);
            __builtin_amdgcn_fence(__ATOMIC_ACQUIRE, "agent");
            asm volatile("s_waitcnt vmcnt(0)" ::: "memory");
        }
    }
    __syncthreads();
}

#define FRESH_IDS int tid_ = threadIdx.x; asm volatile("" : "+v"(tid_)); const int tid = tid_, lane = tid & 63, wave = __builtin_amdgcn_readfirstlane(tid >> 6); (void)lane; (void)wave;

__device__ __forceinline__ float wave_sum(float v) {
#pragma unroll
    for (int o = 1; o < 64; o <<= 1) v += __shfl_xor(v, o);
    return v;
}
__device__ __forceinline__ void p0_transpose_item(const float* W, int K, int N, bf16* WT, int row_off, LAS float* scr, int item, int lane) {
    const int nblk = N / 32, kb = item / nblk, nb = item % nblk, k0 = 64 * kb, n0 = 32 * nb;
#pragma unroll
    for (int i = 0; i < 32; ++i) { const int kk = 2 * i + (lane >> 5); scr[kk * 33 + (lane & 31)] = W[(size_t)(k0 + kk) * N + n0 + (lane & 31)]; }
    LDS_WAIT(); asm volatile("" ::: "memory");
    const int c = lane & 7;
#pragma unroll
    for (int j = 0; j < 4; ++j) { const int n = (lane >> 3) + 8 * j; const LAS float* s = scr + (8 * c) * 33 + n;
        v4u o; o.x = pk2(s[0 * 33], s[1 * 33]); o.y = pk2(s[2 * 33], s[3 * 33]); o.z = pk2(s[4 * 33], s[5 * 33]); o.w = pk2(s[6 * 33], s[7 * 33]);
        *(GAS v4u*)(WT + (size_t)(row_off + n0 + n) * K + k0 + 8 * c) = o; }
    LDS_WAIT(); asm volatile("" ::: "memory");
}

#define GW_LOOP(var, n) for (int var = F.vcu * NWAVES + wave; var < (n); var += F.G * NWAVES)

__device__ __forceinline__ int win_row_off(int n0) {
    const int tile = n0 >> 8; const bool rope = tile < 2 || (tile >= 4 && tile < 12) || (tile >= 20 && tile < 28) || (tile >= 36 && tile < 44);
    if (!rope) return 0;
    const int w = n0 & 255, hsel = w >> 7, half = (w >> 6) & 1, i = w & 63;
    return (half * 128 + hsel * 64 + i) - w;
}
__device__ __forceinline__ void ph_prologue(Frame& F) {
    FRESH_IDS
    for (int ait = F.vcu; ait < 192; ait += F.G) {
        const int l = ait / 96, n0 = (ait % 96) * 64;
        LAS float* sv = (LAS float*)F.lds;
        LAS float* red = (LAS float*)(F.lds + 32768);
        for (int k = tid; k < DM; k += NWAVES * 64) { sv[k] = siluf(F.c[k]); sv[DM + k] = siluf(F.c[DM + k]); sv[2 * DM + k] = siluf(F.c_ctx[k]); }
        __syncthreads();
        const float* W = F.w_ada + (size_t)l * DM * 6144 + n0 + lane;
        float a0 = 0.f, a1 = 0.f, a2 = 0.f;
        const int kb = wave * 256;
#pragma unroll 32
        for (int k = 0; k < 256; ++k) { const float w = W[(size_t)(kb + k) * 6144]; a0 += sv[kb + k] * w; a1 += sv[DM + kb + k] * w; a2 += sv[2 * DM + kb + k] * w; }
        red[(wave * 3 + 0) * 64 + lane] = a0; red[(wave * 3 + 1) * 64 + lane] = a1; red[(wave * 3 + 2) * 64 + lane] = a2;
        __syncthreads();
        if (wave < 3) { float s = 0.f;
#pragma unroll
            for (int w = 0; w < 8; ++w) s += red[(w * 3 + wave) * 64 + lane];
            float* mod = (float*)(F.ws + WS_MOD);
            mod[(size_t)(l * 3 + wave) * 6144 + n0 + lane] = s + F.b_ada[(size_t)l * 6144 + n0 + lane]; }
        __syncthreads();
    }
    { float* ct = (float*)(F.ws + WS_COS); float* st = (float*)(F.ws + WS_SIN);
      for (int i = (F.vcu * NWAVES * 64) + tid; i < SEQ * 64; i += F.G * NWAVES * 64) {
          const int t = i >> 6, j = i & 63, f = j & 31; const float pos = (float)((j < 32) ? (t >> 6) : (t & 63));
          const float inv = expf(-(float)f * (9.210340371976184f / 32.f)); const float ang = pos * inv;
          ct[i] = cosf(ang); st[i] = sinf(ang); } }
    LAS float* scr = (LAS float*)(F.lds + wave * 16384);
    constexpr int I_IN = (DM / 64) * (INC / 32), I_P = (DM / 64) * (DM / 32);
    bf16* WinT = (bf16*)(F.ws + WS_WINT); bf16* WpT = (bf16*)(F.ws + WS_WPT);
    GW_LOOP(it, I_IN + 6 * I_P) {
        if (it < I_IN) { p0_transpose_item(F.w_in, DM, INC, WinT, win_row_off(32 * (it % (INC / 32))), scr, it, lane); continue; }
        const int r = it - I_IN, mi = r / I_P, ii = r % I_P, l = mi / 3, w = mi % 3;
        const float* W = (w == 0 ? F.w_pa : (w == 1 ? F.w_pb : F.w_out)) + (size_t)l * DM * DM;
        p0_transpose_item(W, DM, DM, WpT + (size_t)mi * DM * DM, 0, scr, ii, lane);
    }
}

__device__ __forceinline__ void ph_hnorm(Frame& F, int l, const float* xcur, const float* ctxcur) {
    FRESH_IDS
    bf16* H = (bf16*)(F.ws + WS_S0);
    const float* gp = F.g_pre + (size_t)l * DM;
    GW_LOOP(row, MROWS) {
        const int b = row / RPB, rr = row % RPB; const float* src; int v;
        if (rr < CTX) { src = ctxcur + (size_t)(b * CTX + rr) * DM; v = 2; } else { src = xcur + (size_t)(b * SEQ + rr - CTX) * DM; v = b; }
        const float* md = (const float*)(F.ws + WS_MOD) + (size_t)(l * 3 + v) * 6144;
        f32x4 xv[8]; float s = 0.f;
#pragma unroll
        for (int j = 0; j < 8; ++j) { xv[j] = ((const f32x4*)src)[lane + 64 * j]; s += (xv[j].x * xv[j].x + xv[j].y * xv[j].y) + (xv[j].z * xv[j].z + xv[j].w * xv[j].w); }
        const float rs = rsqrtf(wave_sum(s) * (1.f / DM) + EPS);
#pragma unroll
        for (int j = 0; j < 8; ++j) { const int q = lane + 64 * j;
            const f32x4 g = ((const f32x4*)gp)[q], sh = ((const f32x4*)md)[q], sc = ((const f32x4*)(md + DM))[q];
            const f32x4 y = (xv[j] * rs) * g * (sc + 1.f) + sh;
            v2u o; o.x = pk2(y.x, y.y); o.y = pk2(y.z, y.w);
            *(v2u*)(H + (size_t)row * DM + 4 * q) = o; }
    }
}

__device__ __forceinline__ void ph_rope(Frame& F) {
    FRESH_IDS
    bf16* PX = (bf16*)(F.ws + WS_PX);
    const float* ct = (const float*)(F.ws + WS_COS); const float* st = (const float*)(F.ws + WS_SIN);
    const unsigned total = (unsigned)NB * SEQ * 52 * 8;
    for (unsigned idx = (unsigned)(F.vcu * NWAVES * 64 + tid); idx < total; idx += (unsigned)(F.G * NWAVES * 64)) {
        const unsigned ch = idx & 7, hr = idx >> 3, hh = hr % 52, rowL = hr / 52, b = rowL / SEQ, t = rowL % SEQ;
        const int col = (hh < 4) ? (C_KA + hh * 128) : (hh < 20) ? (C_KB + (hh - 4) * 128) : (hh < 36) ? (C_QA + (hh - 20) * 128) : (C_QB + (hh - 36) * 128);
        bf16* p = PX + (size_t)(b * RPB + CTX + t) * INC + col + ch * 8;
        const v4u x1 = *(const v4u*)p, x2 = *(const v4u*)(p + 64);
        const f32x4 c0 = *(const f32x4*)(ct + t * 64 + ch * 8), c1 = *(const f32x4*)(ct + t * 64 + ch * 8 + 4);
        const f32x4 s0 = *(const f32x4*)(st + t * 64 + ch * 8), s1 = *(const f32x4*)(st + t * 64 + ch * 8 + 4);
        v4u y1, y2;
#define ROPE2(W, CA, SA, CB, SB) { const float a0 = bflo(x1.W), a1 = bfhi(x1.W), b0 = bflo(x2.W), b1 = bfhi(x2.W); \
            y1.W = pk2(a0 * CA - b0 * SA, a1 * CB - b1 * SB); y2.W = pk2(b0 * CA + a0 * SA, b1 * CB + a1 * SB); }
        ROPE2(x, c0.x, s0.x, c0.y, s0.y) ROPE2(y, c0.z, s0.z, c0.w, s0.w) ROPE2(z, c1.x, s1.x, c1.y, s1.y) ROPE2(w, c1.z, s1.z, c1.w, s1.w)
#undef ROPE2
        *(v4u*)p = y1; *(v4u*)(p + 64) = y2;
    }
}

__device__ __forceinline__ void ph_convert_win(Frame& F, int l) {
    FRESH_IDS
    LAS float* scr = (LAS float*)(F.lds + wave * 16384);
    constexpr int I_IN = (DM / 64) * (INC / 32);
    bf16* WinT = (bf16*)(F.ws + WS_WINT);
    GW_LOOP(it, I_IN) p0_transpose_item(F.w_in + (size_t)l * DM * INC, DM, INC, WinT, win_row_off(32 * (it % (INC / 32))), scr, it, lane);
}

__device__ __forceinline__ void ph_attn(Frame& F, int l, char* lds) {
    const att::bf16* PX = (const att::bf16*)(F.ws + WS_PX);
    att::bf16* OA = (att::bf16*)(F.ws + WS_S0);
    att::bf16* OB0 = (att::bf16*)(F.ws + WS_S0 + SLOT);
    const float NINF = -INFINITY;
    const int nB = 1024, nA = 1024, nC = (l == 0) ? 64 : 0;
    for (int u = F.vcu; u < nB + nA + nC; u += F.G) {
        if (u < nB) {
            const int hd = u >> 5, qb = u & 31, b = hd >> 4, h8 = (hd >> 1) & 7, m = hd & 1;
            const size_t qrow = (size_t)b * RPB + CTX + qb * 256, krow = (size_t)b * RPB;
            att::attn_body_v256(PX + qrow * INC + C_QB + (h8 * 2 + m) * 128, PX + krow * INC + C_KB + (h8 * 2 + m) * 128, PX + krow * INC + C_VB + h8 * 256,
                                OB0 + (size_t)m * (SLOT / 2) + qrow * DM + h8 * 256, RPB / 64, F.lds);
            __syncthreads();
        } else if (u < nB + nA) {
            const int v = u - nB, b = v >> 9, kvh = (v >> 7) & 3, qb = v & 127, q0 = qb * 64;
            const int lo = (q0 - 128 > 0) ? q0 - 128 : 0, he = (q0 + 192 < SEQ) ? q0 + 192 : SEQ, nloc = (he - lo) >> 6;
            const size_t qrow = (size_t)b * RPB + CTX + q0, krow = (size_t)b * RPB;
            att::attn_body_a(PX + qrow * INC + C_QA + kvh * 512, PX + krow * INC + C_KA + kvh * 128, PX + krow * INC + C_VA + kvh * 128,
                             OA + qrow * DM + kvh * 512, 4 + nloc, 4, lo, q0, F.sink + l * 16 + kvh * 4, F.lds);
            __syncthreads();
        } else {
            const int v = u - nB - nA;
            if (v < 32) {
                const int hd = v, b = hd >> 4, h8 = (hd >> 1) & 7, m = hd & 1; const size_t krow = (size_t)b * RPB;
                att::attn_body_v256(PX + krow * INC + C_QB + (h8 * 2 + m) * 128, PX + krow * INC + C_KB + (h8 * 2 + m) * 128, PX + krow * INC + C_VB + h8 * 256,
                                    OB0 + (size_t)m * (SLOT / 2) + krow * DM + h8 * 256, 4, F.lds);
                __syncthreads();
            } else {
                const int w = v - 32, b = w >> 4, kvh = (w >> 2) & 3, cb = w & 3; const size_t krow = (size_t)b * RPB, qrow = krow + cb * 64;
                att::attn_body_a(PX + qrow * INC + C_QA + kvh * 512, PX + krow * INC + C_KA + kvh * 128, PX + krow * INC + C_VA + kvh * 128,
                                 OA + qrow * DM + kvh * 512, 4, 4, 0, 0, F.sink + l * 16 + kvh * 4, F.lds);
                __syncthreads();
            }
        }
    }
}

__device__ __forceinline__ void ph_post(Frame& F, int l) {
    FRESH_IDS
    const bf16* PX = (const bf16*)(F.ws + WS_PX);
    const bf16* OA = (const bf16*)(F.ws + WS_S0); const bf16* OB0 = (const bf16*)(F.ws + WS_S0 + SLOT); const bf16* OB1 = (const bf16*)(F.ws + WS_S0 + 2 * SLOT);
    bf16* GA = (bf16*)(F.ws + WS_S0 + 3 * SLOT); bf16* GB = (bf16*)(F.ws + WS_S0 + 4 * SLOT);
    const float lam_init = 0.8f - 0.6f * expf(-0.3f * (float)l);
    const float* lq = F.lam_qk + (size_t)l * 512;
    const float d1 = wave_sum(lq[lane] * lq[128 + lane] + lq[64 + lane] * lq[192 + lane]);
    const float d2 = wave_sum(lq[256 + lane] * lq[384 + lane] + lq[320 + lane] * lq[448 + lane]);
    const float lam = expf(d1) - expf(d2) + lam_init;
    const f32x4 gs0 = ((const f32x4*)(F.g_subln + (size_t)l * 256))[2 * (lane & 31)] * (1.f - lam_init), gs1 = ((const f32x4*)(F.g_subln + (size_t)l * 256))[2 * (lane & 31) + 1] * (1.f - lam_init);
    GW_LOOP(row, MROWS) {
        if (l != 0 && (row % RPB) < CTX) continue;
        const size_t ro = (size_t)row * DM + 8 * lane, rp = (size_t)row * INC + 8 * lane;
        v4u oa[4], za[4], o0[4], o1[4], zb[4];
#pragma unroll
        for (int j = 0; j < 4; ++j) { oa[j] = *(const v4u*)(OA + ro + 512 * j); za[j] = *(const v4u*)(PX + rp + C_ZA + 512 * j);
            o0[j] = *(const v4u*)(OB0 + ro + 512 * j); o1[j] = *(const v4u*)(OB1 + ro + 512 * j); zb[j] = *(const v4u*)(PX + rp + C_ZB + 512 * j); }
#pragma unroll
        for (int j = 0; j < 4; ++j) { v4u o;
#define GA2(W) o.W = pk2(bflo(oa[j].W) * siluf(bflo(za[j].W)), bfhi(oa[j].W) * siluf(bfhi(za[j].W)));
            GA2(x) GA2(y) GA2(z) GA2(w)
#undef GA2
            *(v4u*)(GA + ro + 512 * j) = o; }
#pragma unroll
        for (int j = 0; j < 4; ++j) {
            f32x4 da, db;
            da.x = bflo(o0[j].x) - lam * bflo(o1[j].x); da.y = bfhi(o0[j].x) - lam * bfhi(o1[j].x); da.z = bflo(o0[j].y) - lam * bflo(o1[j].y); da.w = bfhi(o0[j].y) - lam * bfhi(o1[j].y);
            db.x = bflo(o0[j].z) - lam * bflo(o1[j].z); db.y = bfhi(o0[j].z) - lam * bfhi(o1[j].z); db.z = bflo(o0[j].w) - lam * bflo(o1[j].w); db.w = bfhi(o0[j].w) - lam * bfhi(o1[j].w);
            float ss = ((da.x * da.x + da.y * da.y) + (da.z * da.z + da.w * da.w)) + ((db.x * db.x + db.y * db.y) + (db.z * db.z + db.w * db.w));
#pragma unroll
            for (int o_ = 1; o_ < 32; o_ <<= 1) ss += __shfl_xor(ss, o_);
            const float rs = rsqrtf(ss * (1.f / 256.f) + EPS);
            const f32x4 ya = da * rs * gs0, yb = db * rs * gs1;
            v4u o; o.x = pk2(ya.x * siluf(bflo(zb[j].x)), ya.y * siluf(bfhi(zb[j].x))); o.y = pk2(ya.z * siluf(bflo(zb[j].y)), ya.w * siluf(bfhi(zb[j].y)));
            o.z = pk2(yb.x * siluf(bflo(zb[j].z)), yb.y * siluf(bfhi(zb[j].z))); o.w = pk2(yb.z * siluf(bflo(zb[j].w)), yb.w * siluf(bfhi(zb[j].w)));
            *(v4u*)(GB + ro + 512 * j) = o; }
    }
}

__device__ __forceinline__ void ph_merge(Frame& F, int l) {
    FRESH_IDS
    const bf16* PX = (const bf16*)(F.ws + WS_PX);
    const bf16* YA = (const bf16*)(F.ws + WS_S0); const bf16* YB = (const bf16*)(F.ws + WS_S0 + SLOT); bf16* MG = (bf16*)(F.ws + WS_S0 + 2 * SLOT);
    const unsigned total = (unsigned)MROWS * (DM / 8);
    for (unsigned i = (unsigned)(F.vcu * NWAVES * 64 + tid); i < total; i += (unsigned)(F.G * NWAVES * 64)) {
        const unsigned row = i >> 8, c = (i & 255) * 8;
        if (l != 0 && (row % RPB) < CTX) continue;
        const v4u ya = *(const v4u*)(YA + (size_t)row * DM + c), yb = *(const v4u*)(YB + (size_t)row * DM + c);
        const v4u ga = *(const v4u*)(PX + (size_t)row * INC + C_GA + c), gb = *(const v4u*)(PX + (size_t)row * INC + C_GB + c);
        v4u o;
#define MRG(W) o.W = pk2(sigmf(bflo(ga.W)) * bflo(ya.W) + sigmf(bflo(gb.W)) * bflo(yb.W), sigmf(bfhi(ga.W)) * bfhi(ya.W) + sigmf(bfhi(gb.W)) * bfhi(yb.W));
        MRG(x) MRG(y) MRG(z) MRG(w)
#undef MRG
        *(v4u*)(MG + (size_t)row * DM + c) = o;
    }
}

__device__ __forceinline__ void ph_res(Frame& F, int l, const float* xcur, const float* ctxcur) {
    FRESH_IDS
    const bf16* OX = (const bf16*)(F.ws + WS_S0 + 3 * SLOT);
    bf16* H = (bf16*)(F.ws + WS_S0);
    const float* gp = F.g_post + (size_t)l * DM;
    const bool nxt = (l + 1 < DEPTH);
    const float* gpn = F.g_pre + (size_t)(l + 1) * DM;
    GW_LOOP(row, MROWS) {
        const int b = row / RPB, rr = row % RPB; const float* src; float* dst; int v;
        if (rr < CTX) { if (!nxt) continue; src = ctxcur + (size_t)(b * CTX + rr) * DM; dst = nullptr; v = 2; }
        else { src = xcur + (size_t)(b * SEQ + rr - CTX) * DM; dst = F.out + (size_t)(b * SEQ + rr - CTX) * DM; v = b; }
        const float* gt = (const float*)(F.ws + WS_MOD) + (size_t)(l * 3 + v) * 6144 + 2 * DM;
        f32x4 ov[8]; float s = 0.f;
#pragma unroll
        for (int j = 0; j < 8; ++j) { const v2u w = *(const v2u*)(OX + (size_t)row * DM + 4 * (lane + 64 * j));
            ov[j] = (f32x4){bflo(w.x), bfhi(w.x), bflo(w.y), bfhi(w.y)}; s += (ov[j].x * ov[j].x + ov[j].y * ov[j].y) + (ov[j].z * ov[j].z + ov[j].w * ov[j].w); }
        const float rs = rsqrtf(wave_sum(s) * (1.f / DM) + EPS);
        float s2 = 0.f;
#pragma unroll
        for (int j = 0; j < 8; ++j) { const int q = lane + 64 * j;
            const f32x4 g = ((const f32x4*)gp)[q], gate = ((const f32x4*)gt)[q], xr = ((const f32x4*)src)[q];
            ov[j] = xr + gate * ((ov[j] * rs) * g);
            if (dst) ((f32x4*)dst)[q] = ov[j];
            s2 += (ov[j].x * ov[j].x + ov[j].y * ov[j].y) + (ov[j].z * ov[j].z + ov[j].w * ov[j].w); }
        if (nxt) {
            const float* md = (const float*)(F.ws + WS_MOD) + (size_t)((l + 1) * 3 + v) * 6144;
            const float rs2 = rsqrtf(wave_sum(s2) * (1.f / DM) + EPS);
#pragma unroll
            for (int j = 0; j < 8; ++j) { const int q = lane + 64 * j;
                const f32x4 g = ((const f32x4*)gpn)[q], sh = ((const f32x4*)md)[q], sc = ((const f32x4*)(md + DM))[q];
                const f32x4 y = (ov[j] * rs2) * g * (sc + 1.f) + sh;
                v2u o; o.x = pk2(y.x, y.y); o.y = pk2(y.z, y.w);
                *(v2u*)(H + (size_t)row * DM + 4 * q) = o; }
        }
    }
}

typedef short sg_bf16x8 __attribute__((ext_vector_type(8)));
template <bool DUAL>
__device__ __forceinline__ void small_ctx_gemm(Frame& F, const bf16* A0, const bf16* W0, const bf16* A1, const bf16* W1, const bf16* PXg, bf16* O) {
    FRESH_IDS
    const int fr = lane & 15, fq = lane >> 4, wc = wave & 3, wr = wave >> 2;
    for (int t = F.vcu; t < 8 * 32; t += F.G) {
        const int tr = t >> 5, tc = t & 31;
        const int c0 = tr * 64 + wr * 32, b = c0 >> 8;
        const size_t row0 = (size_t)b * RPB + (c0 & 255);
        const int col0 = tc * 64 + wc * 16;
        f32x4 acc[2][2] = {};
#pragma unroll
        for (int gsel = 0; gsel < (DUAL ? 2 : 1); ++gsel) {
            const bf16* Ap = (gsel ? A1 : A0) + (row0 + fr) * DM + 8 * fq;
            const bf16* Bp = (gsel ? W1 : W0) + (size_t)(col0 + fr) * DM + 8 * fq;
#pragma unroll 8
            for (int k = 0; k < DM; k += 32) {
                const sg_bf16x8 a0 = *(const sg_bf16x8*)(Ap + k), a1 = *(const sg_bf16x8*)(Ap + 16 * DM + k), bb = *(const sg_bf16x8*)(Bp + k);
                acc[gsel][0] = __builtin_amdgcn_mfma_f32_16x16x32_bf16(bb, a0, acc[gsel][0], 0, 0, 0);
                acc[gsel][1] = __builtin_amdgcn_mfma_f32_16x16x32_bf16(bb, a1, acc[gsel][1], 0, 0, 0);
            }
        }
#pragma unroll
        for (int rb = 0; rb < 2; ++rb) { const size_t row = row0 + rb * 16 + fr; const int col = col0 + 4 * fq;
            f32x4 v = acc[0][rb];
            if (DUAL) { const v2u ga = *(const v2u*)(PXg + row * INC + C_GA + col), gb = *(const v2u*)(PXg + row * INC + C_GB + col); const f32x4 w = acc[1][rb];
                v.x = sigmf(bflo(ga.x)) * v.x + sigmf(bflo(gb.x)) * w.x; v.y = sigmf(bfhi(ga.x)) * v.y + sigmf(bfhi(gb.x)) * w.y;
                v.z = sigmf(bflo(ga.y)) * v.z + sigmf(bflo(gb.y)) * w.z; v.w = sigmf(bfhi(ga.y)) * v.w + sigmf(bfhi(gb.y)) * w.w; }
            v2u o; o.x = pk2(v.x, v.y); o.y = pk2(v.z, v.w);
            *(v2u*)(O + row * DM + col) = o; }
    }
}

__device__ __forceinline__ void run_gemm_in(Frame& F, const bf16* A, const bf16* Bt, bf16* O) {
    pg8::Gemm g{A, Bt, MROWS, INC, DM}; pg8::RowSkipOrder S; S.init(INC, F.G, (int)blockIdx.x, false);
    pg8::EpiRope E{O, INC, (const float*)(F.ws + WS_COS), (const float*)(F.ws + WS_SIN)};
    pg8::gemm_phase<pg8::EpiRope, pg8::RowSkipOrder, true, true>(F.lds, g, S, E);
}
__device__ __forceinline__ void run_gemm_skip(Frame& F, const bf16* A, const bf16* Bt, bf16* O, bool skip) {
    pg8::Gemm g{A, Bt, MROWS, DM, DM}; pg8::RowSkipOrder S; S.init(DM, F.G, (int)blockIdx.x, skip);
    pg8::EpiBf16 E{O, DM};
    pg8::gemm_phase<pg8::EpiBf16, pg8::RowSkipOrder, true, true>(F.lds, g, S, E);
}
template <bool ADD>
__device__ __forceinline__ void run_gemm_gate(Frame& F, const bf16* A, const bf16* Bt, bf16* O, const bf16* T, const bf16* G, bool skip) {
    pg8::Gemm g{A, Bt, MROWS, DM, DM}; pg8::RowSkipOrder S; S.init(DM, F.G, (int)blockIdx.x, skip);
    pg8::EpiGate<ADD> E{O, T, G, DM, INC};
    pg8::gemm_phase<pg8::EpiGate<ADD>, pg8::RowSkipOrder, true, true>(F.lds, g, S, E);
}

struct Args { const float* in[15]; float* out; unsigned char* ws; };
__global__ void __launch_bounds__(NWAVES * 64, 2) fwd_mega(Args args) {
    extern __shared__ __attribute__((aligned(16))) unsigned char lds[];
    cg::grid_group grid = cg::this_grid();
    Frame F;
    F.lds = (LAS unsigned char*)lds;
    F.G = gridDim.x; { const int bx = blockIdx.x; F.vcu = (F.G % 8 == 0) ? (bx % 8) * (F.G / 8) + bx / 8 : bx; }
    F.x = args.in[0]; F.c = args.in[1]; F.ctx = args.in[2]; F.c_ctx = args.in[3]; F.w_ada = args.in[4]; F.b_ada = args.in[5]; F.g_pre = args.in[6]; F.g_post = args.in[7];
    F.w_in = args.in[8]; F.sink = args.in[9]; F.lam_qk = args.in[10]; F.g_subln = args.in[11]; F.w_pa = args.in[12]; F.w_pb = args.in[13]; F.w_out = args.in[14];
    F.out = args.out; F.ws = args.ws;
    volatile LAS unsigned* MISC = (volatile LAS unsigned*)(F.lds + 149504);
    if (threadIdx.x < 32) MISC[threadIdx.x] = 0u;
    __syncthreads();
    const XcdBarrier bar = xcd_barrier_post((unsigned*)(F.ws + WS_BAR), MISC + 8);
    bf16* WinT = (bf16*)(F.ws + WS_WINT); bf16* WpT = (bf16*)(F.ws + WS_WPT); bf16* PX = (bf16*)(F.ws + WS_PX);
    bf16* S0 = (bf16*)(F.ws + WS_S0); bf16* S1 = (bf16*)(F.ws + WS_S0 + SLOT); bf16* S2 = (bf16*)(F.ws + WS_S0 + 2 * SLOT); bf16* S3 = (bf16*)(F.ws + WS_S0 + 3 * SLOT); bf16* S4 = (bf16*)(F.ws + WS_S0 + 4 * SLOT);

    ph_prologue(F);
    grid.sync();
#pragma unroll 1
    for (int l = 0; l < DEPTH; ++l) {
        const float* xcur = (l == 0) ? F.x : F.out;
        const float* ctxcur = (l == 0) ? F.ctx : (const float*)(F.ws + WS_CTX1);
        if (l == 0) { ph_hnorm(F, l, xcur, ctxcur); xcd_barrier(bar); }
        run_gemm_in(F, S0, WinT, PX);
        xcd_barrier(bar);
        ph_attn(F, l, (char*)lds);
        xcd_barrier(bar);
        ph_post(F, l);
        if (l + 1 < DEPTH) ph_convert_win(F, l + 1);
        xcd_barrier(bar);
        run_gemm_gate<false>(F, S3, WpT + (size_t)(l * 3 + 0) * DM * DM, S0, S0, PX + C_GA, true);
        run_gemm_gate<true>(F, S4, WpT + (size_t)(l * 3 + 1) * DM * DM, S2, S0, PX + C_GB, true);
        if (l + 1 < DEPTH) small_ctx_gemm<true>(F, S3, WpT + (size_t)(l * 3 + 0) * DM * DM, S4, WpT + (size_t)(l * 3 + 1) * DM * DM, PX, S2);
        xcd_barrier(bar);
        run_gemm_skip(F, S2, WpT + (size_t)(l * 3 + 2) * DM * DM, S3, true);
        if (l + 1 < DEPTH) small_ctx_gemm<false>(F, S2, WpT + (size_t)(l * 3 + 2) * DM * DM, nullptr, nullptr, PX, S3);
        xcd_barrier(bar);
        ph_res(F, l, xcur, ctxcur);
        if (l + 1 < DEPTH) xcd_barrier(bar);
    }
}

extern "C" void kernel_launch(void* const* d_in, const int* in_sizes, int n_in, void* d_out, int out_size, void* d_ws, size_t ws_size, hipStream_t stream) {
    static int grid = 0;
    if (grid == 0) {
        if (n_in != 15 || out_size != NB * SEQ * DM || ws_size < WS_END) { fprintf(stderr, "kernel_launch: unexpected shapes: n_in %d out %d ws %zu (need %zu)\n", n_in, out_size, ws_size, (size_t)WS_END); grid = -1; return; }
        int dev = 0, cus = 0, per_cu = 0;
        if (hipGetDevice(&dev) != hipSuccess || hipDeviceGetAttribute(&cus, hipDeviceAttributeMultiprocessorCount, dev) != hipSuccess) { grid = -1; return; }
        if (hipFuncSetAttribute((const void*)fwd_mega, hipFuncAttributeMaxDynamicSharedMemorySize, LDS_BYTES) != hipSuccess) { fprintf(stderr, "kernel_launch: hipFuncSetAttribute failed\n"); grid = -1; return; }
        if (hipOccupancyMaxActiveBlocksPerMultiprocessor(&per_cu, (const void*)fwd_mega, NWAVES * 64, LDS_BYTES) != hipSuccess || per_cu < 1) { fprintf(stderr, "kernel_launch: occupancy query says %d\n", per_cu); per_cu = 1; }
        (void)hipGetLastError();
        grid = cus * per_cu;
    }
    if (grid < 0) return;
    if (hipMemsetAsync((char*)d_ws + WS_BAR, 0, WS_BAR_BYTES, stream) != hipSuccess) { fprintf(stderr, "kernel_launch: memset of the barrier words failed\n"); return; }
    Args a{};
    for (int i = 0; i < 15; ++i) a.in[i] = (const float*)d_in[i];
    a.out = (float*)d_out; a.ws = (unsigned char*)d_ws;
    void* kargs[] = {&a};
    hipError_t e = hipLaunchCooperativeKernel((const void*)fwd_mega, dim3(grid), dim3(NWAVES * 64), kargs, LDS_BYTES, stream);
    if (e != hipSuccess) fprintf(stderr, "kernel_launch: cooperative launch failed: %s (grid %d)\n", hipGetErrorString(e), grid);
}
```

```cpp
#include <hip/hip_runtime.h>
#include <hip/hip_bf16.h>
#include <hip/hip_cooperative_groups.h>
#include <cstdio>
#include <cstdint>
#include <cmath>
namespace cg = cooperative_groups;

constexpr int DM = 2048, NB = 2, SEQ = 8192, DEPTH = 2, CTX = 256;
constexpr int RPB = CTX + SEQ;
constexpr int MROWS = NB * RPB;
constexpr int INC = 17408;
constexpr int C_KA = 0, C_VA = 512, C_KB = 1024, C_VB = 3072, C_QA = 5120, C_ZA = 7168, C_QB = 9216, C_ZB = 11264, C_GA = 13312, C_GB = 15360;
constexpr float EPS = 1e-6f;

namespace pg8 {
#define PG8_LAS __attribute__((address_space(3)))
typedef unsigned short bf16_t;
typedef short bf16x8 __attribute__((ext_vector_type(8)));
typedef float f32x4 __attribute__((ext_vector_type(4)));
typedef unsigned u32x4 __attribute__((ext_vector_type(4)));
constexpr int BM = 256, BK = 64, HALF = 128, HTB = HALF * BK * 2  , STAGE_BYTES = 8 * HTB, NXCD = 8, WGM = 8;

__host__ __device__ __forceinline__ int lds_byte(int r, int c) { const int st = (r >> 4) * 2 + (c >> 5), rr = r & 15, cc = c & 31, ob = rr * 64 + cc * 2; return st * 1024 + (ob ^ (((ob >> 9) & 1) << 5)); }
__host__ __device__ __forceinline__ void stage_rc(int b, int& R, int& C) { const int st = b / 1024, sb = b % 1024, swz = sb ^ (((sb >> 9) & 1) << 5); R = (st >> 1) * 16 + swz / 64; C = (st & 1) * 32 + (swz % 64) / 2; }
__host__ __device__ __forceinline__ int perm32(int rho) { const int n = rho >> 4, i = rho & 15; return 8 * (i >> 2) + 4 * n + (i & 3); }

struct Unit { int pm, pn; };
struct Gemm { const bf16_t* A; const bf16_t* Bt; int M, N, K; };

struct StaticOrder {
    int nM, nN, nwg, G, c;
    __host__ __device__ void init(int M, int N, int G_, int c_) { nM = M / BM; nN = N / BM; nwg = nM * nN; G = G_; c = c_; }
    __host__ __device__ bool next(int i, Unit& u) const {
        const long L = (long)i * G + c; if (L >= nwg) return false;
        int wgid = (int)L; { const int q = nwg / NXCD, r = nwg % NXCD, xcd = wgid % NXCD, off = wgid / NXCD; wgid = (xcd < r ? xcd * (q + 1) : r * (q + 1) + (xcd - r) * q) + off; }
        const int nig = WGM * nN, gid = wgid / nig, fm = gid * WGM, gsz = (nM - fm) < WGM ? (nM - fm) : WGM;
        u.pm = fm + ((wgid % nig) % gsz); u.pn = (wgid % nig) / gsz; return true;
    }
    __device__ __forceinline__ void a_ready(const Unit&) const {}
    __device__ __forceinline__ void done(const Unit&) const {}
};

__device__ __forceinline__ unsigned cvt_pk_bf16(float lo, float hi) { unsigned r; asm volatile("v_cvt_pk_bf16_f32 %0, %1, %2" : "=v"(r) : "v"(lo), "v"(hi)); return r; }
typedef float f32x2 __attribute__((ext_vector_type(2)));

struct EpiBf16 {
    static constexpr bool PERM = true, AFTER_DRAIN = false;
    bf16_t* O; int ldc;
    __device__ __forceinline__ void operator()(const f32x4 (&acc)[2][2][4][2], const Unit& u, int wr, int wc, int fr, int fq) const {
        const int row0 = u.pm * BM + wr * 64 + fr; const int col0 = u.pn * BM + wc * 32 + 8 * fq;
#pragma unroll
        for (int ai = 0; ai < 2; ++ai)
#pragma unroll
            for (int m = 0; m < 4; ++m) { bf16_t* rowp = O + (size_t)(row0 + ai * HALF + m * 16) * ldc + col0;
#pragma unroll
                for (int bj = 0; bj < 2; ++bj) { const f32x4 v0 = acc[ai][bj][m][0], v1 = acc[ai][bj][m][1];
                    u32x4 w; w.x = cvt_pk_bf16(v0[0], v0[1]); w.y = cvt_pk_bf16(v0[2], v0[3]); w.z = cvt_pk_bf16(v1[0], v1[1]); w.w = cvt_pk_bf16(v1[2], v1[3]);
                    *(u32x4*)(rowp + bj * HALF) = w; } }
    }
};

__device__ __forceinline__ float sigm_(float x) { return 1.f / (1.f + __expf(-x)); }
__device__ __forceinline__ float blo_(unsigned w) { return __builtin_bit_cast(float, w << 16); }
__device__ __forceinline__ float bhi_(unsigned w) { return __builtin_bit_cast(float, w & 0xffff0000u); }
template <bool ADD> struct EpiGate {
    static constexpr bool PERM = true, AFTER_DRAIN = false;
    bf16_t* O; const bf16_t* T; const bf16_t* G; int ldc; int ldg;
    __device__ __forceinline__ void operator()(const f32x4 (&acc)[2][2][4][2], const Unit& u, int wr, int wc, int fr, int fq) const {
        const int row0 = u.pm * BM + wr * 64 + fr; const int col0 = u.pn * BM + wc * 32 + 8 * fq;
#pragma unroll
        for (int ai = 0; ai < 2; ++ai)
#pragma unroll
            for (int m = 0; m < 4; ++m) { const size_t row = (size_t)(row0 + ai * HALF + m * 16);
#pragma unroll
                for (int bj = 0; bj < 2; ++bj) { const f32x4 v0 = acc[ai][bj][m][0], v1 = acc[ai][bj][m][1];
                    const u32x4 g = *(const u32x4*)(G + row * ldg + col0 + bj * HALF);
                    float r0 = sigm_(blo_(g.x)) * v0[0], r1 = sigm_(bhi_(g.x)) * v0[1], r2 = sigm_(blo_(g.y)) * v0[2], r3 = sigm_(bhi_(g.y)) * v0[3];
                    float r4 = sigm_(blo_(g.z)) * v1[0], r5 = sigm_(bhi_(g.z)) * v1[1], r6 = sigm_(blo_(g.w)) * v1[2], r7 = sigm_(bhi_(g.w)) * v1[3];
                    if (ADD) { const u32x4 t = *(const u32x4*)(T + row * ldc + col0 + bj * HALF);
                        r0 += blo_(t.x); r1 += bhi_(t.x); r2 += blo_(t.y); r3 += bhi_(t.y); r4 += blo_(t.z); r5 += bhi_(t.z); r6 += blo_(t.w); r7 += bhi_(t.w); }
                    u32x4 w; w.x = cvt_pk_bf16(r0, r1); w.y = cvt_pk_bf16(r2, r3); w.z = cvt_pk_bf16(r4, r5); w.w = cvt_pk_bf16(r6, r7);
                    *(u32x4*)(O + row * ldc + col0 + bj * HALF) = w; } }
    }
};
struct RowSkipOrder {
    StaticOrder base; bool skip;
    __device__ void init(int N, int G_, int c_, bool skip_) { skip = skip_; base.init(skip_ ? 16384 : 16896, N, G_, c_); }
    __device__ bool next(int i, Unit& u) const { if (!base.next(i, u)) return false; if (skip) u.pm += 1 + (u.pm >= 32 ? 1 : 0); return true; }
    __device__ __forceinline__ void a_ready(const Unit&) const {}
    __device__ __forceinline__ void done(const Unit&) const {}
};

struct EpiRope {
    static constexpr bool PERM = true, AFTER_DRAIN = false;
    bf16_t* O; int ldc; const float* ct; const float* st;
    __device__ __forceinline__ void operator()(const f32x4 (&acc)[2][2][4][2], const Unit& u, int wr, int wc, int fr, int fq) const {
        const int pn = u.pn; const bool rope = pn < 2 || (pn >= 4 && pn < 12) || (pn >= 20 && pn < 28) || (pn >= 36 && pn < 44);
        const int row0 = u.pm * BM + wr * 64 + fr;
        if (!rope) {
            const int col0 = pn * BM + wc * 32 + 8 * fq;
#pragma unroll
            for (int ai = 0; ai < 2; ++ai)
#pragma unroll
                for (int m = 0; m < 4; ++m) { bf16_t* rowp = O + (size_t)(row0 + ai * HALF + m * 16) * ldc + col0;
#pragma unroll
                    for (int bj = 0; bj < 2; ++bj) { const f32x4 v0 = acc[ai][bj][m][0], v1 = acc[ai][bj][m][1];
                        u32x4 w; w.x = cvt_pk_bf16(v0[0], v0[1]); w.y = cvt_pk_bf16(v0[2], v0[3]); w.z = cvt_pk_bf16(v1[0], v1[1]); w.w = cvt_pk_bf16(v1[2], v1[3]);
                        *(u32x4*)(rowp + bj * HALF) = w; } }
            return;
        }
        const bool isctx = (u.pm == 0) || (u.pm == 33);
        const int i0 = 32 * (wc & 1) + 8 * fq, ocol = pn * BM + (wc >> 1) * 128 + i0;
        const int tbase = row0 - (u.pm >= 33 ? 8448 : 0) - 256;
        float invr[8];
#pragma unroll
        for (int e_ = 0; e_ < 8; ++e_) invr[e_] = __builtin_amdgcn_exp2f(-(float)(8 * fq + e_) * (13.287712379549449f / 32.f)) * 0.15915494309189535f;
#pragma unroll
        for (int ai = 0; ai < 2; ++ai)
#pragma unroll
            for (int m = 0; m < 4; ++m) { const int t = tbase + ai * HALF + m * 16;
                f32x4 c0 = {1.f, 1.f, 1.f, 1.f}, c1 = c0, s0 = {0.f, 0.f, 0.f, 0.f}, s1 = s0;
                if (!isctx) { const float pos = (float)((wc & 1) ? (t & 63) : (t >> 6));
#pragma unroll
                    for (int e_ = 0; e_ < 4; ++e_) { const float r0 = pos * invr[e_], r1 = pos * invr[4 + e_];
                        c0[e_] = __builtin_amdgcn_cosf(r0); s0[e_] = __builtin_amdgcn_sinf(r0); c1[e_] = __builtin_amdgcn_cosf(r1); s1[e_] = __builtin_amdgcn_sinf(r1); } }
                const f32x4 a0 = acc[ai][0][m][0], a1 = acc[ai][0][m][1], b0 = acc[ai][1][m][0], b1 = acc[ai][1][m][1];
                const f32x4 y0 = a0 * c0 - b0 * s0, y1 = a1 * c1 - b1 * s1, z0 = b0 * c0 + a0 * s0, z1 = b1 * c1 + a1 * s1;
                bf16_t* rowp = O + (size_t)(row0 + ai * HALF + m * 16) * ldc + ocol;
                u32x4 w; w.x = cvt_pk_bf16(y0[0], y0[1]); w.y = cvt_pk_bf16(y0[2], y0[3]); w.z = cvt_pk_bf16(y1[0], y1[1]); w.w = cvt_pk_bf16(y1[2], y1[3]);
                *(u32x4*)rowp = w;
                u32x4 x; x.x = cvt_pk_bf16(z0[0], z0[1]); x.y = cvt_pk_bf16(z0[2], z0[3]); x.z = cvt_pk_bf16(z1[0], z1[1]); x.w = cvt_pk_bf16(z1[2], z1[3]);
                *(u32x4*)(rowp + 64) = x; }
    }
};

template <class Epi, class Sched, bool ALIGN_EPI = false, bool SP2 = false>
__device__ __forceinline__ void gemm_phase(PG8_LAS unsigned char* lds, const Gemm g, const Sched& S, const Epi& E) {
    int tid_ = threadIdx.x; asm volatile("" : "+v"(tid_));
    const int tid = tid_, wid = __builtin_amdgcn_readfirstlane(tid >> 6), lane = tid & 63, wr = wid >> 2, wc = wid & 3, fr = lane & 15, fq = lane >> 4;
    const int K = g.K, nt = K / BK;
    unsigned voffA[2], voffB[2];
#pragma unroll
    for (int i = 0; i < 2; ++i) { int R, C; stage_rc(tid * 16 + i * 8192, R, C); const int Rb = Epi::PERM ? ((R & ~31) + perm32(R & 31)) : R;
        voffA[i] = (unsigned)(R * K + C) * 2u; voffB[i] = (unsigned)(Rb * K + C) * 2u; }
    const size_t kstep = (size_t)(BK * 2);
    const size_t hstep = (size_t)HALF * K * 2;
    const size_t tstep = 2 * hstep;
    const unsigned ldsw = (unsigned)wid * 1024u;
    const int aoff = lds_byte(wr * 64 + fr, fq * 8), boff = lds_byte(wc * 32 + fr, fq * 8);
#define PG8_SA(b, h) (((b) * 2 + (h)) * HTB)
#define PG8_SB(b, h) ((4 + (b) * 2 + (h)) * HTB)
#define PG8_STAGE(bufoff, gbase, voff) do { _Pragma("unroll") for (int _i = 0; _i < 2; ++_i) \
        __builtin_amdgcn_global_load_lds((const unsigned*)((const char*)(gbase) + (voff)[_i]), (PG8_LAS unsigned*)(lds + (bufoff) + ldsw + _i * 8192), 16, 0, 0); } while (0)
#define PG8_LDA(dst, b, h) do { _Pragma("unroll") for (int m = 0; m < 4; ++m) _Pragma("unroll") for (int k = 0; k < 2; ++k) dst[m][k] = *(const PG8_LAS bf16x8*)(lds + PG8_SA(b, h) + aoff + m * 2048 + k * 1024); } while (0)
#define PG8_LDB(dst, b, h) do { _Pragma("unroll") for (int n = 0; n < 2; ++n) _Pragma("unroll") for (int k = 0; k < 2; ++k) dst[n][k] = *(const PG8_LAS bf16x8*)(lds + PG8_SB(b, h) + boff + n * 2048 + k * 1024); } while (0)
#define PG8_MMA(ai, bj, At, Bt) do { __builtin_amdgcn_s_setprio(1); _Pragma("unroll") for (int m = 0; m < 4; ++m) _Pragma("unroll") for (int n = 0; n < 2; ++n) _Pragma("unroll") for (int k = 0; k < 2; ++k) \
        acc[ai][bj][m][n] = __builtin_amdgcn_mfma_f32_16x16x32_bf16(Bt[n][k], At[m][k], acc[ai][bj][m][n], 0, 0, 0); __builtin_amdgcn_s_setprio(0); } while (0)
#define PG8_WAIT_V(n) asm volatile("s_waitcnt vmcnt(" #n ")" ::: "memory")
#define PG8_WAIT_L(n) asm volatile("s_waitcnt lgkmcnt(" #n ")" ::: "memory")
#define PG8_BAR __builtin_amdgcn_s_barrier()
#define PG8_SCHED __builtin_amdgcn_sched_barrier(0)
    Unit cur, nxt; int ui = 0;
    if (!S.next(0, cur)) return;
    f32x4 acc[2][2][4][2];
#pragma unroll
    for (int a = 0; a < 2; ++a)
#pragma unroll
        for (int b = 0; b < 2; ++b)
#pragma unroll
            for (int m = 0; m < 4; ++m)
#pragma unroll
                for (int n = 0; n < 2; ++n) acc[a][b][m][n] = (f32x4){0.f, 0.f, 0.f, 0.f};
    bf16x8 At[4][2], B0[2][2], B1[2][2];
    const char* cA = (const char*)g.A + (size_t)cur.pm * tstep; const char* cB = (const char*)g.Bt + (size_t)cur.pn * tstep;
    S.a_ready(cur);
    if constexpr (SP2) {
        PG8_STAGE(PG8_SB(0, 0), cB, voffB); PG8_STAGE(PG8_SB(0, 1), cB + hstep, voffB); PG8_STAGE(PG8_SA(0, 0), cA, voffA); PG8_STAGE(PG8_SA(0, 1), cA + hstep, voffA);
        if (wr == 1) PG8_BAR;
        PG8_WAIT_V(2); PG8_BAR;
        PG8_STAGE(PG8_SB(1, 0), cB + kstep, voffB); PG8_STAGE(PG8_SA(1, 0), cA + kstep, voffA); PG8_STAGE(PG8_SB(1, 1), cB + hstep + kstep, voffB);
        PG8_WAIT_V(6); PG8_BAR;
    } else {
        PG8_STAGE(PG8_SB(0, 0), cB, voffB); PG8_STAGE(PG8_SA(0, 0), cA, voffA); PG8_STAGE(PG8_SB(0, 1), cB + hstep, voffB); PG8_STAGE(PG8_SA(0, 1), cA + hstep, voffA);
        if (wr == 1) PG8_BAR;
        PG8_WAIT_V(4); PG8_BAR;
        PG8_STAGE(PG8_SB(1, 0), cB + kstep, voffB); PG8_STAGE(PG8_SA(1, 0), cA + kstep, voffA); PG8_STAGE(PG8_SB(1, 1), cB + hstep + kstep, voffB);
        PG8_WAIT_V(6); PG8_BAR;
    }
    for (;;) {
        const bool has_next = S.next(ui + 1, nxt);
        const char* nA = has_next ? (const char*)g.A + (size_t)nxt.pm * tstep : cA; const char* nB = has_next ? (const char*)g.Bt + (size_t)nxt.pn * tstep : cB;
        for (int t = 0; t < nt; t += 2) {
            const bool last = (t == nt - 2);
            const char* a1 = cA + (size_t)(t + 1) * kstep;
            const char* a2 = last ? nA : cA + (size_t)(t + 2) * kstep; const char* b2 = last ? nB : cB + (size_t)(t + 2) * kstep;
            const char* a3 = a2 + kstep; const char* b3 = b2 + kstep;
            if (last && has_next) S.a_ready(nxt);
            if constexpr (SP2) {
            PG8_LDB(B0, 0, 0); PG8_LDB(B1, 0, 1); PG8_SCHED; PG8_LDA(At, 0, 0); PG8_STAGE(PG8_SA(1, 1), a1 + hstep, voffA);
            PG8_WAIT_V(8); PG8_WAIT_L(0); PG8_BAR; PG8_MMA(0, 0, At, B0); PG8_MMA(0, 1, At, B1); PG8_BAR; PG8_SCHED;
            PG8_LDA(At, 0, 1); PG8_STAGE(PG8_SB(0, 0), b2, voffB); PG8_STAGE(PG8_SB(0, 1), b2 + hstep, voffB); PG8_STAGE(PG8_SA(0, 0), a2, voffA);
            PG8_WAIT_V(8); PG8_WAIT_L(0); PG8_BAR; PG8_MMA(1, 0, At, B0); PG8_MMA(1, 1, At, B1); PG8_BAR; PG8_SCHED;
            PG8_LDB(B0, 1, 0); PG8_LDB(B1, 1, 1); PG8_SCHED; PG8_LDA(At, 1, 0); PG8_STAGE(PG8_SA(0, 1), a2 + hstep, voffA);
            PG8_WAIT_V(8); PG8_WAIT_L(0); PG8_BAR; PG8_MMA(0, 0, At, B0); PG8_MMA(0, 1, At, B1); PG8_BAR; PG8_SCHED;
            PG8_LDA(At, 1, 1); PG8_STAGE(PG8_SB(1, 0), b3, voffB); PG8_STAGE(PG8_SB(1, 1), b3 + hstep, voffB); PG8_STAGE(PG8_SA(1, 0), a3, voffA);
            PG8_WAIT_V(8); PG8_WAIT_L(0); PG8_BAR; PG8_MMA(1, 0, At, B0); PG8_MMA(1, 1, At, B1); PG8_BAR; PG8_SCHED;
            } else {
            PG8_LDB(B0, 0, 0); PG8_SCHED; PG8_LDA(At, 0, 0); PG8_STAGE(PG8_SA(1, 1), a1 + hstep, voffA);
            PG8_WAIT_L(8); PG8_BAR; PG8_WAIT_L(0); PG8_MMA(0, 0, At, B0); PG8_BAR; PG8_SCHED;
            PG8_LDB(B1, 0, 1); PG8_STAGE(PG8_SB(0, 0), b2, voffB);
            PG8_BAR; PG8_WAIT_L(0); PG8_MMA(0, 1, At, B1); PG8_BAR;
            PG8_LDA(At, 0, 1); PG8_STAGE(PG8_SA(0, 0), a2, voffA);
            PG8_BAR; PG8_WAIT_L(0); PG8_MMA(1, 0, At, B0); PG8_BAR; PG8_SCHED;
            PG8_STAGE(PG8_SB(0, 1), b2 + hstep, voffB);
            PG8_WAIT_V(6); PG8_BAR; PG8_MMA(1, 1, At, B1); PG8_BAR;
            PG8_LDB(B0, 1, 0); PG8_SCHED; PG8_LDA(At, 1, 0); PG8_STAGE(PG8_SA(0, 1), a2 + hstep, voffA);
            PG8_WAIT_L(8); PG8_BAR; PG8_WAIT_L(0); PG8_MMA(0, 0, At, B0); PG8_BAR; PG8_SCHED;
            PG8_LDB(B1, 1, 1); PG8_STAGE(PG8_SB(1, 0), b3, voffB);
            PG8_BAR; PG8_WAIT_L(0); PG8_MMA(0, 1, At, B1); PG8_BAR;
            PG8_LDA(At, 1, 1); PG8_STAGE(PG8_SA(1, 0), a3, voffA);
            PG8_BAR; PG8_WAIT_L(0); PG8_MMA(1, 0, At, B0); PG8_BAR; PG8_SCHED;
            PG8_STAGE(PG8_SB(1, 1), b3 + hstep, voffB);
            PG8_WAIT_V(6); PG8_BAR; PG8_MMA(1, 1, At, B1); PG8_BAR;
            }
        }
        if constexpr (ALIGN_EPI) { if (wr == 0) PG8_BAR; }
        if constexpr (!Epi::AFTER_DRAIN) { E(acc, cur, wr, wc, fr, fq); S.done(cur); }
        if (!has_next) break;
#pragma unroll
        for (int a = 0; a < 2; ++a)
#pragma unroll
            for (int b = 0; b < 2; ++b)
#pragma unroll
                for (int m = 0; m < 4; ++m)
#pragma unroll
                    for (int n = 0; n < 2; ++n) acc[a][b][m][n] = (f32x4){0.f, 0.f, 0.f, 0.f};
        cur = nxt; cA = nA; cB = nB; ++ui;
        if constexpr (ALIGN_EPI) { if (wr == 1) PG8_BAR; }
    }
    PG8_WAIT_V(0);
    if constexpr (!ALIGN_EPI) { if (wr == 0) PG8_BAR; }
    PG8_BAR;
    if constexpr (Epi::AFTER_DRAIN) { E.fused(acc, cur, wr, wc, fr, fq, lds, wid, lane); S.done(cur); }
#undef PG8_SA
#undef PG8_SB
#undef PG8_STAGE
#undef PG8_LDA
#undef PG8_LDB
#undef PG8_MMA
#undef PG8_WAIT_V
#undef PG8_WAIT_L
#undef PG8_BAR
#undef PG8_SCHED
}
}

namespace att {
using bf16 = unsigned short;
constexpr int D = 128, NW = 8, QBLK = 32, KVBLK = 64;
constexpr float SCALE = 0.088388347648318440f;
constexpr float THR = 8.f;
constexpr int SDEPTH = 2;
constexpr int LDQ = INC, LDK = INC, LDO = DM;
constexpr size_t SHM_V = KVBLK * D * 2, SHM_K = KVBLK * D * 2, SHM_ATTN = 2 * SHM_V + 2 * SHM_K + NW * 64 * 4;

using bf16x8 = __attribute__((ext_vector_type(8))) short;
using s16x4  = __attribute__((ext_vector_type(4))) short;
using f32x16 = __attribute__((ext_vector_type(16))) float;
using f32x8  = __attribute__((ext_vector_type(8))) float;
using u32x4  = __attribute__((ext_vector_type(4))) unsigned;
#define KSWZ(row, colB) ((row) * 256 + ((colB) ^ (((row) & 7) << 4)))
#define SBAR() __builtin_amdgcn_sched_barrier(0)
__device__ __forceinline__ int crow(int r, int hi) { return (r & 3) + 8 * (r >> 2) + 4 * hi; }
__device__ __forceinline__ unsigned cvtpk(float lo, float hi) {
  unsigned r; asm volatile("v_cvt_pk_bf16_f32 %0, %1, %2" : "=v"(r) : "v"(lo), "v"(hi)); return r;
}
template <typename TIn> struct Stage;
template <> struct Stage<bf16>  { using T = bf16x8;
  __device__ static __forceinline__ T ld8(const bf16* p) { return *reinterpret_cast<const bf16x8*>(p); }
  __device__ static __forceinline__ bf16x8 tobf(T x) { return x; } };
template <> struct Stage<float> { using T = f32x8;
  __device__ static __forceinline__ T ld8(const float* p) { return *reinterpret_cast<const f32x8*>(p); }
  __device__ static __forceinline__ bf16x8 tobf(T x) {
    u32x4 w = {cvtpk(x[0], x[1]), cvtpk(x[2], x[3]), cvtpk(x[4], x[5]), cvtpk(x[6], x[7])}; return *reinterpret_cast<bf16x8*>(&w); } };

__device__ __forceinline__ void partialSM(f32x16& p0, f32x16& p1, float& m_reg, float& mn, float& alpha) {
  constexpr float C = SCALE * 1.4426950408889634f;
  float pmax = p0[0]; for (int r = 1; r < 16; ++r) pmax = fmaxf(pmax, p0[r]); for (int r = 0; r < 16; ++r) pmax = fmaxf(pmax, p1[r]);
  { auto rr = __builtin_amdgcn_permlane32_swap(__float_as_uint(pmax), __float_as_uint(pmax), false, false);
    pmax = fmaxf(__uint_as_float(rr[0]), __uint_as_float(rr[1])); }
  if (__builtin_expect(__all(pmax - m_reg <= THR / SCALE), 1)) { mn = m_reg; alpha = 1.f; }
  else { mn = fmaxf(m_reg, pmax); alpha = __builtin_amdgcn_exp2f((m_reg - mn) * C); m_reg = mn; }
  float mnC = -mn * C;
  for (int r = 0; r < 16; ++r) p0[r] = fmaf(p0[r], C, mnC); for (int r = 0; r < 16; ++r) p1[r] = fmaf(p1[r], C, mnC);
  for (int r = 0; r < 16; ++r) p0[r] = __builtin_amdgcn_exp2f(p0[r]);
}
__device__ __forceinline__ void finishSM(f32x16& p0, f32x16& p1, float alpha, float& l_reg, bf16x8& pa0, bf16x8& pa1, bf16x8& pa2, bf16x8& pa3) {
  for (int r = 0; r < 16; ++r) p1[r] = __builtin_amdgcn_exp2f(p1[r]);
  float ps = 0; for (int r = 0; r < 16; ++r) ps += p0[r]; for (int r = 0; r < 16; ++r) ps += p1[r];
  { auto rr = __builtin_amdgcn_permlane32_swap(__float_as_uint(ps), __float_as_uint(ps), false, false);
    ps = __uint_as_float(rr[0]) + __uint_as_float(rr[1]); }
  l_reg = l_reg * alpha + ps;
#define PK4(P, BASE, OUT) do { unsigned a0 = cvtpk(P[BASE + 0], P[BASE + 1]), a1 = cvtpk(P[BASE + 2], P[BASE + 3]);   \
    unsigned b0 = cvtpk(P[BASE + 4], P[BASE + 5]), b1 = cvtpk(P[BASE + 6], P[BASE + 7]);                              \
    auto r0 = __builtin_amdgcn_permlane32_swap(a0, b0, false, false); auto r1 = __builtin_amdgcn_permlane32_swap(a1, b1, false, false); \
    u32x4 w = {r0[0], r1[0], r0[1], r1[1]}; OUT = *reinterpret_cast<bf16x8*>(&w); } while (0)
  PK4(p0, 0, pa0); PK4(p0, 8, pa1); PK4(p1, 0, pa2); PK4(p1, 8, pa3);
#undef PK4
}
__device__ __forceinline__ void qkt(f32x16& p0, f32x16& p1, const bf16* Ks, const bf16x8* qr, int r32, int hi) {
  p0 = f32x16{}; p1 = f32x16{};
  for (int d0 = 0; d0 < 8; ++d0) { int cb = (d0 * 16 + hi * 8) * 2;
    bf16x8 b0 = *reinterpret_cast<const bf16x8*>((const char*)Ks + KSWZ(r32, cb));
    bf16x8 b1 = *reinterpret_cast<const bf16x8*>((const char*)Ks + KSWZ(32 + r32, cb));
    p0 = __builtin_amdgcn_mfma_f32_32x32x16_bf16(b0, qr[d0], p0, 0, 0, 0);
    p1 = __builtin_amdgcn_mfma_f32_32x32x16_bf16(b1, qr[d0], p1, 0, 0, 0); }
}
__device__ __forceinline__ int v_st(int k, int c) { const int kk = (k & ~0xC) | ((k & 4) << 1) | ((k & 8) >> 1); return ((kk >> 3) * 4 + (c >> 5)) * 512 + ((kk & 7) * 32 + (c & 31)) * 2; }
__device__ __forceinline__ int v_rd_base(int lane) { return ((lane & 3) << 3) | (((lane >> 2) & 3) << 6) | (((lane >> 4) & 1) << 5) | (((lane >> 5) & 1) << 8); }
constexpr int v_rd_off(int d0, int ks, int half) { return d0 * 512 + ks * 4096 + half * 2048; }
template <int OFF> __device__ __forceinline__ s16x4 tr_read(int vb) {
  s16x4 r; asm volatile("ds_read_b64_tr_b16 %0, %1 offset:%2" : "=&v"(r) : "v"(vb), "i"(OFF) : "memory"); return r;
}
template <int D0> __device__ __forceinline__ void pv_one(f32x16& od, int vb, bf16x8 pa0, bf16x8 pa1, bf16x8 pa2, bf16x8 pa3) {
  const s16x4 l0 = tr_read<v_rd_off(D0, 0, 0)>(vb), h0 = tr_read<v_rd_off(D0, 0, 1)>(vb), l1 = tr_read<v_rd_off(D0, 1, 0)>(vb), h1 = tr_read<v_rd_off(D0, 1, 1)>(vb);
  const s16x4 l2 = tr_read<v_rd_off(D0, 2, 0)>(vb), h2 = tr_read<v_rd_off(D0, 2, 1)>(vb), l3 = tr_read<v_rd_off(D0, 3, 0)>(vb), h3 = tr_read<v_rd_off(D0, 3, 1)>(vb);
  asm volatile("s_waitcnt lgkmcnt(0)" ::: "memory"); SBAR();
#define PK(L, H) (bf16x8){L[0], L[1], L[2], L[3], H[0], H[1], H[2], H[3]}
  od = __builtin_amdgcn_mfma_f32_32x32x16_bf16(pa0, PK(l0, h0), od, 0, 0, 0);
  od = __builtin_amdgcn_mfma_f32_32x32x16_bf16(pa1, PK(l1, h1), od, 0, 0, 0);
  od = __builtin_amdgcn_mfma_f32_32x32x16_bf16(pa2, PK(l2, h2), od, 0, 0, 0);
  od = __builtin_amdgcn_mfma_f32_32x32x16_bf16(pa3, PK(l3, h3), od, 0, 0, 0);
#undef PK
}
__device__ __forceinline__ void pv_d0(f32x16* o, int vb, bf16x8 pa0, bf16x8 pa1, bf16x8 pa2, bf16x8 pa3) {
  pv_one<0>(o[0], vb, pa0, pa1, pa2, pa3); pv_one<1>(o[1], vb, pa0, pa1, pa2, pa3); pv_one<2>(o[2], vb, pa0, pa1, pa2, pa3); pv_one<3>(o[3], vb, pa0, pa1, pa2, pa3);
}

__device__ __forceinline__ void band_mask(f32x16& p0, f32x16& p1, int dq  , int hi) {
#pragma unroll
  for (int r = 0; r < 16; ++r) { const int d = dq - crow(r, hi);
    if ((unsigned)(d + 128) > 256u) p0[r] = -1e30f;
    if ((unsigned)(d + 96) > 256u) p1[r] = -1e30f; }
}
template <bool MASK>
__device__ __forceinline__ void attn_body(const bf16* __restrict__ Qb, const bf16* __restrict__ Kh, const bf16* __restrict__ Vh,
                                          bf16* __restrict__ Ob, int NT, int NCT, int lo, int qpos0, float sinkl2, char* lds) {
  using St = Stage<bf16>;
  int tid_ = threadIdx.x; asm volatile("" : "+v"(tid_));
  const int tid = tid_, wid = tid >> 6, lane = tid & 63, r32 = lane & 31, hi = lane >> 5;
  bf16* V_lds = (bf16*)lds; bf16* K_lds = (bf16*)(lds + 2 * SHM_V);
  float* ws = (float*)(lds + 2 * SHM_V + 2 * SHM_K) + wid * 64; float* li_l = ws; float* al_l = ws + 32;
  float m_reg = -1e30f, l_reg = 0; f32x16 o[4] = {}; bf16x8 qr[8];
  const bf16* Qw = Qb + (long)(wid * QBLK + r32) * LDQ + hi * 8;
#pragma unroll
  for (int d0 = 0; d0 < 8; ++d0) qr[d0] = St::ld8(Qw + d0 * 16);
  const int sr = tid >> 4, sc = (tid & 15) * 8, vst0 = v_st(sr, sc), vst1 = v_st(32 + sr, sc);
  const int vb0 = (int)(uintptr_t)V_lds + v_rd_base(lane);
  const int qi = qpos0 + wid * QBLK + r32;
  struct { typename St::T vs0, vs1, ks0, ks1; } sr_[SDEPTH];
#define TROW(j) (64 * (j) + ((j) >= NCT ? lo : 0))
#define SLOAD(i, k0) do { const long k0_ = (k0); sr_[i].vs0 = St::ld8(&Vh[(k0_ + sr) * LDK + sc]); sr_[i].vs1 = St::ld8(&Vh[(k0_ + 32 + sr) * LDK + sc]); \
    sr_[i].ks0 = St::ld8(&Kh[(k0_ + sr) * LDK + sc]); sr_[i].ks1 = St::ld8(&Kh[(k0_ + 32 + sr) * LDK + sc]); } while (0)
#define SWRITE(b, i) do { *(bf16x8*)((char*)V_lds + (b) * SHM_V + vst0) = St::tobf(sr_[i].vs0);          \
    *(bf16x8*)((char*)V_lds + (b) * SHM_V + vst1) = St::tobf(sr_[i].vs1); int kc = sc * 2;               \
    *(bf16x8*)((char*)K_lds + (b) * SHM_K + KSWZ(sr, kc)) = St::tobf(sr_[i].ks0);                       \
    *(bf16x8*)((char*)K_lds + (b) * SHM_K + KSWZ(32 + sr, kc)) = St::tobf(sr_[i].ks1); } while (0)
#define SWAIT() do { if constexpr (SDEPTH == 2) asm volatile("s_waitcnt vmcnt(4)" ::: "memory"); else asm volatile("s_waitcnt vmcnt(0)" ::: "memory"); } while (0)
#define RESC(a) do { if (__any((a) < 1.f)) { if (hi == 0) al_l[r32] = (a); asm volatile("s_waitcnt lgkmcnt(0)" ::: "memory"); \
    for (int d = 0; d < 4; ++d) for (int r = 0; r < 16; ++r) o[d][r] *= al_l[crow(r, hi)]; } } while (0)
#define AMASK(P0, P1, j) do { if constexpr (MASK) { if ((j) >= NCT) band_mask(P0, P1, qi - (lo + 64 * ((j) - NCT)), hi); } } while (0)
  f32x16 pA0, pA1, pB0, pB1; float mnA, mnB, alA, alB; bf16x8 pa0, pa1, pa2, pa3;
  constexpr int SE = 0, SO = SDEPTH - 1;
  SLOAD(SE, TROW(0)); asm volatile("s_waitcnt vmcnt(0)" ::: "memory"); SWRITE(0, SE); __syncthreads();
  qkt(pA0, pA1, K_lds, qr, r32, hi); AMASK(pA0, pA1, 0); partialSM(pA0, pA1, m_reg, mnA, alA);
  SLOAD(SO, TROW(1)); if constexpr (SDEPTH == 2) { if (2 < NT) SLOAD(SE, TROW(2)); }
  SWAIT(); SWRITE(1, SO); __syncthreads();
  for (int j = 1; j + 1 < NT; j += 2) {
    SBAR(); qkt(pB0, pB1, (bf16*)((char*)K_lds + SHM_K), qr, r32, hi); AMASK(pB0, pB1, j);
    finishSM(pA0, pA1, alA, l_reg, pa0, pa1, pa2, pa3); SBAR();
    SLOAD(SO, TROW(j + SDEPTH)); SBAR();
    pv_d0(o, vb0, pa0, pa1, pa2, pa3); partialSM(pB0, pB1, m_reg, mnB, alB);
    __syncthreads(); SWAIT(); SWRITE(0, SE);
    RESC(alB); __syncthreads();
    SBAR(); qkt(pA0, pA1, K_lds, qr, r32, hi); AMASK(pA0, pA1, j + 1);
    finishSM(pB0, pB1, alB, l_reg, pa0, pa1, pa2, pa3); SBAR();
    if (SDEPTH == 1 || j + 3 < NT) SLOAD(SE, TROW(j + 1 + SDEPTH)); SBAR();
    pv_d0(o, vb0 + (int)SHM_V, pa0, pa1, pa2, pa3); partialSM(pA0, pA1, m_reg, mnA, alA);
    __syncthreads(); SWAIT(); SWRITE(1, SO);
    RESC(alA); __syncthreads();
  }
  SBAR(); qkt(pB0, pB1, (bf16*)((char*)K_lds + SHM_K), qr, r32, hi); AMASK(pB0, pB1, NT - 1);
  finishSM(pA0, pA1, alA, l_reg, pa0, pa1, pa2, pa3); SBAR();
  pv_d0(o, vb0, pa0, pa1, pa2, pa3); partialSM(pB0, pB1, m_reg, mnB, alB);
  __syncthreads(); RESC(alB);
  finishSM(pB0, pB1, alB, l_reg, pa0, pa1, pa2, pa3); SBAR();
  pv_d0(o, vb0 + (int)SHM_V, pa0, pa1, pa2, pa3);
  l_reg += __builtin_amdgcn_exp2f(sinkl2 - m_reg * (SCALE * 1.4426950408889634f));
  if (hi == 0) li_l[r32] = l_reg; asm volatile("s_waitcnt lgkmcnt(0)" ::: "memory");
  float rli[16];
#pragma unroll
  for (int r = 0; r < 16; ++r) rli[r] = __builtin_amdgcn_rcpf(li_l[crow(r, hi)]);
  bf16* Ow = Ob + (long)(wid * QBLK) * LDO;
#pragma unroll
  for (int r = 0; r < 16; ++r) { int orow = crow(r, hi);
    for (int d0 = 0; d0 < 4; ++d0) { const float v = o[d0][r] * rli[r]; const unsigned u = __builtin_bit_cast(unsigned, v);
      Ow[(long)orow * LDO + d0 * 32 + r32] = (bf16)((u + 0x7fffu + ((u >> 16) & 1u)) >> 16); } }
  __syncthreads();
#undef TROW
#undef SLOAD
#undef SWRITE
#undef SWAIT
#undef RESC
#undef AMASK
}

template <int OFF> __device__ __forceinline__ bf16x8 k_read(int addr) { bf16x8 r; asm volatile("ds_read_b128 %0, %1 offset:%2" : "=&v"(r) : "v"(addr), "i"(OFF) : "memory"); return r; }
__device__ __forceinline__ void qkt_pipe(f32x16& p0, f32x16& p1, const bf16* Ks, const bf16x8* qr, int r32, int hi) {
  p0 = f32x16{}; p1 = f32x16{};
  const int kb = (int)(uintptr_t)Ks + r32 * 256, sw = (r32 & 7) << 4;
  const int e0 = kb + ((0 * 32 + hi * 16) ^ sw), e1 = kb + ((1 * 32 + hi * 16) ^ sw), e2 = kb + ((2 * 32 + hi * 16) ^ sw), e3 = kb + ((3 * 32 + hi * 16) ^ sw);
  bf16x8 a0, a1, b0, b1;
#define LGK(n) do { asm volatile("s_waitcnt lgkmcnt(" #n ")" ::: "memory"); SBAR(); } while (0)
#define MM(A0, A1, d) do { p0 = __builtin_amdgcn_mfma_f32_32x32x16_bf16(A0, qr[d], p0, 0, 0, 0); p1 = __builtin_amdgcn_mfma_f32_32x32x16_bf16(A1, qr[d], p1, 0, 0, 0); SBAR(); } while (0)
  a0 = k_read<0>(e0); a1 = k_read<8192>(e0); b0 = k_read<0>(e1); b1 = k_read<8192>(e1);
  LGK(2); MM(a0, a1, 0); a0 = k_read<0>(e2); a1 = k_read<8192>(e2);
  LGK(2); MM(b0, b1, 1); b0 = k_read<0>(e3); b1 = k_read<8192>(e3);
  LGK(2); MM(a0, a1, 2); a0 = k_read<128>(e0); a1 = k_read<8320>(e0);
  LGK(2); MM(b0, b1, 3); b0 = k_read<128>(e1); b1 = k_read<8320>(e1);
  LGK(2); MM(a0, a1, 4); a0 = k_read<128>(e2); a1 = k_read<8320>(e2);
  LGK(2); MM(b0, b1, 5); b0 = k_read<128>(e3); b1 = k_read<8320>(e3);
  LGK(2); MM(a0, a1, 6);
  LGK(0); MM(b0, b1, 7);
#undef LGK
#undef MM
}
struct VFr { s16x4 l0, h0, l1, h1, l2, h2, l3, h3; };
template <int DB> __device__ __forceinline__ void pv_ld(VFr& f, int vb) {
  constexpr int I = (DB >> 2) * 16384, D0 = DB & 3;
  f.l0 = tr_read<I + v_rd_off(D0, 0, 0)>(vb); f.h0 = tr_read<I + v_rd_off(D0, 0, 1)>(vb); f.l1 = tr_read<I + v_rd_off(D0, 1, 0)>(vb); f.h1 = tr_read<I + v_rd_off(D0, 1, 1)>(vb);
  f.l2 = tr_read<I + v_rd_off(D0, 2, 0)>(vb); f.h2 = tr_read<I + v_rd_off(D0, 2, 1)>(vb); f.l3 = tr_read<I + v_rd_off(D0, 3, 0)>(vb); f.h3 = tr_read<I + v_rd_off(D0, 3, 1)>(vb);
}
__device__ __forceinline__ void pv_mm(f32x16& od, const VFr& f, bf16x8 pa0, bf16x8 pa1, bf16x8 pa2, bf16x8 pa3) {
#define PK(L, H) (bf16x8){L[0], L[1], L[2], L[3], H[0], H[1], H[2], H[3]}
  od = __builtin_amdgcn_mfma_f32_32x32x16_bf16(pa0, PK(f.l0, f.h0), od, 0, 0, 0);
  od = __builtin_amdgcn_mfma_f32_32x32x16_bf16(pa1, PK(f.l1, f.h1), od, 0, 0, 0);
  od = __builtin_amdgcn_mfma_f32_32x32x16_bf16(pa2, PK(f.l2, f.h2), od, 0, 0, 0);
  od = __builtin_amdgcn_mfma_f32_32x32x16_bf16(pa3, PK(f.l3, f.h3), od, 0, 0, 0);
#undef PK
}
__device__ __forceinline__ void pv_all(f32x16* o, int vb, bf16x8 pa0, bf16x8 pa1, bf16x8 pa2, bf16x8 pa3) {
  VFr fa, fb;
#define W8() do { asm volatile("s_waitcnt lgkmcnt(8)" ::: "memory"); SBAR(); } while (0)
#define W0() do { asm volatile("s_waitcnt lgkmcnt(0)" ::: "memory"); SBAR(); } while (0)
  pv_ld<0>(fa, vb);
  pv_ld<1>(fb, vb); W8(); pv_mm(o[0], fa, pa0, pa1, pa2, pa3); SBAR();
  pv_ld<2>(fa, vb); W8(); pv_mm(o[1], fb, pa0, pa1, pa2, pa3); SBAR();
  pv_ld<3>(fb, vb); W8(); pv_mm(o[2], fa, pa0, pa1, pa2, pa3); SBAR();
  pv_ld<4>(fa, vb); W8(); pv_mm(o[3], fb, pa0, pa1, pa2, pa3); SBAR();
  pv_ld<5>(fb, vb); W8(); pv_mm(o[4], fa, pa0, pa1, pa2, pa3); SBAR();
  pv_ld<6>(fa, vb); W8(); pv_mm(o[5], fb, pa0, pa1, pa2, pa3); SBAR();
  pv_ld<7>(fb, vb); W8(); pv_mm(o[6], fa, pa0, pa1, pa2, pa3); SBAR();
  W0(); pv_mm(o[7], fb, pa0, pa1, pa2, pa3);
#undef W8
#undef W0
}
#define ATT_LAS __attribute__((address_space(3)))
struct VH { s16x4 l0, h0, l1, h1; };
template <int DB, int KS> __device__ __forceinline__ void pv_ldh(VH& f, int vb) {
  constexpr int I = (DB >> 2) * 16384, D0 = DB & 3;
  f.l0 = tr_read<I + v_rd_off(D0, KS, 0)>(vb); f.h0 = tr_read<I + v_rd_off(D0, KS, 1)>(vb); f.l1 = tr_read<I + v_rd_off(D0, KS + 1, 0)>(vb); f.h1 = tr_read<I + v_rd_off(D0, KS + 1, 1)>(vb);
}
#define PKV(L, H) (bf16x8){L[0], L[1], L[2], L[3], H[0], H[1], H[2], H[3]}
#define PK4S(P, BASE, OUT) do { unsigned a0_ = cvtpk(P[BASE + 0], P[BASE + 1]), a1_ = cvtpk(P[BASE + 2], P[BASE + 3]);   \
    unsigned b0_ = cvtpk(P[BASE + 4], P[BASE + 5]), b1_ = cvtpk(P[BASE + 6], P[BASE + 7]);                              \
    auto r0_ = __builtin_amdgcn_permlane32_swap(a0_, b0_, false, false); auto r1_ = __builtin_amdgcn_permlane32_swap(a1_, b1_, false, false); \
    u32x4 w_ = {r0_[0], r1_[0], r0_[1], r1_[1]}; OUT = *reinterpret_cast<bf16x8*>(&w_); } while (0)
__device__ __forceinline__ void smpv_all(f32x16& p0, f32x16& p1, float alpha, float& l_reg, f32x16* o, int vb,
                                         const char* kb, const char* vbg, ATT_LAS unsigned char* kdst, ATT_LAS unsigned char* vdst, bool dma) {
  bf16x8 pa0, pa1, pa2, pa3; VH fa, fb; float s0 = 0.f, s1 = 0.f;
  PK4S(p0, 0, pa0); PK4S(p0, 8, pa1);
#define WL(n) do { asm volatile("s_waitcnt lgkmcnt(" #n ")" ::: "memory"); SBAR(); } while (0)
#define P1BLK(B, FC, FN, LAST) do { if (!(LAST)) pv_ldh<((B) + 1) & 7, 0>(FN, vb); if (LAST) WL(0); else WL(4); \
    o[B] = __builtin_amdgcn_mfma_f32_32x32x16_bf16(pa0, PKV(FC.l0, FC.h0), o[B], 0, 0, 0); \
    p1[2 * (B)] = __builtin_amdgcn_exp2f(p1[2 * (B)]); s0 += p0[2 * (B)]; s1 += p0[2 * (B) + 1]; SBAR(); \
    o[B] = __builtin_amdgcn_mfma_f32_32x32x16_bf16(pa1, PKV(FC.l1, FC.h1), o[B], 0, 0, 0); \
    p1[2 * (B) + 1] = __builtin_amdgcn_exp2f(p1[2 * (B) + 1]); if ((B) > 0) { s0 += p1[2 * (B) - 2]; s1 += p1[2 * (B) - 1]; } SBAR(); } while (0)
  pv_ldh<0, 0>(fa, vb);
  P1BLK(0, fa, fb, false); P1BLK(1, fb, fa, false); P1BLK(2, fa, fb, false); P1BLK(3, fb, fa, false);
  P1BLK(4, fa, fb, false); P1BLK(5, fb, fa, false); P1BLK(6, fa, fb, false); P1BLK(7, fb, fa, true);
  pv_ldh<0, 2>(fa, vb);
  s0 += p1[14]; s1 += p1[15];
  float ps = s0 + s1;
  { auto rr = __builtin_amdgcn_permlane32_swap(__float_as_uint(ps), __float_as_uint(ps), false, false); ps = __uint_as_float(rr[0]) + __uint_as_float(rr[1]); }
  l_reg = l_reg * alpha + ps;
  PK4S(p1, 0, pa2); PK4S(p1, 8, pa3); SBAR();
#define DMAP(B) do { if (dma) { if ((B) < 2) __builtin_amdgcn_global_load_lds((const unsigned*)(kb + (B) * (32 * LDK * 2)), (ATT_LAS unsigned*)(kdst + (B) * 8192), 16, 0, 0); \
      else if ((B) < 6) __builtin_amdgcn_global_load_lds((const unsigned*)(vbg + (((B) - 2) & 1) * (32 * LDK * 2) + (((B) - 2) >> 1) * 256), (ATT_LAS unsigned*)(vdst + ((B) - 2) * 8192), 16, 0, 0); } } while (0)
#define P2BLK(B, FC, FN, LAST) do { if (!(LAST)) pv_ldh<((B) + 1) & 7, 2>(FN, vb); if (LAST) WL(0); else WL(4); \
    o[B] = __builtin_amdgcn_mfma_f32_32x32x16_bf16(pa2, PKV(FC.l0, FC.h0), o[B], 0, 0, 0); DMAP(B); \
    o[B] = __builtin_amdgcn_mfma_f32_32x32x16_bf16(pa3, PKV(FC.l1, FC.h1), o[B], 0, 0, 0); SBAR(); } while (0)
  P2BLK(0, fa, fb, false); P2BLK(1, fb, fa, false); P2BLK(2, fa, fb, false); P2BLK(3, fb, fa, false);
  P2BLK(4, fa, fb, false); P2BLK(5, fb, fa, false); P2BLK(6, fa, fb, false); P2BLK(7, fb, fa, true);
#undef WL
#undef P1BLK
#undef P2BLK
#undef DMAP
}
#undef PKV
#undef PK4S
__device__ __forceinline__ void attn_body_v256(const bf16* __restrict__ Qb, const bf16* __restrict__ Kh, const bf16* __restrict__ Vh,
                                               bf16* __restrict__ Ob, int NT, ATT_LAS unsigned char* ldsl) {
  using St = Stage<bf16>;
  int tid_ = threadIdx.x; asm volatile("" : "+v"(tid_));
  const int tid = tid_, wid = __builtin_amdgcn_readfirstlane(tid >> 6), lane = tid & 63, r32 = lane & 31, hi = lane >> 5;
  char* lds = (char*)ldsl;
  float* ws = (float*)(lds + 147456) + wid * 64; float* li_l = ws; float* al_l = ws + 32;
  float m_reg = -1e30f, l_reg = 0; f32x16 o[8] = {}; bf16x8 qr[8];
  const bf16* Qw = Qb + (long)(wid * QBLK + r32) * LDQ + hi * 8;
#pragma unroll
  for (int d0 = 0; d0 < 8; ++d0) qr[d0] = St::ld8(Qw + d0 * 16);
  unsigned offK0, offV0;
  { const int row = wid * 4 + (lane >> 4), colB = ((lane & 15) * 16) ^ ((row & 7) << 4); offK0 = (unsigned)row * (LDK * 2) + (unsigned)colB;
    const int sub = wid * 2 + (lane >> 5), kkhi = sub >> 2, cblk = sub & 3, within = (lane & 31) * 16, kk = kkhi * 8 + (within >> 6);
    const int k = (kk & ~0xC) | ((kk & 4) << 1) | ((kk & 8) >> 1), c = cblk * 32 + ((within & 63) >> 1);
    offV0 = (unsigned)k * (LDK * 2) + (unsigned)c * 2; }
  const int vb0 = (int)(uintptr_t)lds + 16384 + v_rd_base(lane);
#define DMA_TILE(j, sbo) do { const char* kb_ = (const char*)Kh + (size_t)(j) * (64 * LDK * 2) + offK0; const char* vb_ = (const char*)Vh + (size_t)(j) * (64 * LDK * 2) + offV0; \
    _Pragma("unroll") for (int i_ = 0; i_ < 2; ++i_) __builtin_amdgcn_global_load_lds((const unsigned*)(kb_ + i_ * (32 * LDK * 2)), (ATT_LAS unsigned*)(ldsl + (sbo) + (i_ * 8 + wid) * 1024), 16, 0, 0); \
    _Pragma("unroll") for (int i_ = 0; i_ < 4; ++i_) __builtin_amdgcn_global_load_lds((const unsigned*)(vb_ + (i_ & 1) * (32 * LDK * 2) + (i_ >> 1) * 256), (ATT_LAS unsigned*)(ldsl + (sbo) + 16384 + (i_ * 8 + wid) * 1024), 16, 0, 0); } while (0)
#define RESC8(a) do { if (__any((a) < 1.f)) { if (hi == 0) al_l[r32] = (a); asm volatile("s_waitcnt lgkmcnt(0)" ::: "memory"); \
    for (int d = 0; d < 8; ++d) for (int r = 0; r < 16; ++r) o[d][r] *= al_l[crow(r, hi)]; } } while (0)
#define TILE_SYNC() do { asm volatile("s_waitcnt vmcnt(0)" ::: "memory"); __builtin_amdgcn_s_barrier(); asm volatile("" ::: "memory"); } while (0)
  f32x16 p0, p1; float mn, al;
#pragma unroll
  for (int d0 = 0; d0 < 8; ++d0) asm volatile("" : "+v"(qr[d0]));
  if (wid >= 4) __builtin_amdgcn_s_setprio(2);
  DMA_TILE(0, 0); DMA_TILE(1, 49152);
  int sb = 0, sb2 = 98304;
  for (int j = 0; j < NT; ++j) {
    if (j + 1 < NT) asm volatile("s_waitcnt vmcnt(6)" ::: "memory"); else asm volatile("s_waitcnt vmcnt(0)" ::: "memory");
    __builtin_amdgcn_s_barrier(); asm volatile("" ::: "memory");
    qkt_pipe(p0, p1, (const bf16*)(lds + sb), qr, r32, hi); partialSM(p0, p1, m_reg, mn, al); RESC8(al); SBAR();
    smpv_all(p0, p1, al, l_reg, o, vb0 + sb, (const char*)Kh + (size_t)(j + 2) * (64 * LDK * 2) + offK0, (const char*)Vh + (size_t)(j + 2) * (64 * LDK * 2) + offV0,
             ldsl + sb2 + wid * 1024, ldsl + sb2 + 16384 + wid * 1024, j + 2 < NT);
    sb = (sb == 98304) ? 0 : sb + 49152; sb2 = (sb2 == 98304) ? 0 : sb2 + 49152;
  }
  __builtin_amdgcn_s_setprio(0);
  if (hi == 0) li_l[r32] = l_reg; asm volatile("s_waitcnt lgkmcnt(0)" ::: "memory");
  float rli[16];
#pragma unroll
  for (int r = 0; r < 16; ++r) rli[r] = __builtin_amdgcn_rcpf(li_l[crow(r, hi)]);
  bf16* Ow = Ob + (long)(wid * QBLK) * LDO;
#pragma unroll
  for (int r = 0; r < 16; ++r) { int orow = crow(r, hi);
#pragma unroll
    for (int d0 = 0; d0 < 8; ++d0) { const float v = o[d0][r] * rli[r]; const unsigned u = __builtin_bit_cast(unsigned, v);
      Ow[(long)orow * LDO + d0 * 32 + r32] = (bf16)((u + 0x7fffu + ((u >> 16) & 1u)) >> 16); } }
#undef DMA_TILE
#undef RESC8
#undef TILE_SYNC
}
__device__ __forceinline__ void attn_body_a(const bf16* __restrict__ Qb, const bf16* __restrict__ Kh, const bf16* __restrict__ Vh, bf16* __restrict__ Ob,
                                            int NT, int NCT, int lo, int qpos0, const float* __restrict__ sk4, ATT_LAS unsigned char* ldsl) {
  using St = Stage<bf16>;
  int tid_ = threadIdx.x; asm volatile("" : "+v"(tid_));
  const int tid = tid_, wid = __builtin_amdgcn_readfirstlane(tid >> 6), lane = tid & 63, r32 = lane & 31, hi = lane >> 5;
  const int g = wid >> 1, rh = wid & 1;
  char* lds = (char*)ldsl;
  float* ws = (float*)(lds + 98304) + wid * 64; float* li_l = ws; float* al_l = ws + 32;
  float m_reg = -1e30f, l_reg = 0; f32x16 o[4] = {}; bf16x8 qr[8];
  const bf16* Qw = Qb + (long)(rh * QBLK + r32) * LDQ + g * 128 + hi * 8;
#pragma unroll
  for (int d0 = 0; d0 < 8; ++d0) qr[d0] = St::ld8(Qw + d0 * 16);
  const float sinkl2 = sk4[g] * 1.4426950408889634f;
  const int qi = qpos0 + rh * QBLK + r32;
  unsigned offK0, offV0;
  { const int row = wid * 4 + (lane >> 4), colB = ((lane & 15) * 16) ^ ((row & 7) << 4); offK0 = (unsigned)row * (LDK * 2) + (unsigned)colB;
    const int sub = wid * 2 + (lane >> 5), kkhi = sub >> 2, cblk = sub & 3, within = (lane & 31) * 16, kk = kkhi * 8 + (within >> 6);
    const int k = (kk & ~0xC) | ((kk & 4) << 1) | ((kk & 8) >> 1), c = cblk * 32 + ((within & 63) >> 1);
    offV0 = (unsigned)k * (LDK * 2) + (unsigned)c * 2; }
  const int vb0 = (int)(uintptr_t)lds + 16384 + v_rd_base(lane);
#define TROWA(j) (64 * (j) + ((j) >= NCT ? lo : 0))
#define DMA_TILE(j, sb) do { const size_t ro_ = (size_t)TROWA(j) * (LDK * 2); const char* kb_ = (const char*)Kh + ro_ + offK0; const char* vb_ = (const char*)Vh + ro_ + offV0; \
    _Pragma("unroll") for (int i_ = 0; i_ < 2; ++i_) { __builtin_amdgcn_global_load_lds((const unsigned*)(kb_ + i_ * (32 * LDK * 2)), (ATT_LAS unsigned*)(ldsl + (sb) + (i_ * 8 + wid) * 1024), 16, 0, 0); \
      __builtin_amdgcn_global_load_lds((const unsigned*)(vb_ + i_ * (32 * LDK * 2)), (ATT_LAS unsigned*)(ldsl + (sb) + 16384 + (i_ * 8 + wid) * 1024), 16, 0, 0); } } while (0)
#define RESC4(a) do { if (__any((a) < 1.f)) { if (hi == 0) al_l[r32] = (a); asm volatile("s_waitcnt lgkmcnt(0)" ::: "memory"); \
    for (int d = 0; d < 4; ++d) for (int r = 0; r < 16; ++r) o[d][r] *= al_l[crow(r, hi)]; } } while (0)
  f32x16 p0, p1; float mn, al; bf16x8 pa0, pa1, pa2, pa3;
#pragma unroll
  for (int d0 = 0; d0 < 8; ++d0) asm volatile("" : "+v"(qr[d0]));
  DMA_TILE(0, 0);
  int sb = 0;
  for (int j = 0; j < NT; ++j) {
    asm volatile("s_waitcnt vmcnt(0)" ::: "memory"); __builtin_amdgcn_s_barrier(); asm volatile("" ::: "memory");
    if (j + 1 < NT) DMA_TILE(j + 1, sb ^ 32768);
    qkt_pipe(p0, p1, (const bf16*)(lds + sb), qr, r32, hi);
    if (j >= NCT) band_mask(p0, p1, qi - (lo + 64 * (j - NCT)), hi);
    partialSM(p0, p1, m_reg, mn, al); RESC4(al); finishSM(p0, p1, al, l_reg, pa0, pa1, pa2, pa3); SBAR();
    pv_d0(o, vb0 + sb, pa0, pa1, pa2, pa3);
    sb ^= 32768;
  }
  l_reg += __builtin_amdgcn_exp2f(sinkl2 - m_reg * (SCALE * 1.4426950408889634f));
  if (hi == 0) li_l[r32] = l_reg; asm volatile("s_waitcnt lgkmcnt(0)" ::: "memory");
  float rli[16];
#pragma unroll
  for (int r = 0; r < 16; ++r) rli[r] = __builtin_amdgcn_rcpf(li_l[crow(r, hi)]);
  bf16* Ow = Ob + (long)(rh * QBLK) * LDO + g * 128;
#pragma unroll
  for (int r = 0; r < 16; ++r) { int orow = crow(r, hi);
#pragma unroll
    for (int d0 = 0; d0 < 4; ++d0) { const float v = o[d0][r] * rli[r]; const unsigned u = __builtin_bit_cast(unsigned, v);
      Ow[(long)orow * LDO + d0 * 32 + r32] = (bf16)((u + 0x7fffu + ((u >> 16) & 1u)) >> 16); } }
#undef TROWA
#undef DMA_TILE
#undef RESC4
}
}

constexpr size_t MiB = 1u << 20;
constexpr size_t SLOT = (size_t)MROWS * DM * 2;
constexpr size_t WS_MOD = 0;
constexpr size_t WS_BAR = 1 * MiB, WS_BAR_BYTES = 16384;
constexpr size_t WS_COS = 2 * MiB, WS_SIN = 4 * MiB;
constexpr size_t WS_CTX1 = 6 * MiB;
constexpr size_t WS_WINT = 16 * MiB;
constexpr size_t WS_WPT = WS_WINT + 68 * MiB;
constexpr size_t WS_PX = WS_WPT + 48 * MiB;
constexpr size_t WS_S0 = WS_PX + (size_t)MROWS * INC * 2;
constexpr size_t WS_END = WS_S0 + 5 * SLOT;
static_assert(WS_END <= 4ull * DEPTH * DM * INC * 4, "workspace map exceeds the guaranteed 4x largest tensor");

constexpr int NWAVES = 8;
constexpr int LDS_BYTES = 149760;

#define GAS __attribute__((address_space(1)))
#define LAS __attribute__((address_space(3)))
typedef unsigned short bf16;
typedef unsigned v4u __attribute__((ext_vector_type(4)));
typedef unsigned v2u __attribute__((ext_vector_type(2)));
typedef float f32x4 __attribute__((ext_vector_type(4)));
#define LDS_WAIT() asm volatile("s_waitcnt lgkmcnt(0)" ::: "memory")
__device__ __forceinline__ unsigned f2bf(float f) { unsigned u = __builtin_bit_cast(unsigned, f); return (u + 0x7fffu + ((u >> 16) & 1u)) >> 16; }
__device__ __forceinline__ unsigned pk2(float lo, float hi) { return f2bf(lo) | (f2bf(hi) << 16); }
__device__ __forceinline__ float bflo(unsigned w) { return __builtin_bit_cast(float, w << 16); }
__device__ __forceinline__ float bfhi(unsigned w) { return __builtin_bit_cast(float, w & 0xffff0000u); }
__device__ __forceinline__ float siluf(float x) { return x / (1.f + __expf(-x)); }
__device__ __forceinline__ float sigmf(float x) { return 1.f / (1.f + __expf(-x)); }

struct Frame {
    LAS unsigned char* lds;
    int vcu, G;
    const float *x, *c, *ctx, *c_ctx, *w_ada, *b_ada, *g_pre, *g_post, *w_in, *sink, *lam_qk, *g_subln, *w_pa, *w_pb, *w_out;
    float* out; unsigned char* ws;
};

#define XB_TMO      128
#define XB_XCNT(j)  (256  + 64 * (j))
#define XB_XSUB(j)  (1280 + 64 * (j))
#define XB_XGEN(j)  (2304 + 64 * (j))
#define XB_TOP      3328
#define XB_TOPGEN   3392
#define XCD_BAR_WORDS 3456
#define XB_SPIN_CAP (1u << 18)

__device__ __forceinline__ unsigned xb_ld(unsigned* p)              { return __hip_atomic_load(p, __ATOMIC_RELAXED, __HIP_MEMORY_SCOPE_AGENT); }
__device__ __forceinline__ unsigned xb_add(unsigned* p, unsigned v) { return __hip_atomic_fetch_add(p, v, __ATOMIC_RELAXED, __HIP_MEMORY_SCOPE_AGENT); }
__device__ __forceinline__ unsigned xb_xcc_id() { return (unsigned)__builtin_amdgcn_s_getreg((3 << 11) | 20) & 0xFu; }
#define XB_SPIN(cond, bar) do { unsigned _sp = 0; while (cond) { __builtin_amdgcn_s_sleep(1); \
    if ((++_sp & 255u) == 0u) { if (xb_ld(&(bar)[XB_TMO])) break; if (_sp > XB_SPIN_CAP) { atomicAdd(&(bar)[XB_TMO], 1u); break; } } } } while (0)

struct XcdBarrier {
    unsigned* bar; unsigned x;
    volatile LAS unsigned* st;
};

__device__ __forceinline__ XcdBarrier xcd_barrier_post(unsigned* bar, volatile LAS unsigned* st) {
    XcdBarrier b; b.bar = bar; b.x = xb_xcc_id(); b.st = st;
    if (threadIdx.x == 0) (void)xb_add(&bar[XB_XCNT(b.x)], 1u);
    return b;
}
__device__ __forceinline__ void xcd_barrier_complete(unsigned* bar, unsigned x, unsigned& nloc, unsigned& nx) {
    const unsigned G = gridDim.x * gridDim.y * gridDim.z;
    unsigned sum, cnt, mine, sp = 0u;
    for (;;) {
        sum = 0u; cnt = 0u; mine = 0u;
#pragma unroll
        for (unsigned j = 0; j < 16; ++j) { const unsigned c = xb_ld(&bar[XB_XCNT(j)]); sum += c; cnt += (c > 0u) ? 1u : 0u; mine = (j == x) ? c : mine; }
        if (sum == G) break;
        __builtin_amdgcn_s_sleep(1);
        if ((++sp & 255u) == 0u) { if (xb_ld(&bar[XB_TMO])) break; if (sp > XB_SPIN_CAP) { atomicAdd(&bar[XB_TMO], 1u); break; } }
    }
    nloc = mine > 0u ? mine : 1u; nx = cnt > 0u ? cnt : 1u;
}

__device__ __forceinline__ void xcd_barrier(const XcdBarrier& b) {
    asm volatile("s_waitcnt vmcnt(0)" ::: "memory");
    __syncthreads();
    if (threadIdx.x == 0) {
        unsigned* bar = b.bar;
        __builtin_amdgcn_s_waitcnt(0);
        unsigned nloc = b.st[0], nx = b.st[1];
        if (nloc == 0u) { xcd_barrier_complete(bar, b.x, nloc, nx); b.st[0] = nloc; b.st[1] = nx; }
        const unsigned old = xb_add(&bar[XB_XSUB(b.x)], 1u);
        const unsigned gen = old / nloc;
        if (old + 1u == (gen + 1u) * nloc) {
            __builtin_amdgcn_fence(__ATOMIC_RELEASE, "agent");
            asm volatile("s_waitcnt vmcnt(0)" ::: "memory");
            const unsigned og = xb_add(&bar[XB_TOP], 1u);
            const unsigned tg = og / nx;
            if (og + 1u == (tg + 1u) * nx) xb_add(&bar[XB_TOPGEN], 1u);
            else XB_SPIN(xb_ld(&bar[XB_TOPGEN]) == tg, bar);
            __builtin_amdgcn_fence(__ATOMIC_ACQUIRE, "agent");
            xb_add(&bar[XB_XGEN(b.x)], 1u);
            asm volatile("s_waitcnt vmcnt(0)" ::: "memory");
        } else {
            XB_SPIN(xb_ld(&bar[XB_XGEN(b.x)]) == gen, bar);
            __builtin_amdgcn_fence(__ATOMIC_ACQUIRE, "agent");
            asm volatile("s_waitcnt vmcnt(0)" ::: "memory");
        }
    }
    __syncthreads();
}

#define FRESH_IDS int tid_ = threadIdx.x; asm volatile("" : "+v"(tid_)); const int tid = tid_, lane = tid & 63, wave = __builtin_amdgcn_readfirstlane(tid >> 6); (void)lane; (void)wave;

__device__ __forceinline__ float wave_sum(float v) {
#pragma unroll
    for (int o = 1; o < 64; o <<= 1) v += __shfl_xor(v, o);
    return v;
}
__device__ __forceinline__ void p0_transpose_item(const float* W, int K, int N, bf16* WT, int row_off, LAS float* scr, int item, int lane) {
    const int nblk = N / 32, kb = item / nblk, nb = item % nblk, k0 = 64 * kb, n0 = 32 * nb;
#pragma unroll
    for (int i = 0; i < 32; ++i) { const int kk = 2 * i + (lane >> 5); scr[kk * 33 + (lane & 31)] = W[(size_t)(k0 + kk) * N + n0 + (lane & 31)]; }
    LDS_WAIT(); asm volatile("" ::: "memory");
    const int c = lane & 7;
#pragma unroll
    for (int j = 0; j < 4; ++j) { const int n = (lane >> 3) + 8 * j; const LAS float* s = scr + (8 * c) * 33 + n;
        v4u o; o.x = pk2(s[0 * 33], s[1 * 33]); o.y = pk2(s[2 * 33], s[3 * 33]); o.z = pk2(s[4 * 33], s[5 * 33]); o.w = pk2(s[6 * 33], s[7 * 33]);
        *(GAS v4u*)(WT + (size_t)(row_off + n0 + n) * K + k0 + 8 * c) = o; }
    LDS_WAIT(); asm volatile("" ::: "memory");
}

#define GW_LOOP(var, n) for (int var = F.vcu * NWAVES + wave; var < (n); var += F.G * NWAVES)

__device__ __forceinline__ int win_row_off(int n0) {
    const int tile = n0 >> 8; const bool rope = tile < 2 || (tile >= 4 && tile < 12) || (tile >= 20 && tile < 28) || (tile >= 36 && tile < 44);
    if (!rope) return 0;
    const int w = n0 & 255, hsel = w >> 7, half = (w >> 6) & 1, i = w & 63;
    return (half * 128 + hsel * 64 + i) - w;
}
__device__ __forceinline__ void ph_prologue(Frame& F) {
    FRESH_IDS
    for (int ait = F.vcu; ait < 192; ait += F.G) {
        const int l = ait / 96, n0 = (ait % 96) * 64;
        LAS float* sv = (LAS float*)F.lds;
        LAS float* red = (LAS float*)(F.lds + 32768);
        for (int k = tid; k < DM; k += NWAVES * 64) { sv[k] = siluf(F.c[k]); sv[DM + k] = siluf(F.c[DM + k]); sv[2 * DM + k] = siluf(F.c_ctx[k]); }
        __syncthreads();
        const float* W = F.w_ada + (size_t)l * DM * 6144 + n0 + lane;
        float a0 = 0.f, a1 = 0.f, a2 = 0.f;
        const int kb = wave * 256;
#pragma unroll 32
        for (int k = 0; k < 256; ++k) { const float w = W[(size_t)(kb + k) * 6144]; a0 += sv[kb + k] * w; a1 += sv[DM + kb + k] * w; a2 += sv[2 * DM + kb + k] * w; }
        red[(wave * 3 + 0) * 64 + lane] = a0; red[(wave * 3 + 1) * 64 + lane] = a1; red[(wave * 3 + 2) * 64 + lane] = a2;
        __syncthreads();
        if (wave < 3) { float s = 0.f;
#pragma unroll
            for (int w = 0; w < 8; ++w) s += red[(w * 3 + wave) * 64 + lane];
            float* mod = (float*)(F.ws + WS_MOD);
            mod[(size_t)(l * 3 + wave) * 6144 + n0 + lane] = s + F.b_ada[(size_t)l * 6144 + n0 + lane]; }
        __syncthreads();
    }
    { float* ct = (float*)(F.ws + WS_COS); float* st = (float*)(F.ws + WS_SIN);
      for (int i = (F.vcu * NWAVES * 64) + tid; i < SEQ * 64; i += F.G * NWAVES * 64) {
          const int t = i >> 6, j = i & 63, f = j & 31; const float pos = (float)((j < 32) ? (t >> 6) : (t & 63));
          const float inv = expf(-(float)f * (9.210340371976184f / 32.f)); const float ang = pos * inv;
          ct[i] = cosf(ang); st[i] = sinf(ang); } }
    LAS float* scr = (LAS float*)(F.lds + wave * 16384);
    constexpr int I_IN = (DM / 64) * (INC / 32), I_P = (DM / 64) * (DM / 32);
    bf16* WinT = (bf16*)(F.ws + WS_WINT); bf16* WpT = (bf16*)(F.ws + WS_WPT);
    GW_LOOP(it, I_IN + 6 * I_P) {
        if (it < I_IN) { p0_transpose_item(F.w_in, DM, INC, WinT, win_row_off(32 * (it % (INC / 32))), scr, it, lane); continue; }
        const int r = it - I_IN, mi = r / I_P, ii = r % I_P, l = mi / 3, w = mi % 3;
        const float* W = (w == 0 ? F.w_pa : (w == 1 ? F.w_pb : F.w_out)) + (size_t)l * DM * DM;
        p0_transpose_item(W, DM, DM, WpT + (size_t)mi * DM * DM, 0, scr, ii, lane);
    }
}

__device__ __forceinline__ void ph_hnorm(Frame& F, int l, const float* xcur, const float* ctxcur) {
    FRESH_IDS
    bf16* H = (bf16*)(F.ws + WS_S0);
    const float* gp = F.g_pre + (size_t)l * DM;
    GW_LOOP(row, MROWS) {
        const int b = row / RPB, rr = row % RPB; const float* src; int v;
        if (rr < CTX) { src = ctxcur + (size_t)(b * CTX + rr) * DM; v = 2; } else { src = xcur + (size_t)(b * SEQ + rr - CTX) * DM; v = b; }
        const float* md = (const float*)(F.ws + WS_MOD) + (size_t)(l * 3 + v) * 6144;
        f32x4 xv[8]; float s = 0.f;
#pragma unroll
        for (int j = 0; j < 8; ++j) { xv[j] = ((const f32x4*)src)[lane + 64 * j]; s += (xv[j].x * xv[j].x + xv[j].y * xv[j].y) + (xv[j].z * xv[j].z + xv[j].w * xv[j].w); }
        const float rs = rsqrtf(wave_sum(s) * (1.f / DM) + EPS);
#pragma unroll
        for (int j = 0; j < 8; ++j) { const int q = lane + 64 * j;
            const f32x4 g = ((const f32x4*)gp)[q], sh = ((const f32x4*)md)[q], sc = ((const f32x4*)(md + DM))[q];
            const f32x4 y = (xv[j] * rs) * g * (sc + 1.f) + sh;
            v2u o; o.x = pk2(y.x, y.y); o.y = pk2(y.z, y.w);
            *(v2u*)(H + (size_t)row * DM + 4 * q) = o; }
    }
}

__device__ __forceinline__ void ph_rope(Frame& F) {
    FRESH_IDS
    bf16* PX = (bf16*)(F.ws + WS_PX);
    const float* ct = (const float*)(F.ws + WS_COS); const float* st = (const float*)(F.ws + WS_SIN);
    const unsigned total = (unsigned)NB * SEQ * 52 * 8;
    for (unsigned idx = (unsigned)(F.vcu * NWAVES * 64 + tid); idx < total; idx += (unsigned)(F.G * NWAVES * 64)) {
        const unsigned ch = idx & 7, hr = idx >> 3, hh = hr % 52, rowL = hr / 52, b = rowL / SEQ, t = rowL % SEQ;
        const int col = (hh < 4) ? (C_KA + hh * 128) : (hh < 20) ? (C_KB + (hh - 4) * 128) : (hh < 36) ? (C_QA + (hh - 20) * 128) : (C_QB + (hh - 36) * 128);
        bf16* p = PX + (size_t)(b * RPB + CTX + t) * INC + col + ch * 8;
        const v4u x1 = *(const v4u*)p, x2 = *(const v4u*)(p + 64);
        const f32x4 c0 = *(const f32x4*)(ct + t * 64 + ch * 8), c1 = *(const f32x4*)(ct + t * 64 + ch * 8 + 4);
        const f32x4 s0 = *(const f32x4*)(st + t * 64 + ch * 8), s1 = *(const f32x4*)(st + t * 64 + ch * 8 + 4);
        v4u y1, y2;
#define ROPE2(W, CA, SA, CB, SB) { const float a0 = bflo(x1.W), a1 = bfhi(x1.W), b0 = bflo(x2.W), b1 = bfhi(x2.W); \
            y1.W = pk2(a0 * CA - b0 * SA, a1 * CB - b1 * SB); y2.W = pk2(b0 * CA + a0 * SA, b1 * CB + a1 * SB); }
        ROPE2(x, c0.x, s0.x, c0.y, s0.y) ROPE2(y, c0.z, s0.z, c0.w, s0.w) ROPE2(z, c1.x, s1.x, c1.y, s1.y) ROPE2(w, c1.z, s1.z, c1.w, s1.w)
#undef ROPE2
        *(v4u*)p = y1; *(v4u*)(p + 64) = y2;
    }
}

__device__ __forceinline__ void ph_convert_win(Frame& F, int l) {
    FRESH_IDS
    LAS float* scr = (LAS float*)(F.lds + wave * 16384);
    constexpr int I_IN = (DM / 64) * (INC / 32);
    bf16* WinT = (bf16*)(F.ws + WS_WINT);
    GW_LOOP(it, I_IN) p0_transpose_item(F.w_in + (size_t)l * DM * INC, DM, INC, WinT, win_row_off(32 * (it % (INC / 32))), scr, it, lane);
}

__device__ __forceinline__ void ph_attn(Frame& F, int l, char* lds) {
    const att::bf16* PX = (const att::bf16*)(F.ws + WS_PX);
    att::bf16* OA = (att::bf16*)(F.ws + WS_S0);
    att::bf16* OB0 = (att::bf16*)(F.ws + WS_S0 + SLOT);
    const float NINF = -INFINITY;
    const int nB = 1024, nA = 1024, nC = (l == 0) ? 64 : 0;
    for (int u = F.vcu; u < nB + nA + nC; u += F.G) {
        if (u < nB) {
            const int hd = u >> 5, qb = u & 31, b = hd >> 4, h8 = (hd >> 1) & 7, m = hd & 1;
            const size_t qrow = (size_t)b * RPB + CTX + qb * 256, krow = (size_t)b * RPB;
            att::attn_body_v256(PX + qrow * INC + C_QB + (h8 * 2 + m) * 128, PX + krow * INC + C_KB + (h8 * 2 + m) * 128, PX + krow * INC + C_VB + h8 * 256,
                                OB0 + (size_t)m * (SLOT / 2) + qrow * DM + h8 * 256, RPB / 64, F.lds);
            __syncthreads();
        } else if (u < nB + nA) {
            const int v = u - nB, b = v >> 9, kvh = (v >> 7) & 3, qb = v & 127, q0 = qb * 64;
            const int lo = (q0 - 128 > 0) ? q0 - 128 : 0, he = (q0 + 192 < SEQ) ? q0 + 192 : SEQ, nloc = (he - lo) >> 6;
            const size_t qrow = (size_t)b * RPB + CTX + q0, krow = (size_t)b * RPB;
            att::attn_body_a(PX + qrow * INC + C_QA + kvh * 512, PX + krow * INC + C_KA + kvh * 128, PX + krow * INC + C_VA + kvh * 128,
                             OA + qrow * DM + kvh * 512, 4 + nloc, 4, lo, q0, F.sink + l * 16 + kvh * 4, F.lds);
            __syncthreads();
        } else {
            const int v = u - nB - nA;
            if (v < 32) {
                const int hd = v, b = hd >> 4, h8 = (hd >> 1) & 7, m = hd & 1; const size_t krow = (size_t)b * RPB;
                att::attn_body_v256(PX + krow * INC + C_QB + (h8 * 2 + m) * 128, PX + krow * INC + C_KB + (h8 * 2 + m) * 128, PX + krow * INC + C_VB + h8 * 256,
                                    OB0 + (size_t)m * (SLOT / 2) + krow * DM + h8 * 256, 4, F.lds);
                __syncthreads();
            } else {
                const int w = v - 32, b = w >> 4, kvh = (w >> 2) & 3, cb = w & 3; const size_t krow = (size_t)b * RPB, qrow = krow + cb * 64;
                att::attn_body_a(PX + qrow * INC + C_QA + kvh * 512, PX + krow * INC + C_KA + kvh * 128, PX + krow * INC + C_VA + kvh * 128,
                                 OA + qrow * DM + kvh * 512, 4, 4, 0, 0, F.sink + l * 16 + kvh * 4, F.lds);
                __syncthreads();
            }
        }
    }
}

__device__ __forceinline__ void ph_post(Frame& F, int l) {
    FRESH_IDS
    const bf16* PX = (const bf16*)(F.ws + WS_PX);
    const bf16* OA = (const bf16*)(F.ws + WS_S0); const bf16* OB0 = (const bf16*)(F.ws + WS_S0 + SLOT); const bf16* OB1 = (const bf16*)(F.ws + WS_S0 + 2 * SLOT);
    bf16* GA = (bf16*)(F.ws + WS_S0 + 3 * SLOT); bf16* GB = (bf16*)(F.ws + WS_S0 + 4 * SLOT);
    const float lam_init = 0.8f - 0.6f * expf(-0.3f * (float)l);
    const float* lq = F.lam_qk + (size_t)l * 512;
    const float d1 = wave_sum(lq[lane] * lq[128 + lane] + lq[64 + lane] * lq[192 + lane]);
    const float d2 = wave_sum(lq[256 + lane] * lq[384 + lane] + lq[320 + lane] * lq[448 + lane]);
    const float lam = expf(d1) - expf(d2) + lam_init;
    const f32x4 gs0 = ((const f32x4*)(F.g_subln + (size_t)l * 256))[2 * (lane & 31)] * (1.f - lam_init), gs1 = ((const f32x4*)(F.g_subln + (size_t)l * 256))[2 * (lane & 31) + 1] * (1.f - lam_init);
    GW_LOOP(row, MROWS) {
        if (l != 0 && (row % RPB) < CTX) continue;
        const size_t ro = (size_t)row * DM + 8 * lane, rp = (size_t)row * INC + 8 * lane;
        v4u oa[4], za[4], o0[4], o1[4], zb[4];
#pragma unroll
        for (int j = 0; j < 4; ++j) { oa[j] = *(const v4u*)(OA + ro + 512 * j); za[j] = *(const v4u*)(PX + rp + C_ZA + 512 * j);
            o0[j] = *(const v4u*)(OB0 + ro + 512 * j); o1[j] = *(const v4u*)(OB1 + ro + 512 * j); zb[j] = *(const v4u*)(PX + rp + C_ZB + 512 * j); }
#pragma unroll
        for (int j = 0; j < 4; ++j) { v4u o;
#define GA2(W) o.W = pk2(bflo(oa[j].W) * siluf(bflo(za[j].W)), bfhi(oa[j].W) * siluf(bfhi(za[j].W)));
            GA2(x) GA2(y) GA2(z) GA2(w)
#undef GA2
            *(v4u*)(GA + ro + 512 * j) = o; }
#pragma unroll
        for (int j = 0; j < 4; ++j) {
            f32x4 da, db;
            da.x = bflo(o0[j].x) - lam * bflo(o1[j].x); da.y = bfhi(o0[j].x) - lam * bfhi(o1[j].x); da.z = bflo(o0[j].y) - lam * bflo(o1[j].y); da.w = bfhi(o0[j].y) - lam * bfhi(o1[j].y);
            db.x = bflo(o0[j].z) - lam * bflo(o1[j].z); db.y = bfhi(o0[j].z) - lam * bfhi(o1[j].z); db.z = bflo(o0[j].w) - lam * bflo(o1[j].w); db.w = bfhi(o0[j].w) - lam * bfhi(o1[j].w);
            float ss = ((da.x * da.x + da.y * da.y) + (da.z * da.z + da.w * da.w)) + ((db.x * db.x + db.y * db.y) + (db.z * db.z + db.w * db.w));
#pragma unroll
            for (int o_ = 1; o_ < 32; o_ <<= 1) ss += __shfl_xor(ss, o_);
            const float rs = rsqrtf(ss * (1.f / 256.f) + EPS);
            const f32x4 ya = da * rs * gs0, yb = db * rs * gs1;
            v4u o; o.x = pk2(ya.x * siluf(bflo(zb[j].x)), ya.y * siluf(bfhi(zb[j].x))); o.y = pk2(ya.z * siluf(bflo(zb[j].y)), ya.w * siluf(bfhi(zb[j].y)));
            o.z = pk2(yb.x * siluf(bflo(zb[j].z)), yb.y * siluf(bfhi(zb[j].z))); o.w = pk2(yb.z * siluf(bflo(zb[j].w)), yb.w * siluf(bfhi(zb[j].w)));
            *(v4u*)(GB + ro + 512 * j) = o; }
    }
}

__device__ __forceinline__ void ph_merge(Frame& F, int l) {
    FRESH_IDS
    const bf16* PX = (const bf16*)(F.ws + WS_PX);
    const bf16* YA = (const bf16*)(F.ws + WS_S0); const bf16* YB = (const bf16*)(F.ws + WS_S0 + SLOT); bf16* MG = (bf16*)(F.ws + WS_S0 + 2 * SLOT);
    const unsigned total = (unsigned)MROWS * (DM / 8);
    for (unsigned i = (unsigned)(F.vcu * NWAVES * 64 + tid); i < total; i += (unsigned)(F.G * NWAVES * 64)) {
        const unsigned row = i >> 8, c = (i & 255) * 8;
        if (l != 0 && (row % RPB) < CTX) continue;
        const v4u ya = *(const v4u*)(YA + (size_t)row * DM + c), yb = *(const v4u*)(YB + (size_t)row * DM + c);
        const v4u ga = *(const v4u*)(PX + (size_t)row * INC + C_GA + c), gb = *(const v4u*)(PX + (size_t)row * INC + C_GB + c);
        v4u o;
#define MRG(W) o.W = pk2(sigmf(bflo(ga.W)) * bflo(ya.W) + sigmf(bflo(gb.W)) * bflo(yb.W), sigmf(bfhi(ga.W)) * bfhi(ya.W) + sigmf(bfhi(gb.W)) * bfhi(yb.W));
        MRG(x) MRG(y) MRG(z) MRG(w)
#undef MRG
        *(v4u*)(MG + (size_t)row * DM + c) = o;
    }
}

__device__ __forceinline__ void ph_res(Frame& F, int l, const float* xcur, const float* ctxcur) {
    FRESH_IDS
    const bf16* OX = (const bf16*)(F.ws + WS_S0 + 3 * SLOT);
    bf16* H = (bf16*)(F.ws + WS_S0);
    const float* gp = F.g_post + (size_t)l * DM;
    const bool nxt = (l + 1 < DEPTH);
    const float* gpn = F.g_pre + (size_t)(l + 1) * DM;
    GW_LOOP(row, MROWS) {
        const int b = row / RPB, rr = row % RPB; const float* src; float* dst; int v;
        if (rr < CTX) { if (!nxt) continue; src = ctxcur + (size_t)(b * CTX + rr) * DM; dst = nullptr; v = 2; }
        else { src = xcur + (size_t)(b * SEQ + rr - CTX) * DM; dst = F.out + (size_t)(b * SEQ + rr - CTX) * DM; v = b; }
        const float* gt = (const float*)(F.ws + WS_MOD) + (size_t)(l * 3 + v) * 6144 + 2 * DM;
        f32x4 ov[8]; float s = 0.f;
#pragma unroll
        for (int j = 0; j < 8; ++j) { const v2u w = *(const v2u*)(OX + (size_t)row * DM + 4 * (lane + 64 * j));
            ov[j] = (f32x4){bflo(w.x), bfhi(w.x), bflo(w.y), bfhi(w.y)}; s += (ov[j].x * ov[j].x + ov[j].y * ov[j].y) + (ov[j].z * ov[j].z + ov[j].w * ov[j].w); }
        const float rs = rsqrtf(wave_sum(s) * (1.f / DM) + EPS);
        float s2 = 0.f;
#pragma unroll
        for (int j = 0; j < 8; ++j) { const int q = lane + 64 * j;
            const f32x4 g = ((const f32x4*)gp)[q], gate = ((const f32x4*)gt)[q], xr = ((const f32x4*)src)[q];
            ov[j] = xr + gate * ((ov[j] * rs) * g);
            if (dst) ((f32x4*)dst)[q] = ov[j];
            s2 += (ov[j].x * ov[j].x + ov[j].y * ov[j].y) + (ov[j].z * ov[j].z + ov[j].w * ov[j].w); }
        if (nxt) {
            const float* md = (const float*)(F.ws + WS_MOD) + (size_t)((l + 1) * 3 + v) * 6144;
            const float rs2 = rsqrtf(wave_sum(s2) * (1.f / DM) + EPS);
#pragma unroll
            for (int j = 0; j < 8; ++j) { const int q = lane + 64 * j;
                const f32x4 g = ((const f32x4*)gpn)[q], sh = ((const f32x4*)md)[q], sc = ((const f32x4*)(md + DM))[q];
                const f32x4 y = (ov[j] * rs2) * g * (sc + 1.f) + sh;
                v2u o; o.x = pk2(y.x, y.y); o.y = pk2(y.z, y.w);
                *(v2u*)(H + (size_t)row * DM + 4 * q) = o; }
        }
    }
}

typedef short sg_bf16x8 __attribute__((ext_vector_type(8)));
template <bool DUAL>
__device__ __forceinline__ void small_ctx_gemm(Frame& F, const bf16* A0, const bf16* W0, const bf16* A1, const bf16* W1, const bf16* PXg, bf16* O) {
    FRESH_IDS
    const int fr = lane & 15, fq = lane >> 4, wc = wave & 3, wr = wave >> 2;
    for (int t = F.vcu; t < 8 * 32; t += F.G) {
        const int tr = t >> 5, tc = t & 31;
        const int c0 = tr * 64 + wr * 32, b = c0 >> 8;
        const size_t row0 = (size_t)b * RPB + (c0 & 255);
        const int col0 = tc * 64 + wc * 16;
        f32x4 acc[2][2] = {};
#pragma unroll
        for (int gsel = 0; gsel < (DUAL ? 2 : 1); ++gsel) {
            const bf16* Ap = (gsel ? A1 : A0) + (row0 + fr) * DM + 8 * fq;
            const bf16* Bp = (gsel ? W1 : W0) + (size_t)(col0 + fr) * DM + 8 * fq;
#pragma unroll 8
            for (int k = 0; k < DM; k += 32) {
                const sg_bf16x8 a0 = *(const sg_bf16x8*)(Ap + k), a1 = *(const sg_bf16x8*)(Ap + 16 * DM + k), bb = *(const sg_bf16x8*)(Bp + k);
                acc[gsel][0] = __builtin_amdgcn_mfma_f32_16x16x32_bf16(bb, a0, acc[gsel][0], 0, 0, 0);
                acc[gsel][1] = __builtin_amdgcn_mfma_f32_16x16x32_bf16(bb, a1, acc[gsel][1], 0, 0, 0);
            }
        }
#pragma unroll
        for (int rb = 0; rb < 2; ++rb) { const size_t row = row0 + rb * 16 + fr; const int col = col0 + 4 * fq;
            f32x4 v = acc[0][rb];
            if (DUAL) { const v2u ga = *(const v2u*)(PXg + row * INC + C_GA + col), gb = *(const v2u*)(PXg + row * INC + C_GB + col); const f32x4 w = acc[1][rb];
                v.x = sigmf(bflo(ga.x)) * v.x + sigmf(bflo(gb.x)) * w.x; v.y = sigmf(bfhi(ga.x)) * v.y + sigmf(bfhi(gb.x)) * w.y;
                v.z = sigmf(bflo(ga.y)) * v.z + sigmf(bflo(gb.y)) * w.z; v.w = sigmf(bfhi(ga.y)) * v.w + sigmf(bfhi(gb.y)) * w.w; }
            v2u o; o.x = pk2(v.x, v.y); o.y = pk2(v.z, v.w);
            *(v2u*)(O + row * DM + col) = o; }
    }
}

__device__ __forceinline__ void run_gemm_in(Frame& F, const bf16* A, const bf16* Bt, bf16* O) {
    pg8::Gemm g{A, Bt, MROWS, INC, DM}; pg8::RowSkipOrder S; S.init(INC, F.G, (int)blockIdx.x, false);
    pg8::EpiRope E{O, INC, (const float*)(F.ws + WS_COS), (const float*)(F.ws + WS_SIN)};
    pg8::gemm_phase<pg8::EpiRope, pg8::RowSkipOrder, true, true>(F.lds, g, S, E);
}
__device__ __forceinline__ void run_gemm_skip(Frame& F, const bf16* A, const bf16* Bt, bf16* O, bool skip) {
    pg8::Gemm g{A, Bt, MROWS, DM, DM}; pg8::RowSkipOrder S; S.init(DM, F.G, (int)blockIdx.x, skip);
    pg8::EpiBf16 E{O, DM};
    pg8::gemm_phase<pg8::EpiBf16, pg8::RowSkipOrder, true, true>(F.lds, g, S, E);
}
template <bool ADD>
__device__ __forceinline__ void run_gemm_gate(Frame& F, const bf16* A, const bf16* Bt, bf16* O, const bf16* T, const bf16* G, bool skip) {
    pg8::Gemm g{A, Bt, MROWS, DM, DM}; pg8::RowSkipOrder S; S.init(DM, F.G, (int)blockIdx.x, skip);
    pg8::EpiGate<ADD> E{O, T, G, DM, INC};
    pg8::gemm_phase<pg8::EpiGate<ADD>, pg8::RowSkipOrder, true, true>(F.lds, g, S, E);
}

struct Args { const float* in[15]; float* out; unsigned char* ws; };
__global__ void __launch_bounds__(NWAVES * 64, 2) fwd_mega(Args args) {
    extern __shared__ __attribute__((aligned(16))) unsigned char lds[];
    cg::grid_group grid = cg::this_grid();
    Frame F;
    F.lds = (LAS unsigned char*)lds;
    F.G = gridDim.x; { const int bx = blockIdx.x; F.vcu = (F.G % 8 == 0) ? (bx % 8) * (F.G / 8) + bx / 8 : bx; }
    F.x = args.in[0]; F.c = args.in[1]; F.ctx = args.in[2]; F.c_ctx = args.in[3]; F.w_ada = args.in[4]; F.b_ada = args.in[5]; F.g_pre = args.in[6]; F.g_post = args.in[7];
    F.w_in = args.in[8]; F.sink = args.in[9]; F.lam_qk = args.in[10]; F.g_subln = args.in[11]; F.w_pa = args.in[12]; F.w_pb = args.in[13]; F.w_out = args.in[14];
    F.out = args.out; F.ws = args.ws;
    volatile LAS unsigned* MISC = (volatile LAS unsigned*)(F.lds + 149504);
    if (threadIdx.x < 32) MISC[threadIdx.x] = 0u;
    __syncthreads();
    const XcdBarrier bar = xcd_barrier_post((unsigned*)(F.ws + WS_BAR), MISC + 8);
    bf16* WinT = (bf16*)(F.ws + WS_WINT); bf16* WpT = (bf16*)(F.ws + WS_WPT); bf16* PX = (bf16*)(F.ws + WS_PX);
    bf16* S0 = (bf16*)(F.ws + WS_S0); bf16* S1 = (bf16*)(F.ws + WS_S0 + SLOT); bf16* S2 = (bf16*)(F.ws + WS_S0 + 2 * SLOT); bf16* S3 = (bf16*)(F.ws + WS_S0 + 3 * SLOT); bf16* S4 = (bf16*)(F.ws + WS_S0 + 4 * SLOT);

    ph_prologue(F);
    grid.sync();
#pragma unroll 1
    for (int l = 0; l < DEPTH; ++l) {
        const float* xcur = (l == 0) ? F.x : F.out;
        const float* ctxcur = (l == 0) ? F.ctx : (const float*)(F.ws + WS_CTX1);
        if (l == 0) { ph_hnorm(F, l, xcur, ctxcur); xcd_barrier(bar); }
        run_gemm_in(F, S0, WinT, PX);
        xcd_barrier(bar);
        ph_attn(F, l, (char*)lds);
        xcd_barrier(bar);
        ph_post(F, l);
        if (l + 1 < DEPTH) ph_convert_win(F, l + 1);
        xcd_barrier(bar);
        run_gemm_gate<false>(F, S3, WpT + (size_t)(l * 3 + 0) * DM * DM, S0, S0, PX + C_GA, true);
        run_gemm_gate<true>(F, S4, WpT + (size_t)(l * 3 + 1) * DM * DM, S2, S0, PX + C_GB, true);
        if (l + 1 < DEPTH) small_ctx_gemm<true>(F, S3, WpT + (size_t)(l * 3 + 0) * DM * DM, S4, WpT + (size_t)(l * 3 + 1) * DM * DM, PX, S2);
        xcd_barrier(bar);
        run_gemm_skip(F, S2, WpT + (size_t)(l * 3 + 2) * DM * DM, S3, true);
        if (l + 1 < DEPTH) small_ctx_gemm<false>(F, S2, WpT + (size_t)(l * 3 + 2) * DM * DM, nullptr, nullptr, PX, S3);
        xcd_barrier(bar);
        ph_res(F, l, xcur, ctxcur);
        if (l + 1 < DEPTH) xcd_barrier(bar);
    }
}

extern "C" void kernel_launch(void* const* d_in, const int* in_sizes, int n_in, void* d_out, int out_size, void* d_ws, size_t ws_size, hipStream_t stream) {
    static int grid = 0;
    if (grid == 0) {
        if (n_in != 15 || out_size != NB * SEQ * DM || ws_size < WS_END) { fprintf(stderr, "kernel_launch: unexpected shapes: n_in %d out %d ws %zu (need %zu)\n", n_in, out_size, ws_size, (size_t)WS_END); grid = -1; return; }
        int dev = 0, cus = 0, per_cu = 0;
        if (hipGetDevice(&dev) != hipSuccess || hipDeviceGetAttribute(&cus, hipDeviceAttributeMultiprocessorCount, dev) != hipSuccess) { grid = -1; return; }
        if (hipFuncSetAttribute((const void*)fwd_mega, hipFuncAttributeMaxDynamicSharedMemorySize, LDS_BYTES) != hipSuccess) { fprintf(stderr, "kernel_launch: hipFuncSetAttribute failed\n"); grid = -1; return; }
        if (hipOccupancyMaxActiveBlocksPerMultiprocessor(&per_cu, (const void*)fwd_mega, NWAVES * 64, LDS_BYTES) != hipSuccess || per_cu < 1) { fprintf(stderr, "kernel_launch: occupancy query says %d\n", per_cu); per_cu = 1; }
        (void)hipGetLastError();
        grid = cus * per_cu;
    }
    if (grid < 0) return;
    if (hipMemsetAsync((char*)d_ws + WS_BAR, 0, WS_BAR_BYTES, stream) != hipSuccess) { fprintf(stderr, "kernel_launch: memset of the barrier words failed\n"); return; }
    Args a{};
    for (int i = 0; i < 15; ++i) a.in[i] = (const float*)d_in[i];
    a.out = (float*)d_out; a.ws = (unsigned char*)d_ws;
    void* kargs[] = {&a};
    hipError_t e = hipLaunchCooperativeKernel((const void*)fwd_mega, dim3(grid), dim3(NWAVES * 64), kargs, LDS_BYTES, stream);
    if (e != hipSuccess) fprintf(stderr, "kernel_launch: cooperative launch failed: %s (grid %d)\n", hipGetErrorString(e), grid);
}
```

```cpp
#include <hip/hip_runtime.h>
#include <hip/hip_bf16.h>
#include <hip/hip_cooperative_groups.h>
#include <cstdio>
#include <cstdint>
#include <cmath>
namespace cg = cooperative_groups;

constexpr int DM = 2048, NB = 2, SEQ = 8192, DEPTH = 2, CTX = 256;
constexpr int RPB = CTX + SEQ;
constexpr int MROWS = NB * RPB;
constexpr int INC = 17408;
constexpr int C_KA = 0, C_VA = 512, C_KB = 1024, C_VB = 3072, C_QA = 5120, C_ZA = 7168, C_QB = 9216, C_ZB = 11264, C_GA = 13312, C_GB = 15360;
constexpr float EPS = 1e-6f;

namespace pg8 {
#define PG8_LAS __attribute__((address_space(3)))
typedef unsigned short bf16_t;
typedef short bf16x8 __attribute__((ext_vector_type(8)));
typedef float f32x4 __attribute__((ext_vector_type(4)));
typedef unsigned u32x4 __attribute__((ext_vector_type(4)));
constexpr int BM = 256, BK = 64, HALF = 128, HTB = HALF * BK * 2  , STAGE_BYTES = 8 * HTB, NXCD = 8, WGM = 8;

__host__ __device__ __forceinline__ int lds_byte(int r, int c) { const int st = (r >> 4) * 2 + (c >> 5), rr = r & 15, cc = c & 31, ob = rr * 64 + cc * 2; return st * 1024 + (ob ^ (((ob >> 9) & 1) << 5)); }
__host__ __device__ __forceinline__ void stage_rc(int b, int& R, int& C) { const int st = b / 1024, sb = b % 1024, swz = sb ^ (((sb >> 9) & 1) << 5); R = (st >> 1) * 16 + swz / 64; C = (st & 1) * 32 + (swz % 64) / 2; }
__host__ __device__ __forceinline__ int perm32(int rho) { const int n = rho >> 4, i = rho & 15; return 8 * (i >> 2) + 4 * n + (i & 3); }

struct Unit { int pm, pn; };
struct Gemm { const bf16_t* A; const bf16_t* Bt; int M, N, K; };

struct StaticOrder {
    int nM, nN, nwg, G, c;
    __host__ __device__ void init(int M, int N, int G_, int c_) { nM = M / BM; nN = N / BM; nwg = nM * nN; G = G_; c = c_; }
    __host__ __device__ bool next(int i, Unit& u) const {
        const long L = (long)i * G + c; if (L >= nwg) return false;
        int wgid = (int)L; { const int q = nwg / NXCD, r = nwg % NXCD, xcd = wgid % NXCD, off = wgid / NXCD; wgid = (xcd < r ? xcd * (q + 1) : r * (q + 1) + (xcd - r) * q) + off; }
        const int nig = WGM * nN, gid = wgid / nig, fm = gid * WGM, gsz = (nM - fm) < WGM ? (nM - fm) : WGM;
        u.pm = fm + ((wgid % nig) % gsz); u.pn = (wgid % nig) / gsz; return true;
    }
    __device__ __forceinline__ void a_ready(const Unit&) const {}
    __device__ __forceinline__ void done(const Unit&) const {}
};

__device__ __forceinline__ unsigned cvt_pk_bf16(float lo, float hi) { unsigned r; asm volatile("v_cvt_pk_bf16_f32 %0, %1, %2" : "=v"(r) : "v"(lo), "v"(hi)); return r; }
typedef float f32x2 __attribute__((ext_vector_type(2)));

struct EpiBf16 {
    static constexpr bool PERM = true, AFTER_DRAIN = false;
    bf16_t* O; int ldc;
    __device__ __forceinline__ void operator()(const f32x4 (&acc)[2][2][4][2], const Unit& u, int wr, int wc, int fr, int fq) const {
        const int row0 = u.pm * BM + wr * 64 + fr; const int col0 = u.pn * BM + wc * 32 + 8 * fq;
#pragma unroll
        for (int ai = 0; ai < 2; ++ai)
#pragma unroll
            for (int m = 0; m < 4; ++m) { bf16_t* rowp = O + (size_t)(row0 + ai * HALF + m * 16) * ldc + col0;
#pragma unroll
                for (int bj = 0; bj < 2; ++bj) { const f32x4 v0 = acc[ai][bj][m][0], v1 = acc[ai][bj][m][1];
                    u32x4 w; w.x = cvt_pk_bf16(v0[0], v0[1]); w.y = cvt_pk_bf16(v0[2], v0[3]); w.z = cvt_pk_bf16(v1[0], v1[1]); w.w = cvt_pk_bf16(v1[2], v1[3]);
                    *(u32x4*)(rowp + bj * HALF) = w; } }
    }
};

__device__ __forceinline__ float sigm_(float x) { return __builtin_amdgcn_rcpf(1.f + __builtin_amdgcn_exp2f(x * -1.4426950408889634f)); }
__device__ __forceinline__ float blo_(unsigned w) { return __builtin_bit_cast(float, w << 16); }
__device__ __forceinline__ float bhi_(unsigned w) { return __builtin_bit_cast(float, w & 0xffff0000u); }
template <bool ADD> struct EpiGate {
    static constexpr bool PERM = true, AFTER_DRAIN = false;
    bf16_t* O; const bf16_t* T; const bf16_t* G; int ldc; int ldg;
    __device__ __forceinline__ void operator()(const f32x4 (&acc)[2][2][4][2], const Unit& u, int wr, int wc, int fr, int fq) const {
        const int row0 = u.pm * BM + wr * 64 + fr; const int col0 = u.pn * BM + wc * 32 + 8 * fq;
#pragma unroll
        for (int ai = 0; ai < 2; ++ai) {
            u32x4 g[4][2], t[4][2];
#pragma unroll
            for (int m = 0; m < 4; ++m)
#pragma unroll
                for (int bj = 0; bj < 2; ++bj) { g[m][bj] = *(const u32x4*)(G + (size_t)(row0 + ai * HALF + m * 16) * ldg + col0 + bj * HALF);
                    if (ADD) t[m][bj] = *(const u32x4*)(T + (size_t)(row0 + ai * HALF + m * 16) * ldc + col0 + bj * HALF); }
#pragma unroll
            for (int m = 0; m < 4; ++m) { const size_t row = (size_t)(row0 + ai * HALF + m * 16);
#pragma unroll
                for (int bj = 0; bj < 2; ++bj) { const f32x4 v0 = acc[ai][bj][m][0], v1 = acc[ai][bj][m][1]; const u32x4 gg = g[m][bj];
                    float r0 = sigm_(blo_(gg.x)) * v0[0], r1 = sigm_(bhi_(gg.x)) * v0[1], r2 = sigm_(blo_(gg.y)) * v0[2], r3 = sigm_(bhi_(gg.y)) * v0[3];
                    float r4 = sigm_(blo_(gg.z)) * v1[0], r5 = sigm_(bhi_(gg.z)) * v1[1], r6 = sigm_(blo_(gg.w)) * v1[2], r7 = sigm_(bhi_(gg.w)) * v1[3];
                    if (ADD) { const u32x4 tt = t[m][bj];
                        r0 += blo_(tt.x); r1 += bhi_(tt.x); r2 += blo_(tt.y); r3 += bhi_(tt.y); r4 += blo_(tt.z); r5 += bhi_(tt.z); r6 += blo_(tt.w); r7 += bhi_(tt.w); }
                    u32x4 w; w.x = cvt_pk_bf16(r0, r1); w.y = cvt_pk_bf16(r2, r3); w.z = cvt_pk_bf16(r4, r5); w.w = cvt_pk_bf16(r6, r7);
                    *(u32x4*)(O + row * ldc + col0 + bj * HALF) = w; } }
        }
    }
};
struct RowSkipOrder {
    StaticOrder base; bool skip;
    __device__ void init(int N, int G_, int c_, bool skip_) { skip = skip_; base.init(skip_ ? 16384 : 16896, N, G_, c_); }
    __device__ bool next(int i, Unit& u) const { if (!base.next(i, u)) return false; if (skip) u.pm += 1 + (u.pm >= 32 ? 1 : 0); return true; }
    __device__ __forceinline__ void a_ready(const Unit&) const {}
    __device__ __forceinline__ void done(const Unit&) const {}
};

struct EpiRope {
    static constexpr bool PERM = true, AFTER_DRAIN = false;
    bf16_t* O; int ldc; const float* ct; const float* st;
    __device__ __forceinline__ void operator()(const f32x4 (&acc)[2][2][4][2], const Unit& u, int wr, int wc, int fr, int fq) const {
        const int pn = u.pn; const bool rope = pn < 2 || (pn >= 4 && pn < 12) || (pn >= 20 && pn < 28) || (pn >= 36 && pn < 44);
        const int row0 = u.pm * BM + wr * 64 + fr;
        if (!rope) {
            const int col0 = pn * BM + wc * 32 + 8 * fq;
#pragma unroll
            for (int ai = 0; ai < 2; ++ai)
#pragma unroll
                for (int m = 0; m < 4; ++m) { bf16_t* rowp = O + (size_t)(row0 + ai * HALF + m * 16) * ldc + col0;
#pragma unroll
                    for (int bj = 0; bj < 2; ++bj) { const f32x4 v0 = acc[ai][bj][m][0], v1 = acc[ai][bj][m][1];
                        u32x4 w; w.x = cvt_pk_bf16(v0[0], v0[1]); w.y = cvt_pk_bf16(v0[2], v0[3]); w.z = cvt_pk_bf16(v1[0], v1[1]); w.w = cvt_pk_bf16(v1[2], v1[3]);
                        *(u32x4*)(rowp + bj * HALF) = w; } }
            return;
        }
        const bool isctx = (u.pm == 0) || (u.pm == 33);
        const int i0 = 32 * (wc & 1) + 8 * fq, ocol = pn * BM + (wc >> 1) * 128 + i0;
        const int tbase = row0 - (u.pm >= 33 ? 8448 : 0) - 256;
        float invr[8];
#pragma unroll
        for (int e_ = 0; e_ < 8; ++e_) invr[e_] = __builtin_amdgcn_exp2f(-(float)(8 * fq + e_) * (13.287712379549449f / 32.f)) * 0.15915494309189535f;
#pragma unroll
        for (int ai = 0; ai < 2; ++ai)
#pragma unroll
            for (int m = 0; m < 4; ++m) { const int t = tbase + ai * HALF + m * 16;
                f32x4 c0 = {1.f, 1.f, 1.f, 1.f}, c1 = c0, s0 = {0.f, 0.f, 0.f, 0.f}, s1 = s0;
                if (!isctx) { const float pos = (float)((wc & 1) ? (t & 63) : (t >> 6));
#pragma unroll
                    for (int e_ = 0; e_ < 4; ++e_) { const float r0 = pos * invr[e_], r1 = pos * invr[4 + e_];
                        c0[e_] = __builtin_amdgcn_cosf(r0); s0[e_] = __builtin_amdgcn_sinf(r0); c1[e_] = __builtin_amdgcn_cosf(r1); s1[e_] = __builtin_amdgcn_sinf(r1); } }
                const f32x4 a0 = acc[ai][0][m][0], a1 = acc[ai][0][m][1], b0 = acc[ai][1][m][0], b1 = acc[ai][1][m][1];
                const f32x4 y0 = a0 * c0 - b0 * s0, y1 = a1 * c1 - b1 * s1, z0 = b0 * c0 + a0 * s0, z1 = b1 * c1 + a1 * s1;
                bf16_t* rowp = O + (size_t)(row0 + ai * HALF + m * 16) * ldc + ocol;
                u32x4 w; w.x = cvt_pk_bf16(y0[0], y0[1]); w.y = cvt_pk_bf16(y0[2], y0[3]); w.z = cvt_pk_bf16(y1[0], y1[1]); w.w = cvt_pk_bf16(y1[2], y1[3]);
                *(u32x4*)rowp = w;
                u32x4 x; x.x = cvt_pk_bf16(z0[0], z0[1]); x.y = cvt_pk_bf16(z0[2], z0[3]); x.z = cvt_pk_bf16(z1[0], z1[1]); x.w = cvt_pk_bf16(z1[2], z1[3]);
                *(u32x4*)(rowp + 64) = x; }
    }
};

template <class Epi, class Sched, bool ALIGN_EPI = false, bool SP2 = false>
__device__ __forceinline__ void gemm_phase(PG8_LAS unsigned char* lds, const Gemm g, const Sched& S, const Epi& E) {
    int tid_ = threadIdx.x; asm volatile("" : "+v"(tid_));
    const int tid = tid_, wid = __builtin_amdgcn_readfirstlane(tid >> 6), lane = tid & 63, wr = wid >> 2, wc = wid & 3, fr = lane & 15, fq = lane >> 4;
    const int K = g.K, nt = K / BK;
    unsigned voffA[2], voffB[2];
#pragma unroll
    for (int i = 0; i < 2; ++i) { int R, C; stage_rc(tid * 16 + i * 8192, R, C); const int Rb = Epi::PERM ? ((R & ~31) + perm32(R & 31)) : R;
        voffA[i] = (unsigned)(R * K + C) * 2u; voffB[i] = (unsigned)(Rb * K + C) * 2u; }
    const size_t kstep = (size_t)(BK * 2);
    const size_t hstep = (size_t)HALF * K * 2;
    const size_t tstep = 2 * hstep;
    const unsigned ldsw = (unsigned)wid * 1024u;
    const int aoff = lds_byte(wr * 64 + fr, fq * 8), boff = lds_byte(wc * 32 + fr, fq * 8);
#define PG8_SA(b, h) (((b) * 2 + (h)) * HTB)
#define PG8_SB(b, h) ((4 + (b) * 2 + (h)) * HTB)
#define PG8_STAGE(bufoff, gbase, voff) do { _Pragma("unroll") for (int _i = 0; _i < 2; ++_i) \
        __builtin_amdgcn_global_load_lds((const unsigned*)((const char*)(gbase) + (voff)[_i]), (PG8_LAS unsigned*)(lds + (bufoff) + ldsw + _i * 8192), 16, 0, 0); } while (0)
#define PG8_LDA(dst, b, h) do { _Pragma("unroll") for (int m = 0; m < 4; ++m) _Pragma("unroll") for (int k = 0; k < 2; ++k) dst[m][k] = *(const PG8_LAS bf16x8*)(lds + PG8_SA(b, h) + aoff + m * 2048 + k * 1024); } while (0)
#define PG8_LDB(dst, b, h) do { _Pragma("unroll") for (int n = 0; n < 2; ++n) _Pragma("unroll") for (int k = 0; k < 2; ++k) dst[n][k] = *(const PG8_LAS bf16x8*)(lds + PG8_SB(b, h) + boff + n * 2048 + k * 1024); } while (0)
#define PG8_MMA(ai, bj, At, Bt) do { __builtin_amdgcn_s_setprio(1); _Pragma("unroll") for (int m = 0; m < 4; ++m) _Pragma("unroll") for (int n = 0; n < 2; ++n) _Pragma("unroll") for (int k = 0; k < 2; ++k) \
        acc[ai][bj][m][n] = __builtin_amdgcn_mfma_f32_16x16x32_bf16(Bt[n][k], At[m][k], acc[ai][bj][m][n], 0, 0, 0); __builtin_amdgcn_s_setprio(0); } while (0)
#define PG8_WAIT_V(n) asm volatile("s_waitcnt vmcnt(" #n ")" ::: "memory")
#define PG8_WAIT_L(n) asm volatile("s_waitcnt lgkmcnt(" #n ")" ::: "memory")
#define PG8_BAR __builtin_amdgcn_s_barrier()
#define PG8_SCHED __builtin_amdgcn_sched_barrier(0)
    Unit cur, nxt; int ui = 0;
    if (!S.next(0, cur)) return;
    f32x4 acc[2][2][4][2];
#pragma unroll
    for (int a = 0; a < 2; ++a)
#pragma unroll
        for (int b = 0; b < 2; ++b)
#pragma unroll
            for (int m = 0; m < 4; ++m)
#pragma unroll
                for (int n = 0; n < 2; ++n) acc[a][b][m][n] = (f32x4){0.f, 0.f, 0.f, 0.f};
    bf16x8 At[4][2], B0[2][2], B1[2][2];
    const char* cA = (const char*)g.A + (size_t)cur.pm * tstep; const char* cB = (const char*)g.Bt + (size_t)cur.pn * tstep;
    S.a_ready(cur);
    if constexpr (SP2) {
        PG8_STAGE(PG8_SB(0, 0), cB, voffB); PG8_STAGE(PG8_SB(0, 1), cB + hstep, voffB); PG8_STAGE(PG8_SA(0, 0), cA, voffA); PG8_STAGE(PG8_SA(0, 1), cA + hstep, voffA);
        if (wr == 1) PG8_BAR;
        PG8_WAIT_V(2); PG8_BAR;
        PG8_STAGE(PG8_SB(1, 0), cB + kstep, voffB); PG8_STAGE(PG8_SA(1, 0), cA + kstep, voffA); PG8_STAGE(PG8_SB(1, 1), cB + hstep + kstep, voffB);
        PG8_WAIT_V(6); PG8_BAR;
    } else {
        PG8_STAGE(PG8_SB(0, 0), cB, voffB); PG8_STAGE(PG8_SA(0, 0), cA, voffA); PG8_STAGE(PG8_SB(0, 1), cB + hstep, voffB); PG8_STAGE(PG8_SA(0, 1), cA + hstep, voffA);
        if (wr == 1) PG8_BAR;
        PG8_WAIT_V(4); PG8_BAR;
        PG8_STAGE(PG8_SB(1, 0), cB + kstep, voffB); PG8_STAGE(PG8_SA(1, 0), cA + kstep, voffA); PG8_STAGE(PG8_SB(1, 1), cB + hstep + kstep, voffB);
        PG8_WAIT_V(6); PG8_BAR;
    }
    for (;;) {
        const bool has_next = S.next(ui + 1, nxt);
        const char* nA = has_next ? (const char*)g.A + (size_t)nxt.pm * tstep : cA; const char* nB = has_next ? (const char*)g.Bt + (size_t)nxt.pn * tstep : cB;
        for (int t = 0; t < nt; t += 2) {
            const bool last = (t == nt - 2);
            const char* a1 = cA + (size_t)(t + 1) * kstep;
            const char* a2 = last ? nA : cA + (size_t)(t + 2) * kstep; const char* b2 = last ? nB : cB + (size_t)(t + 2) * kstep;
            const char* a3 = a2 + kstep; const char* b3 = b2 + kstep;
            if (last && has_next) S.a_ready(nxt);
            if constexpr (SP2) {
            PG8_LDB(B0, 0, 0); PG8_LDB(B1, 0, 1); PG8_SCHED; PG8_LDA(At, 0, 0); PG8_STAGE(PG8_SA(1, 1), a1 + hstep, voffA);
            PG8_WAIT_V(8); PG8_WAIT_L(0); PG8_BAR; PG8_MMA(0, 0, At, B0); PG8_MMA(0, 1, At, B1); PG8_BAR; PG8_SCHED;
            PG8_LDA(At, 0, 1); PG8_STAGE(PG8_SB(0, 0), b2, voffB); PG8_STAGE(PG8_SB(0, 1), b2 + hstep, voffB); PG8_STAGE(PG8_SA(0, 0), a2, voffA);
            PG8_WAIT_V(8); PG8_WAIT_L(0); PG8_BAR; PG8_MMA(1, 0, At, B0); PG8_MMA(1, 1, At, B1); PG8_BAR; PG8_SCHED;
            PG8_LDB(B0, 1, 0); PG8_LDB(B1, 1, 1); PG8_SCHED; PG8_LDA(At, 1, 0); PG8_STAGE(PG8_SA(0, 1), a2 + hstep, voffA);
            PG8_WAIT_V(8); PG8_WAIT_L(0); PG8_BAR; PG8_MMA(0, 0, At, B0); PG8_MMA(0, 1, At, B1); PG8_BAR; PG8_SCHED;
            PG8_LDA(At, 1, 1); PG8_STAGE(PG8_SB(1, 0), b3, voffB); PG8_STAGE(PG8_SB(1, 1), b3 + hstep, voffB); PG8_STAGE(PG8_SA(1, 0), a3, voffA);
            PG8_WAIT_V(8); PG8_WAIT_L(0); PG8_BAR; PG8_MMA(1, 0, At, B0); PG8_MMA(1, 1, At, B1); PG8_BAR; PG8_SCHED;
            } else {
            PG8_LDB(B0, 0, 0); PG8_SCHED; PG8_LDA(At, 0, 0); PG8_STAGE(PG8_SA(1, 1), a1 + hstep, voffA);
            PG8_WAIT_L(8); PG8_BAR; PG8_WAIT_L(0); PG8_MMA(0, 0, At, B0); PG8_BAR; PG8_SCHED;
            PG8_LDB(B1, 0, 1); PG8_STAGE(PG8_SB(0, 0), b2, voffB);
            PG8_BAR; PG8_WAIT_L(0); PG8_MMA(0, 1, At, B1); PG8_BAR;
            PG8_LDA(At, 0, 1); PG8_STAGE(PG8_SA(0, 0), a2, voffA);
            PG8_BAR; PG8_WAIT_L(0); PG8_MMA(1, 0, At, B0); PG8_BAR; PG8_SCHED;
            PG8_STAGE(PG8_SB(0, 1), b2 + hstep, voffB);
            PG8_WAIT_V(6); PG8_BAR; PG8_MMA(1, 1, At, B1); PG8_BAR;
            PG8_LDB(B0, 1, 0); PG8_SCHED; PG8_LDA(At, 1, 0); PG8_STAGE(PG8_SA(0, 1), a2 + hstep, voffA);
            PG8_WAIT_L(8); PG8_BAR; PG8_WAIT_L(0); PG8_MMA(0, 0, At, B0); PG8_BAR; PG8_SCHED;
            PG8_LDB(B1, 1, 1); PG8_STAGE(PG8_SB(1, 0), b3, voffB);
            PG8_BAR; PG8_WAIT_L(0); PG8_MMA(0, 1, At, B1); PG8_BAR;
            PG8_LDA(At, 1, 1); PG8_STAGE(PG8_SA(1, 0), a3, voffA);
            PG8_BAR; PG8_WAIT_L(0); PG8_MMA(1, 0, At, B0); PG8_BAR; PG8_SCHED;
            PG8_STAGE(PG8_SB(1, 1), b3 + hstep, voffB);
            PG8_WAIT_V(6); PG8_BAR; PG8_MMA(1, 1, At, B1); PG8_BAR;
            }
        }
        if constexpr (ALIGN_EPI) { if (wr == 0) PG8_BAR; }
        if constexpr (!Epi::AFTER_DRAIN) { E(acc, cur, wr, wc, fr, fq); S.done(cur); }
        if (!has_next) break;
#pragma unroll
        for (int a = 0; a < 2; ++a)
#pragma unroll
            for (int b = 0; b < 2; ++b)
#pragma unroll
                for (int m = 0; m < 4; ++m)
#pragma unroll
                    for (int n = 0; n < 2; ++n) acc[a][b][m][n] = (f32x4){0.f, 0.f, 0.f, 0.f};
        cur = nxt; cA = nA; cB = nB; ++ui;
        if constexpr (ALIGN_EPI) { if (wr == 1) PG8_BAR; }
    }
    PG8_WAIT_V(0);
    if constexpr (!ALIGN_EPI) { if (wr == 0) PG8_BAR; }
    PG8_BAR;
    if constexpr (Epi::AFTER_DRAIN) { E.fused(acc, cur, wr, wc, fr, fq, lds, wid, lane); S.done(cur); }
#undef PG8_SA
#undef PG8_SB
#undef PG8_STAGE
#undef PG8_LDA
#undef PG8_LDB
#undef PG8_MMA
#undef PG8_WAIT_V
#undef PG8_WAIT_L
#undef PG8_BAR
#undef PG8_SCHED
}
}

namespace att {
using bf16 = unsigned short;
constexpr int D = 128, NW = 8, QBLK = 32, KVBLK = 64;
constexpr float SCALE = 0.088388347648318440f;
constexpr float THR = 8.f;
constexpr int SDEPTH = 2;
constexpr int LDQ = INC, LDK = INC, LDO = DM;
constexpr size_t SHM_V = KVBLK * D * 2, SHM_K = KVBLK * D * 2, SHM_ATTN = 2 * SHM_V + 2 * SHM_K + NW * 64 * 4;

using bf16x8 = __attribute__((ext_vector_type(8))) short;
using s16x4  = __attribute__((ext_vector_type(4))) short;
using f32x16 = __attribute__((ext_vector_type(16))) float;
using f32x8  = __attribute__((ext_vector_type(8))) float;
using u32x4  = __attribute__((ext_vector_type(4))) unsigned;
#define KSWZ(row, colB) ((row) * 256 + ((colB) ^ (((row) & 7) << 4)))
#define SBAR() __builtin_amdgcn_sched_barrier(0)
__device__ __forceinline__ int crow(int r, int hi) { return (r & 3) + 8 * (r >> 2) + 4 * hi; }
__device__ __forceinline__ unsigned cvtpk(float lo, float hi) {
  unsigned r; asm volatile("v_cvt_pk_bf16_f32 %0, %1, %2" : "=v"(r) : "v"(lo), "v"(hi)); return r;
}
template <typename TIn> struct Stage;
template <> struct Stage<bf16>  { using T = bf16x8;
  __device__ static __forceinline__ T ld8(const bf16* p) { return *reinterpret_cast<const bf16x8*>(p); }
  __device__ static __forceinline__ bf16x8 tobf(T x) { return x; } };
template <> struct Stage<float> { using T = f32x8;
  __device__ static __forceinline__ T ld8(const float* p) { return *reinterpret_cast<const f32x8*>(p); }
  __device__ static __forceinline__ bf16x8 tobf(T x) {
    u32x4 w = {cvtpk(x[0], x[1]), cvtpk(x[2], x[3]), cvtpk(x[4], x[5]), cvtpk(x[6], x[7])}; return *reinterpret_cast<bf16x8*>(&w); } };

__device__ __forceinline__ void partialSM(f32x16& p0, f32x16& p1, float& m_reg, float& mn, float& alpha) {
  constexpr float C = SCALE * 1.4426950408889634f;
  float pmax = p0[0]; for (int r = 1; r < 16; ++r) pmax = fmaxf(pmax, p0[r]); for (int r = 0; r < 16; ++r) pmax = fmaxf(pmax, p1[r]);
  { auto rr = __builtin_amdgcn_permlane32_swap(__float_as_uint(pmax), __float_as_uint(pmax), false, false);
    pmax = fmaxf(__uint_as_float(rr[0]), __uint_as_float(rr[1])); }
  if (__builtin_expect(__all(pmax - m_reg <= THR / SCALE), 1)) { mn = m_reg; alpha = 1.f; }
  else { mn = fmaxf(m_reg, pmax); alpha = __builtin_amdgcn_exp2f((m_reg - mn) * C); m_reg = mn; }
  float mnC = -mn * C;
  for (int r = 0; r < 16; ++r) p0[r] = fmaf(p0[r], C, mnC); for (int r = 0; r < 16; ++r) p1[r] = fmaf(p1[r], C, mnC);
  for (int r = 0; r < 16; ++r) p0[r] = __builtin_amdgcn_exp2f(p0[r]);
}
__device__ __forceinline__ void finishSM(f32x16& p0, f32x16& p1, float alpha, float& l_reg, bf16x8& pa0, bf16x8& pa1, bf16x8& pa2, bf16x8& pa3) {
  for (int r = 0; r < 16; ++r) p1[r] = __builtin_amdgcn_exp2f(p1[r]);
  float ps = 0; for (int r = 0; r < 16; ++r) ps += p0[r]; for (int r = 0; r < 16; ++r) ps += p1[r];
  { auto rr = __builtin_amdgcn_permlane32_swap(__float_as_uint(ps), __float_as_uint(ps), false, false);
    ps = __uint_as_float(rr[0]) + __uint_as_float(rr[1]); }
  l_reg = l_reg * alpha + ps;
#define PK4(P, BASE, OUT) do { unsigned a0 = cvtpk(P[BASE + 0], P[BASE + 1]), a1 = cvtpk(P[BASE + 2], P[BASE + 3]);   \
    unsigned b0 = cvtpk(P[BASE + 4], P[BASE + 5]), b1 = cvtpk(P[BASE + 6], P[BASE + 7]);                              \
    auto r0 = __builtin_amdgcn_permlane32_swap(a0, b0, false, false); auto r1 = __builtin_amdgcn_permlane32_swap(a1, b1, false, false); \
    u32x4 w = {r0[0], r1[0], r0[1], r1[1]}; OUT = *reinterpret_cast<bf16x8*>(&w); } while (0)
  PK4(p0, 0, pa0); PK4(p0, 8, pa1); PK4(p1, 0, pa2); PK4(p1, 8, pa3);
#undef PK4
}
__device__ __forceinline__ void qkt(f32x16& p0, f32x16& p1, const bf16* Ks, const bf16x8* qr, int r32, int hi) {
  p0 = f32x16{}; p1 = f32x16{};
  for (int d0 = 0; d0 < 8; ++d0) { int cb = (d0 * 16 + hi * 8) * 2;
    bf16x8 b0 = *reinterpret_cast<const bf16x8*>((const char*)Ks + KSWZ(r32, cb));
    bf16x8 b1 = *reinterpret_cast<const bf16x8*>((const char*)Ks + KSWZ(32 + r32, cb));
    p0 = __builtin_amdgcn_mfma_f32_32x32x16_bf16(b0, qr[d0], p0, 0, 0, 0);
    p1 = __builtin_amdgcn_mfma_f32_32x32x16_bf16(b1, qr[d0], p1, 0, 0, 0); }
}
__device__ __forceinline__ int v_st(int k, int c) { const int kk = (k & ~0xC) | ((k & 4) << 1) | ((k & 8) >> 1); return ((kk >> 3) * 4 + (c >> 5)) * 512 + ((kk & 7) * 32 + (c & 31)) * 2; }
__device__ __forceinline__ int v_rd_base(int lane) { return ((lane & 3) << 3) | (((lane >> 2) & 3) << 6) | (((lane >> 4) & 1) << 5) | (((lane >> 5) & 1) << 8); }
constexpr int v_rd_off(int d0, int ks, int half) { return d0 * 512 + ks * 4096 + half * 2048; }
template <int OFF> __device__ __forceinline__ s16x4 tr_read(int vb) {
  s16x4 r; asm volatile("ds_read_b64_tr_b16 %0, %1 offset:%2" : "=&v"(r) : "v"(vb), "i"(OFF) : "memory"); return r;
}
template <int D0> __device__ __forceinline__ void pv_one(f32x16& od, int vb, bf16x8 pa0, bf16x8 pa1, bf16x8 pa2, bf16x8 pa3) {
  const s16x4 l0 = tr_read<v_rd_off(D0, 0, 0)>(vb), h0 = tr_read<v_rd_off(D0, 0, 1)>(vb), l1 = tr_read<v_rd_off(D0, 1, 0)>(vb), h1 = tr_read<v_rd_off(D0, 1, 1)>(vb);
  const s16x4 l2 = tr_read<v_rd_off(D0, 2, 0)>(vb), h2 = tr_read<v_rd_off(D0, 2, 1)>(vb), l3 = tr_read<v_rd_off(D0, 3, 0)>(vb), h3 = tr_read<v_rd_off(D0, 3, 1)>(vb);
  asm volatile("s_waitcnt lgkmcnt(0)" ::: "memory"); SBAR();
#define PK(L, H) (bf16x8){L[0], L[1], L[2], L[3], H[0], H[1], H[2], H[3]}
  od = __builtin_amdgcn_mfma_f32_32x32x16_bf16(pa0, PK(l0, h0), od, 0, 0, 0);
  od = __builtin_amdgcn_mfma_f32_32x32x16_bf16(pa1, PK(l1, h1), od, 0, 0, 0);
  od = __builtin_amdgcn_mfma_f32_32x32x16_bf16(pa2, PK(l2, h2), od, 0, 0, 0);
  od = __builtin_amdgcn_mfma_f32_32x32x16_bf16(pa3, PK(l3, h3), od, 0, 0, 0);
#undef PK
}
__device__ __forceinline__ void pv_d0(f32x16* o, int vb, bf16x8 pa0, bf16x8 pa1, bf16x8 pa2, bf16x8 pa3) {
  pv_one<0>(o[0], vb, pa0, pa1, pa2, pa3); pv_one<1>(o[1], vb, pa0, pa1, pa2, pa3); pv_one<2>(o[2], vb, pa0, pa1, pa2, pa3); pv_one<3>(o[3], vb, pa0, pa1, pa2, pa3);
}

__device__ __forceinline__ void band_mask(f32x16& p0, f32x16& p1, int dq  , int hi) {
#pragma unroll
  for (int r = 0; r < 16; ++r) { const int d = dq - crow(r, hi);
    if ((unsigned)(d + 128) > 256u) p0[r] = -1e30f;
    if ((unsigned)(d + 96) > 256u) p1[r] = -1e30f; }
}
template <bool MASK>
__device__ __forceinline__ void attn_body(const bf16* __restrict__ Qb, const bf16* __restrict__ Kh, const bf16* __restrict__ Vh,
                                          bf16* __restrict__ Ob, int NT, int NCT, int lo, int qpos0, float sinkl2, char* lds) {
  using St = Stage<bf16>;
  int tid_ = threadIdx.x; asm volatile("" : "+v"(tid_));
  const int tid = tid_, wid = tid >> 6, lane = tid & 63, r32 = lane & 31, hi = lane >> 5;
  bf16* V_lds = (bf16*)lds; bf16* K_lds = (bf16*)(lds + 2 * SHM_V);
  float* ws = (float*)(lds + 2 * SHM_V + 2 * SHM_K) + wid * 64; float* li_l = ws; float* al_l = ws + 32;
  float m_reg = -1e30f, l_reg = 0; f32x16 o[4] = {}; bf16x8 qr[8];
  const bf16* Qw = Qb + (long)(wid * QBLK + r32) * LDQ + hi * 8;
#pragma unroll
  for (int d0 = 0; d0 < 8; ++d0) qr[d0] = St::ld8(Qw + d0 * 16);
  const int sr = tid >> 4, sc = (tid & 15) * 8, vst0 = v_st(sr, sc), vst1 = v_st(32 + sr, sc);
  const int vb0 = (int)(uintptr_t)V_lds + v_rd_base(lane);
  const int qi = qpos0 + wid * QBLK + r32;
  struct { typename St::T vs0, vs1, ks0, ks1; } sr_[SDEPTH];
#define TROW(j) (64 * (j) + ((j) >= NCT ? lo : 0))
#define SLOAD(i, k0) do { const long k0_ = (k0); sr_[i].vs0 = St::ld8(&Vh[(k0_ + sr) * LDK + sc]); sr_[i].vs1 = St::ld8(&Vh[(k0_ + 32 + sr) * LDK + sc]); \
    sr_[i].ks0 = St::ld8(&Kh[(k0_ + sr) * LDK + sc]); sr_[i].ks1 = St::ld8(&Kh[(k0_ + 32 + sr) * LDK + sc]); } while (0)
#define SWRITE(b, i) do { *(bf16x8*)((char*)V_lds + (b) * SHM_V + vst0) = St::tobf(sr_[i].vs0);          \
    *(bf16x8*)((char*)V_lds + (b) * SHM_V + vst1) = St::tobf(sr_[i].vs1); int kc = sc * 2;               \
    *(bf16x8*)((char*)K_lds + (b) * SHM_K + KSWZ(sr, kc)) = St::tobf(sr_[i].ks0);                       \
    *(bf16x8*)((char*)K_lds + (b) * SHM_K + KSWZ(32 + sr, kc)) = St::tobf(sr_[i].ks1); } while (0)
#define SWAIT() do { if constexpr (SDEPTH == 2) asm volatile("s_waitcnt vmcnt(4)" ::: "memory"); else asm volatile("s_waitcnt vmcnt(0)" ::: "memory"); } while (0)
#define RESC(a) do { if (__any((a) < 1.f)) { if (hi == 0) al_l[r32] = (a); asm volatile("s_waitcnt lgkmcnt(0)" ::: "memory"); \
    for (int d = 0; d < 4; ++d) for (int r = 0; r < 16; ++r) o[d][r] *= al_l[crow(r, hi)]; } } while (0)
#define AMASK(P0, P1, j) do { if constexpr (MASK) { if ((j) >= NCT) band_mask(P0, P1, qi - (lo + 64 * ((j) - NCT)), hi); } } while (0)
  f32x16 pA0, pA1, pB0, pB1; float mnA, mnB, alA, alB; bf16x8 pa0, pa1, pa2, pa3;
  constexpr int SE = 0, SO = SDEPTH - 1;
  SLOAD(SE, TROW(0)); asm volatile("s_waitcnt vmcnt(0)" ::: "memory"); SWRITE(0, SE); __syncthreads();
  qkt(pA0, pA1, K_lds, qr, r32, hi); AMASK(pA0, pA1, 0); partialSM(pA0, pA1, m_reg, mnA, alA);
  SLOAD(SO, TROW(1)); if constexpr (SDEPTH == 2) { if (2 < NT) SLOAD(SE, TROW(2)); }
  SWAIT(); SWRITE(1, SO); __syncthreads();
  for (int j = 1; j + 1 < NT; j += 2) {
    SBAR(); qkt(pB0, pB1, (bf16*)((char*)K_lds + SHM_K), qr, r32, hi); AMASK(pB0, pB1, j);
    finishSM(pA0, pA1, alA, l_reg, pa0, pa1, pa2, pa3); SBAR();
    SLOAD(SO, TROW(j + SDEPTH)); SBAR();
    pv_d0(o, vb0, pa0, pa1, pa2, pa3); partialSM(pB0, pB1, m_reg, mnB, alB);
    __syncthreads(); SWAIT(); SWRITE(0, SE);
    RESC(alB); __syncthreads();
    SBAR(); qkt(pA0, pA1, K_lds, qr, r32, hi); AMASK(pA0, pA1, j + 1);
    finishSM(pB0, pB1, alB, l_reg, pa0, pa1, pa2, pa3); SBAR();
    if (SDEPTH == 1 || j + 3 < NT) SLOAD(SE, TROW(j + 1 + SDEPTH)); SBAR();
    pv_d0(o, vb0 + (int)SHM_V, pa0, pa1, pa2, pa3); partialSM(pA0, pA1, m_reg, mnA, alA);
    __syncthreads(); SWAIT(); SWRITE(1, SO);
    RESC(alA); __syncthreads();
  }
  SBAR(); qkt(pB0, pB1, (bf16*)((char*)K_lds + SHM_K), qr, r32, hi); AMASK(pB0, pB1, NT - 1);
  finishSM(pA0, pA1, alA, l_reg, pa0, pa1, pa2, pa3); SBAR();
  pv_d0(o, vb0, pa0, pa1, pa2, pa3); partialSM(pB0, pB1, m_reg, mnB, alB);
  __syncthreads(); RESC(alB);
  finishSM(pB0, pB1, alB, l_reg, pa0, pa1, pa2, pa3); SBAR();
  pv_d0(o, vb0 + (int)SHM_V, pa0, pa1, pa2, pa3);
  l_reg += __builtin_amdgcn_exp2f(sinkl2 - m_reg * (SCALE * 1.4426950408889634f));
  if (hi == 0) li_l[r32] = l_reg; asm volatile("s_waitcnt lgkmcnt(0)" ::: "memory");
  float rli[16];
#pragma unroll
  for (int r = 0; r < 16; ++r) rli[r] = __builtin_amdgcn_rcpf(li_l[crow(r, hi)]);
  bf16* Ow = Ob + (long)(wid * QBLK) * LDO;
#pragma unroll
  for (int r = 0; r < 16; ++r) { int orow = crow(r, hi);
    for (int d0 = 0; d0 < 4; ++d0) { const float v = o[d0][r] * rli[r]; const unsigned u = __builtin_bit_cast(unsigned, v);
      Ow[(long)orow * LDO + d0 * 32 + r32] = (bf16)((u + 0x7fffu + ((u >> 16) & 1u)) >> 16); } }
  __syncthreads();
#undef TROW
#undef SLOAD
#undef SWRITE
#undef SWAIT
#undef RESC
#undef AMASK
}

template <int OFF> __device__ __forceinline__ bf16x8 k_read(int addr) { bf16x8 r; asm volatile("ds_read_b128 %0, %1 offset:%2" : "=&v"(r) : "v"(addr), "i"(OFF) : "memory"); return r; }
__device__ __forceinline__ void qkt_pipe(f32x16& p0, f32x16& p1, const bf16* Ks, const bf16x8* qr, int r32, int hi) {
  p0 = f32x16{}; p1 = f32x16{};
  const int kb = (int)(uintptr_t)Ks + r32 * 256, sw = (r32 & 7) << 4;
  const int e0 = kb + ((0 * 32 + hi * 16) ^ sw), e1 = kb + ((1 * 32 + hi * 16) ^ sw), e2 = kb + ((2 * 32 + hi * 16) ^ sw), e3 = kb + ((3 * 32 + hi * 16) ^ sw);
  bf16x8 a0, a1, b0, b1;
#define LGK(n) do { asm volatile("s_waitcnt lgkmcnt(" #n ")" ::: "memory"); SBAR(); } while (0)
#define MM(A0, A1, d) do { p0 = __builtin_amdgcn_mfma_f32_32x32x16_bf16(A0, qr[d], p0, 0, 0, 0); p1 = __builtin_amdgcn_mfma_f32_32x32x16_bf16(A1, qr[d], p1, 0, 0, 0); SBAR(); } while (0)
  a0 = k_read<0>(e0); a1 = k_read<8192>(e0); b0 = k_read<0>(e1); b1 = k_read<8192>(e1);
  LGK(2); MM(a0, a1, 0); a0 = k_read<0>(e2); a1 = k_read<8192>(e2);
  LGK(2); MM(b0, b1, 1); b0 = k_read<0>(e3); b1 = k_read<8192>(e3);
  LGK(2); MM(a0, a1, 2); a0 = k_read<128>(e0); a1 = k_read<8320>(e0);
  LGK(2); MM(b0, b1, 3); b0 = k_read<128>(e1); b1 = k_read<8320>(e1);
  LGK(2); MM(a0, a1, 4); a0 = k_read<128>(e2); a1 = k_read<8320>(e2);
  LGK(2); MM(b0, b1, 5); b0 = k_read<128>(e3); b1 = k_read<8320>(e3);
  LGK(2); MM(a0, a1, 6);
  LGK(0); MM(b0, b1, 7);
#undef LGK
#undef MM
}
struct VFr { s16x4 l0, h0, l1, h1, l2, h2, l3, h3; };
template <int DB> __device__ __forceinline__ void pv_ld(VFr& f, int vb) {
  constexpr int I = (DB >> 2) * 16384, D0 = DB & 3;
  f.l0 = tr_read<I + v_rd_off(D0, 0, 0)>(vb); f.h0 = tr_read<I + v_rd_off(D0, 0, 1)>(vb); f.l1 = tr_read<I + v_rd_off(D0, 1, 0)>(vb); f.h1 = tr_read<I + v_rd_off(D0, 1, 1)>(vb);
  f.l2 = tr_read<I + v_rd_off(D0, 2, 0)>(vb); f.h2 = tr_read<I + v_rd_off(D0, 2, 1)>(vb); f.l3 = tr_read<I + v_rd_off(D0, 3, 0)>(vb); f.h3 = tr_read<I + v_rd_off(D0, 3, 1)>(vb);
}
__device__ __forceinline__ void pv_mm(f32x16& od, const VFr& f, bf16x8 pa0, bf16x8 pa1, bf16x8 pa2, bf16x8 pa3) {
#define PK(L, H) (bf16x8){L[0], L[1], L[2], L[3], H[0], H[1], H[2], H[3]}
  od = __builtin_amdgcn_mfma_f32_32x32x16_bf16(pa0, PK(f.l0, f.h0), od, 0, 0, 0);
  od = __builtin_amdgcn_mfma_f32_32x32x16_bf16(pa1, PK(f.l1, f.h1), od, 0, 0, 0);
  od = __builtin_amdgcn_mfma_f32_32x32x16_bf16(pa2, PK(f.l2, f.h2), od, 0, 0, 0);
  od = __builtin_amdgcn_mfma_f32_32x32x16_bf16(pa3, PK(f.l3, f.h3), od, 0, 0, 0);
#undef PK
}
__device__ __forceinline__ void pv_all(f32x16* o, int vb, bf16x8 pa0, bf16x8 pa1, bf16x8 pa2, bf16x8 pa3) {
  VFr fa, fb;
#define W8() do { asm volatile("s_waitcnt lgkmcnt(8)" ::: "memory"); SBAR(); } while (0)
#define W0() do { asm volatile("s_waitcnt lgkmcnt(0)" ::: "memory"); SBAR(); } while (0)
  pv_ld<0>(fa, vb);
  pv_ld<1>(fb, vb); W8(); pv_mm(o[0], fa, pa0, pa1, pa2, pa3); SBAR();
  pv_ld<2>(fa, vb); W8(); pv_mm(o[1], fb, pa0, pa1, pa2, pa3); SBAR();
  pv_ld<3>(fb, vb); W8(); pv_mm(o[2], fa, pa0, pa1, pa2, pa3); SBAR();
  pv_ld<4>(fa, vb); W8(); pv_mm(o[3], fb, pa0, pa1, pa2, pa3); SBAR();
  pv_ld<5>(fb, vb); W8(); pv_mm(o[4], fa, pa0, pa1, pa2, pa3); SBAR();
  pv_ld<6>(fa, vb); W8(); pv_mm(o[5], fb, pa0, pa1, pa2, pa3); SBAR();
  pv_ld<7>(fb, vb); W8(); pv_mm(o[6], fa, pa0, pa1, pa2, pa3); SBAR();
  W0(); pv_mm(o[7], fb, pa0, pa1, pa2, pa3);
#undef W8
#undef W0
}
#define ATT_LAS __attribute__((address_space(3)))
struct VH { s16x4 l0, h0, l1, h1; };
template <int DB, int KS> __device__ __forceinline__ void pv_ldh(VH& f, int vb) {
  constexpr int I = (DB >> 2) * 16384, D0 = DB & 3;
  f.l0 = tr_read<I + v_rd_off(D0, KS, 0)>(vb); f.h0 = tr_read<I + v_rd_off(D0, KS, 1)>(vb); f.l1 = tr_read<I + v_rd_off(D0, KS + 1, 0)>(vb); f.h1 = tr_read<I + v_rd_off(D0, KS + 1, 1)>(vb);
}
#define PKV(L, H) (bf16x8){L[0], L[1], L[2], L[3], H[0], H[1], H[2], H[3]}
#define PK4S(P, BASE, OUT) do { unsigned a0_ = cvtpk(P[BASE + 0], P[BASE + 1]), a1_ = cvtpk(P[BASE + 2], P[BASE + 3]);   \
    unsigned b0_ = cvtpk(P[BASE + 4], P[BASE + 5]), b1_ = cvtpk(P[BASE + 6], P[BASE + 7]);                              \
    auto r0_ = __builtin_amdgcn_permlane32_swap(a0_, b0_, false, false); auto r1_ = __builtin_amdgcn_permlane32_swap(a1_, b1_, false, false); \
    u32x4 w_ = {r0_[0], r1_[0], r0_[1], r1_[1]}; OUT = *reinterpret_cast<bf16x8*>(&w_); } while (0)
__device__ __forceinline__ void smpv_all(f32x16& p0, f32x16& p1, float alpha, float& l_reg, f32x16* o, int vb,
                                         const char* kb, const char* vbg, ATT_LAS unsigned char* kdst, ATT_LAS unsigned char* vdst, bool dma) {
  bf16x8 pa0, pa1, pa2, pa3; VH fa, fb; float s0 = 0.f, s1 = 0.f;
  PK4S(p0, 0, pa0); PK4S(p0, 8, pa1);
#define WL(n) do { asm volatile("s_waitcnt lgkmcnt(" #n ")" ::: "memory"); SBAR(); } while (0)
#define P1BLK(B, FC, FN, LAST) do { if (!(LAST)) pv_ldh<((B) + 1) & 7, 0>(FN, vb); if (LAST) WL(0); else WL(4); \
    o[B] = __builtin_amdgcn_mfma_f32_32x32x16_bf16(pa0, PKV(FC.l0, FC.h0), o[B], 0, 0, 0); \
    p1[2 * (B)] = __builtin_amdgcn_exp2f(p1[2 * (B)]); s0 += p0[2 * (B)]; s1 += p0[2 * (B) + 1]; SBAR(); \
    o[B] = __builtin_amdgcn_mfma_f32_32x32x16_bf16(pa1, PKV(FC.l1, FC.h1), o[B], 0, 0, 0); \
    p1[2 * (B) + 1] = __builtin_amdgcn_exp2f(p1[2 * (B) + 1]); if ((B) > 0) { s0 += p1[2 * (B) - 2]; s1 += p1[2 * (B) - 1]; } SBAR(); } while (0)
  pv_ldh<0, 0>(fa, vb);
  P1BLK(0, fa, fb, false); P1BLK(1, fb, fa, false); P1BLK(2, fa, fb, false); P1BLK(3, fb, fa, false);
  P1BLK(4, fa, fb, false); P1BLK(5, fb, fa, false); P1BLK(6, fa, fb, false); P1BLK(7, fb, fa, true);
  pv_ldh<0, 2>(fa, vb);
  s0 += p1[14]; s1 += p1[15];
  float ps = s0 + s1;
  { auto rr = __builtin_amdgcn_permlane32_swap(__float_as_uint(ps), __float_as_uint(ps), false, false); ps = __uint_as_float(rr[0]) + __uint_as_float(rr[1]); }
  l_reg = l_reg * alpha + ps;
  PK4S(p1, 0, pa2); PK4S(p1, 8, pa3); SBAR();
#define DMAP(B) do { if (dma) { if ((B) < 2) __builtin_amdgcn_global_load_lds((const unsigned*)(kb + (B) * (32 * LDK * 2)), (ATT_LAS unsigned*)(kdst + (B) * 8192), 16, 0, 0); \
      else if ((B) < 6) __builtin_amdgcn_global_load_lds((const unsigned*)(vbg + (((B) - 2) & 1) * (32 * LDK * 2) + (((B) - 2) >> 1) * 256), (ATT_LAS unsigned*)(vdst + ((B) - 2) * 8192), 16, 0, 0); } } while (0)
#define P2BLK(B, FC, FN, LAST) do { if (!(LAST)) pv_ldh<((B) + 1) & 7, 2>(FN, vb); if (LAST) WL(0); else WL(4); \
    o[B] = __builtin_amdgcn_mfma_f32_32x32x16_bf16(pa2, PKV(FC.l0, FC.h0), o[B], 0, 0, 0); DMAP(B); \
    o[B] = __builtin_amdgcn_mfma_f32_32x32x16_bf16(pa3, PKV(FC.l1, FC.h1), o[B], 0, 0, 0); SBAR(); } while (0)
  P2BLK(0, fa, fb, false); P2BLK(1, fb, fa, false); P2BLK(2, fa, fb, false); P2BLK(3, fb, fa, false);
  P2BLK(4, fa, fb, false); P2BLK(5, fb, fa, false); P2BLK(6, fa, fb, false); P2BLK(7, fb, fa, true);
#undef WL
#undef P1BLK
#undef P2BLK
#undef DMAP
}
#undef PKV
#undef PK4S
__device__ __forceinline__ void attn_body_v256(const bf16* __restrict__ Qb, const bf16* __restrict__ Kh, const bf16* __restrict__ Vh,
                                               bf16* __restrict__ Ob, int NT, ATT_LAS unsigned char* ldsl) {
  using St = Stage<bf16>;
  int tid_ = threadIdx.x; asm volatile("" : "+v"(tid_));
  const int tid = tid_, wid = __builtin_amdgcn_readfirstlane(tid >> 6), lane = tid & 63, r32 = lane & 31, hi = lane >> 5;
  char* lds = (char*)ldsl;
  float* ws = (float*)(lds + 147456) + wid * 64; float* li_l = ws; float* al_l = ws + 32;
  float m_reg = -1e30f, l_reg = 0; f32x16 o[8] = {}; bf16x8 qr[8];
  const bf16* Qw = Qb + (long)(wid * QBLK + r32) * LDQ + hi * 8;
#pragma unroll
  for (int d0 = 0; d0 < 8; ++d0) qr[d0] = St::ld8(Qw + d0 * 16);
  unsigned offK0, offV0;
  { const int row = wid * 4 + (lane >> 4), colB = ((lane & 15) * 16) ^ ((row & 7) << 4); offK0 = (unsigned)row * (LDK * 2) + (unsigned)colB;
    const int sub = wid * 2 + (lane >> 5), kkhi = sub >> 2, cblk = sub & 3, within = (lane & 31) * 16, kk = kkhi * 8 + (within >> 6);
    const int k = (kk & ~0xC) | ((kk & 4) << 1) | ((kk & 8) >> 1), c = cblk * 32 + ((within & 63) >> 1);
    offV0 = (unsigned)k * (LDK * 2) + (unsigned)c * 2; }
  const int vb0 = (int)(uintptr_t)lds + 16384 + v_rd_base(lane);
#define DMA_TILE(j, sbo) do { const char* kb_ = (const char*)Kh + (size_t)(j) * (64 * LDK * 2) + offK0; const char* vb_ = (const char*)Vh + (size_t)(j) * (64 * LDK * 2) + offV0; \
    _Pragma("unroll") for (int i_ = 0; i_ < 2; ++i_) __builtin_amdgcn_global_load_lds((const unsigned*)(kb_ + i_ * (32 * LDK * 2)), (ATT_LAS unsigned*)(ldsl + (sbo) + (i_ * 8 + wid) * 1024), 16, 0, 0); \
    _Pragma("unroll") for (int i_ = 0; i_ < 4; ++i_) __builtin_amdgcn_global_load_lds((const unsigned*)(vb_ + (i_ & 1) * (32 * LDK * 2) + (i_ >> 1) * 256), (ATT_LAS unsigned*)(ldsl + (sbo) + 16384 + (i_ * 8 + wid) * 1024), 16, 0, 0); } while (0)
#define RESC8(a) do { if (__any((a) < 1.f)) { if (hi == 0) al_l[r32] = (a); asm volatile("s_waitcnt lgkmcnt(0)" ::: "memory"); \
    for (int d = 0; d < 8; ++d) for (int r = 0; r < 16; ++r) o[d][r] *= al_l[crow(r, hi)]; } } while (0)
#define TILE_SYNC() do { asm volatile("s_waitcnt vmcnt(0)" ::: "memory"); __builtin_amdgcn_s_barrier(); asm volatile("" ::: "memory"); } while (0)
  f32x16 p0, p1; float mn, al;
#pragma unroll
  for (int d0 = 0; d0 < 8; ++d0) asm volatile("" : "+v"(qr[d0]));
  if (wid >= 4) __builtin_amdgcn_s_setprio(2);
  DMA_TILE(0, 0); DMA_TILE(1, 49152);
  int sb = 0, sb2 = 98304;
  for (int j = 0; j < NT; ++j) {
    if (j + 1 < NT) asm volatile("s_waitcnt vmcnt(6)" ::: "memory"); else asm volatile("s_waitcnt vmcnt(0)" ::: "memory");
    __builtin_amdgcn_s_barrier(); asm volatile("" ::: "memory");
    qkt_pipe(p0, p1, (const bf16*)(lds + sb), qr, r32, hi); partialSM(p0, p1, m_reg, mn, al); RESC8(al); SBAR();
    smpv_all(p0, p1, al, l_reg, o, vb0 + sb, (const char*)Kh + (size_t)(j + 2) * (64 * LDK * 2) + offK0, (const char*)Vh + (size_t)(j + 2) * (64 * LDK * 2) + offV0,
             ldsl + sb2 + wid * 1024, ldsl + sb2 + 16384 + wid * 1024, j + 2 < NT);
    sb = (sb == 98304) ? 0 : sb + 49152; sb2 = (sb2 == 98304) ? 0 : sb2 + 49152;
  }
  __builtin_amdgcn_s_setprio(0);
  if (hi == 0) li_l[r32] = l_reg; asm volatile("s_waitcnt lgkmcnt(0)" ::: "memory");
  float rli[16];
#pragma unroll
  for (int r = 0; r < 16; ++r) rli[r] = __builtin_amdgcn_rcpf(li_l[crow(r, hi)]);
  bf16* Ow = Ob + (long)(wid * QBLK) * LDO;
#pragma unroll
  for (int r = 0; r < 16; ++r) { int orow = crow(r, hi);
#pragma unroll
    for (int d0 = 0; d0 < 8; ++d0) { const float v = o[d0][r] * rli[r]; const unsigned u = __builtin_bit_cast(unsigned, v);
      Ow[(long)orow * LDO + d0 * 32 + r32] = (bf16)((u + 0x7fffu + ((u >> 16) & 1u)) >> 16); } }
#undef DMA_TILE
#undef RESC8
#undef TILE_SYNC
}
__device__ __forceinline__ void attn_body_a(const bf16* __restrict__ Qb, const bf16* __restrict__ Kh, const bf16* __restrict__ Vh, bf16* __restrict__ Ob,
                                            int NT, int NCT, int lo, int qpos0, const float* __restrict__ sk4, ATT_LAS unsigned char* ldsl) {
  using St = Stage<bf16>;
  int tid_ = threadIdx.x; asm volatile("" : "+v"(tid_));
  const int tid = tid_, wid = __builtin_amdgcn_readfirstlane(tid >> 6), lane = tid & 63, r32 = lane & 31, hi = lane >> 5;
  const int g = wid >> 1, rh = wid & 1;
  char* lds = (char*)ldsl;
  float* ws = (float*)(lds + 98304) + wid * 64; float* li_l = ws; float* al_l = ws + 32;
  float m_reg = -1e30f, l_reg = 0; f32x16 o[4] = {}; bf16x8 qr[8];
  const bf16* Qw = Qb + (long)(rh * QBLK + r32) * LDQ + g * 128 + hi * 8;
#pragma unroll
  for (int d0 = 0; d0 < 8; ++d0) qr[d0] = St::ld8(Qw + d0 * 16);
  const float sinkl2 = sk4[g] * 1.4426950408889634f;
  const int qi = qpos0 + rh * QBLK + r32;
  unsigned offK0, offV0;
  { const int row = wid * 4 + (lane >> 4), colB = ((lane & 15) * 16) ^ ((row & 7) << 4); offK0 = (unsigned)row * (LDK * 2) + (unsigned)colB;
    const int sub = wid * 2 + (lane >> 5), kkhi = sub >> 2, cblk = sub & 3, within = (lane & 31) * 16, kk = kkhi * 8 + (within >> 6);
    const int k = (kk & ~0xC) | ((kk & 4) << 1) | ((kk & 8) >> 1), c = cblk * 32 + ((within & 63) >> 1);
    offV0 = (unsigned)k * (LDK * 2) + (unsigned)c * 2; }
  const int vb0 = (int)(uintptr_t)lds + 16384 + v_rd_base(lane);
#define TROWA(j) (64 * (j) + ((j) >= NCT ? lo : 0))
#define DMA_TILE(j, sb) do { const size_t ro_ = (size_t)TROWA(j) * (LDK * 2); const char* kb_ = (const char*)Kh + ro_ + offK0; const char* vb_ = (const char*)Vh + ro_ + offV0; \
    _Pragma("unroll") for (int i_ = 0; i_ < 2; ++i_) { __builtin_amdgcn_global_load_lds((const unsigned*)(kb_ + i_ * (32 * LDK * 2)), (ATT_LAS unsigned*)(ldsl + (sb) + (i_ * 8 + wid) * 1024), 16, 0, 0); \
      __builtin_amdgcn_global_load_lds((const unsigned*)(vb_ + i_ * (32 * LDK * 2)), (ATT_LAS unsigned*)(ldsl + (sb) + 16384 + (i_ * 8 + wid) * 1024), 16, 0, 0); } } while (0)
#define RESC4(a) do { if (__any((a) < 1.f)) { if (hi == 0) al_l[r32] = (a); asm volatile("s_waitcnt lgkmcnt(0)" ::: "memory"); \
    for (int d = 0; d < 4; ++d) for (int r = 0; r < 16; ++r) o[d][r] *= al_l[crow(r, hi)]; } } while (0)
  f32x16 p0, p1; float mn, al; bf16x8 pa0, pa1, pa2, pa3;
#pragma unroll
  for (int d0 = 0; d0 < 8; ++d0) asm volatile("" : "+v"(qr[d0]));
  DMA_TILE(0, 0);
  int sb = 0;
  for (int j = 0; j < NT; ++j) {
    asm volatile("s_waitcnt vmcnt(0)" ::: "memory"); __builtin_amdgcn_s_barrier(); asm volatile("" ::: "memory");
    if (j + 1 < NT) DMA_TILE(j + 1, sb ^ 32768);
    qkt_pipe(p0, p1, (const bf16*)(lds + sb), qr, r32, hi);
    if (j >= NCT) band_mask(p0, p1, qi - (lo + 64 * (j - NCT)), hi);
    partialSM(p0, p1, m_reg, mn, al); RESC4(al); finishSM(p0, p1, al, l_reg, pa0, pa1, pa2, pa3); SBAR();
    pv_d0(o, vb0 + sb, pa0, pa1, pa2, pa3);
    sb ^= 32768;
  }
  l_reg += __builtin_amdgcn_exp2f(sinkl2 - m_reg * (SCALE * 1.4426950408889634f));
  if (hi == 0) li_l[r32] = l_reg; asm volatile("s_waitcnt lgkmcnt(0)" ::: "memory");
  float rli[16];
#pragma unroll
  for (int r = 0; r < 16; ++r) rli[r] = __builtin_amdgcn_rcpf(li_l[crow(r, hi)]);
  bf16* Ow = Ob + (long)(rh * QBLK) * LDO + g * 128;
#pragma unroll
  for (int r = 0; r < 16; ++r) { int orow = crow(r, hi);
#pragma unroll
    for (int d0 = 0; d0 < 4; ++d0) { const float v = o[d0][r] * rli[r]; const unsigned u = __builtin_bit_cast(unsigned, v);
      Ow[(long)orow * LDO + d0 * 32 + r32] = (bf16)((u + 0x7fffu + ((u >> 16) & 1u)) >> 16); } }
#undef TROWA
#undef DMA_TILE
#undef RESC4
}
}

constexpr size_t MiB = 1u << 20;
constexpr size_t SLOT = (size_t)MROWS * DM * 2;
constexpr size_t WS_MOD = 0;
constexpr size_t WS_BAR = 1 * MiB, WS_BAR_BYTES = 16384;
constexpr size_t WS_COS = 2 * MiB, WS_SIN = 4 * MiB;
constexpr size_t WS_CTX1 = 6 * MiB;
constexpr size_t WS_WINT = 16 * MiB;
constexpr size_t WS_WPT = WS_WINT + 68 * MiB;
constexpr size_t WS_PX = WS_WPT + 48 * MiB;
constexpr size_t WS_S0 = WS_PX + (size_t)MROWS * INC * 2;
constexpr size_t WS_END = WS_S0 + 5 * SLOT;
static_assert(WS_END <= 4ull * DEPTH * DM * INC * 4, "workspace map exceeds the guaranteed 4x largest tensor");

constexpr int NWAVES = 8;
constexpr int LDS_BYTES = 149760;

#define GAS __attribute__((address_space(1)))
#define LAS __attribute__((address_space(3)))
typedef unsigned short bf16;
typedef unsigned v4u __attribute__((ext_vector_type(4)));
typedef unsigned v2u __attribute__((ext_vector_type(2)));
typedef float f32x4 __attribute__((ext_vector_type(4)));
#define LDS_WAIT() asm volatile("s_waitcnt lgkmcnt(0)" ::: "memory")
__device__ __forceinline__ unsigned f2bf(float f) { unsigned u = __builtin_bit_cast(unsigned, f); return (u + 0x7fffu + ((u >> 16) & 1u)) >> 16; }
__device__ __forceinline__ unsigned pk2(float lo, float hi) { return f2bf(lo) | (f2bf(hi) << 16); }
__device__ __forceinline__ float bflo(unsigned w) { return __builtin_bit_cast(float, w << 16); }
__device__ __forceinline__ float bfhi(unsigned w) { return __builtin_bit_cast(float, w & 0xffff0000u); }
__device__ __forceinline__ float siluf(float x) { return x / (1.f + __expf(-x)); }
__device__ __forceinline__ float sigmf(float x) { return 1.f / (1.f + __expf(-x)); }

struct Frame {
    LAS unsigned char* lds;
    int vcu, G;
    const float *x, *c, *ctx, *c_ctx, *w_ada, *b_ada, *g_pre, *g_post, *w_in, *sink, *lam_qk, *g_subln, *w_pa, *w_pb, *w_out;
    float* out; unsigned char* ws;
};

#define XB_TMO      128
#define XB_XCNT(j)  (256  + 64 * (j))
#define XB_XSUB(j)  (1280 + 64 * (j))
#define XB_XGEN(j)  (2304 + 64 * (j))
#define XB_TOP      3328
#define XB_TOPGEN   3392
#define XCD_BAR_WORDS 3456
#define XB_SPIN_CAP (1u << 18)

__device__ __forceinline__ unsigned xb_ld(unsigned* p)              { return __hip_atomic_load(p, __ATOMIC_RELAXED, __HIP_MEMORY_SCOPE_AGENT); }
__device__ __forceinline__ unsigned xb_add(unsigned* p, unsigned v) { return __hip_atomic_fetch_add(p, v, __ATOMIC_RELAXED, __HIP_MEMORY_SCOPE_AGENT); }
__device__ __forceinline__ unsigned xb_xcc_id() { return (unsigned)__builtin_amdgcn_s_getreg((3 << 11) | 20) & 0xFu; }
#define XB_SPIN(cond, bar) do { unsigned _sp = 0; while (cond) { __builtin_amdgcn_s_sleep(1); \
    if ((++_sp & 255u) == 0u) { if (xb_ld(&(bar)[XB_TMO])) break; if (_sp > XB_SPIN_CAP) { atomicAdd(&(bar)[XB_TMO], 1u); break; } } } } while (0)

struct XcdBarrier {
    unsigned* bar; unsigned x;
    volatile LAS unsigned* st;
};

__device__ __forceinline__ XcdBarrier xcd_barrier_post(unsigned* bar, volatile LAS unsigned* st) {
    XcdBarrier b; b.bar = bar; b.x = xb_xcc_id(); b.st = st;
    if (threadIdx.x == 0) (void)xb_add(&bar[XB_XCNT(b.x)], 1u);
    return b;
}
__device__ __forceinline__ void xcd_barrier_complete(unsigned* bar, unsigned x, unsigned& nloc, unsigned& nx) {
    const unsigned G = gridDim.x * gridDim.y * gridDim.z;
    unsigned sum, cnt, mine, sp = 0u;
    for (;;) {
        sum = 0u; cnt = 0u; mine = 0u;
#pragma unroll
        for (unsigned j = 0; j < 16; ++j) { const unsigned c = xb_ld(&bar[XB_XCNT(j)]); sum += c; cnt += (c > 0u) ? 1u : 0u; mine = (j == x) ? c : mine; }
        if (sum == G) break;
        __builtin_amdgcn_s_sleep(1);
        if ((++sp & 255u) == 0u) { if (xb_ld(&bar[XB_TMO])) break; if (sp > XB_SPIN_CAP) { atomicAdd(&bar[XB_TMO], 1u); break; } }
    }
    nloc = mine > 0u ? mine : 1u; nx = cnt > 0u ? cnt : 1u;
}

__device__ __forceinline__ void xcd_barrier(const XcdBarrier& b) {
    asm volatile("s_waitcnt vmcnt(0)" ::: "memory");
    __syncthreads();
    if (threadIdx.x == 0) {
        unsigned* bar = b.bar;
        __builtin_amdgcn_s_waitcnt(0);
        unsigned nloc = b.st[0], nx = b.st[1];
        if (nloc == 0u) { xcd_barrier_complete(bar, b.x, nloc, nx); b.st[0] = nloc; b.st[1] = nx; }
        const unsigned old = xb_add(&bar[XB_XSUB(b.x)], 1u);
        const unsigned gen = old / nloc;
        if (old + 1u == (gen + 1u) * nloc) {
            __builtin_amdgcn_fence(__ATOMIC_RELEASE, "agent");
            asm volatile("s_waitcnt vmcnt(0)" ::: "memory");
            const unsigned og = xb_add(&bar[XB_TOP], 1u);
            const unsigned tg = og / nx;
            if (og + 1u == (tg + 1u) * nx) xb_add(&bar[XB_TOPGEN], 1u);
            else XB_SPIN(xb_ld(&bar[XB_TOPGEN]) == tg, bar);
            __builtin_amdgcn_fence(__ATOMIC_ACQUIRE, "agent");
            xb_add(&bar[XB_XGEN(b.x)], 1u);
            asm volatile("s_waitcnt vmcnt(0)" ::: "memory");
        } else {
            XB_SPIN(xb_ld(&bar[XB_XGEN(b.x)]) == gen, bar);
            __builtin_amdgcn_fence(__ATOMIC_ACQUIRE, "agent");
            asm volatile("s_waitcnt vmcnt(0)" ::: "memory");
        }
    }
    __syncthreads();
}

#define FRESH_IDS int tid_ = threadIdx.x; asm volatile("" : "+v"(tid_)); const int tid = tid_, lane = tid & 63, wave = __builtin_amdgcn_readfirstlane(tid >> 6); (void)lane; (void)wave;

template <int CTRL> __device__ __forceinline__ float dpp_mov(float v) { return __builtin_bit_cast(float, __builtin_amdgcn_update_dpp(0, __builtin_bit_cast(int, v), CTRL, 0xf, 0xf, true)); }
__device__ __forceinline__ float half_sum(float v) {
    v += dpp_mov<0xB1>(v); v += dpp_mov<0x4E>(v); v += dpp_mov<0x141>(v); v += dpp_mov<0x140>(v);
    { float a = v, b = v; asm volatile("s_nop 1\n\tv_permlane16_swap_b32 %0, %1" : "+v"(a), "+v"(b)); v = a + b; }
    return v;
}
__device__ __forceinline__ float wave_sum(float v) {
    v = half_sum(v);
    { float a = v, b = v; asm volatile("s_nop 1\n\tv_permlane32_swap_b32 %0, %1" : "+v"(a), "+v"(b)); v = a + b; }
    return v;
}
__device__ __forceinline__ void p0_transpose_item(const float* W, int K, int N, bf16* WT, int row_off, LAS float* scr, int item, int lane) {
    const int nblk = N / 32, kb = item / nblk, nb = item % nblk, k0 = 64 * kb, n0 = 32 * nb;
#pragma unroll
    for (int i = 0; i < 32; ++i) { const int kk = 2 * i + (lane >> 5); scr[kk * 33 + (lane & 31)] = W[(size_t)(k0 + kk) * N + n0 + (lane & 31)]; }
    LDS_WAIT(); asm volatile("" ::: "memory");
    const int c = lane & 7;
#pragma unroll
    for (int j = 0; j < 4; ++j) { const int n = (lane >> 3) + 8 * j; const LAS float* s = scr + (8 * c) * 33 + n;
        v4u o; o.x = pk2(s[0 * 33], s[1 * 33]); o.y = pk2(s[2 * 33], s[3 * 33]); o.z = pk2(s[4 * 33], s[5 * 33]); o.w = pk2(s[6 * 33], s[7 * 33]);
        *(GAS v4u*)(WT + (size_t)(row_off + n0 + n) * K + k0 + 8 * c) = o; }
    LDS_WAIT(); asm volatile("" ::: "memory");
}

#define GW_LOOP(var, n) for (int var = F.vcu * NWAVES + wave; var < (n); var += F.G * NWAVES)

__device__ __forceinline__ int win_row_off(int n0) {
    const int tile = n0 >> 8; const bool rope = tile < 2 || (tile >= 4 && tile < 12) || (tile >= 20 && tile < 28) || (tile >= 36 && tile < 44);
    if (!rope) return 0;
    const int w = n0 & 255, hsel = w >> 7, half = (w >> 6) & 1, i = w & 63;
    return (half * 128 + hsel * 64 + i) - w;
}
__device__ __forceinline__ void ph_prologue(Frame& F) {
    FRESH_IDS
    for (int ait = F.vcu; ait < 192; ait += F.G) {
        const int l = ait / 96, n0 = (ait % 96) * 64;
        LAS float* sv = (LAS float*)F.lds;
        LAS float* red = (LAS float*)(F.lds + 32768);
        for (int k = tid; k < DM; k += NWAVES * 64) { sv[k] = siluf(F.c[k]); sv[DM + k] = siluf(F.c[DM + k]); sv[2 * DM + k] = siluf(F.c_ctx[k]); }
        __syncthreads();
        const float* W = F.w_ada + (size_t)l * DM * 6144 + n0 + lane;
        float a0 = 0.f, a1 = 0.f, a2 = 0.f;
        const int kb = wave * 256;
#pragma unroll 32
        for (int k = 0; k < 256; ++k) { const float w = W[(size_t)(kb + k) * 6144]; a0 += sv[kb + k] * w; a1 += sv[DM + kb + k] * w; a2 += sv[2 * DM + kb + k] * w; }
        red[(wave * 3 + 0) * 64 + lane] = a0; red[(wave * 3 + 1) * 64 + lane] = a1; red[(wave * 3 + 2) * 64 + lane] = a2;
        __syncthreads();
        if (wave < 3) { float s = 0.f;
#pragma unroll
            for (int w = 0; w < 8; ++w) s += red[(w * 3 + wave) * 64 + lane];
            float* mod = (float*)(F.ws + WS_MOD);
            mod[(size_t)(l * 3 + wave) * 6144 + n0 + lane] = s + F.b_ada[(size_t)l * 6144 + n0 + lane]; }
        __syncthreads();
    }
    { float* ct = (float*)(F.ws + WS_COS); float* st = (float*)(F.ws + WS_SIN);
      for (int i = (F.vcu * NWAVES * 64) + tid; i < SEQ * 64; i += F.G * NWAVES * 64) {
          const int t = i >> 6, j = i & 63, f = j & 31; const float pos = (float)((j < 32) ? (t >> 6) : (t & 63));
          const float inv = expf(-(float)f * (9.210340371976184f / 32.f)); const float ang = pos * inv;
          ct[i] = cosf(ang); st[i] = sinf(ang); } }
    LAS float* scr = (LAS float*)(F.lds + wave * 16384);
    constexpr int I_IN = (DM / 64) * (INC / 32), I_P = (DM / 64) * (DM / 32);
    bf16* WinT = (bf16*)(F.ws + WS_WINT); bf16* WpT = (bf16*)(F.ws + WS_WPT);
    GW_LOOP(it, I_IN + 6 * I_P) {
        if (it < I_IN) { p0_transpose_item(F.w_in, DM, INC, WinT, win_row_off(32 * (it % (INC / 32))), scr, it, lane); continue; }
        const int r = it - I_IN, mi = r / I_P, ii = r % I_P, l = mi / 3, w = mi % 3;
        const float* W = (w == 0 ? F.w_pa : (w == 1 ? F.w_pb : F.w_out)) + (size_t)l * DM * DM;
        p0_transpose_item(W, DM, DM, WpT + (size_t)mi * DM * DM, 0, scr, ii, lane);
    }
}

__device__ __forceinline__ void ph_hnorm(Frame& F, int l, const float* xcur, const float* ctxcur) {
    FRESH_IDS
    bf16* H = (bf16*)(F.ws + WS_S0);
    const float* gp = F.g_pre + (size_t)l * DM;
    f32x4 g[8];
#pragma unroll
    for (int j = 0; j < 8; ++j) g[j] = ((const f32x4*)gp)[lane + 64 * j];
    GW_LOOP(row, MROWS) {
        const int b = row / RPB, rr = row % RPB; const float* src; int v;
        if (rr < CTX) { src = ctxcur + (size_t)(b * CTX + rr) * DM; v = 2; } else { src = xcur + (size_t)(b * SEQ + rr - CTX) * DM; v = b; }
        const float* md = (const float*)(F.ws + WS_MOD) + (size_t)(l * 3 + v) * 6144;
        f32x4 xv[8], sh[8], sc[8]; float s = 0.f;
#pragma unroll
        for (int j = 0; j < 8; ++j) xv[j] = ((const f32x4*)src)[lane + 64 * j];
#pragma unroll
        for (int j = 0; j < 8; ++j) { sh[j] = ((const f32x4*)md)[lane + 64 * j]; sc[j] = ((const f32x4*)(md + DM))[lane + 64 * j]; }
#pragma unroll
        for (int j = 0; j < 8; ++j) s += (xv[j].x * xv[j].x + xv[j].y * xv[j].y) + (xv[j].z * xv[j].z + xv[j].w * xv[j].w);
        const float rs = rsqrtf(wave_sum(s) * (1.f / DM) + EPS);
#pragma unroll
        for (int j = 0; j < 8; ++j) { const int q = lane + 64 * j;
            const f32x4 y = (xv[j] * rs) * g[j] * (sc[j] + 1.f) + sh[j];
            v2u o; o.x = pk2(y.x, y.y); o.y = pk2(y.z, y.w);
            *(v2u*)(H + (size_t)row * DM + 4 * q) = o; }
    }
}

__device__ __forceinline__ void ph_rope(Frame& F) {
    FRESH_IDS
    bf16* PX = (bf16*)(F.ws + WS_PX);
    const float* ct = (const float*)(F.ws + WS_COS); const float* st = (const float*)(F.ws + WS_SIN);
    const unsigned total = (unsigned)NB * SEQ * 52 * 8;
    for (unsigned idx = (unsigned)(F.vcu * NWAVES * 64 + tid); idx < total; idx += (unsigned)(F.G * NWAVES * 64)) {
        const unsigned ch = idx & 7, hr = idx >> 3, hh = hr % 52, rowL = hr / 52, b = rowL / SEQ, t = rowL % SEQ;
        const int col = (hh < 4) ? (C_KA + hh * 128) : (hh < 20) ? (C_KB + (hh - 4) * 128) : (hh < 36) ? (C_QA + (hh - 20) * 128) : (C_QB + (hh - 36) * 128);
        bf16* p = PX + (size_t)(b * RPB + CTX + t) * INC + col + ch * 8;
        const v4u x1 = *(const v4u*)p, x2 = *(const v4u*)(p + 64);
        const f32x4 c0 = *(const f32x4*)(ct + t * 64 + ch * 8), c1 = *(const f32x4*)(ct + t * 64 + ch * 8 + 4);
        const f32x4 s0 = *(const f32x4*)(st + t * 64 + ch * 8), s1 = *(const f32x4*)(st + t * 64 + ch * 8 + 4);
        v4u y1, y2;
#define ROPE2(W, CA, SA, CB, SB) { const float a0 = bflo(x1.W), a1 = bfhi(x1.W), b0 = bflo(x2.W), b1 = bfhi(x2.W); \
            y1.W = pk2(a0 * CA - b0 * SA, a1 * CB - b1 * SB); y2.W = pk2(b0 * CA + a0 * SA, b1 * CB + a1 * SB); }
        ROPE2(x, c0.x, s0.x, c0.y, s0.y) ROPE2(y, c0.z, s0.z, c0.w, s0.w) ROPE2(z, c1.x, s1.x, c1.y, s1.y) ROPE2(w, c1.z, s1.z, c1.w, s1.w)
#undef ROPE2
        *(v4u*)p = y1; *(v4u*)(p + 64) = y2;
    }
}

__device__ __forceinline__ void ph_convert_win(Frame& F, int l) {
    FRESH_IDS
    LAS float* scr = (LAS float*)(F.lds + wave * 16384);
    constexpr int I_IN = (DM / 64) * (INC / 32);
    bf16* WinT = (bf16*)(F.ws + WS_WINT);
    GW_LOOP(it, I_IN) p0_transpose_item(F.w_in + (size_t)l * DM * INC, DM, INC, WinT, win_row_off(32 * (it % (INC / 32))), scr, it, lane);
}

__device__ __forceinline__ void ph_attn(Frame& F, int l, char* lds) {
    const att::bf16* PX = (const att::bf16*)(F.ws + WS_PX);
    att::bf16* OA = (att::bf16*)(F.ws + WS_S0);
    att::bf16* OB0 = (att::bf16*)(F.ws + WS_S0 + SLOT);
    const float NINF = -INFINITY;
    const int nB = 1024, nA = 1024, nC = (l == 0) ? 64 : 0;
    for (int u = F.vcu; u < nB + nA + nC; u += F.G) {
        if (u < nB) {
            const int hd = u >> 5, qb = u & 31, b = hd >> 4, h8 = (hd >> 1) & 7, m = hd & 1;
            const size_t qrow = (size_t)b * RPB + CTX + qb * 256, krow = (size_t)b * RPB;
            att::attn_body_v256(PX + qrow * INC + C_QB + (h8 * 2 + m) * 128, PX + krow * INC + C_KB + (h8 * 2 + m) * 128, PX + krow * INC + C_VB + h8 * 256,
                                OB0 + (size_t)m * (SLOT / 2) + qrow * DM + h8 * 256, RPB / 64, F.lds);
            __syncthreads();
        } else if (u < nB + nA) {
            const int v = u - nB, b = v >> 9, kvh = (v >> 7) & 3, qb = v & 127, q0 = qb * 64;
            const int lo = (q0 - 128 > 0) ? q0 - 128 : 0, he = (q0 + 192 < SEQ) ? q0 + 192 : SEQ, nloc = (he - lo) >> 6;
            const size_t qrow = (size_t)b * RPB + CTX + q0, krow = (size_t)b * RPB;
            att::attn_body_a(PX + qrow * INC + C_QA + kvh * 512, PX + krow * INC + C_KA + kvh * 128, PX + krow * INC + C_VA + kvh * 128,
                             OA + qrow * DM + kvh * 512, 4 + nloc, 4, lo, q0, F.sink + l * 16 + kvh * 4, F.lds);
            __syncthreads();
        } else {
            const int v = u - nB - nA;
            if (v < 32) {
                const int hd = v, b = hd >> 4, h8 = (hd >> 1) & 7, m = hd & 1; const size_t krow = (size_t)b * RPB;
                att::attn_body_v256(PX + krow * INC + C_QB + (h8 * 2 + m) * 128, PX + krow * INC + C_KB + (h8 * 2 + m) * 128, PX + krow * INC + C_VB + h8 * 256,
                                    OB0 + (size_t)m * (SLOT / 2) + krow * DM + h8 * 256, 4, F.lds);
                __syncthreads();
            } else {
                const int w = v - 32, b = w >> 4, kvh = (w >> 2) & 3, cb = w & 3; const size_t krow = (size_t)b * RPB, qrow = krow + cb * 64;
                att::attn_body_a(PX + qrow * INC + C_QA + kvh * 512, PX + krow * INC + C_KA + kvh * 128, PX + krow * INC + C_VA + kvh * 128,
                                 OA + qrow * DM + kvh * 512, 4, 4, 0, 0, F.sink + l * 16 + kvh * 4, F.lds);
                __syncthreads();
            }
        }
    }
}

__device__ __forceinline__ void ph_post(Frame& F, int l) {
    FRESH_IDS
    const bf16* PX = (const bf16*)(F.ws + WS_PX);
    const bf16* OA = (const bf16*)(F.ws + WS_S0); const bf16* OB0 = (const bf16*)(F.ws + WS_S0 + SLOT); const bf16* OB1 = (const bf16*)(F.ws + WS_S0 + 2 * SLOT);
    bf16* GA = (bf16*)(F.ws + WS_S0 + 3 * SLOT); bf16* GB = (bf16*)(F.ws + WS_S0 + 4 * SLOT);
    const float lam_init = 0.8f - 0.6f * expf(-0.3f * (float)l);
    const float* lq = F.lam_qk + (size_t)l * 512;
    const float d1 = wave_sum(lq[lane] * lq[128 + lane] + lq[64 + lane] * lq[192 + lane]);
    const float d2 = wave_sum(lq[256 + lane] * lq[384 + lane] + lq[320 + lane] * lq[448 + lane]);
    const float lam = expf(d1) - expf(d2) + lam_init;
    const f32x4 gs0 = ((const f32x4*)(F.g_subln + (size_t)l * 256))[2 * (lane & 31)] * (1.f - lam_init), gs1 = ((const f32x4*)(F.g_subln + (size_t)l * 256))[2 * (lane & 31) + 1] * (1.f - lam_init);
    GW_LOOP(row, MROWS) {
        if (l != 0 && (row % RPB) < CTX) continue;
        const size_t ro = (size_t)row * DM + 8 * lane, rp = (size_t)row * INC + 8 * lane;
        v4u oa[4], za[4], o0[4], o1[4], zb[4];
#pragma unroll
        for (int j = 0; j < 4; ++j) { oa[j] = *(const v4u*)(OA + ro + 512 * j); za[j] = *(const v4u*)(PX + rp + C_ZA + 512 * j);
            o0[j] = *(const v4u*)(OB0 + ro + 512 * j); o1[j] = *(const v4u*)(OB1 + ro + 512 * j); zb[j] = *(const v4u*)(PX + rp + C_ZB + 512 * j); }
#pragma unroll
        for (int j = 0; j < 4; ++j) { v4u o;
#define GA2(W) o.W = pk2(bflo(oa[j].W) * siluf(bflo(za[j].W)), bfhi(oa[j].W) * siluf(bfhi(za[j].W)));
            GA2(x) GA2(y) GA2(z) GA2(w)
#undef GA2
            *(v4u*)(GA + ro + 512 * j) = o; }
#pragma unroll
        for (int j = 0; j < 4; ++j) {
            f32x4 da, db;
            da.x = bflo(o0[j].x) - lam * bflo(o1[j].x); da.y = bfhi(o0[j].x) - lam * bfhi(o1[j].x); da.z = bflo(o0[j].y) - lam * bflo(o1[j].y); da.w = bfhi(o0[j].y) - lam * bfhi(o1[j].y);
            db.x = bflo(o0[j].z) - lam * bflo(o1[j].z); db.y = bfhi(o0[j].z) - lam * bfhi(o1[j].z); db.z = bflo(o0[j].w) - lam * bflo(o1[j].w); db.w = bfhi(o0[j].w) - lam * bfhi(o1[j].w);
            float ss = ((da.x * da.x + da.y * da.y) + (da.z * da.z + da.w * da.w)) + ((db.x * db.x + db.y * db.y) + (db.z * db.z + db.w * db.w));
            ss = half_sum(ss);
            const float rs = rsqrtf(ss * (1.f / 256.f) + EPS);
            const f32x4 ya = da * rs * gs0, yb = db * rs * gs1;
            v4u o; o.x = pk2(ya.x * siluf(bflo(zb[j].x)), ya.y * siluf(bfhi(zb[j].x))); o.y = pk2(ya.z * siluf(bflo(zb[j].y)), ya.w * siluf(bfhi(zb[j].y)));
            o.z = pk2(yb.x * siluf(bflo(zb[j].z)), yb.y * siluf(bfhi(zb[j].z))); o.w = pk2(yb.z * siluf(bflo(zb[j].w)), yb.w * siluf(bfhi(zb[j].w)));
            *(v4u*)(GB + ro + 512 * j) = o; }
    }
}

__device__ __forceinline__ void ph_merge(Frame& F, int l) {
    FRESH_IDS
    const bf16* PX = (const bf16*)(F.ws + WS_PX);
    const bf16* YA = (const bf16*)(F.ws + WS_S0); const bf16* YB = (const bf16*)(F.ws + WS_S0 + SLOT); bf16* MG = (bf16*)(F.ws + WS_S0 + 2 * SLOT);
    const unsigned total = (unsigned)MROWS * (DM / 8);
    for (unsigned i = (unsigned)(F.vcu * NWAVES * 64 + tid); i < total; i += (unsigned)(F.G * NWAVES * 64)) {
        const unsigned row = i >> 8, c = (i & 255) * 8;
        if (l != 0 && (row % RPB) < CTX) continue;
        const v4u ya = *(const v4u*)(YA + (size_t)row * DM + c), yb = *(const v4u*)(YB + (size_t)row * DM + c);
        const v4u ga = *(const v4u*)(PX + (size_t)row * INC + C_GA + c), gb = *(const v4u*)(PX + (size_t)row * INC + C_GB + c);
        v4u o;
#define MRG(W) o.W = pk2(sigmf(bflo(ga.W)) * bflo(ya.W) + sigmf(bflo(gb.W)) * bflo(yb.W), sigmf(bfhi(ga.W)) * bfhi(ya.W) + sigmf(bfhi(gb.W)) * bfhi(yb.W));
        MRG(x) MRG(y) MRG(z) MRG(w)
#undef MRG
        *(v4u*)(MG + (size_t)row * DM + c) = o;
    }
}

__device__ __forceinline__ void ph_res(Frame& F, int l, const float* xcur, const float* ctxcur) {
    FRESH_IDS
    const bf16* OX = (const bf16*)(F.ws + WS_S0 + 3 * SLOT);
    bf16* H = (bf16*)(F.ws + WS_S0);
    const bool nxt = (l + 1 < DEPTH);
    f32x4 gq[8], gn[8];
#pragma unroll
    for (int j = 0; j < 8; ++j) { gq[j] = ((const f32x4*)(F.g_post + (size_t)l * DM))[lane + 64 * j]; gn[j] = nxt ? ((const f32x4*)(F.g_pre + (size_t)(l + 1) * DM))[lane + 64 * j] : (f32x4){0.f, 0.f, 0.f, 0.f}; }
    GW_LOOP(row, MROWS) {
        const int b = row / RPB, rr = row % RPB; const float* src; float* dst; int v;
        if (rr < CTX) { if (!nxt) continue; src = ctxcur + (size_t)(b * CTX + rr) * DM; dst = nullptr; v = 2; }
        else { src = xcur + (size_t)(b * SEQ + rr - CTX) * DM; dst = F.out + (size_t)(b * SEQ + rr - CTX) * DM; v = b; }
        const float* gt = (const float*)(F.ws + WS_MOD) + (size_t)(l * 3 + v) * 6144 + 2 * DM;
        const float* md = (const float*)(F.ws + WS_MOD) + (size_t)((nxt ? l + 1 : l) * 3 + v) * 6144;
        v2u ow[8]; f32x4 xr[8], gate[8], sh[8], sc[8]; f32x4 ov[8]; float s = 0.f;
#pragma unroll
        for (int j = 0; j < 8; ++j) { ow[j] = *(const v2u*)(OX + (size_t)row * DM + 4 * (lane + 64 * j)); xr[j] = ((const f32x4*)src)[lane + 64 * j]; }
#pragma unroll
        for (int j = 0; j < 8; ++j) { gate[j] = ((const f32x4*)gt)[lane + 64 * j]; if (nxt) { sh[j] = ((const f32x4*)md)[lane + 64 * j]; sc[j] = ((const f32x4*)(md + DM))[lane + 64 * j]; } }
#pragma unroll
        for (int j = 0; j < 8; ++j) { ov[j] = (f32x4){bflo(ow[j].x), bfhi(ow[j].x), bflo(ow[j].y), bfhi(ow[j].y)}; s += (ov[j].x * ov[j].x + ov[j].y * ov[j].y) + (ov[j].z * ov[j].z + ov[j].w * ov[j].w); }
        const float rs = rsqrtf(wave_sum(s) * (1.f / DM) + EPS);
        float s2 = 0.f;
#pragma unroll
        for (int j = 0; j < 8; ++j) { const int q = lane + 64 * j;
            ov[j] = xr[j] + gate[j] * ((ov[j] * rs) * gq[j]);
            if (dst) ((f32x4*)dst)[q] = ov[j];
            s2 += (ov[j].x * ov[j].x + ov[j].y * ov[j].y) + (ov[j].z * ov[j].z + ov[j].w * ov[j].w); }
        if (nxt) {
            const float rs2 = rsqrtf(wave_sum(s2) * (1.f / DM) + EPS);
#pragma unroll
            for (int j = 0; j < 8; ++j) { const int q = lane + 64 * j;
                const f32x4 y = (ov[j] * rs2) * gn[j] * (sc[j] + 1.f) + sh[j];
                v2u o; o.x = pk2(y.x, y.y); o.y = pk2(y.z, y.w);
                *(v2u*)(H + (size_t)row * DM + 4 * q) = o; }
        }
    }
}

typedef short sg_bf16x8 __attribute__((ext_vector_type(8)));
template <bool DUAL>
__device__ __forceinline__ void small_ctx_gemm(Frame& F, const bf16* A0, const bf16* W0, const bf16* A1, const bf16* W1, const bf16* PXg, bf16* O) {
    FRESH_IDS
    const int fr = lane & 15, fq = lane >> 4, wc = wave & 3, wr = wave >> 2;
    for (int t = F.vcu; t < 8 * 32; t += F.G) {
        const int tr = t >> 5, tc = t & 31;
        const int c0 = tr * 64 + wr * 32, b = c0 >> 8;
        const size_t row0 = (size_t)b * RPB + (c0 & 255);
        const int col0 = tc * 64 + wc * 16;
        f32x4 acc[2][2] = {};
#pragma unroll
        for (int gsel = 0; gsel < (DUAL ? 2 : 1); ++gsel) {
            const bf16* Ap = (gsel ? A1 : A0) + (row0 + fr) * DM + 8 * fq;
            const bf16* Bp = (gsel ? W1 : W0) + (size_t)(col0 + fr) * DM + 8 * fq;
#pragma unroll 8
            for (int k = 0; k < DM; k += 32) {
                const sg_bf16x8 a0 = *(const sg_bf16x8*)(Ap + k), a1 = *(const sg_bf16x8*)(Ap + 16 * DM + k), bb = *(const sg_bf16x8*)(Bp + k);
                acc[gsel][0] = __builtin_amdgcn_mfma_f32_16x16x32_bf16(bb, a0, acc[gsel][0], 0, 0, 0);
                acc[gsel][1] = __builtin_amdgcn_mfma_f32_16x16x32_bf16(bb, a1, acc[gsel][1], 0, 0, 0);
            }
        }
#pragma unroll
        for (int rb = 0; rb < 2; ++rb) { const size_t row = row0 + rb * 16 + fr; const int col = col0 + 4 * fq;
            f32x4 v = acc[0][rb];
            if (DUAL) { const v2u ga = *(const v2u*)(PXg + row * INC + C_GA + col), gb = *(const v2u*)(PXg + row * INC + C_GB + col); const f32x4 w = acc[1][rb];
                v.x = sigmf(bflo(ga.x)) * v.x + sigmf(bflo(gb.x)) * w.x; v.y = sigmf(bfhi(ga.x)) * v.y + sigmf(bfhi(gb.x)) * w.y;
                v.z = sigmf(bflo(ga.y)) * v.z + sigmf(bflo(gb.y)) * w.z; v.w = sigmf(bfhi(ga.y)) * v.w + sigmf(bfhi(gb.y)) * w.w; }
            v2u o; o.x = pk2(v.x, v.y); o.y = pk2(v.z, v.w);
            *(v2u*)(O + row * DM + col) = o; }
    }
}

__device__ __forceinline__ void run_gemm_in(Frame& F, const bf16* A, const bf16* Bt, bf16* O) {
    pg8::Gemm g{A, Bt, MROWS, INC, DM}; pg8::RowSkipOrder S; S.init(INC, F.G, (int)blockIdx.x, false);
    pg8::EpiRope E{O, INC, (const float*)(F.ws + WS_COS), (const float*)(F.ws + WS_SIN)};
    pg8::gemm_phase<pg8::EpiRope, pg8::RowSkipOrder, true, true>(F.lds, g, S, E);
}
__device__ __forceinline__ void run_gemm_skip(Frame& F, const bf16* A, const bf16* Bt, bf16* O, bool skip) {
    pg8::Gemm g{A, Bt, MROWS, DM, DM}; pg8::RowSkipOrder S; S.init(DM, F.G, (int)blockIdx.x, skip);
    pg8::EpiBf16 E{O, DM};
    pg8::gemm_phase<pg8::EpiBf16, pg8::RowSkipOrder, true, true>(F.lds, g, S, E);
}
template <bool ADD>
__device__ __forceinline__ void run_gemm_gate(Frame& F, const bf16* A, const bf16* Bt, bf16* O, const bf16* T, const bf16* G, bool skip) {
    pg8::Gemm g{A, Bt, MROWS, DM, DM}; pg8::RowSkipOrder S; S.init(DM, F.G, (int)blockIdx.x, skip);
    pg8::EpiGate<ADD> E{O, T, G, DM, INC};
    pg8::gemm_phase<pg8::EpiGate<ADD>, pg8::RowSkipOrder, true, true>(F.lds, g, S, E);
}

struct Args { const float* in[15]; float* out; unsigned char* ws; };
__global__ void __launch_bounds__(NWAVES * 64, 2) fwd_mega(Args args) {
    extern __shared__ __attribute__((aligned(16))) unsigned char lds[];
    cg::grid_group grid = cg::this_grid();
    Frame F;
    F.lds = (LAS unsigned char*)lds;
    F.G = gridDim.x; { const int bx = blockIdx.x; F.vcu = (F.G % 8 == 0) ? (bx % 8) * (F.G / 8) + bx / 8 : bx; }
    F.x = args.in[0]; F.c = args.in[1]; F.ctx = args.in[2]; F.c_ctx = args.in[3]; F.w_ada = args.in[4]; F.b_ada = args.in[5]; F.g_pre = args.in[6]; F.g_post = args.in[7];
    F.w_in = args.in[8]; F.sink = args.in[9]; F.lam_qk = args.in[10]; F.g_subln = args.in[11]; F.w_pa = args.in[12]; F.w_pb = args.in[13]; F.w_out = args.in[14];
    F.out = args.out; F.ws = args.ws;
    volatile LAS unsigned* MISC = (volatile LAS unsigned*)(F.lds + 149504);
    if (threadIdx.x < 32) MISC[threadIdx.x] = 0u;
    __syncthreads();
    const XcdBarrier bar = xcd_barrier_post((unsigned*)(F.ws + WS_BAR), MISC + 8);
    bf16* WinT = (bf16*)(F.ws + WS_WINT); bf16* WpT = (bf16*)(F.ws + WS_WPT); bf16* PX = (bf16*)(F.ws + WS_PX);
    bf16* S0 = (bf16*)(F.ws + WS_S0); bf16* S1 = (bf16*)(F.ws + WS_S0 + SLOT); bf16* S2 = (bf16*)(F.ws + WS_S0 + 2 * SLOT); bf16* S3 = (bf16*)(F.ws + WS_S0 + 3 * SLOT); bf16* S4 = (bf16*)(F.ws + WS_S0 + 4 * SLOT);

    ph_prologue(F);
    grid.sync();
#pragma unroll 1
    for (int l = 0; l < DEPTH; ++l) {
        const float* xcur = (l == 0) ? F.x : F.out;
        const float* ctxcur = (l == 0) ? F.ctx : (const float*)(F.ws + WS_CTX1);
        if (l == 0) { ph_hnorm(F, l, xcur, ctxcur); xcd_barrier(bar); }
        run_gemm_in(F, S0, WinT, PX);
        xcd_barrier(bar);
        ph_attn(F, l, (char*)lds);
        xcd_barrier(bar);
        ph_post(F, l);
        if (l + 1 < DEPTH) ph_convert_win(F, l + 1);
        xcd_barrier(bar);
        run_gemm_gate<false>(F, S3, WpT + (size_t)(l * 3 + 0) * DM * DM, S0, S0, PX + C_GA, true);
        run_gemm_gate<true>(F, S4, WpT + (size_t)(l * 3 + 1) * DM * DM, S2, S0, PX + C_GB, true);
        if (l + 1 < DEPTH) small_ctx_gemm<true>(F, S3, WpT + (size_t)(l * 3 + 0) * DM * DM, S4, WpT + (size_t)(l * 3 + 1) * DM * DM, PX, S2);
        xcd_barrier(bar);
        run_gemm_skip(F, S2, WpT + (size_t)(l * 3 + 2) * DM * DM, S3, true);
        if (l + 1 < DEPTH) small_ctx_gemm<false>(F, S2, WpT + (size_t)(l * 3 + 2) * DM * DM, nullptr, nullptr, PX, S3);
        xcd_barrier(bar);
        ph_res(F, l, xcur, ctxcur);
        if (l + 1 < DEPTH) xcd_barrier(bar);
    }
}

extern "C" void kernel_launch(void* const* d_in, const int* in_sizes, int n_in, void* d_out, int out_size, void* d_ws, size_t ws_size, hipStream_t stream) {
    static int grid = 0;
    if (grid == 0) {
        if (n_in != 15 || out_size != NB * SEQ * DM || ws_size < WS_END) { fprintf(stderr, "kernel_launch: unexpected shapes: n_in %d out %d ws %zu (need %zu)\n", n_in, out_size, ws_size, (size_t)WS_END); grid = -1; return; }
        int dev = 0, cus = 0, per_cu = 0;
        if (hipGetDevice(&dev) != hipSuccess || hipDeviceGetAttribute(&cus, hipDeviceAttributeMultiprocessorCount, dev) != hipSuccess) { grid = -1; return; }
        if (hipFuncSetAttribute((const void*)fwd_mega, hipFuncAttributeMaxDynamicSharedMemorySize, LDS_BYTES) != hipSuccess) { fprintf(stderr, "kernel_launch: hipFuncSetAttribute failed\n"); grid = -1; return; }
        if (hipOccupancyMaxActiveBlocksPerMultiprocessor(&per_cu, (const void*)fwd_mega, NWAVES * 64, LDS_BYTES) != hipSuccess || per_cu < 1) { fprintf(stderr, "kernel_launch: occupancy query says %d\n", per_cu); per_cu = 1; }
        (void)hipGetLastError();
        grid = cus * per_cu;
    }
    if (grid < 0) return;
    if (hipMemsetAsync((char*)d_ws + WS_BAR, 0, WS_BAR_BYTES, stream) != hipSuccess) { fprintf(stderr, "kernel_launch: memset of the barrier words failed\n"); return; }
    Args a{};
    for (int i = 0; i < 15; ++i) a.in[i] = (const float*)d_in[i];
    a.out = (float*)d_out; a.ws = (unsigned char*)d_ws;
    void* kargs[] = {&a};
    hipError_t e = hipLaunchCooperativeKernel((const void*)fwd_mega, dim3(grid), dim3(NWAVES * 64), kargs, LDS_BYTES, stream);
    if (e != hipSuccess) fprintf(stderr, "kernel_launch: cooperative launch failed: %s (grid %d)\n", hipGetErrorString(e), grid);
}
```

```cpp
#include <hip/hip_runtime.h>
#include <hip/hip_bf16.h>
#include <hip/hip_cooperative_groups.h>
#include <cstdio>
#include <cstdint>
#include <cmath>
namespace cg = cooperative_groups;

constexpr int DM = 2048, NB = 2, SEQ = 8192, DEPTH = 2, CTX = 256;
constexpr int RPB = CTX + SEQ;
constexpr int MROWS = NB * RPB;
constexpr int INC = 17408;
constexpr int C_KA = 0, C_VA = 512, C_KB = 1024, C_VB = 3072, C_QA = 5120, C_ZA = 7168, C_QB = 9216, C_ZB = 11264, C_GA = 13312, C_GB = 15360;
constexpr float EPS = 1e-6f;

namespace pg8 {
#define PG8_LAS __attribute__((address_space(3)))
typedef unsigned short bf16_t;
typedef short bf16x8 __attribute__((ext_vector_type(8)));
typedef float f32x4 __attribute__((ext_vector_type(4)));
typedef unsigned u32x4 __attribute__((ext_vector_type(4)));
constexpr int BM = 256, BK = 64, HALF = 128, HTB = HALF * BK * 2  , STAGE_BYTES = 8 * HTB, NXCD = 8, WGM = 8;

__host__ __device__ __forceinline__ int lds_byte(int r, int c) { const int st = (r >> 4) * 2 + (c >> 5), rr = r & 15, cc = c & 31, ob = rr * 64 + cc * 2; return st * 1024 + (ob ^ (((ob >> 9) & 1) << 5)); }
__host__ __device__ __forceinline__ void stage_rc(int b, int& R, int& C) { const int st = b / 1024, sb = b % 1024, swz = sb ^ (((sb >> 9) & 1) << 5); R = (st >> 1) * 16 + swz / 64; C = (st & 1) * 32 + (swz % 64) / 2; }
__host__ __device__ __forceinline__ int perm32(int rho) { const int n = rho >> 4, i = rho & 15; return 8 * (i >> 2) + 4 * n + (i & 3); }

struct Unit { int pm, pn; };
struct Gemm { const bf16_t* A; const bf16_t* Bt; int M, N, K; };

struct StaticOrder {
    int nM, nN, nwg, G, c;
    __host__ __device__ void init(int M, int N, int G_, int c_) { nM = M / BM; nN = N / BM; nwg = nM * nN; G = G_; c = c_; }
    __host__ __device__ bool next(int i, Unit& u) const {
        const long L = (long)i * G + c; if (L >= nwg) return false;
        int wgid = (int)L; { const int q = nwg / NXCD, r = nwg % NXCD, xcd = wgid % NXCD, off = wgid / NXCD; wgid = (xcd < r ? xcd * (q + 1) : r * (q + 1) + (xcd - r) * q) + off; }
        const int nig = WGM * nN, gid = wgid / nig, fm = gid * WGM, gsz = (nM - fm) < WGM ? (nM - fm) : WGM;
        u.pm = fm + ((wgid % nig) % gsz); u.pn = (wgid % nig) / gsz; return true;
    }
    __device__ __forceinline__ void a_ready(const Unit&) const {}
    __device__ __forceinline__ void done(const Unit&) const {}
};

__device__ __forceinline__ unsigned cvt_pk_bf16(float lo, float hi) { unsigned r; asm volatile("v_cvt_pk_bf16_f32 %0, %1, %2" : "=v"(r) : "v"(lo), "v"(hi)); return r; }
typedef float f32x2 __attribute__((ext_vector_type(2)));

struct EpiBf16 {
    static constexpr bool PERM = true, AFTER_DRAIN = false;
    bf16_t* O; int ldc;
    __device__ __forceinline__ void operator()(const f32x4 (&acc)[2][2][4][2], const Unit& u, int wr, int wc, int fr, int fq) const {
        const int row0 = u.pm * BM + wr * 64 + fr; const int col0 = u.pn * BM + wc * 32 + 8 * fq;
#pragma unroll
        for (int ai = 0; ai < 2; ++ai)
#pragma unroll
            for (int m = 0; m < 4; ++m) { bf16_t* rowp = O + (size_t)(row0 + ai * HALF + m * 16) * ldc + col0;
#pragma unroll
                for (int bj = 0; bj < 2; ++bj) { const f32x4 v0 = acc[ai][bj][m][0], v1 = acc[ai][bj][m][1];
                    u32x4 w; w.x = cvt_pk_bf16(v0[0], v0[1]); w.y = cvt_pk_bf16(v0[2], v0[3]); w.z = cvt_pk_bf16(v1[0], v1[1]); w.w = cvt_pk_bf16(v1[2], v1[3]);
                    *(u32x4*)(rowp + bj * HALF) = w; } }
    }
};

__device__ __forceinline__ float sigm_(float x) { return __builtin_amdgcn_rcpf(1.f + __builtin_amdgcn_exp2f(x * -1.4426950408889634f)); }
__device__ __forceinline__ float blo_(unsigned w) { return __builtin_bit_cast(float, w << 16); }
__device__ __forceinline__ float bhi_(unsigned w) { return __builtin_bit_cast(float, w & 0xffff0000u); }
template <bool ADD> struct EpiGate {
    static constexpr bool PERM = true, AFTER_DRAIN = false;
    bf16_t* O; const bf16_t* T; const bf16_t* G; int ldc; int ldg;
    __device__ __forceinline__ void operator()(const f32x4 (&acc)[2][2][4][2], const Unit& u, int wr, int wc, int fr, int fq) const {
        const int row0 = u.pm * BM + wr * 64 + fr; const int col0 = u.pn * BM + wc * 32 + 8 * fq;
#pragma unroll
        for (int ai = 0; ai < 2; ++ai) {
            u32x4 g[4][2], t[4][2];
#pragma unroll
            for (int m = 0; m < 4; ++m)
#pragma unroll
                for (int bj = 0; bj < 2; ++bj) { g[m][bj] = *(const u32x4*)(G + (size_t)(row0 + ai * HALF + m * 16) * ldg + col0 + bj * HALF);
                    if (ADD) t[m][bj] = *(const u32x4*)(T + (size_t)(row0 + ai * HALF + m * 16) * ldc + col0 + bj * HALF); }
#pragma unroll
            for (int m = 0; m < 4; ++m) { const size_t row = (size_t)(row0 + ai * HALF + m * 16);
#pragma unroll
                for (int bj = 0; bj < 2; ++bj) { const f32x4 v0 = acc[ai][bj][m][0], v1 = acc[ai][bj][m][1]; const u32x4 gg = g[m][bj];
                    float r0 = sigm_(blo_(gg.x)) * v0[0], r1 = sigm_(bhi_(gg.x)) * v0[1], r2 = sigm_(blo_(gg.y)) * v0[2], r3 = sigm_(bhi_(gg.y)) * v0[3];
                    float r4 = sigm_(blo_(gg.z)) * v1[0], r5 = sigm_(bhi_(gg.z)) * v1[1], r6 = sigm_(blo_(gg.w)) * v1[2], r7 = sigm_(bhi_(gg.w)) * v1[3];
                    if (ADD) { const u32x4 tt = t[m][bj];
                        r0 += blo_(tt.x); r1 += bhi_(tt.x); r2 += blo_(tt.y); r3 += bhi_(tt.y); r4 += blo_(tt.z); r5 += bhi_(tt.z); r6 += blo_(tt.w); r7 += bhi_(tt.w); }
                    u32x4 w; w.x = cvt_pk_bf16(r0, r1); w.y = cvt_pk_bf16(r2, r3); w.z = cvt_pk_bf16(r4, r5); w.w = cvt_pk_bf16(r6, r7);
                    *(u32x4*)(O + row * ldc + col0 + bj * HALF) = w; } }
        }
    }
};
struct RowSkipOrder {
    StaticOrder base; bool skip;
    __device__ void init(int N, int G_, int c_, bool skip_) { skip = skip_; base.init(skip_ ? 16384 : 16896, N, G_, c_); }
    __device__ bool next(int i, Unit& u) const { if (!base.next(i, u)) return false; if (skip) u.pm += 1 + (u.pm >= 32 ? 1 : 0); return true; }
    __device__ __forceinline__ void a_ready(const Unit&) const {}
    __device__ __forceinline__ void done(const Unit&) const {}
};

struct EpiRope {
    static constexpr bool PERM = true, AFTER_DRAIN = false;
    bf16_t* O; int ldc; const float* ct; const float* st;
    __device__ __forceinline__ void operator()(const f32x4 (&acc)[2][2][4][2], const Unit& u, int wr, int wc, int fr, int fq) const {
        const int pn = u.pn; const bool rope = pn < 2 || (pn >= 4 && pn < 12) || (pn >= 20 && pn < 28) || (pn >= 36 && pn < 44);
        const int row0 = u.pm * BM + wr * 64 + fr;
        if (!rope) {
            const int col0 = pn * BM + wc * 32 + 8 * fq;
#pragma unroll
            for (int ai = 0; ai < 2; ++ai)
#pragma unroll
                for (int m = 0; m < 4; ++m) { bf16_t* rowp = O + (size_t)(row0 + ai * HALF + m * 16) * ldc + col0;
#pragma unroll
                    for (int bj = 0; bj < 2; ++bj) { const f32x4 v0 = acc[ai][bj][m][0], v1 = acc[ai][bj][m][1];
                        u32x4 w; w.x = cvt_pk_bf16(v0[0], v0[1]); w.y = cvt_pk_bf16(v0[2], v0[3]); w.z = cvt_pk_bf16(v1[0], v1[1]); w.w = cvt_pk_bf16(v1[2], v1[3]);
                        *(u32x4*)(rowp + bj * HALF) = w; } }
            return;
        }
        const bool isctx = (u.pm == 0) || (u.pm == 33);
        const int i0 = 32 * (wc & 1) + 8 * fq, ocol = pn * BM + (wc >> 1) * 128 + i0;
        const int tbase = row0 - (u.pm >= 33 ? 8448 : 0) - 256;
        float invr[8];
#pragma unroll
        for (int e_ = 0; e_ < 8; ++e_) invr[e_] = __builtin_amdgcn_exp2f(-(float)(8 * fq + e_) * (13.287712379549449f / 32.f)) * 0.15915494309189535f;
#pragma unroll
        for (int ai = 0; ai < 2; ++ai)
#pragma unroll
            for (int m = 0; m < 4; ++m) { const int t = tbase + ai * HALF + m * 16;
                f32x4 c0 = {1.f, 1.f, 1.f, 1.f}, c1 = c0, s0 = {0.f, 0.f, 0.f, 0.f}, s1 = s0;
                if (!isctx) { const float pos = (float)((wc & 1) ? (t & 63) : (t >> 6));
#pragma unroll
                    for (int e_ = 0; e_ < 4; ++e_) { const float r0 = pos * invr[e_], r1 = pos * invr[4 + e_];
                        c0[e_] = __builtin_amdgcn_cosf(r0); s0[e_] = __builtin_amdgcn_sinf(r0); c1[e_] = __builtin_amdgcn_cosf(r1); s1[e_] = __builtin_amdgcn_sinf(r1); } }
                const f32x4 a0 = acc[ai][0][m][0], a1 = acc[ai][0][m][1], b0 = acc[ai][1][m][0], b1 = acc[ai][1][m][1];
                const f32x4 y0 = a0 * c0 - b0 * s0, y1 = a1 * c1 - b1 * s1, z0 = b0 * c0 + a0 * s0, z1 = b1 * c1 + a1 * s1;
                bf16_t* rowp = O + (size_t)(row0 + ai * HALF + m * 16) * ldc + ocol;
                u32x4 w; w.x = cvt_pk_bf16(y0[0], y0[1]); w.y = cvt_pk_bf16(y0[2], y0[3]); w.z = cvt_pk_bf16(y1[0], y1[1]); w.w = cvt_pk_bf16(y1[2], y1[3]);
                *(u32x4*)rowp = w;
                u32x4 x; x.x = cvt_pk_bf16(z0[0], z0[1]); x.y = cvt_pk_bf16(z0[2], z0[3]); x.z = cvt_pk_bf16(z1[0], z1[1]); x.w = cvt_pk_bf16(z1[2], z1[3]);
                *(u32x4*)(rowp + 64) = x; }
    }
};

template <class Epi, class Sched, bool ALIGN_EPI = false, bool SP2 = false>
__device__ __forceinline__ void gemm_phase(PG8_LAS unsigned char* lds, const Gemm g, const Sched& S, const Epi& E) {
    int tid_ = threadIdx.x; asm volatile("" : "+v"(tid_));
    const int tid = tid_, wid = __builtin_amdgcn_readfirstlane(tid >> 6), lane = tid & 63, wr = wid >> 2, wc = wid & 3, fr = lane & 15, fq = lane >> 4;
    const int K = g.K, nt = K / BK;
    unsigned voffA[2], voffB[2];
#pragma unroll
    for (int i = 0; i < 2; ++i) { int R, C; stage_rc(tid * 16 + i * 8192, R, C); const int Rb = Epi::PERM ? ((R & ~31) + perm32(R & 31)) : R;
        voffA[i] = (unsigned)(R * K + C) * 2u; voffB[i] = (unsigned)(Rb * K + C) * 2u; }
    const size_t kstep = (size_t)(BK * 2);
    const size_t hstep = (size_t)HALF * K * 2;
    const size_t tstep = 2 * hstep;
    const unsigned ldsw = (unsigned)wid * 1024u;
    const int aoff = lds_byte(wr * 64 + fr, fq * 8), boff = lds_byte(wc * 32 + fr, fq * 8);
#define PG8_SA(b, h) (((b) * 2 + (h)) * HTB)
#define PG8_SB(b, h) ((4 + (b) * 2 + (h)) * HTB)
#define PG8_STAGE(bufoff, gbase, voff) do { _Pragma("unroll") for (int _i = 0; _i < 2; ++_i) \
        __builtin_amdgcn_global_load_lds((const unsigned*)((const char*)(gbase) + (voff)[_i]), (PG8_LAS unsigned*)(lds + (bufoff) + ldsw + _i * 8192), 16, 0, 0); } while (0)
#define PG8_LDA(dst, b, h) do { _Pragma("unroll") for (int m = 0; m < 4; ++m) _Pragma("unroll") for (int k = 0; k < 2; ++k) dst[m][k] = *(const PG8_LAS bf16x8*)(lds + PG8_SA(b, h) + aoff + m * 2048 + k * 1024); } while (0)
#define PG8_LDB(dst, b, h) do { _Pragma("unroll") for (int n = 0; n < 2; ++n) _Pragma("unroll") for (int k = 0; k < 2; ++k) dst[n][k] = *(const PG8_LAS bf16x8*)(lds + PG8_SB(b, h) + boff + n * 2048 + k * 1024); } while (0)
#define PG8_MMA(ai, bj, At, Bt) do { __builtin_amdgcn_s_setprio(1); _Pragma("unroll") for (int m = 0; m < 4; ++m) _Pragma("unroll") for (int n = 0; n < 2; ++n) _Pragma("unroll") for (int k = 0; k < 2; ++k) \
        acc[ai][bj][m][n] = __builtin_amdgcn_mfma_f32_16x16x32_bf16(Bt[n][k], At[m][k], acc[ai][bj][m][n], 0, 0, 0); __builtin_amdgcn_s_setprio(0); } while (0)
#define PG8_WAIT_V(n) asm volatile("s_waitcnt vmcnt(" #n ")" ::: "memory")
#define PG8_WAIT_L(n) asm volatile("s_waitcnt lgkmcnt(" #n ")" ::: "memory")
#define PG8_BAR __builtin_amdgcn_s_barrier()
#define PG8_SCHED __builtin_amdgcn_sched_barrier(0)
    Unit cur, nxt; int ui = 0;
    if (!S.next(0, cur)) return;
    f32x4 acc[2][2][4][2];
#pragma unroll
    for (int a = 0; a < 2; ++a)
#pragma unroll
        for (int b = 0; b < 2; ++b)
#pragma unroll
            for (int m = 0; m < 4; ++m)
#pragma unroll
                for (int n = 0; n < 2; ++n) acc[a][b][m][n] = (f32x4){0.f, 0.f, 0.f, 0.f};
    bf16x8 At[4][2], B0[2][2], B1[2][2];
    const char* cA = (const char*)g.A + (size_t)cur.pm * tstep; const char* cB = (const char*)g.Bt + (size_t)cur.pn * tstep;
    S.a_ready(cur);
    if constexpr (SP2) {
        PG8_STAGE(PG8_SB(0, 0), cB, voffB); PG8_STAGE(PG8_SB(0, 1), cB + hstep, voffB); PG8_STAGE(PG8_SA(0, 0), cA, voffA); PG8_STAGE(PG8_SA(0, 1), cA + hstep, voffA);
        if (wr == 1) PG8_BAR;
        PG8_WAIT_V(2); PG8_BAR;
        PG8_STAGE(PG8_SB(1, 0), cB + kstep, voffB); PG8_STAGE(PG8_SA(1, 0), cA + kstep, voffA); PG8_STAGE(PG8_SB(1, 1), cB + hstep + kstep, voffB);
        PG8_WAIT_V(6); PG8_BAR;
    } else {
        PG8_STAGE(PG8_SB(0, 0), cB, voffB); PG8_STAGE(PG8_SA(0, 0), cA, voffA); PG8_STAGE(PG8_SB(0, 1), cB + hstep, voffB); PG8_STAGE(PG8_SA(0, 1), cA + hstep, voffA);
        if (wr == 1) PG8_BAR;
        PG8_WAIT_V(4); PG8_BAR;
        PG8_STAGE(PG8_SB(1, 0), cB + kstep, voffB); PG8_STAGE(PG8_SA(1, 0), cA + kstep, voffA); PG8_STAGE(PG8_SB(1, 1), cB + hstep + kstep, voffB);
        PG8_WAIT_V(6); PG8_BAR;
    }
    for (;;) {
        const bool has_next = S.next(ui + 1, nxt);
        const char* nA = has_next ? (const char*)g.A + (size_t)nxt.pm * tstep : cA; const char* nB = has_next ? (const char*)g.Bt + (size_t)nxt.pn * tstep : cB;
        for (int t = 0; t < nt; t += 2) {
            const bool last = (t == nt - 2);
            const char* a1 = cA + (size_t)(t + 1) * kstep;
            const char* a2 = last ? nA : cA + (size_t)(t + 2) * kstep; const char* b2 = last ? nB : cB + (size_t)(t + 2) * kstep;
            const char* a3 = a2 + kstep; const char* b3 = b2 + kstep;
            if (last && has_next) S.a_ready(nxt);
            if constexpr (SP2) {
            PG8_LDB(B0, 0, 0); PG8_LDB(B1, 0, 1); PG8_SCHED; PG8_LDA(At, 0, 0); PG8_STAGE(PG8_SA(1, 1), a1 + hstep, voffA);
            PG8_WAIT_V(8); PG8_WAIT_L(0); PG8_BAR; PG8_MMA(0, 0, At, B0); PG8_MMA(0, 1, At, B1); PG8_BAR; PG8_SCHED;
            PG8_LDA(At, 0, 1); PG8_STAGE(PG8_SB(0, 0), b2, voffB); PG8_STAGE(PG8_SB(0, 1), b2 + hstep, voffB); PG8_STAGE(PG8_SA(0, 0), a2, voffA);
            PG8_WAIT_V(8); PG8_WAIT_L(0); PG8_BAR; PG8_MMA(1, 0, At, B0); PG8_MMA(1, 1, At, B1); PG8_BAR; PG8_SCHED;
            PG8_LDB(B0, 1, 0); PG8_LDB(B1, 1, 1); PG8_SCHED; PG8_LDA(At, 1, 0); PG8_STAGE(PG8_SA(0, 1), a2 + hstep, voffA);
            PG8_WAIT_V(8); PG8_WAIT_L(0); PG8_BAR; PG8_MMA(0, 0, At, B0); PG8_MMA(0, 1, At, B1); PG8_BAR; PG8_SCHED;
            PG8_LDA(At, 1, 1); PG8_STAGE(PG8_SB(1, 0), b3, voffB); PG8_STAGE(PG8_SB(1, 1), b3 + hstep, voffB); PG8_STAGE(PG8_SA(1, 0), a3, voffA);
            PG8_WAIT_V(8); PG8_WAIT_L(0); PG8_BAR; PG8_MMA(1, 0, At, B0); PG8_MMA(1, 1, At, B1); PG8_BAR; PG8_SCHED;
            } else {
            PG8_LDB(B0, 0, 0); PG8_SCHED; PG8_LDA(At, 0, 0); PG8_STAGE(PG8_SA(1, 1), a1 + hstep, voffA);
            PG8_WAIT_L(8); PG8_BAR; PG8_WAIT_L(0); PG8_MMA(0, 0, At, B0); PG8_BAR; PG8_SCHED;
            PG8_LDB(B1, 0, 1); PG8_STAGE(PG8_SB(0, 0), b2, voffB);
            PG8_BAR; PG8_WAIT_L(0); PG8_MMA(0, 1, At, B1); PG8_BAR;
            PG8_LDA(At, 0, 1); PG8_STAGE(PG8_SA(0, 0), a2, voffA);
            PG8_BAR; PG8_WAIT_L(0); PG8_MMA(1, 0, At, B0); PG8_BAR; PG8_SCHED;
            PG8_STAGE(PG8_SB(0, 1), b2 + hstep, voffB);
            PG8_WAIT_V(6); PG8_BAR; PG8_MMA(1, 1, At, B1); PG8_BAR;
            PG8_LDB(B0, 1, 0); PG8_SCHED; PG8_LDA(At, 1, 0); PG8_STAGE(PG8_SA(0, 1), a2 + hstep, voffA);
            PG8_WAIT_L(8); PG8_BAR; PG8_WAIT_L(0); PG8_MMA(0, 0, At, B0); PG8_BAR; PG8_SCHED;
            PG8_LDB(B1, 1, 1); PG8_STAGE(PG8_SB(1, 0), b3, voffB);
            PG8_BAR; PG8_WAIT_L(0); PG8_MMA(0, 1, At, B1); PG8_BAR;
            PG8_LDA(At, 1, 1); PG8_STAGE(PG8_SA(1, 0), a3, voffA);
            PG8_BAR; PG8_WAIT_L(0); PG8_MMA(1, 0, At, B0); PG8_BAR; PG8_SCHED;
            PG8_STAGE(PG8_SB(1, 1), b3 + hstep, voffB);
            PG8_WAIT_V(6); PG8_BAR; PG8_MMA(1, 1, At, B1); PG8_BAR;
            }
        }
        if constexpr (ALIGN_EPI) { if (wr == 0) PG8_BAR; }
        if constexpr (!Epi::AFTER_DRAIN) { E(acc, cur, wr, wc, fr, fq); S.done(cur); }
        if (!has_next) break;
#pragma unroll
        for (int a = 0; a < 2; ++a)
#pragma unroll
            for (int b = 0; b < 2; ++b)
#pragma unroll
                for (int m = 0; m < 4; ++m)
#pragma unroll
                    for (int n = 0; n < 2; ++n) acc[a][b][m][n] = (f32x4){0.f, 0.f, 0.f, 0.f};
        cur = nxt; cA = nA; cB = nB; ++ui;
        if constexpr (ALIGN_EPI) { if (wr == 1) PG8_BAR; }
    }
    PG8_WAIT_V(0);
    if constexpr (!ALIGN_EPI) { if (wr == 0) PG8_BAR; }
    PG8_BAR;
    if constexpr (Epi::AFTER_DRAIN) { E.fused(acc, cur, wr, wc, fr, fq, lds, wid, lane); S.done(cur); }
#undef PG8_SA
#undef PG8_SB
#undef PG8_STAGE
#undef PG8_LDA
#undef PG8_LDB
#undef PG8_MMA
#undef PG8_WAIT_V
#undef PG8_WAIT_L
#undef PG8_BAR
#undef PG8_SCHED
}
}

namespace att {
using bf16 = unsigned short;
constexpr int D = 128, NW = 8, QBLK = 32, KVBLK = 64;
constexpr float SCALE = 0.088388347648318440f;
constexpr float THR = 8.f;
constexpr int SDEPTH = 2;
constexpr int LDQ = INC, LDK = INC, LDO = DM;
constexpr size_t SHM_V = KVBLK * D * 2, SHM_K = KVBLK * D * 2, SHM_ATTN = 2 * SHM_V + 2 * SHM_K + NW * 64 * 4;

using bf16x8 = __attribute__((ext_vector_type(8))) short;
using s16x4  = __attribute__((ext_vector_type(4))) short;
using f32x16 = __attribute__((ext_vector_type(16))) float;
using f32x8  = __attribute__((ext_vector_type(8))) float;
using u32x4  = __attribute__((ext_vector_type(4))) unsigned;
#define KSWZ(row, colB) ((row) * 256 + ((colB) ^ (((row) & 7) << 4)))
#define SBAR() __builtin_amdgcn_sched_barrier(0)
__device__ __forceinline__ int crow(int r, int hi) { return (r & 3) + 8 * (r >> 2) + 4 * hi; }
__device__ __forceinline__ unsigned cvtpk(float lo, float hi) {
  unsigned r; asm volatile("v_cvt_pk_bf16_f32 %0, %1, %2" : "=v"(r) : "v"(lo), "v"(hi)); return r;
}
template <typename TIn> struct Stage;
template <> struct Stage<bf16>  { using T = bf16x8;
  __device__ static __forceinline__ T ld8(const bf16* p) { return *reinterpret_cast<const bf16x8*>(p); }
  __device__ static __forceinline__ bf16x8 tobf(T x) { return x; } };
template <> struct Stage<float> { using T = f32x8;
  __device__ static __forceinline__ T ld8(const float* p) { return *reinterpret_cast<const f32x8*>(p); }
  __device__ static __forceinline__ bf16x8 tobf(T x) {
    u32x4 w = {cvtpk(x[0], x[1]), cvtpk(x[2], x[3]), cvtpk(x[4], x[5]), cvtpk(x[6], x[7])}; return *reinterpret_cast<bf16x8*>(&w); } };

__device__ __forceinline__ void partialSM(f32x16& p0, f32x16& p1, float& m_reg, float& mn, float& alpha) {
  constexpr float C = SCALE * 1.4426950408889634f;
  float pmax = p0[0]; for (int r = 1; r < 16; ++r) pmax = fmaxf(pmax, p0[r]); for (int r = 0; r < 16; ++r) pmax = fmaxf(pmax, p1[r]);
  { auto rr = __builtin_amdgcn_permlane32_swap(__float_as_uint(pmax), __float_as_uint(pmax), false, false);
    pmax = fmaxf(__uint_as_float(rr[0]), __uint_as_float(rr[1])); }
  if (__builtin_expect(__all(pmax - m_reg <= THR / SCALE), 1)) { mn = m_reg; alpha = 1.f; }
  else { mn = fmaxf(m_reg, pmax); alpha = __builtin_amdgcn_exp2f((m_reg - mn) * C); m_reg = mn; }
  float mnC = -mn * C;
  for (int r = 0; r < 16; ++r) p0[r] = fmaf(p0[r], C, mnC); for (int r = 0; r < 16; ++r) p1[r] = fmaf(p1[r], C, mnC);
  for (int r = 0; r < 16; ++r) p0[r] = __builtin_amdgcn_exp2f(p0[r]);
}
__device__ __forceinline__ void finishSM(f32x16& p0, f32x16& p1, float alpha, float& l_reg, bf16x8& pa0, bf16x8& pa1, bf16x8& pa2, bf16x8& pa3) {
  for (int r = 0; r < 16; ++r) p1[r] = __builtin_amdgcn_exp2f(p1[r]);
  float ps = 0; for (int r = 0; r < 16; ++r) ps += p0[r]; for (int r = 0; r < 16; ++r) ps += p1[r];
  { auto rr = __builtin_amdgcn_permlane32_swap(__float_as_uint(ps), __float_as_uint(ps), false, false);
    ps = __uint_as_float(rr[0]) + __uint_as_float(rr[1]); }
  l_reg = l_reg * alpha + ps;
#define PK4(P, BASE, OUT) do { unsigned a0 = cvtpk(P[BASE + 0], P[BASE + 1]), a1 = cvtpk(P[BASE + 2], P[BASE + 3]);   \
    unsigned b0 = cvtpk(P[BASE + 4], P[BASE + 5]), b1 = cvtpk(P[BASE + 6], P[BASE + 7]);                              \
    auto r0 = __builtin_amdgcn_permlane32_swap(a0, b0, false, false); auto r1 = __builtin_amdgcn_permlane32_swap(a1, b1, false, false); \
    u32x4 w = {r0[0], r1[0], r0[1], r1[1]}; OUT = *reinterpret_cast<bf16x8*>(&w); } while (0)
  PK4(p0, 0, pa0); PK4(p0, 8, pa1); PK4(p1, 0, pa2); PK4(p1, 8, pa3);
#undef PK4
}
__device__ __forceinline__ void qkt(f32x16& p0, f32x16& p1, const bf16* Ks, const bf16x8* qr, int r32, int hi) {
  p0 = f32x16{}; p1 = f32x16{};
  for (int d0 = 0; d0 < 8; ++d0) { int cb = (d0 * 16 + hi * 8) * 2;
    bf16x8 b0 = *reinterpret_cast<const bf16x8*>((const char*)Ks + KSWZ(r32, cb));
    bf16x8 b1 = *reinterpret_cast<const bf16x8*>((const char*)Ks + KSWZ(32 + r32, cb));
    p0 = __builtin_amdgcn_mfma_f32_32x32x16_bf16(b0, qr[d0], p0, 0, 0, 0);
    p1 = __builtin_amdgcn_mfma_f32_32x32x16_bf16(b1, qr[d0], p1, 0, 0, 0); }
}
__device__ __forceinline__ int v_st(int k, int c) { const int kk = (k & ~0xC) | ((k & 4) << 1) | ((k & 8) >> 1); return ((kk >> 3) * 4 + (c >> 5)) * 512 + ((kk & 7) * 32 + (c & 31)) * 2; }
__device__ __forceinline__ int v_rd_base(int lane) { return ((lane & 3) << 3) | (((lane >> 2) & 3) << 6) | (((lane >> 4) & 1) << 5) | (((lane >> 5) & 1) << 8); }
constexpr int v_rd_off(int d0, int ks, int half) { return d0 * 512 + ks * 4096 + half * 2048; }
template <int OFF> __device__ __forceinline__ s16x4 tr_read(int vb) {
  s16x4 r; asm volatile("ds_read_b64_tr_b16 %0, %1 offset:%2" : "=&v"(r) : "v"(vb), "i"(OFF) : "memory"); return r;
}
template <int D0> __device__ __forceinline__ void pv_one(f32x16& od, int vb, bf16x8 pa0, bf16x8 pa1, bf16x8 pa2, bf16x8 pa3) {
  const s16x4 l0 = tr_read<v_rd_off(D0, 0, 0)>(vb), h0 = tr_read<v_rd_off(D0, 0, 1)>(vb), l1 = tr_read<v_rd_off(D0, 1, 0)>(vb), h1 = tr_read<v_rd_off(D0, 1, 1)>(vb);
  const s16x4 l2 = tr_read<v_rd_off(D0, 2, 0)>(vb), h2 = tr_read<v_rd_off(D0, 2, 1)>(vb), l3 = tr_read<v_rd_off(D0, 3, 0)>(vb), h3 = tr_read<v_rd_off(D0, 3, 1)>(vb);
  asm volatile("s_waitcnt lgkmcnt(0)" ::: "memory"); SBAR();
#define PK(L, H) (bf16x8){L[0], L[1], L[2], L[3], H[0], H[1], H[2], H[3]}
  od = __builtin_amdgcn_mfma_f32_32x32x16_bf16(pa0, PK(l0, h0), od, 0, 0, 0);
  od = __builtin_amdgcn_mfma_f32_32x32x16_bf16(pa1, PK(l1, h1), od, 0, 0, 0);
  od = __builtin_amdgcn_mfma_f32_32x32x16_bf16(pa2, PK(l2, h2), od, 0, 0, 0);
  od = __builtin_amdgcn_mfma_f32_32x32x16_bf16(pa3, PK(l3, h3), od, 0, 0, 0);
#undef PK
}
__device__ __forceinline__ void pv_d0(f32x16* o, int vb, bf16x8 pa0, bf16x8 pa1, bf16x8 pa2, bf16x8 pa3) {
  pv_one<0>(o[0], vb, pa0, pa1, pa2, pa3); pv_one<1>(o[1], vb, pa0, pa1, pa2, pa3); pv_one<2>(o[2], vb, pa0, pa1, pa2, pa3); pv_one<3>(o[3], vb, pa0, pa1, pa2, pa3);
}

__device__ __forceinline__ void band_mask(f32x16& p0, f32x16& p1, int dq  , int hi) {
#pragma unroll
  for (int r = 0; r < 16; ++r) { const int d = dq - crow(r, hi);
    if ((unsigned)(d + 128) > 256u) p0[r] = -1e30f;
    if ((unsigned)(d + 96) > 256u) p1[r] = -1e30f; }
}
template <bool MASK>
__device__ __forceinline__ void attn_body(const bf16* __restrict__ Qb, const bf16* __restrict__ Kh, const bf16* __restrict__ Vh,
                                          bf16* __restrict__ Ob, int NT, int NCT, int lo, int qpos0, float sinkl2, char* lds) {
  using St = Stage<bf16>;
  int tid_ = threadIdx.x; asm volatile("" : "+v"(tid_));
  const int tid = tid_, wid = tid >> 6, lane = tid & 63, r32 = lane & 31, hi = lane >> 5;
  bf16* V_lds = (bf16*)lds; bf16* K_lds = (bf16*)(lds + 2 * SHM_V);
  float* ws = (float*)(lds + 2 * SHM_V + 2 * SHM_K) + wid * 64; float* li_l = ws; float* al_l = ws + 32;
  float m_reg = -1e30f, l_reg = 0; f32x16 o[4] = {}; bf16x8 qr[8];
  const bf16* Qw = Qb + (long)(wid * QBLK + r32) * LDQ + hi * 8;
#pragma unroll
  for (int d0 = 0; d0 < 8; ++d0) qr[d0] = St::ld8(Qw + d0 * 16);
  const int sr = tid >> 4, sc = (tid & 15) * 8, vst0 = v_st(sr, sc), vst1 = v_st(32 + sr, sc);
  const int vb0 = (int)(uintptr_t)V_lds + v_rd_base(lane);
  const int qi = qpos0 + wid * QBLK + r32;
  struct { typename St::T vs0, vs1, ks0, ks1; } sr_[SDEPTH];
#define TROW(j) (64 * (j) + ((j) >= NCT ? lo : 0))
#define SLOAD(i, k0) do { const long k0_ = (k0); sr_[i].vs0 = St::ld8(&Vh[(k0_ + sr) * LDK + sc]); sr_[i].vs1 = St::ld8(&Vh[(k0_ + 32 + sr) * LDK + sc]); \
    sr_[i].ks0 = St::ld8(&Kh[(k0_ + sr) * LDK + sc]); sr_[i].ks1 = St::ld8(&Kh[(k0_ + 32 + sr) * LDK + sc]); } while (0)
#define SWRITE(b, i) do { *(bf16x8*)((char*)V_lds + (b) * SHM_V + vst0) = St::tobf(sr_[i].vs0);          \
    *(bf16x8*)((char*)V_lds + (b) * SHM_V + vst1) = St::tobf(sr_[i].vs1); int kc = sc * 2;               \
    *(bf16x8*)((char*)K_lds + (b) * SHM_K + KSWZ(sr, kc)) = St::tobf(sr_[i].ks0);                       \
    *(bf16x8*)((char*)K_lds + (b) * SHM_K + KSWZ(32 + sr, kc)) = St::tobf(sr_[i].ks1); } while (0)
#define SWAIT() do { if constexpr (SDEPTH == 2) asm volatile("s_waitcnt vmcnt(4)" ::: "memory"); else asm volatile("s_waitcnt vmcnt(0)" ::: "memory"); } while (0)
#define RESC(a) do { if (__any((a) < 1.f)) { if (hi == 0) al_l[r32] = (a); asm volatile("s_waitcnt lgkmcnt(0)" ::: "memory"); \
    for (int d = 0; d < 4; ++d) for (int r = 0; r < 16; ++r) o[d][r] *= al_l[crow(r, hi)]; } } while (0)
#define AMASK(P0, P1, j) do { if constexpr (MASK) { if ((j) >= NCT) band_mask(P0, P1, qi - (lo + 64 * ((j) - NCT)), hi); } } while (0)
  f32x16 pA0, pA1, pB0, pB1; float mnA, mnB, alA, alB; bf16x8 pa0, pa1, pa2, pa3;
  constexpr int SE = 0, SO = SDEPTH - 1;
  SLOAD(SE, TROW(0)); asm volatile("s_waitcnt vmcnt(0)" ::: "memory"); SWRITE(0, SE); __syncthreads();
  qkt(pA0, pA1, K_lds, qr, r32, hi); AMASK(pA0, pA1, 0); partialSM(pA0, pA1, m_reg, mnA, alA);
  SLOAD(SO, TROW(1)); if constexpr (SDEPTH == 2) { if (2 < NT) SLOAD(SE, TROW(2)); }
  SWAIT(); SWRITE(1, SO); __syncthreads();
  for (int j = 1; j + 1 < NT; j += 2) {
    SBAR(); qkt(pB0, pB1, (bf16*)((char*)K_lds + SHM_K), qr, r32, hi); AMASK(pB0, pB1, j);
    finishSM(pA0, pA1, alA, l_reg, pa0, pa1, pa2, pa3); SBAR();
    SLOAD(SO, TROW(j + SDEPTH)); SBAR();
    pv_d0(o, vb0, pa0, pa1, pa2, pa3); partialSM(pB0, pB1, m_reg, mnB, alB);
    __syncthreads(); SWAIT(); SWRITE(0, SE);
    RESC(alB); __syncthreads();
    SBAR(); qkt(pA0, pA1, K_lds, qr, r32, hi); AMASK(pA0, pA1, j + 1);
    finishSM(pB0, pB1, alB, l_reg, pa0, pa1, pa2, pa3); SBAR();
    if (SDEPTH == 1 || j + 3 < NT) SLOAD(SE, TROW(j + 1 + SDEPTH)); SBAR();
    pv_d0(o, vb0 + (int)SHM_V, pa0, pa1, pa2, pa3); partialSM(pA0, pA1, m_reg, mnA, alA);
    __syncthreads(); SWAIT(); SWRITE(1, SO);
    RESC(alA); __syncthreads();
  }
  SBAR(); qkt(pB0, pB1, (bf16*)((char*)K_lds + SHM_K), qr, r32, hi); AMASK(pB0, pB1, NT - 1);
  finishSM(pA0, pA1, alA, l_reg, pa0, pa1, pa2, pa3); SBAR();
  pv_d0(o, vb0, pa0, pa1, pa2, pa3); partialSM(pB0, pB1, m_reg, mnB, alB);
  __syncthreads(); RESC(alB);
  finishSM(pB0, pB1, alB, l_reg, pa0, pa1, pa2, pa3); SBAR();
  pv_d0(o, vb0 + (int)SHM_V, pa0, pa1, pa2, pa3);
  l_reg += __builtin_amdgcn_exp2f(sinkl2 - m_reg * (SCALE * 1.4426950408889634f));
  if (hi == 0) li_l[r32] = l_reg; asm volatile("s_waitcnt lgkmcnt(0)" ::: "memory");
  float rli[16];
#pragma unroll
  for (int r = 0; r < 16; ++r) rli[r] = __builtin_amdgcn_rcpf(li_l[crow(r, hi)]);
  bf16* Ow = Ob + (long)(wid * QBLK) * LDO;
#pragma unroll
  for (int r = 0; r < 16; ++r) { int orow = crow(r, hi);
    for (int d0 = 0; d0 < 4; ++d0) { const float v = o[d0][r] * rli[r]; const unsigned u = __builtin_bit_cast(unsigned, v);
      Ow[(long)orow * LDO + d0 * 32 + r32] = (bf16)((u + 0x7fffu + ((u >> 16) & 1u)) >> 16); } }
  __syncthreads();
#undef TROW
#undef SLOAD
#undef SWRITE
#undef SWAIT
#undef RESC
#undef AMASK
}

template <int OFF> __device__ __forceinline__ bf16x8 k_read(int addr) { bf16x8 r; asm volatile("ds_read_b128 %0, %1 offset:%2" : "=&v"(r) : "v"(addr), "i"(OFF) : "memory"); return r; }
__device__ __forceinline__ void qkt_pipe(f32x16& p0, f32x16& p1, const bf16* Ks, const bf16x8* qr, int r32, int hi) {
  p0 = f32x16{}; p1 = f32x16{};
  const int kb = (int)(uintptr_t)Ks + r32 * 256, sw = (r32 & 7) << 4;
  const int e0 = kb + ((0 * 32 + hi * 16) ^ sw), e1 = kb + ((1 * 32 + hi * 16) ^ sw), e2 = kb + ((2 * 32 + hi * 16) ^ sw), e3 = kb + ((3 * 32 + hi * 16) ^ sw);
  bf16x8 a0, a1, b0, b1;
#define LGK(n) do { asm volatile("s_waitcnt lgkmcnt(" #n ")" ::: "memory"); SBAR(); } while (0)
#define MM(A0, A1, d) do { p0 = __builtin_amdgcn_mfma_f32_32x32x16_bf16(A0, qr[d], p0, 0, 0, 0); p1 = __builtin_amdgcn_mfma_f32_32x32x16_bf16(A1, qr[d], p1, 0, 0, 0); SBAR(); } while (0)
  a0 = k_read<0>(e0); a1 = k_read<8192>(e0); b0 = k_read<0>(e1); b1 = k_read<8192>(e1);
  LGK(2); MM(a0, a1, 0); a0 = k_read<0>(e2); a1 = k_read<8192>(e2);
  LGK(2); MM(b0, b1, 1); b0 = k_read<0>(e3); b1 = k_read<8192>(e3);
  LGK(2); MM(a0, a1, 2); a0 = k_read<128>(e0); a1 = k_read<8320>(e0);
  LGK(2); MM(b0, b1, 3); b0 = k_read<128>(e1); b1 = k_read<8320>(e1);
  LGK(2); MM(a0, a1, 4); a0 = k_read<128>(e2); a1 = k_read<8320>(e2);
  LGK(2); MM(b0, b1, 5); b0 = k_read<128>(e3); b1 = k_read<8320>(e3);
  LGK(2); MM(a0, a1, 6);
  LGK(0); MM(b0, b1, 7);
#undef LGK
#undef MM
}
struct VFr { s16x4 l0, h0, l1, h1, l2, h2, l3, h3; };
template <int DB> __device__ __forceinline__ void pv_ld(VFr& f, int vb) {
  constexpr int I = (DB >> 2) * 16384, D0 = DB & 3;
  f.l0 = tr_read<I + v_rd_off(D0, 0, 0)>(vb); f.h0 = tr_read<I + v_rd_off(D0, 0, 1)>(vb); f.l1 = tr_read<I + v_rd_off(D0, 1, 0)>(vb); f.h1 = tr_read<I + v_rd_off(D0, 1, 1)>(vb);
  f.l2 = tr_read<I + v_rd_off(D0, 2, 0)>(vb); f.h2 = tr_read<I + v_rd_off(D0, 2, 1)>(vb); f.l3 = tr_read<I + v_rd_off(D0, 3, 0)>(vb); f.h3 = tr_read<I + v_rd_off(D0, 3, 1)>(vb);
}
__device__ __forceinline__ void pv_mm(f32x16& od, const VFr& f, bf16x8 pa0, bf16x8 pa1, bf16x8 pa2, bf16x8 pa3) {
#define PK(L, H) (bf16x8){L[0], L[1], L[2], L[3], H[0], H[1], H[2], H[3]}
  od = __builtin_amdgcn_mfma_f32_32x32x16_bf16(pa0, PK(f.l0, f.h0), od, 0, 0, 0);
  od = __builtin_amdgcn_mfma_f32_32x32x16_bf16(pa1, PK(f.l1, f.h1), od, 0, 0, 0);
  od = __builtin_amdgcn_mfma_f32_32x32x16_bf16(pa2, PK(f.l2, f.h2), od, 0, 0, 0);
  od = __builtin_amdgcn_mfma_f32_32x32x16_bf16(pa3, PK(f.l3, f.h3), od, 0, 0, 0);
#undef PK
}
__device__ __forceinline__ void pv_all(f32x16* o, int vb, bf16x8 pa0, bf16x8 pa1, bf16x8 pa2, bf16x8 pa3) {
  VFr fa, fb;
#define W8() do { asm volatile("s_waitcnt lgkmcnt(8)" ::: "memory"); SBAR(); } while (0)
#define W0() do { asm volatile("s_waitcnt lgkmcnt(0)" ::: "memory"); SBAR(); } while (0)
  pv_ld<0>(fa, vb);
  pv_ld<1>(fb, vb); W8(); pv_mm(o[0], fa, pa0, pa1, pa2, pa3); SBAR();
  pv_ld<2>(fa, vb); W8(); pv_mm(o[1], fb, pa0, pa1, pa2, pa3); SBAR();
  pv_ld<3>(fb, vb); W8(); pv_mm(o[2], fa, pa0, pa1, pa2, pa3); SBAR();
  pv_ld<4>(fa, vb); W8(); pv_mm(o[3], fb, pa0, pa1, pa2, pa3); SBAR();
  pv_ld<5>(fb, vb); W8(); pv_mm(o[4], fa, pa0, pa1, pa2, pa3); SBAR();
  pv_ld<6>(fa, vb); W8(); pv_mm(o[5], fb, pa0, pa1, pa2, pa3); SBAR();
  pv_ld<7>(fb, vb); W8(); pv_mm(o[6], fa, pa0, pa1, pa2, pa3); SBAR();
  W0(); pv_mm(o[7], fb, pa0, pa1, pa2, pa3);
#undef W8
#undef W0
}
#define ATT_LAS __attribute__((address_space(3)))
struct VH { s16x4 l0, h0, l1, h1; };
template <int DB, int KS> __device__ __forceinline__ void pv_ldh(VH& f, int vb) {
  constexpr int I = (DB >> 2) * 16384, D0 = DB & 3;
  f.l0 = tr_read<I + v_rd_off(D0, KS, 0)>(vb); f.h0 = tr_read<I + v_rd_off(D0, KS, 1)>(vb); f.l1 = tr_read<I + v_rd_off(D0, KS + 1, 0)>(vb); f.h1 = tr_read<I + v_rd_off(D0, KS + 1, 1)>(vb);
}
#define PKV(L, H) (bf16x8){L[0], L[1], L[2], L[3], H[0], H[1], H[2], H[3]}
#define PK4S(P, BASE, OUT) do { unsigned a0_ = cvtpk(P[BASE + 0], P[BASE + 1]), a1_ = cvtpk(P[BASE + 2], P[BASE + 3]);   \
    unsigned b0_ = cvtpk(P[BASE + 4], P[BASE + 5]), b1_ = cvtpk(P[BASE + 6], P[BASE + 7]);                              \
    auto r0_ = __builtin_amdgcn_permlane32_swap(a0_, b0_, false, false); auto r1_ = __builtin_amdgcn_permlane32_swap(a1_, b1_, false, false); \
    u32x4 w_ = {r0_[0], r1_[0], r0_[1], r1_[1]}; OUT = *reinterpret_cast<bf16x8*>(&w_); } while (0)
__device__ __forceinline__ void smpv_all(f32x16& p0, f32x16& p1, float alpha, float& l_reg, f32x16* o, int vb,
                                         const char* kb, const char* vbg, ATT_LAS unsigned char* kdst, ATT_LAS unsigned char* vdst, bool dma) {
  bf16x8 pa0, pa1, pa2, pa3; VH fa, fb; float s0 = 0.f, s1 = 0.f;
  PK4S(p0, 0, pa0); PK4S(p0, 8, pa1);
#define WL(n) do { asm volatile("s_waitcnt lgkmcnt(" #n ")" ::: "memory"); SBAR(); } while (0)
#define P1BLK(B, FC, FN, LAST) do { if (!(LAST)) pv_ldh<((B) + 1) & 7, 0>(FN, vb); if (LAST) WL(0); else WL(4); \
    o[B] = __builtin_amdgcn_mfma_f32_32x32x16_bf16(pa0, PKV(FC.l0, FC.h0), o[B], 0, 0, 0); \
    p1[2 * (B)] = __builtin_amdgcn_exp2f(p1[2 * (B)]); s0 += p0[2 * (B)]; s1 += p0[2 * (B) + 1]; SBAR(); \
    o[B] = __builtin_amdgcn_mfma_f32_32x32x16_bf16(pa1, PKV(FC.l1, FC.h1), o[B], 0, 0, 0); \
    p1[2 * (B) + 1] = __builtin_amdgcn_exp2f(p1[2 * (B) + 1]); if ((B) > 0) { s0 += p1[2 * (B) - 2]; s1 += p1[2 * (B) - 1]; } SBAR(); } while (0)
  pv_ldh<0, 0>(fa, vb);
  P1BLK(0, fa, fb, false); P1BLK(1, fb, fa, false); P1BLK(2, fa, fb, false); P1BLK(3, fb, fa, false);
  P1BLK(4, fa, fb, false); P1BLK(5, fb, fa, false); P1BLK(6, fa, fb, false); P1BLK(7, fb, fa, true);
  pv_ldh<0, 2>(fa, vb);
  s0 += p1[14]; s1 += p1[15];
  float ps = s0 + s1;
  { auto rr = __builtin_amdgcn_permlane32_swap(__float_as_uint(ps), __float_as_uint(ps), false, false); ps = __uint_as_float(rr[0]) + __uint_as_float(rr[1]); }
  l_reg = l_reg * alpha + ps;
  PK4S(p1, 0, pa2); PK4S(p1, 8, pa3); SBAR();
#define DMAP(B) do { if (dma) { if ((B) < 2) __builtin_amdgcn_global_load_lds((const unsigned*)(kb + (B) * (32 * LDK * 2)), (ATT_LAS unsigned*)(kdst + (B) * 8192), 16, 0, 0); \
      else if ((B) < 6) __builtin_amdgcn_global_load_lds((const unsigned*)(vbg + (((B) - 2) & 1) * (32 * LDK * 2) + (((B) - 2) >> 1) * 256), (ATT_LAS unsigned*)(vdst + ((B) - 2) * 8192), 16, 0, 0); } } while (0)
#define P2BLK(B, FC, FN, LAST) do { if (!(LAST)) pv_ldh<((B) + 1) & 7, 2>(FN, vb); if (LAST) WL(0); else WL(4); \
    o[B] = __builtin_amdgcn_mfma_f32_32x32x16_bf16(pa2, PKV(FC.l0, FC.h0), o[B], 0, 0, 0); DMAP(B); \
    o[B] = __builtin_amdgcn_mfma_f32_32x32x16_bf16(pa3, PKV(FC.l1, FC.h1), o[B], 0, 0, 0); SBAR(); } while (0)
  P2BLK(0, fa, fb, false); P2BLK(1, fb, fa, false); P2BLK(2, fa, fb, false); P2BLK(3, fb, fa, false);
  P2BLK(4, fa, fb, false); P2BLK(5, fb, fa, false); P2BLK(6, fa, fb, false); P2BLK(7, fb, fa, true);
#undef WL
#undef P1BLK
#undef P2BLK
#undef DMAP
}
#undef PKV
#undef PK4S
__device__ __forceinline__ void attn_body_v256(const bf16* __restrict__ Qb, const bf16* __restrict__ Kh, const bf16* __restrict__ Vh,
                                               bf16* __restrict__ Ob, int NT, ATT_LAS unsigned char* ldsl) {
  using St = Stage<bf16>;
  int tid_ = threadIdx.x; asm volatile("" : "+v"(tid_));
  const int tid = tid_, wid = __builtin_amdgcn_readfirstlane(tid >> 6), lane = tid & 63, r32 = lane & 31, hi = lane >> 5;
  char* lds = (char*)ldsl;
  float* ws = (float*)(lds + 147456) + wid * 64; float* li_l = ws; float* al_l = ws + 32;
  float m_reg = -1e30f, l_reg = 0; f32x16 o[8] = {}; bf16x8 qr[8];
  const bf16* Qw = Qb + (long)(wid * QBLK + r32) * LDQ + hi * 8;
#pragma unroll
  for (int d0 = 0; d0 < 8; ++d0) qr[d0] = St::ld8(Qw + d0 * 16);
  unsigned offK0, offV0;
  { const int row = wid * 4 + (lane >> 4), colB = ((lane & 15) * 16) ^ ((row & 7) << 4); offK0 = (unsigned)row * (LDK * 2) + (unsigned)colB;
    const int sub = wid * 2 + (lane >> 5), kkhi = sub >> 2, cblk = sub & 3, within = (lane & 31) * 16, kk = kkhi * 8 + (within >> 6);
    const int k = (kk & ~0xC) | ((kk & 4) << 1) | ((kk & 8) >> 1), c = cblk * 32 + ((within & 63) >> 1);
    offV0 = (unsigned)k * (LDK * 2) + (unsigned)c * 2; }
  const int vb0 = (int)(uintptr_t)lds + 16384 + v_rd_base(lane);
#define DMA_TILE(j, sbo) do { const char* kb_ = (const char*)Kh + (size_t)(j) * (64 * LDK * 2) + offK0; const char* vb_ = (const char*)Vh + (size_t)(j) * (64 * LDK * 2) + offV0; \
    _Pragma("unroll") for (int i_ = 0; i_ < 2; ++i_) __builtin_amdgcn_global_load_lds((const unsigned*)(kb_ + i_ * (32 * LDK * 2)), (ATT_LAS unsigned*)(ldsl + (sbo) + (i_ * 8 + wid) * 1024), 16, 0, 0); \
    _Pragma("unroll") for (int i_ = 0; i_ < 4; ++i_) __builtin_amdgcn_global_load_lds((const unsigned*)(vb_ + (i_ & 1) * (32 * LDK * 2) + (i_ >> 1) * 256), (ATT_LAS unsigned*)(ldsl + (sbo) + 16384 + (i_ * 8 + wid) * 1024), 16, 0, 0); } while (0)
#define RESC8(a) do { if (__any((a) < 1.f)) { if (hi == 0) al_l[r32] = (a); asm volatile("s_waitcnt lgkmcnt(0)" ::: "memory"); \
    for (int d = 0; d < 8; ++d) for (int r = 0; r < 16; ++r) o[d][r] *= al_l[crow(r, hi)]; } } while (0)
#define TILE_SYNC() do { asm volatile("s_waitcnt vmcnt(0)" ::: "memory"); __builtin_amdgcn_s_barrier(); asm volatile("" ::: "memory"); } while (0)
  f32x16 p0, p1; float mn, al;
#pragma unroll
  for (int d0 = 0; d0 < 8; ++d0) asm volatile("" : "+v"(qr[d0]));
  if (wid >= 4) __builtin_amdgcn_s_setprio(2);
  DMA_TILE(0, 0); DMA_TILE(1, 49152);
  int sb = 0, sb2 = 98304;
  for (int j = 0; j < NT; ++j) {
    if (j + 1 < NT) asm volatile("s_waitcnt vmcnt(6)" ::: "memory"); else asm volatile("s_waitcnt vmcnt(0)" ::: "memory");
    __builtin_amdgcn_s_barrier(); asm volatile("" ::: "memory");
    qkt_pipe(p0, p1, (const bf16*)(lds + sb), qr, r32, hi); partialSM(p0, p1, m_reg, mn, al); RESC8(al); SBAR();
    smpv_all(p0, p1, al, l_reg, o, vb0 + sb, (const char*)Kh + (size_t)(j + 2) * (64 * LDK * 2) + offK0, (const char*)Vh + (size_t)(j + 2) * (64 * LDK * 2) + offV0,
             ldsl + sb2 + wid * 1024, ldsl + sb2 + 16384 + wid * 1024, j + 2 < NT);
    sb = (sb == 98304) ? 0 : sb + 49152; sb2 = (sb2 == 98304) ? 0 : sb2 + 49152;
  }
  __builtin_amdgcn_s_setprio(0);
  if (hi == 0) li_l[r32] = l_reg; asm volatile("s_waitcnt lgkmcnt(0)" ::: "memory");
  float rli[16];
#pragma unroll
  for (int r = 0; r < 16; ++r) rli[r] = __builtin_amdgcn_rcpf(li_l[crow(r, hi)]);
  bf16* Ow = Ob + (long)(wid * QBLK) * LDO;
#pragma unroll
  for (int r = 0; r < 16; ++r) { int orow = crow(r, hi);
#pragma unroll
    for (int d0 = 0; d0 < 8; ++d0) { const float v = o[d0][r] * rli[r]; const unsigned u = __builtin_bit_cast(unsigned, v);
      Ow[(long)orow * LDO + d0 * 32 + r32] = (bf16)((u + 0x7fffu + ((u >> 16) & 1u)) >> 16); } }
#undef DMA_TILE
#undef RESC8
#undef TILE_SYNC
}
__device__ __forceinline__ void attn_body_a(const bf16* __restrict__ Qb, const bf16* __restrict__ Kh, const bf16* __restrict__ Vh, bf16* __restrict__ Ob,
                                            int NT, int NCT, int lo, int qpos0, const float* __restrict__ sk4, const bf16* __restrict__ Zb, ATT_LAS unsigned char* ldsl) {
  using St = Stage<bf16>;
  int tid_ = threadIdx.x; asm volatile("" : "+v"(tid_));
  const int tid = tid_, wid = __builtin_amdgcn_readfirstlane(tid >> 6), lane = tid & 63, r32 = lane & 31, hi = lane >> 5;
  const int g = wid >> 1, rh = wid & 1;
  char* lds = (char*)ldsl;
  float* ws = (float*)(lds + 98304) + wid * 64; float* li_l = ws; float* al_l = ws + 32;
  float m_reg = -1e30f, l_reg = 0; f32x16 o[4] = {}; bf16x8 qr[8];
  const bf16* Qw = Qb + (long)(rh * QBLK + r32) * LDQ + g * 128 + hi * 8;
#pragma unroll
  for (int d0 = 0; d0 < 8; ++d0) qr[d0] = St::ld8(Qw + d0 * 16);
  const float sinkl2 = sk4[g] * 1.4426950408889634f;
  const int qi = qpos0 + rh * QBLK + r32;
  unsigned offK0, offV0;
  { const int row = wid * 4 + (lane >> 4), colB = ((lane & 15) * 16) ^ ((row & 7) << 4); offK0 = (unsigned)row * (LDK * 2) + (unsigned)colB;
    const int sub = wid * 2 + (lane >> 5), kkhi = sub >> 2, cblk = sub & 3, within = (lane & 31) * 16, kk = kkhi * 8 + (within >> 6);
    const int k = (kk & ~0xC) | ((kk & 4) << 1) | ((kk & 8) >> 1), c = cblk * 32 + ((within & 63) >> 1);
    offV0 = (unsigned)k * (LDK * 2) + (unsigned)c * 2; }
  const int vb0 = (int)(uintptr_t)lds + 16384 + v_rd_base(lane);
#define TROWA(j) (64 * (j) + ((j) >= NCT ? lo : 0))
#define DMA_TILE(j, sb) do { const size_t ro_ = (size_t)TROWA(j) * (LDK * 2); const char* kb_ = (const char*)Kh + ro_ + offK0; const char* vb_ = (const char*)Vh + ro_ + offV0; \
    _Pragma("unroll") for (int i_ = 0; i_ < 2; ++i_) { __builtin_amdgcn_global_load_lds((const unsigned*)(kb_ + i_ * (32 * LDK * 2)), (ATT_LAS unsigned*)(ldsl + (sb) + (i_ * 8 + wid) * 1024), 16, 0, 0); \
      __builtin_amdgcn_global_load_lds((const unsigned*)(vb_ + i_ * (32 * LDK * 2)), (ATT_LAS unsigned*)(ldsl + (sb) + 16384 + (i_ * 8 + wid) * 1024), 16, 0, 0); } } while (0)
#define RESC4(a) do { if (__any((a) < 1.f)) { if (hi == 0) al_l[r32] = (a); asm volatile("s_waitcnt lgkmcnt(0)" ::: "memory"); \
    for (int d = 0; d < 4; ++d) for (int r = 0; r < 16; ++r) o[d][r] *= al_l[crow(r, hi)]; } } while (0)
  f32x16 p0, p1; float mn, al; bf16x8 pa0, pa1, pa2, pa3;
#pragma unroll
  for (int d0 = 0; d0 < 8; ++d0) asm volatile("" : "+v"(qr[d0]));
  DMA_TILE(0, 0);
  int sb = 0;
  for (int j = 0; j < NT; ++j) {
    asm volatile("s_waitcnt vmcnt(0)" ::: "memory"); __builtin_amdgcn_s_barrier(); asm volatile("" ::: "memory");
    if (j + 1 < NT) DMA_TILE(j + 1, sb ^ 32768);
    qkt_pipe(p0, p1, (const bf16*)(lds + sb), qr, r32, hi);
    if (j >= NCT) band_mask(p0, p1, qi - (lo + 64 * (j - NCT)), hi);
    partialSM(p0, p1, m_reg, mn, al); RESC4(al); finishSM(p0, p1, al, l_reg, pa0, pa1, pa2, pa3); SBAR();
    pv_d0(o, vb0 + sb, pa0, pa1, pa2, pa3);
    sb ^= 32768;
  }
  l_reg += __builtin_amdgcn_exp2f(sinkl2 - m_reg * (SCALE * 1.4426950408889634f));
  if (hi == 0) li_l[r32] = l_reg; asm volatile("s_waitcnt lgkmcnt(0)" ::: "memory");
  float rli[16];
#pragma unroll
  for (int r = 0; r < 16; ++r) rli[r] = __builtin_amdgcn_rcpf(li_l[crow(r, hi)]);
  bf16* Ow = Ob + (long)(rh * QBLK) * LDO + g * 128;
  const bf16* Zw = Zb + (long)(rh * QBLK) * LDQ + g * 128;
  bf16 zz[16][4];
#pragma unroll
  for (int r = 0; r < 16; ++r)
#pragma unroll
    for (int d0 = 0; d0 < 4; ++d0) zz[r][d0] = Zw[(long)crow(r, hi) * LDQ + d0 * 32 + r32];
#pragma unroll
  for (int r = 0; r < 16; ++r) { int orow = crow(r, hi);
#pragma unroll
    for (int d0 = 0; d0 < 4; ++d0) { const float z = __builtin_bit_cast(float, (unsigned)zz[r][d0] << 16);
      const float v = o[d0][r] * rli[r] * (z * __builtin_amdgcn_rcpf(1.f + __builtin_amdgcn_exp2f(z * -1.4426950408889634f))); const unsigned u = __builtin_bit_cast(unsigned, v);
      Ow[(long)orow * LDO + d0 * 32 + r32] = (bf16)((u + 0x7fffu + ((u >> 16) & 1u)) >> 16); } }
#undef TROWA
#undef DMA_TILE
#undef RESC4
}
}

constexpr size_t MiB = 1u << 20;
constexpr size_t SLOT = (size_t)MROWS * DM * 2;
constexpr size_t WS_MOD = 0;
constexpr size_t WS_BAR = 1 * MiB, WS_BAR_BYTES = 16384;
constexpr size_t WS_COS = 2 * MiB, WS_SIN = 4 * MiB;
constexpr size_t WS_CTX1 = 6 * MiB;
constexpr size_t WS_WINT = 16 * MiB;
constexpr size_t WS_WPT = WS_WINT + 68 * MiB;
constexpr size_t WS_PX = WS_WPT + 48 * MiB;
constexpr size_t WS_S0 = WS_PX + (size_t)MROWS * INC * 2;
constexpr size_t WS_END = WS_S0 + 5 * SLOT;
static_assert(WS_END <= 4ull * DEPTH * DM * INC * 4, "workspace map exceeds the guaranteed 4x largest tensor");

constexpr int NWAVES = 8;
constexpr int LDS_BYTES = 149760;

#define GAS __attribute__((address_space(1)))
#define LAS __attribute__((address_space(3)))
typedef unsigned short bf16;
typedef unsigned v4u __attribute__((ext_vector_type(4)));
typedef unsigned v2u __attribute__((ext_vector_type(2)));
typedef float f32x4 __attribute__((ext_vector_type(4)));
#define LDS_WAIT() asm volatile("s_waitcnt lgkmcnt(0)" ::: "memory")
__device__ __forceinline__ unsigned f2bf(float f) { unsigned u = __builtin_bit_cast(unsigned, f); return (u + 0x7fffu + ((u >> 16) & 1u)) >> 16; }
__device__ __forceinline__ unsigned pk2(float lo, float hi) { return f2bf(lo) | (f2bf(hi) << 16); }
__device__ __forceinline__ float bflo(unsigned w) { return __builtin_bit_cast(float, w << 16); }
__device__ __forceinline__ float bfhi(unsigned w) { return __builtin_bit_cast(float, w & 0xffff0000u); }
__device__ __forceinline__ float siluf(float x) { return x * __builtin_amdgcn_rcpf(1.f + __builtin_amdgcn_exp2f(x * -1.4426950408889634f)); }
__device__ __forceinline__ float sigmf(float x) { return __builtin_amdgcn_rcpf(1.f + __builtin_amdgcn_exp2f(x * -1.4426950408889634f)); }

struct Frame {
    LAS unsigned char* lds;
    int vcu, G;
    const float *x, *c, *ctx, *c_ctx, *w_ada, *b_ada, *g_pre, *g_post, *w_in, *sink, *lam_qk, *g_subln, *w_pa, *w_pb, *w_out;
    float* out; unsigned char* ws;
};

#define XB_TMO      128
#define XB_XCNT(j)  (256  + 64 * (j))
#define XB_XSUB(j)  (1280 + 64 * (j))
#define XB_XGEN(j)  (2304 + 64 * (j))
#define XB_TOP      3328
#define XB_TOPGEN   3392
#define XCD_BAR_WORDS 3456
#define XB_SPIN_CAP (1u << 18)

__device__ __forceinline__ unsigned xb_ld(unsigned* p)              { return __hip_atomic_load(p, __ATOMIC_RELAXED, __HIP_MEMORY_SCOPE_AGENT); }
__device__ __forceinline__ unsigned xb_add(unsigned* p, unsigned v) { return __hip_atomic_fetch_add(p, v, __ATOMIC_RELAXED, __HIP_MEMORY_SCOPE_AGENT); }
__device__ __forceinline__ unsigned xb_xcc_id() { return (unsigned)__builtin_amdgcn_s_getreg((3 << 11) | 20) & 0xFu; }
#define XB_SPIN(cond, bar) do { unsigned _sp = 0; while (cond) { __builtin_amdgcn_s_sleep(1); \
    if ((++_sp & 255u) == 0u) { if (xb_ld(&(bar)[XB_TMO])) break; if (_sp > XB_SPIN_CAP) { atomicAdd(&(bar)[XB_TMO], 1u); break; } } } } while (0)

struct XcdBarrier {
    unsigned* bar; unsigned x;
    volatile LAS unsigned* st;
};

__device__ __forceinline__ XcdBarrier xcd_barrier_post(unsigned* bar, volatile LAS unsigned* st) {
    XcdBarrier b; b.bar = bar; b.x = xb_xcc_id(); b.st = st;
    if (threadIdx.x == 0) (void)xb_add(&bar[XB_XCNT(b.x)], 1u);
    return b;
}
__device__ __forceinline__ void xcd_barrier_complete(unsigned* bar, unsigned x, unsigned& nloc, unsigned& nx) {
    const unsigned G = gridDim.x * gridDim.y * gridDim.z;
    unsigned sum, cnt, mine, sp = 0u;
    for (;;) {
        sum = 0u; cnt = 0u; mine = 0u;
#pragma unroll
        for (unsigned j = 0; j < 16; ++j) { const unsigned c = xb_ld(&bar[XB_XCNT(j)]); sum += c; cnt += (c > 0u) ? 1u : 0u; mine = (j == x) ? c : mine; }
        if (sum == G) break;
        __builtin_amdgcn_s_sleep(1);
        if ((++sp & 255u) == 0u) { if (xb_ld(&bar[XB_TMO])) break; if (sp > XB_SPIN_CAP) { atomicAdd(&bar[XB_TMO], 1u); break; } }
    }
    nloc = mine > 0u ? mine : 1u; nx = cnt > 0u ? cnt : 1u;
}

__device__ __forceinline__ void xcd_barrier(const XcdBarrier& b) {
    asm volatile("s_waitcnt vmcnt(0)" ::: "memory");
    __syncthreads();
    if (threadIdx.x == 0) {
        unsigned* bar = b.bar;
        __builtin_amdgcn_s_waitcnt(0);
        unsigned nloc = b.st[0], nx = b.st[1];
        if (nloc == 0u) { xcd_barrier_complete(bar, b.x, nloc, nx); b.st[0] = nloc; b.st[1] = nx; }
        const unsigned old = xb_add(&bar[XB_XSUB(b.x)], 1u);
        const unsigned gen = old / nloc;
        if (old + 1u == (gen + 1u) * nloc) {
            __builtin_amdgcn_fence(__ATOMIC_RELEASE, "agent");
            asm volatile("s_waitcnt vmcnt(0)" ::: "memory");
            const unsigned og = xb_add(&bar[XB_TOP], 1u);
            const unsigned tg = og / nx;
            if (og + 1u == (tg + 1u) * nx) xb_add(&bar[XB_TOPGEN], 1u);
            else XB_SPIN(xb_ld(&bar[XB_TOPGEN]) == tg, bar);
            __builtin_amdgcn_fence(__ATOMIC_ACQUIRE, "agent");
            xb_add(&bar[XB_XGEN(b.x)], 1u);
            asm volatile("s_waitcnt vmcnt(0)" ::: "memory");
        } else {
            XB_SPIN(xb_ld(&bar[XB_XGEN(b.x)]) == gen, bar);
            __builtin_amdgcn_fence(__ATOMIC_ACQUIRE, "agent");
            asm volatile("s_waitcnt vmcnt(0)" ::: "memory");
        }
    }
    __syncthreads();
}

#define FRESH_IDS int tid_ = threadIdx.x; asm volatile("" : "+v"(tid_)); const int tid = tid_, lane = tid & 63, wave = __builtin_amdgcn_readfirstlane(tid >> 6); (void)lane; (void)wave;

template <int CTRL> __device__ __forceinline__ float dpp_mov(float v) { return __builtin_bit_cast(float, __builtin_amdgcn_update_dpp(0, __builtin_bit_cast(int, v), CTRL, 0xf, 0xf, true)); }
__device__ __forceinline__ float half_sum(float v) {
    v += dpp_mov<0xB1>(v); v += dpp_mov<0x4E>(v); v += dpp_mov<0x141>(v); v += dpp_mov<0x140>(v);
    { float a = v, b = v; asm volatile("s_nop 1\n\tv_permlane16_swap_b32 %0, %1" : "+v"(a), "+v"(b)); v = a + b; }
    return v;
}
__device__ __forceinline__ float wave_sum(float v) {
    v = half_sum(v);
    { float a = v, b = v; asm volatile("s_nop 1\n\tv_permlane32_swap_b32 %0, %1" : "+v"(a), "+v"(b)); v = a + b; }
    return v;
}
__device__ __forceinline__ void p0_transpose_item(const float* W, int K, int N, bf16* WT, int row_off, LAS float* scr, int item, int lane) {
    const int nblk = N / 32, kb = item / nblk, nb = item % nblk, k0 = 64 * kb, n0 = 32 * nb;
#pragma unroll
    for (int i = 0; i < 32; ++i) { const int kk = 2 * i + (lane >> 5); scr[kk * 33 + (lane & 31)] = W[(size_t)(k0 + kk) * N + n0 + (lane & 31)]; }
    LDS_WAIT(); asm volatile("" ::: "memory");
    const int c = lane & 7;
#pragma unroll
    for (int j = 0; j < 4; ++j) { const int n = (lane >> 3) + 8 * j; const LAS float* s = scr + (8 * c) * 33 + n;
        v4u o; o.x = pk2(s[0 * 33], s[1 * 33]); o.y = pk2(s[2 * 33], s[3 * 33]); o.z = pk2(s[4 * 33], s[5 * 33]); o.w = pk2(s[6 * 33], s[7 * 33]);
        *(GAS v4u*)(WT + (size_t)(row_off + n0 + n) * K + k0 + 8 * c) = o; }
    LDS_WAIT(); asm volatile("" ::: "memory");
}

#define GW_LOOP(var, n) for (int var = F.vcu * NWAVES + wave; var < (n); var += F.G * NWAVES)

__device__ __forceinline__ int win_row_off(int n0) {
    const int tile = n0 >> 8; const bool rope = tile < 2 || (tile >= 4 && tile < 12) || (tile >= 20 && tile < 28) || (tile >= 36 && tile < 44);
    if (!rope) return 0;
    const int w = n0 & 255, hsel = w >> 7, half = (w >> 6) & 1, i = w & 63;
    return (half * 128 + hsel * 64 + i) - w;
}
__device__ __forceinline__ void ph_prologue(Frame& F) {
    FRESH_IDS
    for (int ait = F.vcu; ait < 192; ait += F.G) {
        const int l = ait / 96, n0 = (ait % 96) * 64;
        LAS float* sv = (LAS float*)F.lds;
        LAS float* red = (LAS float*)(F.lds + 32768);
        for (int k = tid; k < DM; k += NWAVES * 64) { sv[k] = siluf(F.c[k]); sv[DM + k] = siluf(F.c[DM + k]); sv[2 * DM + k] = siluf(F.c_ctx[k]); }
        __syncthreads();
        const float* W = F.w_ada + (size_t)l * DM * 6144 + n0 + lane;
        float a0 = 0.f, a1 = 0.f, a2 = 0.f;
        const int kb = wave * 256;
#pragma unroll 32
        for (int k = 0; k < 256; ++k) { const float w = W[(size_t)(kb + k) * 6144]; a0 += sv[kb + k] * w; a1 += sv[DM + kb + k] * w; a2 += sv[2 * DM + kb + k] * w; }
        red[(wave * 3 + 0) * 64 + lane] = a0; red[(wave * 3 + 1) * 64 + lane] = a1; red[(wave * 3 + 2) * 64 + lane] = a2;
        __syncthreads();
        if (wave < 3) { float s = 0.f;
#pragma unroll
            for (int w = 0; w < 8; ++w) s += red[(w * 3 + wave) * 64 + lane];
            float* mod = (float*)(F.ws + WS_MOD);
            mod[(size_t)(l * 3 + wave) * 6144 + n0 + lane] = s + F.b_ada[(size_t)l * 6144 + n0 + lane]; }
        __syncthreads();
    }
    { float* ct = (float*)(F.ws + WS_COS); float* st = (float*)(F.ws + WS_SIN);
      for (int i = (F.vcu * NWAVES * 64) + tid; i < SEQ * 64; i += F.G * NWAVES * 64) {
          const int t = i >> 6, j = i & 63, f = j & 31; const float pos = (float)((j < 32) ? (t >> 6) : (t & 63));
          const float inv = expf(-(float)f * (9.210340371976184f / 32.f)); const float ang = pos * inv;
          ct[i] = cosf(ang); st[i] = sinf(ang); } }
    LAS float* scr = (LAS float*)(F.lds + wave * 16384);
    constexpr int I_IN = (DM / 64) * (INC / 32), I_P = (DM / 64) * (DM / 32);
    bf16* WinT = (bf16*)(F.ws + WS_WINT); bf16* WpT = (bf16*)(F.ws + WS_WPT);
    GW_LOOP(it, I_IN + 6 * I_P) {
        if (it < I_IN) { p0_transpose_item(F.w_in, DM, INC, WinT, win_row_off(32 * (it % (INC / 32))), scr, it, lane); continue; }
        const int r = it - I_IN, mi = r / I_P, ii = r % I_P, l = mi / 3, w = mi % 3;
        const float* W = (w == 0 ? F.w_pa : (w == 1 ? F.w_pb : F.w_out)) + (size_t)l * DM * DM;
        p0_transpose_item(W, DM, DM, WpT + (size_t)mi * DM * DM, 0, scr, ii, lane);
    }
}

__device__ __forceinline__ void ph_hnorm(Frame& F, int l, const float* xcur, const float* ctxcur) {
    FRESH_IDS
    bf16* H = (bf16*)(F.ws + WS_S0);
    const float* gp = F.g_pre + (size_t)l * DM;
    f32x4 g[8];
#pragma unroll
    for (int j = 0; j < 8; ++j) g[j] = ((const f32x4*)gp)[lane + 64 * j];
    GW_LOOP(row, MROWS) {
        const int b = row / RPB, rr = row % RPB; const float* src; int v;
        if (rr < CTX) { src = ctxcur + (size_t)(b * CTX + rr) * DM; v = 2; } else { src = xcur + (size_t)(b * SEQ + rr - CTX) * DM; v = b; }
        const float* md = (const float*)(F.ws + WS_MOD) + (size_t)(l * 3 + v) * 6144;
        f32x4 xv[8], sh[8], sc[8]; float s = 0.f;
#pragma unroll
        for (int j = 0; j < 8; ++j) xv[j] = ((const f32x4*)src)[lane + 64 * j];
#pragma unroll
        for (int j = 0; j < 8; ++j) { sh[j] = ((const f32x4*)md)[lane + 64 * j]; sc[j] = ((const f32x4*)(md + DM))[lane + 64 * j]; }
#pragma unroll
        for (int j = 0; j < 8; ++j) s += (xv[j].x * xv[j].x + xv[j].y * xv[j].y) + (xv[j].z * xv[j].z + xv[j].w * xv[j].w);
        const float rs = rsqrtf(wave_sum(s) * (1.f / DM) + EPS);
#pragma unroll
        for (int j = 0; j < 8; ++j) { const int q = lane + 64 * j;
            const f32x4 y = (xv[j] * rs) * g[j] * (sc[j] + 1.f) + sh[j];
            v2u o; o.x = pk2(y.x, y.y); o.y = pk2(y.z, y.w);
            *(v2u*)(H + (size_t)row * DM + 4 * q) = o; }
    }
}

__device__ __forceinline__ void ph_rope(Frame& F) {
    FRESH_IDS
    bf16* PX = (bf16*)(F.ws + WS_PX);
    const float* ct = (const float*)(F.ws + WS_COS); const float* st = (const float*)(F.ws + WS_SIN);
    const unsigned total = (unsigned)NB * SEQ * 52 * 8;
    for (unsigned idx = (unsigned)(F.vcu * NWAVES * 64 + tid); idx < total; idx += (unsigned)(F.G * NWAVES * 64)) {
        const unsigned ch = idx & 7, hr = idx >> 3, hh = hr % 52, rowL = hr / 52, b = rowL / SEQ, t = rowL % SEQ;
        const int col = (hh < 4) ? (C_KA + hh * 128) : (hh < 20) ? (C_KB + (hh - 4) * 128) : (hh < 36) ? (C_QA + (hh - 20) * 128) : (C_QB + (hh - 36) * 128);
        bf16* p = PX + (size_t)(b * RPB + CTX + t) * INC + col + ch * 8;
        const v4u x1 = *(const v4u*)p, x2 = *(const v4u*)(p + 64);
        const f32x4 c0 = *(const f32x4*)(ct + t * 64 + ch * 8), c1 = *(const f32x4*)(ct + t * 64 + ch * 8 + 4);
        const f32x4 s0 = *(const f32x4*)(st + t * 64 + ch * 8), s1 = *(const f32x4*)(st + t * 64 + ch * 8 + 4);
        v4u y1, y2;
#define ROPE2(W, CA, SA, CB, SB) { const float a0 = bflo(x1.W), a1 = bfhi(x1.W), b0 = bflo(x2.W), b1 = bfhi(x2.W); \
            y1.W = pk2(a0 * CA - b0 * SA, a1 * CB - b1 * SB); y2.W = pk2(b0 * CA + a0 * SA, b1 * CB + a1 * SB); }
        ROPE2(x, c0.x, s0.x, c0.y, s0.y) ROPE2(y, c0.z, s0.z, c0.w, s0.w) ROPE2(z, c1.x, s1.x, c1.y, s1.y) ROPE2(w, c1.z, s1.z, c1.w, s1.w)
#undef ROPE2
        *(v4u*)p = y1; *(v4u*)(p + 64) = y2;
    }
}

__device__ __forceinline__ void ph_convert_win(Frame& F, int l) {
    FRESH_IDS
    LAS float* scr = (LAS float*)(F.lds + wave * 16384);
    constexpr int I_IN = (DM / 64) * (INC / 32);
    bf16* WinT = (bf16*)(F.ws + WS_WINT);
    GW_LOOP(it, I_IN) p0_transpose_item(F.w_in + (size_t)l * DM * INC, DM, INC, WinT, win_row_off(32 * (it % (INC / 32))), scr, it, lane);
}

__device__ __forceinline__ void ph_attn(Frame& F, int l, char* lds) {
    const att::bf16* PX = (const att::bf16*)(F.ws + WS_PX);
    att::bf16* GAo = (att::bf16*)(F.ws + WS_S0 + 3 * SLOT);
    att::bf16* OB0 = (att::bf16*)(F.ws + WS_S0 + SLOT);
    const float NINF = -INFINITY;
    const int nB = 1024, nA = 1024, nC = (l == 0) ? 64 : 0;
    for (int u = F.vcu; u < nB + nA + nC; u += F.G) {
        if (u < nB) {
            const int hd = u >> 5, qb = u & 31, b = hd >> 4, h8 = (hd >> 1) & 7, m = hd & 1;
            const size_t qrow = (size_t)b * RPB + CTX + qb * 256, krow = (size_t)b * RPB;
            att::attn_body_v256(PX + qrow * INC + C_QB + (h8 * 2 + m) * 128, PX + krow * INC + C_KB + (h8 * 2 + m) * 128, PX + krow * INC + C_VB + h8 * 256,
                                OB0 + (size_t)m * (SLOT / 2) + qrow * DM + h8 * 256, RPB / 64, F.lds);
            __syncthreads();
        } else if (u < nB + nA) {
            const int v = u - nB, b = v >> 9, kvh = (v >> 7) & 3, qb = v & 127, q0 = qb * 64;
            const int lo = (q0 - 128 > 0) ? q0 - 128 : 0, he = (q0 + 192 < SEQ) ? q0 + 192 : SEQ, nloc = (he - lo) >> 6;
            const size_t qrow = (size_t)b * RPB + CTX + q0, krow = (size_t)b * RPB;
            att::attn_body_a(PX + qrow * INC + C_QA + kvh * 512, PX + krow * INC + C_KA + kvh * 128, PX + krow * INC + C_VA + kvh * 128,
                             GAo + qrow * DM + kvh * 512, 4 + nloc, 4, lo, q0, F.sink + l * 16 + kvh * 4, PX + qrow * INC + C_ZA + kvh * 512, F.lds);
            __syncthreads();
        } else {
            const int v = u - nB - nA;
            if (v < 32) {
                const int hd = v, b = hd >> 4, h8 = (hd >> 1) & 7, m = hd & 1; const size_t krow = (size_t)b * RPB;
                att::attn_body_v256(PX + krow * INC + C_QB + (h8 * 2 + m) * 128, PX + krow * INC + C_KB + (h8 * 2 + m) * 128, PX + krow * INC + C_VB + h8 * 256,
                                    OB0 + (size_t)m * (SLOT / 2) + krow * DM + h8 * 256, 4, F.lds);
                __syncthreads();
            } else {
                const int w = v - 32, b = w >> 4, kvh = (w >> 2) & 3, cb = w & 3; const size_t krow = (size_t)b * RPB, qrow = krow + cb * 64;
                att::attn_body_a(PX + qrow * INC + C_QA + kvh * 512, PX + krow * INC + C_KA + kvh * 128, PX + krow * INC + C_VA + kvh * 128,
                                 GAo + qrow * DM + kvh * 512, 4, 4, 0, 0, F.sink + l * 16 + kvh * 4, PX + qrow * INC + C_ZA + kvh * 512, F.lds);
                __syncthreads();
            }
        }
    }
}

__device__ __forceinline__ void ph_post(Frame& F, int l) {
    FRESH_IDS
    const bf16* PX = (const bf16*)(F.ws + WS_PX);
    const bf16* OB0 = (const bf16*)(F.ws + WS_S0 + SLOT); const bf16* OB1 = (const bf16*)(F.ws + WS_S0 + 2 * SLOT);
    bf16* GB = (bf16*)(F.ws + WS_S0 + 4 * SLOT);
    const float lam_init = 0.8f - 0.6f * expf(-0.3f * (float)l);
    const float* lq = F.lam_qk + (size_t)l * 512;
    const float d1 = wave_sum(lq[lane] * lq[128 + lane] + lq[64 + lane] * lq[192 + lane]);
    const float d2 = wave_sum(lq[256 + lane] * lq[384 + lane] + lq[320 + lane] * lq[448 + lane]);
    const float lam = expf(d1) - expf(d2) + lam_init;
    const f32x4 gs0 = ((const f32x4*)(F.g_subln + (size_t)l * 256))[2 * (lane & 31)] * (1.f - lam_init), gs1 = ((const f32x4*)(F.g_subln + (size_t)l * 256))[2 * (lane & 31) + 1] * (1.f - lam_init);
    GW_LOOP(row, MROWS) {
        if (l != 0 && (row % RPB) < CTX) continue;
        const size_t ro = (size_t)row * DM + 8 * lane, rp = (size_t)row * INC + 8 * lane;
        v4u o0[4], o1[4], zb[4];
#pragma unroll
        for (int j = 0; j < 4; ++j) {
            o0[j] = *(const v4u*)(OB0 + ro + 512 * j); o1[j] = *(const v4u*)(OB1 + ro + 512 * j); zb[j] = *(const v4u*)(PX + rp + C_ZB + 512 * j); }
#pragma unroll
        for (int j = 0; j < 4; ++j) {
            f32x4 da, db;
            da.x = bflo(o0[j].x) - lam * bflo(o1[j].x); da.y = bfhi(o0[j].x) - lam * bfhi(o1[j].x); da.z = bflo(o0[j].y) - lam * bflo(o1[j].y); da.w = bfhi(o0[j].y) - lam * bfhi(o1[j].y);
            db.x = bflo(o0[j].z) - lam * bflo(o1[j].z); db.y = bfhi(o0[j].z) - lam * bfhi(o1[j].z); db.z = bflo(o0[j].w) - lam * bflo(o1[j].w); db.w = bfhi(o0[j].w) - lam * bfhi(o1[j].w);
            float ss = ((da.x * da.x + da.y * da.y) + (da.z * da.z + da.w * da.w)) + ((db.x * db.x + db.y * db.y) + (db.z * db.z + db.w * db.w));
            ss = half_sum(ss);
            const float rs = rsqrtf(ss * (1.f / 256.f) + EPS);
            const f32x4 ya = da * rs * gs0, yb = db * rs * gs1;
            v4u o; o.x = pk2(ya.x * siluf(bflo(zb[j].x)), ya.y * siluf(bfhi(zb[j].x))); o.y = pk2(ya.z * siluf(bflo(zb[j].y)), ya.w * siluf(bfhi(zb[j].y)));
            o.z = pk2(yb.x * siluf(bflo(zb[j].z)), yb.y * siluf(bfhi(zb[j].z))); o.w = pk2(yb.z * siluf(bflo(zb[j].w)), yb.w * siluf(bfhi(zb[j].w)));
            *(v4u*)(GB + ro + 512 * j) = o; }
    }
}

__device__ __forceinline__ void ph_merge(Frame& F, int l) {
    FRESH_IDS
    const bf16* PX = (const bf16*)(F.ws + WS_PX);
    const bf16* YA = (const bf16*)(F.ws + WS_S0); const bf16* YB = (const bf16*)(F.ws + WS_S0 + SLOT); bf16* MG = (bf16*)(F.ws + WS_S0 + 2 * SLOT);
    const unsigned total = (unsigned)MROWS * (DM / 8);
    for (unsigned i = (unsigned)(F.vcu * NWAVES * 64 + tid); i < total; i += (unsigned)(F.G * NWAVES * 64)) {
        const unsigned row = i >> 8, c = (i & 255) * 8;
        if (l != 0 && (row % RPB) < CTX) continue;
        const v4u ya = *(const v4u*)(YA + (size_t)row * DM + c), yb = *(const v4u*)(YB + (size_t)row * DM + c);
        const v4u ga = *(const v4u*)(PX + (size_t)row * INC + C_GA + c), gb = *(const v4u*)(PX + (size_t)row * INC + C_GB + c);
        v4u o;
#define MRG(W) o.W = pk2(sigmf(bflo(ga.W)) * bflo(ya.W) + sigmf(bflo(gb.W)) * bflo(yb.W), sigmf(bfhi(ga.W)) * bfhi(ya.W) + sigmf(bfhi(gb.W)) * bfhi(yb.W));
        MRG(x) MRG(y) MRG(z) MRG(w)
#undef MRG
        *(v4u*)(MG + (size_t)row * DM + c) = o;
    }
}

__device__ __forceinline__ void ph_res(Frame& F, int l, const float* xcur, const float* ctxcur) {
    FRESH_IDS
    const bf16* OX = (const bf16*)(F.ws + WS_S0 + 3 * SLOT);
    bf16* H = (bf16*)(F.ws + WS_S0);
    const bool nxt = (l + 1 < DEPTH);
    f32x4 gq[8], gn[8];
#pragma unroll
    for (int j = 0; j < 8; ++j) { gq[j] = ((const f32x4*)(F.g_post + (size_t)l * DM))[lane + 64 * j]; gn[j] = nxt ? ((const f32x4*)(F.g_pre + (size_t)(l + 1) * DM))[lane + 64 * j] : (f32x4){0.f, 0.f, 0.f, 0.f}; }
    GW_LOOP(row, MROWS) {
        const int b = row / RPB, rr = row % RPB; const float* src; float* dst; int v;
        if (rr < CTX) { if (!nxt) continue; src = ctxcur + (size_t)(b * CTX + rr) * DM; dst = nullptr; v = 2; }
        else { src = xcur + (size_t)(b * SEQ + rr - CTX) * DM; dst = F.out + (size_t)(b * SEQ + rr - CTX) * DM; v = b; }
        const float* gt = (const float*)(F.ws + WS_MOD) + (size_t)(l * 3 + v) * 6144 + 2 * DM;
        const float* md = (const float*)(F.ws + WS_MOD) + (size_t)((nxt ? l + 1 : l) * 3 + v) * 6144;
        v2u ow[8]; f32x4 xr[8], gate[8], sh[8], sc[8]; f32x4 ov[8]; float s = 0.f;
#pragma unroll
        for (int j = 0; j < 8; ++j) { ow[j] = *(const v2u*)(OX + (size_t)row * DM + 4 * (lane + 64 * j)); xr[j] = ((const f32x4*)src)[lane + 64 * j]; }
#pragma unroll
        for (int j = 0; j < 8; ++j) { gate[j] = ((const f32x4*)gt)[lane + 64 * j]; if (nxt) { sh[j] = ((const f32x4*)md)[lane + 64 * j]; sc[j] = ((const f32x4*)(md + DM))[lane + 64 * j]; } }
#pragma unroll
        for (int j = 0; j < 8; ++j) { ov[j] = (f32x4){bflo(ow[j].x), bfhi(ow[j].x), bflo(ow[j].y), bfhi(ow[j].y)}; s += (ov[j].x * ov[j].x + ov[j].y * ov[j].y) + (ov[j].z * ov[j].z + ov[j].w * ov[j].w); }
        const float rs = rsqrtf(wave_sum(s) * (1.f / DM) + EPS);
        float s2 = 0.f;
#pragma unroll
        for (int j = 0; j < 8; ++j) { const int q = lane + 64 * j;
            ov[j] = xr[j] + gate[j] * ((ov[j] * rs) * gq[j]);
            if (dst) ((f32x4*)dst)[q] = ov[j];
            s2 += (ov[j].x * ov[j].x + ov[j].y * ov[j].y) + (ov[j].z * ov[j].z + ov[j].w * ov[j].w); }
        if (nxt) {
            const float rs2 = rsqrtf(wave_sum(s2) * (1.f / DM) + EPS);
#pragma unroll
            for (int j = 0; j < 8; ++j) { const int q = lane + 64 * j;
                const f32x4 y = (ov[j] * rs2) * gn[j] * (sc[j] + 1.f) + sh[j];
                v2u o; o.x = pk2(y.x, y.y); o.y = pk2(y.z, y.w);
                *(v2u*)(H + (size_t)row * DM + 4 * q) = o; }
        }
    }
}

typedef short sg_bf16x8 __attribute__((ext_vector_type(8)));
template <bool DUAL>
__device__ __forceinline__ void small_ctx_gemm(Frame& F, const bf16* A0, const bf16* W0, const bf16* A1, const bf16* W1, const bf16* PXg, bf16* O) {
    FRESH_IDS
    const int fr = lane & 15, fq = lane >> 4, wc = wave & 3, wr = wave >> 2;
    for (int t = F.vcu; t < 8 * 32; t += F.G) {
        const int tr = t >> 5, tc = t & 31;
        const int c0 = tr * 64 + wr * 32, b = c0 >> 8;
        const size_t row0 = (size_t)b * RPB + (c0 & 255);
        const int col0 = tc * 64 + wc * 16;
        f32x4 acc[2][2] = {};
#pragma unroll
        for (int gsel = 0; gsel < (DUAL ? 2 : 1); ++gsel) {
            const bf16* Ap = (gsel ? A1 : A0) + (row0 + fr) * DM + 8 * fq;
            const bf16* Bp = (gsel ? W1 : W0) + (size_t)(col0 + fr) * DM + 8 * fq;
#pragma unroll 8
            for (int k = 0; k < DM; k += 32) {
                const sg_bf16x8 a0 = *(const sg_bf16x8*)(Ap + k), a1 = *(const sg_bf16x8*)(Ap + 16 * DM + k), bb = *(const sg_bf16x8*)(Bp + k);
                acc[gsel][0] = __builtin_amdgcn_mfma_f32_16x16x32_bf16(bb, a0, acc[gsel][0], 0, 0, 0);
                acc[gsel][1] = __builtin_amdgcn_mfma_f32_16x16x32_bf16(bb, a1, acc[gsel][1], 0, 0, 0);
            }
        }
#pragma unroll
        for (int rb = 0; rb < 2; ++rb) { const size_t row = row0 + rb * 16 + fr; const int col = col0 + 4 * fq;
            f32x4 v = acc[0][rb];
            if (DUAL) { const v2u ga = *(const v2u*)(PXg + row * INC + C_GA + col), gb = *(const v2u*)(PXg + row * INC + C_GB + col); const f32x4 w = acc[1][rb];
                v.x = sigmf(bflo(ga.x)) * v.x + sigmf(bflo(gb.x)) * w.x; v.y = sigmf(bfhi(ga.x)) * v.y + sigmf(bfhi(gb.x)) * w.y;
                v.z = sigmf(bflo(ga.y)) * v.z + sigmf(bflo(gb.y)) * w.z; v.w = sigmf(bfhi(ga.y)) * v.w + sigmf(bfhi(gb.y)) * w.w; }
            v2u o; o.x = pk2(v.x, v.y); o.y = pk2(v.z, v.w);
            *(v2u*)(O + row * DM + col) = o; }
    }
}

__device__ __forceinline__ void run_gemm_in(Frame& F, const bf16* A, const bf16* Bt, bf16* O) {
    pg8::Gemm g{A, Bt, MROWS, INC, DM}; pg8::RowSkipOrder S; S.init(INC, F.G, (int)blockIdx.x, false);
    pg8::EpiRope E{O, INC, (const float*)(F.ws + WS_COS), (const float*)(F.ws + WS_SIN)};
    pg8::gemm_phase<pg8::EpiRope, pg8::RowSkipOrder, true, true>(F.lds, g, S, E);
}
__device__ __forceinline__ void run_gemm_skip(Frame& F, const bf16* A, const bf16* Bt, bf16* O, bool skip) {
    pg8::Gemm g{A, Bt, MROWS, DM, DM}; pg8::RowSkipOrder S; S.init(DM, F.G, (int)blockIdx.x, skip);
    pg8::EpiBf16 E{O, DM};
    pg8::gemm_phase<pg8::EpiBf16, pg8::RowSkipOrder, true, true>(F.lds, g, S, E);
}
template <bool ADD>
__device__ __forceinline__ void run_gemm_gate(Frame& F, const bf16* A, const bf16* Bt, bf16* O, const bf16* T, const bf16* G, bool skip) {
    pg8::Gemm g{A, Bt, MROWS, DM, DM}; pg8::RowSkipOrder S; S.init(DM, F.G, (int)blockIdx.x, skip);
    pg8::EpiGate<ADD> E{O, T, G, DM, INC};
    pg8::gemm_phase<pg8::EpiGate<ADD>, pg8::RowSkipOrder, true, true>(F.lds, g, S, E);
}

struct Args { const float* in[15]; float* out; unsigned char* ws; };
__global__ void __launch_bounds__(NWAVES * 64, 2) fwd_mega(Args args) {
    extern __shared__ __attribute__((aligned(16))) unsigned char lds[];
    cg::grid_group grid = cg::this_grid();
    Frame F;
    F.lds = (LAS unsigned char*)lds;
    F.G = gridDim.x; { const int bx = blockIdx.x; F.vcu = (F.G % 8 == 0) ? (bx % 8) * (F.G / 8) + bx / 8 : bx; }
    F.x = args.in[0]; F.c = args.in[1]; F.ctx = args.in[2]; F.c_ctx = args.in[3]; F.w_ada = args.in[4]; F.b_ada = args.in[5]; F.g_pre = args.in[6]; F.g_post = args.in[7];
    F.w_in = args.in[8]; F.sink = args.in[9]; F.lam_qk = args.in[10]; F.g_subln = args.in[11]; F.w_pa = args.in[12]; F.w_pb = args.in[13]; F.w_out = args.in[14];
    F.out = args.out; F.ws = args.ws;
    volatile LAS unsigned* MISC = (volatile LAS unsigned*)(F.lds + 149504);
    if (threadIdx.x < 32) MISC[threadIdx.x] = 0u;
    __syncthreads();
    const XcdBarrier bar = xcd_barrier_post((unsigned*)(F.ws + WS_BAR), MISC + 8);
    bf16* WinT = (bf16*)(F.ws + WS_WINT); bf16* WpT = (bf16*)(F.ws + WS_WPT); bf16* PX = (bf16*)(F.ws + WS_PX);
    bf16* S0 = (bf16*)(F.ws + WS_S0); bf16* S1 = (bf16*)(F.ws + WS_S0 + SLOT); bf16* S2 = (bf16*)(F.ws + WS_S0 + 2 * SLOT); bf16* S3 = (bf16*)(F.ws + WS_S0 + 3 * SLOT); bf16* S4 = (bf16*)(F.ws + WS_S0 + 4 * SLOT);

    ph_prologue(F);
    grid.sync();
#pragma unroll 1
    for (int l = 0; l < DEPTH; ++l) {
        const float* xcur = (l == 0) ? F.x : F.out;
        const float* ctxcur = (l == 0) ? F.ctx : (const float*)(F.ws + WS_CTX1);
        if (l == 0) { ph_hnorm(F, l, xcur, ctxcur); xcd_barrier(bar); }
        run_gemm_in(F, S0, WinT, PX);
        xcd_barrier(bar);
        ph_attn(F, l, (char*)lds);
        xcd_barrier(bar);
        ph_post(F, l);
        if (l + 1 < DEPTH) ph_convert_win(F, l + 1);
        xcd_barrier(bar);
        run_gemm_gate<false>(F, S3, WpT + (size_t)(l * 3 + 0) * DM * DM, S0, S0, PX + C_GA, true);
        run_gemm_gate<true>(F, S4, WpT + (size_t)(l * 3 + 1) * DM * DM, S2, S0, PX + C_GB, true);
        if (l + 1 < DEPTH) small_ctx_gemm<true>(F, S3, WpT + (size_t)(l * 3 + 0) * DM * DM, S4, WpT + (size_t)(l * 3 + 1) * DM * DM, PX, S2);
        xcd_barrier(bar);
        run_gemm_skip(F, S2, WpT + (size_t)(l * 3 + 2) * DM * DM, S3, true);
        if (l + 1 < DEPTH) small_ctx_gemm<false>(F, S2, WpT + (size_t)(l * 3 + 2) * DM * DM, nullptr, nullptr, PX, S3);
        xcd_barrier(bar);
        ph_res(F, l, xcur, ctxcur);
        if (l + 1 < DEPTH) xcd_barrier(bar);
    }
}

extern "C" void kernel_launch(void* const* d_in, const int* in_sizes, int n_in, void* d_out, int out_size, void* d_ws, size_t ws_size, hipStream_t stream) {
    static int grid = 0;
    if (grid == 0) {
        if (n_in != 15 || out_size != NB * SEQ * DM || ws_size < WS_END) { fprintf(stderr, "kernel_launch: unexpected shapes: n_in %d out %d ws %zu (need %zu)\n", n_in, out_size, ws_size, (size_t)WS_END); grid = -1; return; }
        int dev = 0, cus = 0, per_cu = 0;
        if (hipGetDevice(&dev) != hipSuccess || hipDeviceGetAttribute(&cus, hipDeviceAttributeMultiprocessorCount, dev) != hipSuccess) { grid = -1; return; }
        if (hipFuncSetAttribute((const void*)fwd_mega, hipFuncAttributeMaxDynamicSharedMemorySize, LDS_BYTES) != hipSuccess) { fprintf(stderr, "kernel_launch: hipFuncSetAttribute failed\n"); grid = -1; return; }
        if (hipOccupancyMaxActiveBlocksPerMultiprocessor(&per_cu, (const void*)fwd_mega, NWAVES * 64, LDS_BYTES) != hipSuccess || per_cu < 1) { fprintf(stderr, "kernel_launch: occupancy query says %d\n", per_cu); per_cu = 1; }
        (void)hipGetLastError();
        grid = cus * per_cu;
    }
    if (grid < 0) return;
    if (hipMemsetAsync((char*)d_ws + WS_BAR, 0, WS_BAR_BYTES, stream) != hipSuccess) { fprintf(stderr, "kernel_launch: memset of the barrier words failed\n"); return; }
    Args a{};
    for (int i = 0; i < 15; ++i) a.in[i] = (const float*)d_in[i];
    a.out = (float*)d_out; a.ws = (unsigned char*)d_ws;
    void* kargs[] = {&a};
    hipError_t e = hipLaunchCooperativeKernel((const void*)fwd_mega, dim3(grid), dim3(NWAVES * 64), kargs, LDS_BYTES, stream);
    if (e != hipSuccess) fprintf(stderr, "kernel_launch: cooperative launch failed: %s (grid %d)\n", hipGetErrorString(e), grid);
}
```
